# Optimizing an MI355X kernel written in HIP

```python
import jax, jax.numpy as jnp
from jax import lax
import numpy as np

D_MODEL = 2048
BATCH = 8
SEQ = 2048
DEPTH = 2

N_EVEN = (DEPTH + 1) // 2
N_ODD = DEPTH // 2
EPS = 1e-6
D_PLE = 256
D_HGRN = D_MODEL // 2
HGRN_HEADS = 8
HGRN_HEAD_DIM = D_HGRN // HGRN_HEADS
CHUNK = 64
D_CONV = D_MODEL // 2
CONV_WIDTH = 3
D_IN_PROJ = 4 * D_HGRN + 3 * D_CONV
POOL_WINDOWS = (2, 4, 8, 16)
N_POOL_GROUPS = len(POOL_WINDOWS)
POOL_GROUP_DIM = D_MODEL // N_POOL_GROUPS
D_FF = 5632
N_EXPERTS = 8
TOP_K = 2
D_FF_EXPERT = 1024

kernel_name = 'hybrid_hgrn2_shortconv_pool_moe_trunk'


def rms_norm(x, gain):
    x32 = x.astype(jnp.float32)
    y = x32 * lax.rsqrt(jnp.mean(x32 * x32, axis=-1, keepdims=True) + EPS)
    return (y * gain.astype(jnp.float32)).astype(x.dtype)


def hgrn2_chunked(q, k, v, log_f):
    b_, s_, h_, dk = q.shape
    dv = v.shape[-1]
    n_chunks = s_ // CHUNK

    def to_chunks(t):
        return t.reshape(b_, n_chunks, CHUNK, h_, t.shape[-1]).transpose(0, 3, 1, 2, 4)

    q, k, v, log_f = to_chunks(q), to_chunks(k), to_chunks(v), to_chunks(log_f)
    cum = jnp.cumsum(log_f, axis=3)
    ref = cum[:, :, :, CHUNK // 2:CHUNK // 2 + 1, :]
    last = cum[:, :, :, -1:, :]
    scores = jnp.einsum('bhncd,bhnsd->bhncs', q * jnp.exp(cum - ref), k * jnp.exp(ref - cum))
    causal = jnp.tril(jnp.ones((CHUNK, CHUNK), dtype=bool))
    scores = jnp.where(causal, scores, 0.0)
    o_intra = jnp.einsum('bhncs,bhnsv->bhncv', scores, v)
    kv = jnp.einsum('bhncd,bhncv->bhndv', k * jnp.exp(last - cum), v)
    decay = jnp.exp(last[:, :, :, 0, :])

    def step(state, inp):
        dec, kv_c = inp
        return dec[..., None] * state + kv_c, state

    s0 = jnp.zeros((b_, h_, dk, dv), jnp.float32)
    _, s_prev = lax.scan(step, s0, (jnp.moveaxis(decay, 2, 0), jnp.moveaxis(kv, 2, 0)))
    o_inter = jnp.einsum('bhncd,nbhdv->bhncv', q * jnp.exp(cum), s_prev)
    o = o_intra + o_inter
    return o.transpose(0, 2, 3, 1, 4).reshape(b_, s_, h_, dv)


def hgrn2_shortconv_mixer(h, w_in, lb, hgrn_gain, conv_w, w_out):
    b_, s_, _ = h.shape
    u = h @ w_in
    q, f_raw, i_val, g, gate_b, gate_c, v_conv = jnp.split(
        u, [D_HGRN, 2 * D_HGRN, 3 * D_HGRN, 4 * D_HGRN,
            4 * D_HGRN + D_CONV, 4 * D_HGRN + 2 * D_CONV], axis=-1)

    def heads(t):
        return t.reshape(b_, s_, HGRN_HEADS, HGRN_HEAD_DIM)

    f = lb + (1.0 - lb) * jax.nn.sigmoid(f_raw.astype(jnp.float32))
    o = hgrn2_chunked(heads(jax.nn.silu(q.astype(jnp.float32))), heads(1.0 - f),
                      heads(i_val.astype(jnp.float32)), heads(jnp.log(f)))
    o = o * lax.rsqrt(jnp.mean(o * o, axis=-1, keepdims=True) + EPS)
    o = o.reshape(b_, s_, D_HGRN) * hgrn_gain.astype(jnp.float32) * jax.nn.silu(g.astype(jnp.float32))
    a_out = o.astype(h.dtype)

    t = gate_c * v_conv
    padded = jnp.pad(t, ((0, 0), (CONV_WIDTH - 1, 0), (0, 0)))
    conv = sum(padded[:, j:j + s_] * conv_w[j] for j in range(CONV_WIDTH))
    b_out = gate_b * conv

    return jnp.concatenate([a_out, b_out], axis=-1) @ w_out


def pool_mixer(h, pool_w, pool_scale):
    b_, s_, _ = h.shape
    hg = h.astype(jnp.float32).reshape(b_, s_, N_POOL_GROUPS, POOL_GROUP_DIM)
    csum = jnp.cumsum(hg, axis=1)
    pos = jnp.arange(1, s_ + 1, dtype=jnp.float32)
    diffs = []
    for gi, w in enumerate(POOL_WINDOWS):
        c = csum[:, :, gi]
        prev = jnp.pad(c, ((0, 0), (w, 0), (0, 0)))[:, :s_]
        mean = (c - prev) / jnp.minimum(pos, float(w))[None, :, None]
        diffs.append(mean - hg[:, :, gi])
    d = jnp.stack(diffs, axis=2).astype(h.dtype)
    y = jnp.einsum('bsgc,gce->bsge', d, pool_w).reshape(b_, s_, D_MODEL)
    return y * pool_scale


def swiglu(h, w_gate, w_up, w_down):
    return (jax.nn.silu(h @ w_gate) * (h @ w_up)) @ w_down


def moe_swiglu(h, w_router, w_gate_e, w_up_e, w_down_e):
    logits = (h @ w_router).astype(jnp.float32)
    probs = jax.nn.softmax(logits, axis=-1)
    top_p, top_i = lax.top_k(probs, TOP_K)
    top_p = top_p / jnp.sum(top_p, axis=-1, keepdims=True)
    gates = jnp.sum(jax.nn.one_hot(top_i, N_EXPERTS, dtype=jnp.float32) * top_p[..., None], axis=-2)
    gates = gates.astype(h.dtype)
    y = jnp.zeros_like(h)
    for e in range(N_EXPERTS):
        y = y + gates[..., e:e + 1] * swiglu(h, w_gate_e[e], w_up_e[e], w_down_e[e])
    return y


def per_layer_embedding(x, p_i, norm_gain, w_gate, w_proj):
    gate = jax.nn.sigmoid(rms_norm(x, norm_gain) @ w_gate)
    return gate * (p_i @ w_proj)


def setup_inputs(seed: int = 0) -> dict:
    key = jax.random.key(seed)
    ks = jax.random.split(key, 32)
    f32 = jnp.float32

    def nrm(k, shape, fan_in):
        return jax.random.normal(k, shape, f32) * (fan_in ** -0.5)

    def gain(k, shape):
        return 1.0 + 0.02 * jax.random.normal(k, shape, f32)

    return {
        'x': jax.random.normal(ks[0], (BATCH, SEQ, D_MODEL), f32),
        'p': jax.random.normal(ks[1], (DEPTH, BATCH, SEQ, D_PLE), f32),
        'final_norm_gain': gain(ks[2], (D_MODEL,)),
        'lb_table': 1.0 + 0.1 * jax.random.normal(ks[3], (DEPTH + 1, D_HGRN), f32),
        'mix_norm_even': gain(ks[4], (N_EVEN, D_MODEL)),
        'w_in_even': nrm(ks[5], (N_EVEN, D_MODEL, D_IN_PROJ), D_MODEL),
        'hgrn_norm_gain': gain(ks[6], (N_EVEN, D_HGRN)),
        'conv_w': nrm(ks[7], (N_EVEN, CONV_WIDTH, D_CONV), CONV_WIDTH),
        'w_out_even': nrm(ks[8], (N_EVEN, D_MODEL, D_MODEL), D_MODEL),
        'ffn_norm_even': gain(ks[9], (N_EVEN, D_MODEL)),
        'w_gate_dense': nrm(ks[10], (N_EVEN, D_MODEL, D_FF), D_MODEL),
        'w_up_dense': nrm(ks[11], (N_EVEN, D_MODEL, D_FF), D_MODEL),
        'w_down_dense': nrm(ks[12], (N_EVEN, D_FF, D_MODEL), D_FF),
        'mix_norm_odd': gain(ks[13], (N_ODD, D_MODEL)),
        'pool_w': nrm(ks[14], (N_ODD, N_POOL_GROUPS, POOL_GROUP_DIM, POOL_GROUP_DIM), POOL_GROUP_DIM),
        'pool_scale': gain(ks[15], (N_ODD, D_MODEL)),
        'ffn_norm_odd': gain(ks[16], (N_ODD, D_MODEL)),
        'w_router': nrm(ks[17], (N_ODD, D_MODEL, N_EXPERTS), D_MODEL),
        'w_gate_exp': nrm(ks[18], (N_ODD, N_EXPERTS, D_MODEL, D_FF_EXPERT), D_MODEL),
        'w_up_exp': nrm(ks[19], (N_ODD, N_EXPERTS, D_MODEL, D_FF_EXPERT), D_MODEL),
        'w_down_exp': nrm(ks[20], (N_ODD, N_EXPERTS, D_FF_EXPERT, D_MODEL), D_FF_EXPERT),
        'ple_norm': gain(ks[21], (DEPTH, D_MODEL)),
        'ple_gate_w': nrm(ks[22], (DEPTH, D_MODEL, D_MODEL), D_MODEL),
        'ple_proj': nrm(ks[23], (DEPTH, D_PLE, D_MODEL), D_PLE),
    }


def reference(x, p, final_norm_gain, lb_table, mix_norm_even, w_in_even, hgrn_norm_gain,
              conv_w, w_out_even, ffn_norm_even, w_gate_dense, w_up_dense, w_down_dense,
              mix_norm_odd, pool_w, pool_scale, ffn_norm_odd, w_router, w_gate_exp,
              w_up_exp, w_down_exp, ple_norm, ple_gate_w, ple_proj):
    lb_all = jnp.cumsum(jax.nn.softmax(lb_table.astype(jnp.float32), axis=0), axis=0)
    for i in range(DEPTH):
        j = i // 2
        if i % 2 == 0:
            x = x + hgrn2_shortconv_mixer(rms_norm(x, mix_norm_even[j]), w_in_even[j], lb_all[i],
                                          hgrn_norm_gain[j], conv_w[j], w_out_even[j])
            x = x + swiglu(rms_norm(x, ffn_norm_even[j]), w_gate_dense[j], w_up_dense[j], w_down_dense[j])
        else:
            x = x + pool_mixer(rms_norm(x, mix_norm_odd[j]), pool_w[j], pool_scale[j])
            x = x + moe_swiglu(rms_norm(x, ffn_norm_odd[j]), w_router[j], w_gate_exp[j],
                               w_up_exp[j], w_down_exp[j])
        x = x + per_layer_embedding(x, p[i], ple_norm[i], ple_gate_w[i], ple_proj[i])
    return rms_norm(x, final_norm_gain)
```

```cpp
#include <hip/hip_runtime.h>
#include <cstdio>
#include <cstdint>

constexpr int DM = 2048, BATCH = 8, SEQ = 2048, M = BATCH * SEQ;
constexpr int DH = 1024, NH = 8, HD = 128, CHUNK = 64, DC = 1024, DFF = 5632, NE = 8, DFE = 1024, DPLE = 256;
constexpr int NIN = 7168;
constexpr int UP = 6144;
constexpr float EPS = 1e-6f;
constexpr int NWAVES = 8;

constexpr size_t MiB = 1u << 20;
constexpr size_t WS_CTL = 0, CTL_ZERO_BYTES = 256 * 1024;
constexpr size_t WS_LBV = 1 * MiB;
constexpr size_t WS_RS4 = 1 * MiB + 64 * 1024;
constexpr size_t WS_TOP = 1 * MiB + 192 * 1024;
constexpr size_t WS_TOPW = 1 * MiB + 320 * 1024;
constexpr size_t WS_SSPA = 2 * MiB, WS_SSPB = 4 * MiB;
constexpr size_t WS_LIST = 6 * MiB;
constexpr size_t WS_GWL = 7 * MiB;
constexpr size_t WS_TOKC = 8 * MiB;
constexpr int RCAP = 36864;
constexpr size_t WS_GWC = WS_TOKC + (size_t)RCAP * 4, WS_RSC = WS_GWC + (size_t)RCAP * 4;
constexpr size_t WS_WIN = 10 * MiB;
constexpr size_t WS_WOUT = 38 * MiB;
constexpr size_t WS_WGU = 46 * MiB;
constexpr size_t WS_WD = 90 * MiB;
constexpr size_t WS_WPOOL = 112 * MiB;
constexpr size_t WS_WMGU = 114 * MiB;
constexpr size_t WS_WMD = 178 * MiB;
constexpr size_t WS_WPG = 210 * MiB;
constexpr size_t WS_WPP = 226 * MiB;
constexpr size_t WS_PB = 228 * MiB;
constexpr size_t WS_XB = 244 * MiB;
constexpr size_t WS_A2 = 308 * MiB;
constexpr size_t WS_BIG = 372 * MiB;
constexpr size_t WS_HE = 10 * MiB;
constexpr size_t WS_END = 564 * MiB;
static_assert(WS_BIG + (size_t)M * UP * 2 <= WS_END && WS_HE + (size_t)RCAP * DFE * 2 <= WS_WD, "ws map");
static_assert(WS_BIG + (size_t)RCAP * DM * 2 <= WS_END, "ws map XG");
constexpr int CW_BAR = 4096;
constexpr int CW_MOE = 16384;
constexpr int CW_DBG = 20000;

constexpr int RING_BYTES = 131072;
constexpr int LDSCTL_OFF = RING_BYTES, MISC_OFF = LDSCTL_OFF + 320;
constexpr int LDS_BYTES = 147456;

#define GAS __attribute__((address_space(1)))
#define LAS __attribute__((address_space(3)))
typedef unsigned short bf16;
typedef unsigned v4u __attribute__((ext_vector_type(4)));
typedef unsigned v2u __attribute__((ext_vector_type(2)));
typedef float f32x4 __attribute__((ext_vector_type(4)));
typedef float f32x2 __attribute__((ext_vector_type(2)));
typedef float f32x16 __attribute__((ext_vector_type(16)));
typedef short bf16x8 __attribute__((ext_vector_type(8)));
typedef short bf16x4 __attribute__((ext_vector_type(4)));
typedef GAS unsigned gu32;
#define RLX_AGENT __ATOMIC_RELAXED, __HIP_MEMORY_SCOPE_AGENT
#define LDS_WAIT() asm volatile("s_waitcnt lgkmcnt(0)" ::: "memory")
#define VM_WAIT() asm volatile("s_waitcnt vmcnt(0)" ::: "memory")
#define LDS_BAR() do { asm volatile("s_waitcnt lgkmcnt(0)" ::: "memory"); __builtin_amdgcn_s_barrier(); asm volatile("" ::: "memory"); } while (0)
__device__ __forceinline__ unsigned f2bf(float f) { unsigned u = __builtin_bit_cast(unsigned, f); return (u + 0x7fffu + ((u >> 16) & 1u)) >> 16; }
__device__ __forceinline__ unsigned pk2(float lo, float hi) { return f2bf(lo) | (f2bf(hi) << 16); }
__device__ __forceinline__ unsigned cvt_pk_bf16(float lo, float hi) { unsigned r; asm volatile("v_cvt_pk_bf16_f32 %0, %1, %2" : "=v"(r) : "v"(lo), "v"(hi)); return r; }
__device__ __forceinline__ float bflo(unsigned u) { return __builtin_bit_cast(float, u << 16); }
__device__ __forceinline__ float bfhi(unsigned u) { return __builtin_bit_cast(float, u & 0xffff0000u); }
__device__ __forceinline__ float fast_rcp(float x) { return __builtin_amdgcn_rcpf(x); }
__device__ __forceinline__ float sigmoidf_(float x) { return fast_rcp(1.0f + __expf(-x)); }
__device__ __forceinline__ float siluf_(float x) { return x * sigmoidf_(x); }
__device__ __forceinline__ float wave_sum(float v) {
#pragma unroll
    for (int o = 1; o < 64; o <<= 1) v += __shfl_xor(v, o);
    return v;
}

#define XB_TMO      128
#define XB_XCNT(j)  (256  + 64 * (j))
#define XB_XSUB(j)  (1280 + 64 * (j))
#define XB_XGEN(j)  (2304 + 64 * (j))
#define XB_TOP      3328
#define XB_TOPGEN   3392
#define XCD_BAR_WORDS 3456
#define XB_SPIN_CAP (1u << 18)
__device__ __forceinline__ unsigned xb_ld(unsigned* p)              { return __hip_atomic_load(p, __ATOMIC_RELAXED, __HIP_MEMORY_SCOPE_AGENT); }
__device__ __forceinline__ unsigned xb_add(unsigned* p, unsigned v) { return __hip_atomic_fetch_add(p, v, __ATOMIC_RELAXED, __HIP_MEMORY_SCOPE_AGENT); }
__device__ __forceinline__ unsigned xb_xcc_id() { return (unsigned)__builtin_amdgcn_s_getreg((3 << 11) | 20) & 0xFu; }
#define XB_SPIN(cond, bar) do { unsigned _sp = 0; while (cond) { __builtin_amdgcn_s_sleep(1); \
    if ((++_sp & 255u) == 0u) { if (xb_ld(&(bar)[XB_TMO])) break; if (_sp > XB_SPIN_CAP) { atomicAdd(&(bar)[XB_TMO], 1u); break; } } } } while (0)
struct XcdBarrier { unsigned* bar; unsigned x; volatile LAS unsigned* st; };
__device__ __forceinline__ XcdBarrier xcd_barrier_post(unsigned* bar, volatile LAS unsigned* st) {
    XcdBarrier b; b.bar = bar; b.x = xb_xcc_id(); b.st = st;
    if (threadIdx.x == 0) (void)xb_add(&bar[XB_XCNT(b.x)], 1u);
    return b;
}
__device__ __forceinline__ void xcd_barrier_complete(unsigned* bar, unsigned x, unsigned& nloc, unsigned& nx) {
    const unsigned G = gridDim.x * gridDim.y * gridDim.z;
    unsigned sum, cnt, mine, sp = 0u;
    for (;;) {
        sum = 0u; cnt = 0u; mine = 0u;
#pragma unroll
        for (unsigned j = 0; j < 16; ++j) { const unsigned c = xb_ld(&bar[XB_XCNT(j)]); sum += c; cnt += (c > 0u) ? 1u : 0u; mine = (j == x) ? c : mine; }
        if (sum == G) break;
        __builtin_amdgcn_s_sleep(1);
        if ((++sp & 255u) == 0u) { if (xb_ld(&bar[XB_TMO])) break; if (sp > XB_SPIN_CAP) { atomicAdd(&bar[XB_TMO], 1u); break; } }
    }
    nloc = mine > 0u ? mine : 1u; nx = cnt > 0u ? cnt : 1u;
}
__device__ __forceinline__ void xcd_barrier(const XcdBarrier& b) {
    asm volatile("s_waitcnt vmcnt(0)" ::: "memory");
    __syncthreads();
    if (threadIdx.x == 0) {
        unsigned* bar = b.bar;
        __builtin_amdgcn_s_waitcnt(0);
        unsigned nloc = b.st[0], nx = b.st[1];
        if (nloc == 0u) { xcd_barrier_complete(bar, b.x, nloc, nx); b.st[0] = nloc; b.st[1] = nx; }
        const unsigned old = xb_add(&bar[XB_XSUB(b.x)], 1u);
        const unsigned gen = old / nloc;
        if (old + 1u == (gen + 1u) * nloc) {
            __builtin_amdgcn_fence(__ATOMIC_RELEASE, "agent");
            asm volatile("s_waitcnt vmcnt(0)" ::: "memory");
            const unsigned og = xb_add(&bar[XB_TOP], 1u);
            const unsigned tg = og / nx;
            if (og + 1u == (tg + 1u) * nx) xb_add(&bar[XB_TOPGEN], 1u);
            else XB_SPIN(xb_ld(&bar[XB_TOPGEN]) == tg, bar);
            __builtin_amdgcn_fence(__ATOMIC_ACQUIRE, "agent");
            xb_add(&bar[XB_XGEN(b.x)], 1u);
            asm volatile("s_waitcnt vmcnt(0)" ::: "memory");
        } else {
            XB_SPIN(xb_ld(&bar[XB_XGEN(b.x)]) == gen, bar);
            __builtin_amdgcn_fence(__ATOMIC_ACQUIRE, "agent");
            asm volatile("s_waitcnt vmcnt(0)" ::: "memory");
        }
    }
    __syncthreads();
}

namespace pg8 {
constexpr int BM = 256, BK = 64, HALF = 128, HTB = HALF * BK * 2, STAGE_BYTES = 8 * HTB, NXCD = 8, WGM = 8;
__host__ __device__ __forceinline__ int lds_byte(int r, int c) { const int st = (r >> 4) * 2 + (c >> 5), rr = r & 15, cc = c & 31, ob = rr * 64 + cc * 2; return st * 1024 + (ob ^ (((ob >> 9) & 1) << 5)); }
__host__ __device__ __forceinline__ void stage_rc(int b, int& R, int& C) { const int st = b / 1024, sb = b % 1024, swz = sb ^ (((sb >> 9) & 1) << 5); R = (st >> 1) * 16 + swz / 64; C = (st & 1) * 32 + (swz % 64) / 2; }
__host__ __device__ __forceinline__ int perm32(int rho) { const int n = rho >> 4, i = rho & 15; return 8 * (i >> 2) + 4 * n + (i & 3); }
struct Unit { int pm, pn; const char* a; const char* b; };
struct GridOrder {
    int nM, nN, nwg, G, c;
    __device__ __forceinline__ void init(int nM_, int nN_, int G_, int c_) { nM = nM_; nN = nN_; nwg = nM * nN; G = G_; c = c_; }
    __device__ __forceinline__ bool tile(int i, int& pm, int& pn) const {
        const long L = (long)i * G + c; if (L >= nwg) return false;
        int wgid = (int)L; { const int q = nwg / NXCD, r = nwg % NXCD, xcd = wgid % NXCD, off = wgid / NXCD; wgid = (xcd < r ? xcd * (q + 1) : r * (q + 1) + (xcd - r) * q) + off; }
        const int nig = WGM * nN, gid = wgid / nig, fm = gid * WGM, gsz = (nM - fm) < WGM ? (nM - fm) : WGM;
        pm = fm + ((wgid % nig) % gsz); pn = (wgid % nig) / gsz; return true;
    }
};

template <class Epi, class Sched, bool ALIGN_EPI>
__device__ __forceinline__ void gemm_phase(LAS unsigned char* lds, const int K, const int lda, const int ldb, const Sched& S, const Epi& E) {
    int tid_ = threadIdx.x; asm volatile("" : "+v"(tid_));
    const int tid = tid_, wid = __builtin_amdgcn_readfirstlane(tid >> 6), lane = tid & 63, wr = wid >> 2, wc = wid & 3, fr = lane & 15, fq = lane >> 4;
    const int nt = K / BK;
    unsigned voffA[2], voffB[2];
#pragma unroll
    for (int i = 0; i < 2; ++i) { int R, C; stage_rc(tid * 16 + i * 8192, R, C); const int Rb = Epi::PERM ? ((R & ~31) + perm32(R & 31)) : R;
        voffA[i] = (unsigned)(R * lda + C) * 2u; voffB[i] = (unsigned)(Rb * ldb + C) * 2u; }
    const size_t kstep = (size_t)(BK * 2);
    const size_t hstepA = (size_t)HALF * lda * 2, hstepB = (size_t)HALF * ldb * 2;
    const unsigned ldsw = (unsigned)wid * 1024u;
    const int aoff = lds_byte(wr * 64 + fr, fq * 8), boff = lds_byte(wc * 32 + fr, fq * 8);
#define PG8_SA(b, h) (((b) * 2 + (h)) * HTB)
#define PG8_SB(b, h) ((4 + (b) * 2 + (h)) * HTB)
#define PG8_STAGE(bufoff, gbase, voff) do { _Pragma("unroll") for (int _i = 0; _i < 2; ++_i) \
        __builtin_amdgcn_global_load_lds((const unsigned*)((const char*)(gbase) + (voff)[_i]), (LAS unsigned*)(lds + (bufoff) + ldsw + _i * 8192), 16, 0, 0); } while (0)
#define PG8_LDA(dst, b, h) do { _Pragma("unroll") for (int m = 0; m < 4; ++m) _Pragma("unroll") for (int k = 0; k < 2; ++k) dst[m][k] = *(const LAS bf16x8*)(lds + PG8_SA(b, h) + aoff + m * 2048 + k * 1024); } while (0)
#define PG8_LDB(dst, b, h) do { _Pragma("unroll") for (int n = 0; n < 2; ++n) _Pragma("unroll") for (int k = 0; k < 2; ++k) dst[n][k] = *(const LAS bf16x8*)(lds + PG8_SB(b, h) + boff + n * 2048 + k * 1024); } while (0)
#define PG8_MMA(ai, bj, At, Bt) do { __builtin_amdgcn_s_setprio(1); _Pragma("unroll") for (int m = 0; m < 4; ++m) _Pragma("unroll") for (int n = 0; n < 2; ++n) _Pragma("unroll") for (int k = 0; k < 2; ++k) \
        acc[ai][bj][m][n] = __builtin_amdgcn_mfma_f32_16x16x32_bf16(Bt[n][k], At[m][k], acc[ai][bj][m][n], 0, 0, 0); __builtin_amdgcn_s_setprio(0); } while (0)
#define PG8_WAIT_V(n) asm volatile("s_waitcnt vmcnt(" #n ")" ::: "memory")
#define PG8_WAIT_L(n) asm volatile("s_waitcnt lgkmcnt(" #n ")" ::: "memory")
#define PG8_BAR __builtin_amdgcn_s_barrier()
#define PG8_SCHED __builtin_amdgcn_sched_barrier(0)
    Unit cur, nxt; int ui = 0;
    if (!S.next(0, cur)) return;
    f32x4 acc[2][2][4][2];
#pragma unroll
    for (int a = 0; a < 2; ++a)
#pragma unroll
        for (int b = 0; b < 2; ++b)
#pragma unroll
            for (int m = 0; m < 4; ++m)
#pragma unroll
                for (int n = 0; n < 2; ++n) acc[a][b][m][n] = (f32x4){0.f, 0.f, 0.f, 0.f};
    bf16x8 At[4][2], B0[2][2], B1[2][2];
    const char* cA = cur.a; const char* cB = cur.b;
    PG8_STAGE(PG8_SB(0, 0), cB, voffB); PG8_STAGE(PG8_SB(0, 1), cB + hstepB, voffB); PG8_STAGE(PG8_SA(0, 0), cA, voffA); PG8_STAGE(PG8_SA(0, 1), cA + hstepA, voffA);
    if (wr == 1) PG8_BAR;
    PG8_WAIT_V(2); PG8_BAR;
    PG8_STAGE(PG8_SB(1, 0), cB + kstep, voffB); PG8_STAGE(PG8_SA(1, 0), cA + kstep, voffA); PG8_STAGE(PG8_SB(1, 1), cB + hstepB + kstep, voffB);
    PG8_WAIT_V(6); PG8_BAR;
    for (;;) {
        const bool has_next = S.next(ui + 1, nxt);
        const char* nA = has_next ? nxt.a : cA; const char* nB = has_next ? nxt.b : cB;
#pragma nounroll
        for (int t = 0; t < nt; t += 2) {
            const bool last = (t == nt - 2);
            const char* a1 = cA + (size_t)(t + 1) * kstep;
            const char* a2 = last ? nA : cA + (size_t)(t + 2) * kstep; const char* b2 = last ? nB : cB + (size_t)(t + 2) * kstep;
            const char* a3 = a2 + kstep; const char* b3 = b2 + kstep;
            PG8_LDB(B0, 0, 0); PG8_LDB(B1, 0, 1); PG8_SCHED; PG8_LDA(At, 0, 0); PG8_STAGE(PG8_SA(1, 1), a1 + hstepA, voffA);
            PG8_WAIT_V(8); PG8_WAIT_L(0); PG8_BAR; PG8_MMA(0, 0, At, B0); PG8_MMA(0, 1, At, B1); PG8_BAR; PG8_SCHED;
            PG8_LDA(At, 0, 1); PG8_STAGE(PG8_SB(0, 0), b2, voffB); PG8_STAGE(PG8_SB(0, 1), b2 + hstepB, voffB); PG8_STAGE(PG8_SA(0, 0), a2, voffA);
            PG8_WAIT_V(8); PG8_WAIT_L(0); PG8_BAR; PG8_MMA(1, 0, At, B0); PG8_MMA(1, 1, At, B1); PG8_BAR; PG8_SCHED;
            PG8_LDB(B0, 1, 0); PG8_LDB(B1, 1, 1); PG8_SCHED; PG8_LDA(At, 1, 0); PG8_STAGE(PG8_SA(0, 1), a2 + hstepA, voffA);
            PG8_WAIT_V(8); PG8_WAIT_L(0); PG8_BAR; PG8_MMA(0, 0, At, B0); PG8_MMA(0, 1, At, B1); PG8_BAR; PG8_SCHED;
            PG8_LDA(At, 1, 1); PG8_STAGE(PG8_SB(1, 0), b3, voffB); PG8_STAGE(PG8_SB(1, 1), b3 + hstepB, voffB); PG8_STAGE(PG8_SA(1, 0), a3, voffA);
            PG8_WAIT_V(8); PG8_WAIT_L(0); PG8_BAR; PG8_MMA(1, 0, At, B0); PG8_MMA(1, 1, At, B1); PG8_BAR; PG8_SCHED;
        }
        if constexpr (ALIGN_EPI) { if (wr == 0) PG8_BAR; }
        E(acc, cur, wr, wc, fr, fq);
        if (!has_next) break;
#pragma unroll
        for (int a = 0; a < 2; ++a)
#pragma unroll
            for (int b = 0; b < 2; ++b)
#pragma unroll
                for (int m = 0; m < 4; ++m)
#pragma unroll
                    for (int n = 0; n < 2; ++n) acc[a][b][m][n] = (f32x4){0.f, 0.f, 0.f, 0.f};
        cur = nxt; cA = nA; cB = nB; ++ui;
        if constexpr (ALIGN_EPI) { if (wr == 1) PG8_BAR; }
    }
    PG8_WAIT_V(0);
    if constexpr (!ALIGN_EPI) { if (wr == 0) PG8_BAR; }
    PG8_BAR;
#undef PG8_SA
#undef PG8_SB
#undef PG8_STAGE
#undef PG8_LDA
#undef PG8_LDB
#undef PG8_MMA
#undef PG8_WAIT_V
#undef PG8_WAIT_L
#undef PG8_BAR
#undef PG8_SCHED
}
}
using pg8::Unit;

struct SchedGrid {
    pg8::GridOrder o; const char* A; const char* B; size_t at, bt;
    __device__ __forceinline__ bool next(int i, Unit& u) const { if (!o.tile(i, u.pm, u.pn)) return false; u.a = A + (size_t)u.pm * at; u.b = B + (size_t)u.pn * bt; return true; }
};
struct SchedPool {
    pg8::GridOrder o; const char* A; const char* B; size_t at, bt;
    __device__ __forceinline__ bool next(int i, Unit& u) const { if (!o.tile(i, u.pm, u.pn)) return false; u.a = A + (size_t)u.pm * at + (size_t)(u.pn >> 1) * 1024; u.b = B + (size_t)u.pn * bt; return true; }
};
struct SchedPJ {
    pg8::GridOrder o; const char* A; const char* B; size_t at, bt;
    __device__ __forceinline__ bool next(int i, Unit& u) const { if (!o.tile(i, u.pm, u.pn)) return false; u.a = A + (size_t)u.pm * at; u.b = B + (size_t)((u.pm >> 6) * 8 + u.pn) * bt; return true; }
};
struct SchedMoe {
    const LAS int* tile_e; int rt0, rt1, G, c; const char* A; const char* B; size_t at, bt, be;
    __device__ __forceinline__ bool next(int i, Unit& u) const {
        const int L = i * G + c, n = (rt1 - rt0) * 8; if (L >= n) return false;
        u.pm = rt0 + (L >> 3); u.pn = L & 7; const int e = tile_e[u.pm];
        u.a = A + (size_t)u.pm * at; u.b = B + (size_t)e * be + (size_t)u.pn * bt; return true; }
};

__device__ __forceinline__ void load_rstd(const float* ssp, int row0, int fq, float (&rs)[2][4]) {
#pragma unroll
    for (int ai = 0; ai < 2; ++ai)
#pragma unroll
        for (int m = 0; m < 4; ++m) {
            const float* sp = ssp + (size_t)(row0 + ai * 128 + m * 16) * 32 + fq * 8;
            const f32x4 a = *(const f32x4*)sp, b = *(const f32x4*)(sp + 4);
            float s = ((a[0] + a[1]) + (a[2] + a[3])) + ((b[0] + b[1]) + (b[2] + b[3]));
            s += __shfl_xor(s, 16); s += __shfl_xor(s, 32);
            rs[ai][m] = 1.0f / sqrtf(s * (1.0f / DM) + EPS);
        }
}
struct EpiInProj {
    static constexpr bool PERM = true;
    bf16* U; const float* ssp; const float* lbv;
    __device__ __forceinline__ void operator()(const f32x4 (&acc)[2][2][4][2], const Unit& u, int wr, int wc, int fr, int fq) const {
        const int row0 = u.pm * 256 + wr * 64 + fr;
        float rs[2][4]; load_rstd(ssp, row0, fq, rs);
        const int pn = u.pn;
        if (pn >= 20) {
            const int col0 = 5120 + (pn - 20) * 128 + wc * 32 + 8 * fq;
#pragma unroll
            for (int ai = 0; ai < 2; ++ai)
#pragma unroll
                for (int m = 0; m < 4; ++m) { const float r2 = rs[ai][m] * rs[ai][m];
                    const f32x4 a0 = acc[ai][0][m][0] * acc[ai][1][m][0] * r2, a1 = acc[ai][0][m][1] * acc[ai][1][m][1] * r2;
                    v4u w; w.x = cvt_pk_bf16(a0[0], a0[1]); w.y = cvt_pk_bf16(a0[2], a0[3]); w.z = cvt_pk_bf16(a1[0], a1[1]); w.w = cvt_pk_bf16(a1[2], a1[3]);
                    *(v4u*)(U + (size_t)(row0 + ai * 128 + m * 16) * UP + col0) = w; }
            return;
        }
        const int kind = pn >> 2;
        const int col0 = pn * 256 + wc * 32 + 8 * fq;
        f32x4 lb[2][2];
        if (kind == 1) {
#pragma unroll
            for (int bj = 0; bj < 2; ++bj)
#pragma unroll
                for (int n = 0; n < 2; ++n) lb[bj][n] = *(const f32x4*)(lbv + (col0 - 1024) + bj * 128 + 4 * n);
            asm volatile("" :: "v"(lb[0][0]), "v"(lb[0][1]), "v"(lb[1][0]), "v"(lb[1][1]));
        }
#pragma unroll
        for (int ai = 0; ai < 2; ++ai)
#pragma unroll
            for (int m = 0; m < 4; ++m) { bf16* rowp = U + (size_t)(row0 + ai * 128 + m * 16) * UP + col0; const float r = rs[ai][m];
#pragma unroll
                for (int bj = 0; bj < 2; ++bj) { f32x4 v0 = acc[ai][bj][m][0] * r, v1 = acc[ai][bj][m][1] * r;
                    if (kind == 0 || kind == 3) {
#pragma unroll
                        for (int j = 0; j < 4; ++j) { v0[j] = siluf_(v0[j]); v1[j] = siluf_(v1[j]); }
                    } else if (kind == 1) {
#pragma unroll
                        for (int j = 0; j < 4; ++j) { v0[j] = __logf(lb[bj][0][j] + (1.0f - lb[bj][0][j]) * sigmoidf_(v0[j])); v1[j] = __logf(lb[bj][1][j] + (1.0f - lb[bj][1][j]) * sigmoidf_(v1[j])); }
                    }
                    v4u w; w.x = cvt_pk_bf16(v0[0], v0[1]); w.y = cvt_pk_bf16(v0[2], v0[3]); w.z = cvt_pk_bf16(v1[0], v1[1]); w.w = cvt_pk_bf16(v1[2], v1[3]);
                    *(v4u*)(rowp + bj * 128) = w; } }
    }
};
struct EpiBf16Plain {
    static constexpr bool PERM = true;
    bf16* O; int ldc;
    __device__ __forceinline__ void operator()(const f32x4 (&acc)[2][2][4][2], const Unit& u, int wr, int wc, int fr, int fq) const {
        const int row0 = u.pm * 256 + wr * 64 + fr, col0 = u.pn * 256 + wc * 32 + 8 * fq;
#pragma unroll
        for (int ai = 0; ai < 2; ++ai)
#pragma unroll
            for (int m = 0; m < 4; ++m) { bf16* rowp = O + (size_t)(row0 + ai * 128 + m * 16) * ldc + col0;
#pragma unroll
                for (int bj = 0; bj < 2; ++bj) { const f32x4 v0 = acc[ai][bj][m][0], v1 = acc[ai][bj][m][1];
                    v4u w; w.x = cvt_pk_bf16(v0[0], v0[1]); w.y = cvt_pk_bf16(v0[2], v0[3]); w.z = cvt_pk_bf16(v1[0], v1[1]); w.w = cvt_pk_bf16(v1[2], v1[3]);
                    *(v4u*)(rowp + bj * 128) = w; } }
    }
};
template <bool ROWTAB> struct EpiSwiglu {
    static constexpr bool PERM = true;
    bf16* H; int ldc; const float* ssp; const float* rtab;
    __device__ __forceinline__ void operator()(const f32x4 (&acc)[2][2][4][2], const Unit& u, int wr, int wc, int fr, int fq) const {
        const int row0 = u.pm * 256 + wr * 64 + fr, col0 = u.pn * 128 + wc * 32 + 8 * fq;
        float rs[2][4];
        if constexpr (ROWTAB) {
#pragma unroll
            for (int ai = 0; ai < 2; ++ai)
#pragma unroll
                for (int m = 0; m < 4; ++m) rs[ai][m] = rtab[row0 + ai * 128 + m * 16];
        } else load_rstd(ssp, row0, fq, rs);
#pragma unroll
        for (int ai = 0; ai < 2; ++ai)
#pragma unroll
            for (int m = 0; m < 4; ++m) { const float r = rs[ai][m];
                f32x4 h0, h1;
#pragma unroll
                for (int j = 0; j < 4; ++j) { h0[j] = siluf_(acc[ai][0][m][0][j] * r) * (acc[ai][1][m][0][j] * r); h1[j] = siluf_(acc[ai][0][m][1][j] * r) * (acc[ai][1][m][1][j] * r); }
                v4u w; w.x = cvt_pk_bf16(h0[0], h0[1]); w.y = cvt_pk_bf16(h0[2], h0[3]); w.z = cvt_pk_bf16(h1[0], h1[1]); w.w = cvt_pk_bf16(h1[2], h1[3]);
                *(v4u*)(H + (size_t)(row0 + ai * 128 + m * 16) * ldc + col0) = w; }
    }
};
template <int MODE  , bool WRITE_XB> struct EpiResid {
    static constexpr bool PERM = false;
    const float* xold; float* xnew; bf16* XB; float* ssp_out; const float* colscale; const float* ssp_in; const bf16* PJ;
    __device__ __forceinline__ void operator()(const f32x4 (&acc)[2][2][4][2], const Unit& u, int wr, int wc, int fr, int fq) const {
        const int row0 = u.pm * 256 + wr * 64 + fr, col0 = u.pn * 256 + wc * 32 + 4 * fq;
        float rs[2][4];
        if constexpr (MODE == 2) load_rstd(ssp_in, row0, fq, rs);
        f32x4 cs[2][2];
        if constexpr (MODE == 1) {
#pragma unroll
            for (int bj = 0; bj < 2; ++bj)
#pragma unroll
                for (int n = 0; n < 2; ++n) cs[bj][n] = *(const f32x4*)(colscale + col0 + bj * 128 + n * 16);
        }
#pragma unroll
        for (int ai = 0; ai < 2; ++ai)
#pragma unroll
            for (int m = 0; m < 4; ++m) { const int row = row0 + ai * 128 + m * 16; const size_t off = (size_t)row * DM + col0; float ss = 0.f;
#pragma unroll
                for (int bj = 0; bj < 2; ++bj)
#pragma unroll
                    for (int n = 0; n < 2; ++n) { const size_t o = off + bj * 128 + n * 16; f32x4 v = acc[ai][bj][m][n];
                        if constexpr (MODE == 1) v = v * cs[bj][n];
                        if constexpr (MODE == 2) { const v2u pj = *(const v2u*)(PJ + o); const float r = rs[ai][m];
                            v[0] = sigmoidf_(v[0] * r) * bflo(pj.x); v[1] = sigmoidf_(v[1] * r) * bfhi(pj.x); v[2] = sigmoidf_(v[2] * r) * bflo(pj.y); v[3] = sigmoidf_(v[3] * r) * bfhi(pj.y); }
                        const f32x4 xo = *(const f32x4*)(xold + o); const f32x4 xn = xo + v;
                        *(f32x4*)(xnew + o) = xn;
                        if constexpr (WRITE_XB) { v2u w; w.x = cvt_pk_bf16(xn[0], xn[1]); w.y = cvt_pk_bf16(xn[2], xn[3]); *(v2u*)(XB + o) = w; }
                        ss += (xn[0] * xn[0] + xn[1] * xn[1]) + (xn[2] * xn[2] + xn[3] * xn[3]); }
                ss += __shfl_xor(ss, 16); ss += __shfl_xor(ss, 32);
                if (fq == 0) ssp_out[(size_t)row * 32 + u.pn * 4 + wc] = ss;
            }
    }
};
template <bool RANK2> struct EpiMoeDown {
    static constexpr bool PERM = false;
    float* X; bf16* XB; float* ssp_out; const int* tokc; const float* gwc;
    __device__ __forceinline__ void operator()(const f32x4 (&acc)[2][2][4][2], const Unit& u, int wr, int wc, int fr, int fq) const {
        const int row0 = u.pm * 256 + wr * 64 + fr, col0 = u.pn * 256 + wc * 32 + 4 * fq;
#pragma unroll
        for (int ai = 0; ai < 2; ++ai)
#pragma unroll
            for (int m = 0; m < 4; ++m) { const int cr = row0 + ai * 128 + m * 16; const int tok = tokc[cr]; const float gw = gwc[cr]; const bool ok = tok >= 0;
                const size_t off = (size_t)(ok ? tok : 0) * DM + col0; float ss = 0.f;
#pragma unroll
                for (int bj = 0; bj < 2; ++bj)
#pragma unroll
                    for (int n = 0; n < 2; ++n) { const size_t o = off + bj * 128 + n * 16;
                        if (ok) { const f32x4 xo = *(const f32x4*)(X + o); const f32x4 xn = xo + acc[ai][bj][m][n] * gw;
                            *(f32x4*)(X + o) = xn;
                            if constexpr (RANK2) { v2u w; w.x = cvt_pk_bf16(xn[0], xn[1]); w.y = cvt_pk_bf16(xn[2], xn[3]); *(v2u*)(XB + o) = w;
                                ss += (xn[0] * xn[0] + xn[1] * xn[1]) + (xn[2] * xn[2] + xn[3] * xn[3]); } } }
                if constexpr (RANK2) { ss += __shfl_xor(ss, 16); ss += __shfl_xor(ss, 32);
                    if (fq == 0 && ok) ssp_out[(size_t)tok * 32 + u.pn * 4 + wc] = ss; }
            }
    }
};

struct Args { const float* in[24]; float* out; unsigned char* ws; };
struct Frame {
    LAS unsigned char* lds; volatile LAS unsigned* MISC; gu32* ctl;
    int tid, lane, wave, G, bx;
};

__device__ __forceinline__ void tr_item(const float* W, int ldw, int k0, int scol0, bf16* WT, int ldt, int drow0, const float* gain, LAS float* scr, int lane) {
#pragma unroll 8
    for (int i = 0; i < 32; ++i) { const int kk = 2 * i + (lane >> 5); float v = W[(size_t)(k0 + kk) * ldw + scol0 + (lane & 31)]; if (gain) v *= gain[k0 + kk]; scr[kk * 33 + (lane & 31)] = v; }
    LDS_WAIT(); asm volatile("" ::: "memory");
    const int c = lane & 7;
#pragma unroll
    for (int j = 0; j < 4; ++j) { const int n = (lane >> 3) + 8 * j; const LAS float* s = scr + (8 * c) * 33 + n;
        v4u o; o.x = pk2(s[0 * 33], s[1 * 33]); o.y = pk2(s[2 * 33], s[3 * 33]); o.z = pk2(s[4 * 33], s[5 * 33]); o.w = pk2(s[6 * 33], s[7 * 33]);
        *(GAS v4u*)(WT + (size_t)(drow0 + n) * ldt + k0 + 8 * c) = o; }
    LDS_WAIT(); asm volatile("" ::: "memory");
}
__device__ __forceinline__ void tr_plain(Frame& F, const float* W, int ldw, int scol0, int K, int N, bf16* WT, int drow0, const float* gain, LAS float* scr) {
    const int gw = F.bx * NWAVES + F.wave, NGW = F.G * NWAVES, nnb = N / 32, nit = (K / 64) * nnb;
    for (int it = gw; it < nit; it += NGW) { const int kb = it / nnb, nb = it % nnb; tr_item(W, ldw, kb * 64, scol0 + nb * 32, WT, K, drow0 + nb * 32, gain, scr, F.lane); }
}
__device__ __forceinline__ void tr_pair(Frame& F, const float* W0, int c0, const float* W1, int c1, int ldw, int K, int NP  , bf16* WT, const float* gain, LAS float* scr) {
    const int gw = F.bx * NWAVES + F.wave, NGW = F.G * NWAVES, nnb = NP * 8, nit = (K / 64) * nnb;
    for (int it = gw; it < nit; it += NGW) { const int kb = it / nnb, nb = it % nnb, j = nb >> 3, q = nb & 7;
        const float* W = (q < 4) ? W0 : W1; const int sc = ((q < 4) ? c0 : c1) + 128 * j + 32 * (q & 3);
        tr_item(W, ldw, kb * 64, sc, WT, K, nb * 32, gain, scr, F.lane); }
}

constexpr int H_QT = 0, H_KT = 17408, H_QC = 34816, H_KH = 52224, H_VT = 70656, H_TOT = 89088, H_DEC = 93184, H_NRM = 93696, H_END = 94720;
constexpr int TP = 272  , CP = 144  ;
__device__ __forceinline__ f32x16 mfma32(bf16x8 a, bf16x8 b, f32x16 c) { return __builtin_amdgcn_mfma_f32_32x32x16_bf16(a, b, c, 0, 0, 0); }
__device__ __forceinline__ bf16x8 pack8(const f32x16& v, int o) {
    v4u w; w.x = cvt_pk_bf16(v[o + 0], v[o + 1]); w.y = cvt_pk_bf16(v[o + 2], v[o + 3]); w.z = cvt_pk_bf16(v[o + 4], v[o + 5]); w.w = cvt_pk_bf16(v[o + 6], v[o + 7]);
    return __builtin_bit_cast(bf16x8, w);
}
__device__ __forceinline__ bf16x8 ld2x8(const LAS unsigned char* p) {
    const v2u a = *(const LAS v2u*)p, b = *(const LAS v2u*)(p + 16); v4u w; w.x = a.x; w.y = a.y; w.z = b.x; w.w = b.y; return __builtin_bit_cast(bf16x8, w);
}
__device__ __forceinline__ void hgrn_phase(Frame& F, const bf16* U, bf16* A2, const float* hgain) {
    const int b = F.bx >> 3, h = F.bx & 7, w = F.wave, lane = F.lane;
    LAS unsigned char* L = F.lds;
    const int eb = w >> 1, tb = w & 1, r = lane & 31, hh = lane >> 5;
    f32x16 S[4];
#pragma unroll
    for (int d = 0; d < 4; ++d)
#pragma unroll
        for (int i = 0; i < 16; ++i) S[d][i] = 0.f;
    const size_t rowbase0 = (size_t)b * SEQ;
    unsigned lf_[8], qs_[8], v_[8], lf32_;
    const bf16* Ucol = U + h * HD + 2 * lane;
#define HG_LOAD(n) do { const bf16* p = Ucol + (rowbase0 + (size_t)(n) * CHUNK + 8 * w) * UP; \
        _Pragma("unroll") for (int j = 0; j < 8; ++j) { qs_[j] = *(const unsigned*)(p + (size_t)j * UP); lf_[j] = *(const unsigned*)(p + (size_t)j * UP + 1024); v_[j] = *(const unsigned*)(p + (size_t)j * UP + 2048); } \
        lf32_ = *(const unsigned*)(Ucol + (rowbase0 + (size_t)(n) * CHUNK + 32) * UP + 1024); } while (0)
    HG_LOAD(0);
    for (int n = 0; n < SEQ / CHUNK; ++n) {
        const size_t rowbase = rowbase0 + (size_t)n * CHUNK;
        float c0[8], c1[8];
        { float a0 = 0.f, a1 = 0.f;
#pragma unroll
          for (int j = 0; j < 8; ++j) { a0 += bflo(lf_[j]); a1 += bfhi(lf_[j]); c0[j] = a0; c1[j] = a1; }
          *(LAS f32x2*)(L + H_TOT + (w * 128 + 2 * lane) * 4) = (f32x2){a0, a1}; }
        LDS_BAR();
        { float pre0 = 0.f, pre1 = 0.f, ref0 = 0.f, ref1 = 0.f, last0 = 0.f, last1 = 0.f;
#pragma unroll
          for (int ww = 0; ww < 8; ++ww) { const f32x2 t = *(const LAS f32x2*)(L + H_TOT + (ww * 128 + 2 * lane) * 4);
              if (ww < w) { pre0 += t.x; pre1 += t.y; } if (ww < 4) { ref0 += t.x; ref1 += t.y; } last0 += t.x; last1 += t.y; }
          ref0 += bflo(lf32_); ref1 += bfhi(lf32_);
          const float eref0 = __expf(ref0), eref1 = __expf(ref1), elr0 = __expf(last0 - ref0), elr1 = __expf(last1 - ref1);
          if (w == 0) *(LAS f32x2*)(L + H_DEC + 2 * lane * 4) = (f32x2){__expf(last0), __expf(last1)};
          unsigned kh0[4], kh1[4], vt0[4], vt1[4];
#pragma unroll
          for (int j = 0; j < 8; ++j) {
              const float cum0 = pre0 + c0[j], cum1 = pre1 + c1[j];
              const float E10 = __expf(cum0 - ref0), E11 = __expf(cum1 - ref1), E20 = fast_rcp(E10), E21 = fast_rcp(E11);
              const float k0 = 1.0f - __expf(bflo(lf_[j])), k1 = 1.0f - __expf(bfhi(lf_[j]));
              const float q0 = bflo(qs_[j]), q1 = bfhi(qs_[j]);
              const float qt0 = q0 * E10, qt1 = q1 * E11, kt0 = k0 * E20, kt1 = k1 * E21;
              const int t = 8 * w + j;
              *(LAS unsigned*)(L + H_QT + t * TP + 4 * lane) = cvt_pk_bf16(qt0, qt1);
              *(LAS unsigned*)(L + H_KT + t * TP + 4 * lane) = cvt_pk_bf16(kt0, kt1);
              *(LAS unsigned*)(L + H_QC + t * TP + 4 * lane) = cvt_pk_bf16(qt0 * eref0, qt1 * eref1);
              const unsigned kk = cvt_pk_bf16(kt0 * elr0, kt1 * elr1);
              if (j & 1) { kh0[j >> 1] |= (kk << 16); kh1[j >> 1] |= (kk & 0xffff0000u); vt0[j >> 1] |= (v_[j] << 16); vt1[j >> 1] |= (v_[j] & 0xffff0000u); }
              else { kh0[j >> 1] = kk & 0xffffu; kh1[j >> 1] = kk >> 16; vt0[j >> 1] = v_[j] & 0xffffu; vt1[j >> 1] = v_[j] >> 16; }
          }
          *(LAS v4u*)(L + H_KH + (2 * lane) * CP + 16 * w) = (v4u){kh0[0], kh0[1], kh0[2], kh0[3]};
          *(LAS v4u*)(L + H_KH + (2 * lane + 1) * CP + 16 * w) = (v4u){kh1[0], kh1[1], kh1[2], kh1[3]};
          *(LAS v4u*)(L + H_VT + (2 * lane) * CP + 16 * w) = (v4u){vt0[0], vt0[1], vt0[2], vt0[3]};
          *(LAS v4u*)(L + H_VT + (2 * lane + 1) * CP + 16 * w) = (v4u){vt1[0], vt1[1], vt1[2], vt1[3]};
        }
        LDS_BAR();
        if (n + 1 < SEQ / CHUNK) HG_LOAD(n + 1);
        f32x16 O;
#pragma unroll
        for (int i = 0; i < 16; ++i) O[i] = 0.f;
#pragma unroll
        for (int sb = 0; sb < 2; ++sb) {
            if (sb <= tb) {
                f32x16 P;
#pragma unroll
                for (int i = 0; i < 16; ++i) P[i] = 0.f;
#pragma unroll
                for (int ks = 0; ks < 8; ++ks) {
                    const bf16x8 a = *(const LAS bf16x8*)(L + H_KT + (32 * sb + r) * TP + (16 * ks + 8 * hh) * 2);
                    const bf16x8 bq = *(const LAS bf16x8*)(L + H_QT + (32 * tb + r) * TP + (16 * ks + 8 * hh) * 2);
                    P = mfma32(a, bq, P);
                }
                if (sb == tb) {
#pragma unroll
                    for (int i = 0; i < 16; ++i) { const int s = (i & 3) + 8 * (i >> 2) + 4 * hh; if (s > r) P[i] = 0.f; }
                }
#pragma unroll
                for (int k2 = 0; k2 < 2; ++k2) {
                    const bf16x8 av = ld2x8(L + H_VT + (32 * eb + r) * CP + (32 * sb + 16 * k2 + 4 * hh) * 2);
                    O = mfma32(av, pack8(P, 8 * k2), O);
                }
            }
        }
#pragma unroll
        for (int db = 0; db < 4; ++db)
#pragma unroll
            for (int k2 = 0; k2 < 2; ++k2) {
                const bf16x8 bq = ld2x8(L + H_QC + (32 * tb + r) * TP + (32 * db + 16 * k2 + 4 * hh) * 2);
                O = mfma32(pack8(S[db], 8 * k2), bq, O);
            }
#pragma unroll
        for (int db = 0; db < 4; ++db) {
#pragma unroll
            for (int q = 0; q < 4; ++q) { const f32x4 dc = *(const LAS f32x4*)(L + H_DEC + (32 * db + 8 * q + 4 * hh) * 4);
                S[db][4 * q + 0] *= dc[0]; S[db][4 * q + 1] *= dc[1]; S[db][4 * q + 2] *= dc[2]; S[db][4 * q + 3] *= dc[3]; }
#pragma unroll
            for (int ks = 0; ks < 4; ++ks) {
                const bf16x8 a = *(const LAS bf16x8*)(L + H_KH + (32 * db + r) * CP + (16 * ks + 8 * hh) * 2);
                const bf16x8 bv = *(const LAS bf16x8*)(L + H_VT + (32 * eb + r) * CP + (16 * ks + 8 * hh) * 2);
                S[db] = mfma32(a, bv, S[db]);
            }
        }
        float ssq = 0.f;
#pragma unroll
        for (int i = 0; i < 16; ++i) ssq += O[i] * O[i];
        ssq += __shfl_xor(ssq, 32);
        if (hh == 0) *(LAS float*)(L + H_NRM + (eb * 64 + 32 * tb + r) * 4) = ssq;
        LDS_BAR();
        { float tot = 0.f;
#pragma unroll
          for (int e4 = 0; e4 < 4; ++e4) tot += *(const LAS float*)(L + H_NRM + (e4 * 64 + 32 * tb + r) * 4);
          const float rstd = 1.0f / sqrtf(tot * (1.0f / HD) + EPS);
          const size_t row = rowbase + 32 * tb + r;
#pragma unroll
          for (int q = 0; q < 4; ++q) { const int e0 = 32 * eb + 8 * q + 4 * hh;
              const f32x4 gn = *(const f32x4*)(hgain + h * HD + e0);
              const v2u gs = *(const v2u*)(U + row * UP + 3072 + h * HD + e0);
              const float o0 = O[4 * q + 0] * rstd * gn[0] * bflo(gs.x), o1 = O[4 * q + 1] * rstd * gn[1] * bfhi(gs.x);
              const float o2 = O[4 * q + 2] * rstd * gn[2] * bflo(gs.y), o3 = O[4 * q + 3] * rstd * gn[3] * bfhi(gs.y);
              v2u wv; wv.x = cvt_pk_bf16(o0, o1); wv.y = cvt_pk_bf16(o2, o3);
              *(v2u*)(A2 + row * DM + h * HD + e0) = wv; }
        }
    }
#undef HG_LOAD
}
__device__ __forceinline__ void conv_phase(Frame& F, const bf16* U, bf16* A2, const float* convw, int first_block) {
    const int nb = F.G - first_block, me = F.bx - first_block, c = 2 * F.tid;
    const float w00 = convw[c], w01 = convw[c + 1], w10 = convw[DC + c], w11 = convw[DC + c + 1], w20 = convw[2 * DC + c], w21 = convw[2 * DC + c + 1];
    for (int u = me; u < M / 32; u += nb) {
        const int R0 = u * 32, t0 = R0 % SEQ;
        const bf16* up = U + (size_t)R0 * UP;
        float a0 = 0.f, a1 = 0.f, b0 = 0.f, b1 = 0.f;
        if (t0 != 0) { const unsigned p2 = *(const unsigned*)(up - 2 * (size_t)UP + 5120 + c), p1 = *(const unsigned*)(up - (size_t)UP + 5120 + c);
            a0 = bflo(p2); a1 = bfhi(p2); b0 = bflo(p1); b1 = bfhi(p1); }
#pragma unroll 8
        for (int j = 0; j < 32; ++j) {
            const unsigned tt = *(const unsigned*)(up + (size_t)j * UP + 5120 + c), gb = *(const unsigned*)(up + (size_t)j * UP + 4096 + c);
            const float t0f = bflo(tt), t1f = bfhi(tt);
            const float y0 = bflo(gb) * (w00 * a0 + w10 * b0 + w20 * t0f), y1 = bfhi(gb) * (w01 * a1 + w11 * b1 + w21 * t1f);
            *(unsigned*)(A2 + (size_t)(R0 + j) * DM + DH + c) = cvt_pk_bf16(y0, y1);
            a0 = b0; a1 = b1; b0 = t0f; b1 = t1f;
        }
    }
}

#ifndef PH_ENABLE
#define PH_ENABLE 0xffffffffu
#endif
#define PH(k) (((PH_ENABLE) >> (k)) & 1u)
__global__ void __launch_bounds__(NWAVES * 64, 2) fwd_kernel(Args args) {
    extern __shared__ __attribute__((aligned(16))) unsigned char lds[];
    Frame F;
    F.lds = (LAS unsigned char*)lds;
    F.MISC = (volatile LAS unsigned*)(F.lds + MISC_OFF);
    F.tid = threadIdx.x; F.lane = F.tid & 63; F.wave = __builtin_amdgcn_readfirstlane(F.tid >> 6);
    F.G = gridDim.x; F.bx = blockIdx.x;
    unsigned char* ws = args.ws;
    F.ctl = (gu32*)(ws + WS_CTL);
    for (int u = F.tid; u < (LDS_BYTES - LDSCTL_OFF) / 4; u += NWAVES * 64) ((LAS unsigned*)(F.lds + LDSCTL_OFF))[u] = 0u;
    __syncthreads();
    XcdBarrier bar = xcd_barrier_post((unsigned*)(F.ctl + CW_BAR), F.MISC + 8);
#define GRID_BAR() xcd_barrier(bar)
#define REFRESH() do { int t_ = threadIdx.x; asm volatile("" : "+v"(t_)); F.tid = t_; F.lane = t_ & 63; F.wave = __builtin_amdgcn_readfirstlane(t_ >> 6); \
        int b_ = blockIdx.x; asm volatile("" : "+s"(b_)); F.bx = b_; gw = F.bx * NWAVES + F.wave; \
        kp_ = (const float* const __attribute__((address_space(4)))*)__builtin_amdgcn_kernarg_segment_ptr(); asm volatile("" : "+s"(kp_)); \
        ws_ = (unsigned char*)kp_[25]; X_ = (float*)kp_[24]; } while (0)
    const float* const __attribute__((address_space(4)))* kp_ = (const float* const __attribute__((address_space(4)))*)__builtin_amdgcn_kernarg_segment_ptr();
    unsigned char* ws_ = args.ws; float* X_ = args.out;
#define I_x (kp_[0])
#define I_p (kp_[1])
#define I_final_gain (kp_[2])
#define I_lb_table (kp_[3])
#define I_mix_norm_even (kp_[4])
#define I_w_in (kp_[5])
#define I_hgrn_gain (kp_[6])
#define I_conv_w (kp_[7])
#define I_w_out (kp_[8])
#define I_ffn_norm_even (kp_[9])
#define I_w_gate (kp_[10])
#define I_w_up (kp_[11])
#define I_w_down (kp_[12])
#define I_mix_norm_odd (kp_[13])
#define I_pool_w (kp_[14])
#define I_pool_scale (kp_[15])
#define I_ffn_norm_odd (kp_[16])
#define I_w_router (kp_[17])
#define I_w_gate_e (kp_[18])
#define I_w_up_e (kp_[19])
#define I_w_down_e (kp_[20])
#define I_ple_norm (kp_[21])
#define I_ple_gate_w (kp_[22])
#define I_ple_proj (kp_[23])
#define W_lbv ((float*)(ws_ + WS_LBV))
#define W_rs4 ((float*)(ws_ + WS_RS4))
#define W_topi ((int*)(ws_ + WS_TOP))
#define W_topw ((float*)(ws_ + WS_TOPW))
#define W_sspA ((float*)(ws_ + WS_SSPA))
#define W_sspB ((float*)(ws_ + WS_SSPB))
#define W_list ((int*)(ws_ + WS_LIST))
#define W_gwl ((float*)(ws_ + WS_GWL))
#define W_tokc ((int*)(ws_ + WS_TOKC))
#define W_gwc ((float*)(ws_ + WS_GWC))
#define W_rsc ((float*)(ws_ + WS_RSC))
#define W_Win_t ((bf16*)(ws_ + WS_WIN))
#define W_Wout_t ((bf16*)(ws_ + WS_WOUT))
#define W_Wgu_t ((bf16*)(ws_ + WS_WGU))
#define W_Wd_t ((bf16*)(ws_ + WS_WD))
#define W_Wpool_t ((bf16*)(ws_ + WS_WPOOL))
#define W_Wmgu_t ((bf16*)(ws_ + WS_WMGU))
#define W_Wmd_t ((bf16*)(ws_ + WS_WMD))
#define W_Wpg_t ((bf16*)(ws_ + WS_WPG))
#define W_Wpp_t ((bf16*)(ws_ + WS_WPP))
#define W_PB ((bf16*)(ws_ + WS_PB))
#define W_XB ((bf16*)(ws_ + WS_XB))
#define W_A2 ((bf16*)(ws_ + WS_A2))
#define W_PJ ((bf16*)(ws_ + WS_A2))
#define W_U ((bf16*)(ws_ + WS_BIG))
#define W_Hh ((bf16*)(ws_ + WS_BIG))
#define W_D1 ((bf16*)(ws_ + WS_BIG))
#define W_XG ((bf16*)(ws_ + WS_BIG))
#define W_HE ((bf16*)(ws_ + WS_HE))
#define W_X (X_)
#define W_XB0 ((bf16*)X_)
    int gw = F.bx * NWAVES + F.wave; const int NGW = F.G * NWAVES;

    if (PH(0)) { REFRESH();
        LAS float* scr = (LAS float*)(F.lds + F.wave * 16384);
        tr_plain(F, I_w_in, NIN, 0, DM, 5120, W_Win_t, 0, I_mix_norm_even, scr);
        tr_pair(F, I_w_in, 5120, I_w_in, 6144, NIN, DM, 8, W_Win_t + (size_t)5120 * DM, I_mix_norm_even, scr);
        tr_plain(F, I_w_out, DM, 0, DM, DM, W_Wout_t, 0, nullptr, scr);
        tr_pair(F, I_w_gate, 0, I_w_up, 0, DFF, DM, DFF / 128, W_Wgu_t, I_ffn_norm_even, scr);
        tr_plain(F, I_w_down, DM, 0, DFF, DM, W_Wd_t, 0, nullptr, scr);
        for (int g = 0; g < 4; ++g) tr_plain(F, I_pool_w + (size_t)g * 512 * 512, 512, 0, 512, 512, W_Wpool_t, 512 * g, I_mix_norm_odd + 512 * g, scr);
        for (int e = 0; e < NE; ++e) tr_pair(F, I_w_gate_e + (size_t)e * DM * DFE, 0, I_w_up_e + (size_t)e * DM * DFE, 0, DFE, DM, DFE / 128, W_Wmgu_t + (size_t)e * 2048 * DM, I_ffn_norm_odd, scr);
        for (int e = 0; e < NE; ++e) tr_plain(F, I_w_down_e + (size_t)e * DFE * DM, DM, 0, DFE, DM, W_Wmd_t + (size_t)e * DM * DFE, 0, nullptr, scr);
        for (int i = 0; i < 2; ++i) tr_plain(F, I_ple_gate_w + (size_t)i * DM * DM, DM, 0, DM, DM, W_Wpg_t + (size_t)i * DM * DM, 0, I_ple_norm + i * DM, scr);
        for (int i = 0; i < 2; ++i) tr_plain(F, I_ple_proj + (size_t)i * DPLE * DM, DM, 0, DPLE, DM, W_Wpp_t + (size_t)i * DM * DPLE, 0, nullptr, scr);
        for (int m = gw; m < M; m += NGW) {
            const GAS f32x4* xr = (const GAS f32x4*)(I_x + (size_t)m * DM) + F.lane; GAS v2u* o8 = (GAS v2u*)(W_XB0 + (size_t)m * DM) + F.lane; float s = 0.f;
#pragma unroll
            for (int j = 0; j < 8; ++j) { const f32x4 v = xr[64 * j]; s += (v[0] * v[0] + v[1] * v[1]) + (v[2] * v[2] + v[3] * v[3]); v2u w; w.x = cvt_pk_bf16(v[0], v[1]); w.y = cvt_pk_bf16(v[2], v[3]); o8[64 * j] = w; }
            s = wave_sum(s);
            if (F.lane < 32) W_sspA[(size_t)m * 32 + F.lane] = (F.lane == 0) ? s : 0.f;
        }
        for (size_t i = (size_t)F.bx * 512 + F.tid; i < (size_t)2 * M * DPLE / 8; i += (size_t)F.G * 512) {
            const f32x4 a = ((const f32x4*)I_p)[2 * i], b2 = ((const f32x4*)I_p)[2 * i + 1];
            v4u w; w.x = cvt_pk_bf16(a[0], a[1]); w.y = cvt_pk_bf16(a[2], a[3]); w.z = cvt_pk_bf16(b2[0], b2[1]); w.w = cvt_pk_bf16(b2[2], b2[3]); ((v4u*)W_PB)[i] = w; }
        if (F.bx == 0) for (int j = F.tid; j < DH; j += 512) { const float t0 = I_lb_table[j], t1 = I_lb_table[DH + j], t2 = I_lb_table[2 * DH + j]; const float mx = fmaxf(t0, fmaxf(t1, t2));
            const float e0 = __expf(t0 - mx), e1 = __expf(t1 - mx), e2 = __expf(t2 - mx); W_lbv[j] = e0 / (e0 + e1 + e2); }
    }
    GRID_BAR();
    const size_t TB2048 = (size_t)256 * DM * 2;
    if (PH(1)) { REFRESH();
        SchedGrid S; S.o.init(M / 256, NIN / 256, F.G, F.bx); S.A = (const char*)W_XB0; S.B = (const char*)W_Win_t; S.at = TB2048; S.bt = TB2048;
        EpiInProj E{W_U, W_sspA, W_lbv};
        pg8::gemm_phase<EpiInProj, SchedGrid, true>(F.lds, DM, DM, DM, S, E);
    }
    GRID_BAR();
    if (PH(2)) { REFRESH(); if (F.bx < BATCH * NH) hgrn_phase(F, W_U, W_A2, I_hgrn_gain); else conv_phase(F, W_U, W_A2, I_conv_w, BATCH * NH); }
    GRID_BAR();
    if (PH(3)) { REFRESH();
        SchedGrid S; S.o.init(M / 256, DM / 256, F.G, F.bx); S.A = (const char*)W_A2; S.B = (const char*)W_Wout_t; S.at = TB2048; S.bt = TB2048;
        EpiResid<0, true> E{I_x, W_X, W_XB, W_sspB, nullptr, nullptr, nullptr};
        pg8::gemm_phase<EpiResid<0, true>, SchedGrid, true>(F.lds, DM, DM, DM, S, E);
    }
    GRID_BAR();
    if (PH(4)) { REFRESH();
        SchedGrid S; S.o.init(M / 256, 2 * DFF / 256, F.G, F.bx); S.A = (const char*)W_XB; S.B = (const char*)W_Wgu_t; S.at = TB2048; S.bt = TB2048;
        EpiSwiglu<false> E{W_Hh, DFF, W_sspB, nullptr};
        pg8::gemm_phase<EpiSwiglu<false>, SchedGrid, true>(F.lds, DM, DM, DM, S, E);
        REFRESH();
        SchedGrid S2; S2.o.init(M / 256, DM / 256, F.G, F.bx); S2.A = (const char*)W_PB; S2.B = (const char*)W_Wpp_t; S2.at = (size_t)256 * DPLE * 2; S2.bt = (size_t)256 * DPLE * 2;
        EpiBf16Plain E2{W_PJ, DM};
        pg8::gemm_phase<EpiBf16Plain, SchedGrid, true>(F.lds, DPLE, DPLE, DPLE, S2, E2);
    }
    GRID_BAR();
    if (PH(5)) { REFRESH();
        SchedGrid S; S.o.init(M / 256, DM / 256, F.G, F.bx); S.A = (const char*)W_Hh; S.B = (const char*)W_Wd_t; S.at = (size_t)256 * DFF * 2; S.bt = (size_t)256 * DFF * 2;
        EpiResid<0, true> E{W_X, W_X, W_XB, W_sspA, nullptr, nullptr, nullptr};
        pg8::gemm_phase<EpiResid<0, true>, SchedGrid, true>(F.lds, DFF, DFF, DFF, S, E);
    }
    GRID_BAR();
    if (PH(6)) { REFRESH();
        SchedGrid S; S.o.init(M / 256, DM / 256, F.G, F.bx); S.A = (const char*)W_XB; S.B = (const char*)W_Wpg_t; S.at = TB2048; S.bt = TB2048;
        EpiResid<2, false> E{W_X, W_X, nullptr, W_sspB, nullptr, W_sspA, W_PJ};
        pg8::gemm_phase<EpiResid<2, false>, SchedGrid, true>(F.lds, DM, DM, DM, S, E);
    }
    GRID_BAR();
    if (PH(7)) { REFRESH();
        LAS float* rt = (LAS float*)F.lds;
        for (int seg = F.bx; seg < M / 64; seg += F.G) {
            const int R0 = seg * 64, t0 = R0 % SEQ;
            for (int i = F.wave; i < 80; i += NWAVES) { const int row = R0 - 16 + i; float v = 0.f;
                if (row >= 0 && F.lane < 32) v = W_sspB[(size_t)row * 32 + F.lane];
                v = wave_sum(v); if (F.lane == 0) rt[i] = 1.0f / sqrtf(v * (1.0f / DM) + EPS); }
            LDS_BAR();
            const int wdw = 2 << (F.tid >> 7);
            const float* xc = W_X + (size_t)R0 * DM + 4 * F.tid;
            f32x4 Ssum = (f32x4){0.f, 0.f, 0.f, 0.f};
            for (int k = 1; k <= wdw; ++k) if (t0 - k >= 0) Ssum += *(const f32x4*)(xc - (size_t)k * DM) * rt[16 - k];
#pragma unroll 4
            for (int j = 0; j < 64; ++j) {
                const f32x4 hv = *(const f32x4*)(xc + (size_t)j * DM) * rt[16 + j];
                Ssum += hv;
                const int tp = t0 + j;
                if (tp - wdw >= 0) Ssum -= *(const f32x4*)(xc + (size_t)(j - wdw) * DM) * rt[16 + j - wdw];
                const float inv = 1.0f / (float)((tp + 1 < wdw) ? (tp + 1) : wdw);
                const f32x4 d = Ssum * inv - hv;
                v2u w; w.x = cvt_pk_bf16(d[0], d[1]); w.y = cvt_pk_bf16(d[2], d[3]);
                *(v2u*)(W_D1 + (size_t)(R0 + j) * DM + 4 * F.tid) = w;
            }
            LDS_BAR();
        }
    }
    GRID_BAR();
    if (PH(8)) { REFRESH();
        SchedPool S; S.o.init(M / 256, DM / 256, F.G, F.bx); S.A = (const char*)W_D1; S.B = (const char*)W_Wpool_t; S.at = TB2048; S.bt = (size_t)256 * 512 * 2;
        EpiResid<1, true> E{W_X, W_X, W_XB, W_sspA, I_pool_scale, nullptr, nullptr};
        pg8::gemm_phase<EpiResid<1, true>, SchedPool, true>(F.lds, 512, DM, 512, S, E);
        REFRESH();
        SchedGrid S2; S2.o.init(M / 256, DM / 256, F.G, F.bx); S2.A = (const char*)(W_PB + (size_t)M * DPLE); S2.B = (const char*)(W_Wpp_t + (size_t)DM * DPLE); S2.at = (size_t)256 * DPLE * 2; S2.bt = (size_t)256 * DPLE * 2;
        EpiBf16Plain E2{W_PJ, DM};
        pg8::gemm_phase<EpiBf16Plain, SchedGrid, true>(F.lds, DPLE, DPLE, DPLE, S2, E2);
    }
    GRID_BAR();
    if (PH(9)) { REFRESH();
        LAS float* wr = (LAS float*)F.lds;
        LAS int* e12 = (LAS int*)(F.lds + 65536);
        LAS float* w12 = (LAS float*)(F.lds + 65536 + 512);
        for (int i = F.tid; i < DM * NE / 4; i += 512) { const int k = i >> 1, e0 = (i & 1) * 4; const f32x4 v = *(const f32x4*)(I_w_router + (size_t)k * NE + e0) * I_ffn_norm_odd[k];
            *(LAS f32x4*)(wr + (((k & 3) * 512 + (k >> 2)) * 8 + e0)) = v; }
        LDS_BAR();
        for (int seg = F.bx; seg < M / 64; seg += F.G) {
            for (int rr = 0; rr < 8; ++rr) {
                const int lrow = F.wave * 8 + rr, row = seg * 64 + lrow;
                const GAS f32x4* xr = (const GAS f32x4*)(W_X + (size_t)row * DM) + F.lane;
                float acc[8]; float ss = 0.f;
#pragma unroll
                for (int e = 0; e < 8; ++e) acc[e] = 0.f;
#pragma unroll
                for (int c = 0; c < 8; ++c) { const f32x4 xv = xr[64 * c]; ss += (xv[0] * xv[0] + xv[1] * xv[1]) + (xv[2] * xv[2] + xv[3] * xv[3]);
#pragma unroll
                    for (int kk = 0; kk < 4; ++kk) { const LAS float* wp = wr + ((kk * 512 + c * 64 + F.lane) * 8); const f32x4 w0 = *(const LAS f32x4*)wp, w1 = *(const LAS f32x4*)(wp + 4);
                        acc[0] += xv[kk] * w0[0]; acc[1] += xv[kk] * w0[1]; acc[2] += xv[kk] * w0[2]; acc[3] += xv[kk] * w0[3];
                        acc[4] += xv[kk] * w1[0]; acc[5] += xv[kk] * w1[1]; acc[6] += xv[kk] * w1[2]; acc[7] += xv[kk] * w1[3]; } }
                ss = wave_sum(ss);
#pragma unroll
                for (int e = 0; e < 8; ++e) acc[e] = wave_sum(acc[e]);
                const float rstd = 1.0f / sqrtf(ss * (1.0f / DM) + EPS);
                int i1 = 0; float l1 = acc[0];
#pragma unroll
                for (int e = 1; e < 8; ++e) if (acc[e] > l1) { l1 = acc[e]; i1 = e; }
                int i2 = -1; float l2 = -3.0e38f;
#pragma unroll
                for (int e = 0; e < 8; ++e) if (e != i1 && acc[e] > l2) { l2 = acc[e]; i2 = e; }
                const float wt1 = 1.0f / (1.0f + __expf((l2 - l1) * rstd)), wt2 = 1.0f - wt1;
                if (F.lane == 0) { e12[2 * lrow] = i1; e12[2 * lrow + 1] = i2; w12[2 * lrow] = wt1; w12[2 * lrow + 1] = wt2; W_rs4[row] = rstd; }
            }
            LDS_BAR();
            if (F.wave == 0) {
                const int row = seg * 64 + F.lane; const int e1 = e12[2 * F.lane], e2 = e12[2 * F.lane + 1]; const float wt1 = w12[2 * F.lane], wt2 = w12[2 * F.lane + 1];
                unsigned long long mk[16]; int mycnt = 0;
#pragma unroll
                for (int g = 0; g < 16; ++g) { const bool pr = (g < 8) ? (e1 == g) : (e2 == g - 8); mk[g] = __ballot(pr); if (F.lane == g) mycnt = __popcll(mk[g]); }
                int base = 0;
                if (F.lane < 16) base = (int)__hip_atomic_fetch_add((unsigned*)(F.ctl + CW_MOE) + F.lane, (unsigned)mycnt, RLX_AGENT);
                const unsigned long long lt = (1ull << F.lane) - 1ull;
#pragma unroll
                for (int g = 0; g < 16; ++g) { const int bg = __shfl(base, g); const bool pr = (g < 8) ? (e1 == g) : (e2 == g - 8);
                    if (pr) { const int slot = bg + __popcll(mk[g] & lt); W_list[(size_t)g * M + slot] = row; W_gwl[(size_t)g * M + slot] = (g < 8) ? wt1 : wt2; } }
            }
            LDS_BAR();
        }
    }
    GRID_BAR();
    LAS int* tile_e = (LAS int*)(F.lds + LDSCTL_OFF + 1024);
    LAS int* gtab = (LAS int*)(F.lds + LDSCTL_OFF + 1024 + 640);
    if (PH(10)) { REFRESH();
        if (F.tid == 0) { int rowp = 0, ti = 0;
            for (int g = 0; g < 16; ++g) { const int c = (int)__hip_atomic_load((unsigned*)(F.ctl + CW_MOE) + g, RLX_AGENT); const int nt = (c + 255) >> 8;
                gtab[g] = rowp; gtab[17 + g] = c; for (int t = 0; t < nt; ++t) tile_e[ti++] = g & 7; rowp += nt * 256; if (g == 7) gtab[33] = ti; }
            gtab[16] = rowp; }
        LDS_BAR();
        const int rtot = gtab[16];
        for (int cr = gw; cr < rtot; cr += NGW) {
            int g = 0;
#pragma unroll
            for (int q = 1; q < 16; ++q) if (cr >= gtab[q]) g = q;
            const int slot = cr - gtab[g]; const bool valid = slot < gtab[17 + g];
            int tok = -1; float gwv = 0.f, rsv = 0.f;
            if (valid) { tok = W_list[(size_t)g * M + slot]; gwv = W_gwl[(size_t)g * M + slot]; rsv = W_rs4[tok]; }
            if (F.lane == 0) { W_tokc[cr] = tok; W_gwc[cr] = gwv; W_rsc[cr] = rsv; }
            v4u* dst = (v4u*)(W_XG + (size_t)cr * DM) + F.lane;
            if (valid) { const v4u* srcp = (const v4u*)(W_XB + (size_t)tok * DM) + F.lane;
#pragma unroll
                for (int j = 0; j < 4; ++j) dst[64 * j] = srcp[64 * j]; }
            else {
#pragma unroll
                for (int j = 0; j < 4; ++j) dst[64 * j] = (v4u){0u, 0u, 0u, 0u}; }
        }
    }
    GRID_BAR();
    const int RT = gtab[16] >> 8, RT1 = gtab[33];
    if (PH(11)) { REFRESH();
        SchedMoe S{tile_e, 0, RT, F.G, F.bx, (const char*)W_XG, (const char*)W_Wmgu_t, TB2048, TB2048, (size_t)2048 * DM * 2};
        EpiSwiglu<true> E{W_HE, DFE, nullptr, W_rsc};
        pg8::gemm_phase<EpiSwiglu<true>, SchedMoe, true>(F.lds, DM, DM, DM, S, E);
    }
    GRID_BAR();
    if (PH(12)) { REFRESH();
        SchedMoe S{tile_e, 0, RT1, F.G, F.bx, (const char*)W_HE, (const char*)W_Wmd_t, (size_t)256 * DFE * 2, (size_t)256 * DFE * 2, (size_t)DM * DFE * 2};
        EpiMoeDown<false> E{W_X, W_XB, W_sspB, W_tokc, W_gwc};
        pg8::gemm_phase<EpiMoeDown<false>, SchedMoe, true>(F.lds, DFE, DFE, DFE, S, E);
    }
    GRID_BAR();
    if (PH(13)) { REFRESH();
        SchedMoe S{tile_e, RT1, RT, F.G, F.bx, (const char*)W_HE, (const char*)W_Wmd_t, (size_t)256 * DFE * 2, (size_t)256 * DFE * 2, (size_t)DM * DFE * 2};
        EpiMoeDown<true> E{W_X, W_XB, W_sspB, W_tokc, W_gwc};
        pg8::gemm_phase<EpiMoeDown<true>, SchedMoe, true>(F.lds, DFE, DFE, DFE, S, E);
    }
    GRID_BAR();
    if (PH(14)) { REFRESH();
        SchedGrid S; S.o.init(M / 256, DM / 256, F.G, F.bx); S.A = (const char*)W_XB; S.B = (const char*)(W_Wpg_t + (size_t)DM * DM); S.at = TB2048; S.bt = TB2048;
        EpiResid<2, false> E{W_X, W_X, nullptr, W_sspA, nullptr, W_sspB, W_PJ};
        pg8::gemm_phase<EpiResid<2, false>, SchedGrid, true>(F.lds, DM, DM, DM, S, E);
    }
    GRID_BAR();
    REFRESH();
    if (PH(15)) for (int m = gw; m < M; m += NGW) {
        float v = (F.lane < 32) ? W_sspA[(size_t)m * 32 + F.lane] : 0.f; v = wave_sum(v);
        const float rstd = 1.0f / sqrtf(v * (1.0f / DM) + EPS);
        GAS f32x4* xr = (GAS f32x4*)(W_X + (size_t)m * DM) + F.lane; const f32x4* gp = (const f32x4*)I_final_gain + F.lane;
#pragma unroll
        for (int j = 0; j < 8; ++j) xr[64 * j] = xr[64 * j] * rstd * gp[64 * j];
    }
}

extern "C" void kernel_launch(void* const* d_in, const int* in_sizes, int n_in, void* d_out, int out_size, void* d_ws, size_t ws_size, hipStream_t stream) {
    (void)in_sizes; (void)out_size;
    static int grid = 0;
    if (grid == 0) {
        if (n_in != 24 || ws_size < WS_END) { fprintf(stderr, "kernel_launch: bad arguments (n_in %d, ws %zu)\n", n_in, ws_size); grid = -1; return; }
        int dev = 0, cus = 0, per_cu = 0;
        if (hipGetDevice(&dev) != hipSuccess || hipDeviceGetAttribute(&cus, hipDeviceAttributeMultiprocessorCount, dev) != hipSuccess) { grid = -1; return; }
        if (hipFuncSetAttribute((const void*)fwd_kernel, hipFuncAttributeMaxDynamicSharedMemorySize, LDS_BYTES) != hipSuccess) { grid = -1; return; }
        if (hipOccupancyMaxActiveBlocksPerMultiprocessor(&per_cu, (const void*)fwd_kernel, NWAVES * 64, LDS_BYTES) != hipSuccess || per_cu < 1) { fprintf(stderr, "kernel_launch: occupancy query says %d\n", per_cu); }
        (void)hipGetLastError();
        grid = cus;
    }
    if (grid < 0) return;
    if (hipMemsetAsync((char*)d_ws + WS_CTL, 0, CTL_ZERO_BYTES, stream) != hipSuccess) return;
    Args a{};
    for (int i = 0; i < 24; ++i) a.in[i] = (const float*)d_in[i];
    a.out = (float*)d_out; a.ws = (unsigned char*)d_ws;
    hipLaunchKernelGGL(fwd_kernel, dim3(grid), dim3(NWAVES * 64), LDS_BYTES, stream, a);
}
```

```cpp
#include <hip/hip_runtime.h>
#include <cstdio>
#include <cstdint>

constexpr int DM = 2048, BATCH = 8, SEQ = 2048, M = BATCH * SEQ;
constexpr int DH = 1024, NH = 8, HD = 128, CHUNK = 64, DC = 1024, DFF = 5632, NE = 8, DFE = 1024, DPLE = 256;
constexpr int NIN = 7168;
constexpr int UP = 6144;
constexpr float EPS = 1e-6f;
constexpr int NWAVES = 8;

constexpr size_t MiB = 1u << 20;
constexpr size_t WS_CTL = 0, CTL_ZERO_BYTES = 256 * 1024;
constexpr size_t WS_LBV = 1 * MiB;
constexpr size_t WS_RS4 = 1 * MiB + 64 * 1024;
constexpr size_t WS_TOP = 1 * MiB + 192 * 1024;
constexpr size_t WS_TOPW = 1 * MiB + 320 * 1024;
constexpr size_t WS_SSPA = 2 * MiB, WS_SSPB = 4 * MiB;
constexpr size_t WS_LIST = 6 * MiB;
constexpr size_t WS_GWL = 7 * MiB;
constexpr size_t WS_TOKC = 8 * MiB;
constexpr int RCAP = 36864;
constexpr size_t WS_GWC = WS_TOKC + (size_t)RCAP * 4, WS_RSC = WS_GWC + (size_t)RCAP * 4;
constexpr size_t WS_WIN = 10 * MiB;
constexpr size_t WS_WOUT = 38 * MiB;
constexpr size_t WS_WGU = 46 * MiB;
constexpr size_t WS_WD = 90 * MiB;
constexpr size_t WS_WPOOL = 112 * MiB;
constexpr size_t WS_WMGU = 114 * MiB;
constexpr size_t WS_WMD = 178 * MiB;
constexpr size_t WS_WPG = 210 * MiB;
constexpr size_t WS_WPP = 226 * MiB;
constexpr size_t WS_PB = 228 * MiB;
constexpr size_t WS_XB = 244 * MiB;
constexpr size_t WS_A2 = 308 * MiB;
constexpr size_t WS_BIG = 372 * MiB;
constexpr size_t WS_HE = 10 * MiB;
constexpr size_t WS_END = 564 * MiB;
static_assert(WS_BIG + (size_t)M * UP * 2 <= WS_END && WS_HE + (size_t)RCAP * DFE * 2 <= WS_WD, "ws map");
static_assert(WS_BIG + (size_t)RCAP * DM * 2 <= WS_END, "ws map XG");
constexpr int CW_BAR = 4096;
constexpr int CW_MOE = 16384;
constexpr int CW_DBG = 20000;

constexpr int RING_BYTES = 131072;
constexpr int LDSCTL_OFF = RING_BYTES, MISC_OFF = LDSCTL_OFF + 320;
constexpr int LDS_BYTES = 147456;

#define GAS __attribute__((address_space(1)))
#define LAS __attribute__((address_space(3)))
typedef unsigned short bf16;
typedef unsigned v4u __attribute__((ext_vector_type(4)));
typedef unsigned v2u __attribute__((ext_vector_type(2)));
typedef float f32x4 __attribute__((ext_vector_type(4)));
typedef float f32x2 __attribute__((ext_vector_type(2)));
typedef float f32x16 __attribute__((ext_vector_type(16)));
typedef short bf16x8 __attribute__((ext_vector_type(8)));
typedef short bf16x4 __attribute__((ext_vector_type(4)));
typedef GAS unsigned gu32;
#define RLX_AGENT __ATOMIC_RELAXED, __HIP_MEMORY_SCOPE_AGENT
#define LDS_WAIT() asm volatile("s_waitcnt lgkmcnt(0)" ::: "memory")
#define VM_WAIT() asm volatile("s_waitcnt vmcnt(0)" ::: "memory")
#define LDS_BAR() do { asm volatile("s_waitcnt lgkmcnt(0)" ::: "memory"); __builtin_amdgcn_s_barrier(); asm volatile("" ::: "memory"); } while (0)
__device__ __forceinline__ unsigned f2bf(float f) { unsigned u = __builtin_bit_cast(unsigned, f); return (u + 0x7fffu + ((u >> 16) & 1u)) >> 16; }
__device__ __forceinline__ unsigned pk2(float lo, float hi) { return f2bf(lo) | (f2bf(hi) << 16); }
__device__ __forceinline__ unsigned cvt_pk_bf16(float lo, float hi) { unsigned r; asm volatile("v_cvt_pk_bf16_f32 %0, %1, %2" : "=v"(r) : "v"(lo), "v"(hi)); return r; }
__device__ __forceinline__ float bflo(unsigned u) { return __builtin_bit_cast(float, u << 16); }
__device__ __forceinline__ float bfhi(unsigned u) { return __builtin_bit_cast(float, u & 0xffff0000u); }
__device__ __forceinline__ float fast_rcp(float x) { return __builtin_amdgcn_rcpf(x); }
__device__ __forceinline__ float sigmoidf_(float x) { return fast_rcp(1.0f + __expf(-x)); }
__device__ __forceinline__ float siluf_(float x) { return x * sigmoidf_(x); }
__device__ __forceinline__ float wave_sum(float v) {
#pragma unroll
    for (int o = 1; o < 64; o <<= 1) v += __shfl_xor(v, o);
    return v;
}

#define XB_TMO      128
#define XB_XCNT(j)  (256  + 64 * (j))
#define XB_XSUB(j)  (1280 + 64 * (j))
#define XB_XGEN(j)  (2304 + 64 * (j))
#define XB_TOP      3328
#define XB_TOPGEN   3392
#define XCD_BAR_WORDS 3456
#define XB_SPIN_CAP (1u << 18)
__device__ __forceinline__ unsigned xb_ld(unsigned* p)              { return __hip_atomic_load(p, __ATOMIC_RELAXED, __HIP_MEMORY_SCOPE_AGENT); }
__device__ __forceinline__ unsigned xb_add(unsigned* p, unsigned v) { return __hip_atomic_fetch_add(p, v, __ATOMIC_RELAXED, __HIP_MEMORY_SCOPE_AGENT); }
__device__ __forceinline__ unsigned xb_xcc_id() { return (unsigned)__builtin_amdgcn_s_getreg((3 << 11) | 20) & 0xFu; }
#define XB_SPIN(cond, bar) do { unsigned _sp = 0; while (cond) { __builtin_amdgcn_s_sleep(1); \
    if ((++_sp & 255u) == 0u) { if (xb_ld(&(bar)[XB_TMO])) break; if (_sp > XB_SPIN_CAP) { atomicAdd(&(bar)[XB_TMO], 1u); break; } } } } while (0)
struct XcdBarrier { unsigned* bar; unsigned x; volatile LAS unsigned* st; };
__device__ __forceinline__ XcdBarrier xcd_barrier_post(unsigned* bar, volatile LAS unsigned* st) {
    XcdBarrier b; b.bar = bar; b.x = xb_xcc_id(); b.st = st;
    if (threadIdx.x == 0) (void)xb_add(&bar[XB_XCNT(b.x)], 1u);
    return b;
}
__device__ __forceinline__ void xcd_barrier_complete(unsigned* bar, unsigned x, unsigned& nloc, unsigned& nx) {
    const unsigned G = gridDim.x * gridDim.y * gridDim.z;
    unsigned sum, cnt, mine, sp = 0u;
    for (;;) {
        sum = 0u; cnt = 0u; mine = 0u;
#pragma unroll
        for (unsigned j = 0; j < 16; ++j) { const unsigned c = xb_ld(&bar[XB_XCNT(j)]); sum += c; cnt += (c > 0u) ? 1u : 0u; mine = (j == x) ? c : mine; }
        if (sum == G) break;
        __builtin_amdgcn_s_sleep(1);
        if ((++sp & 255u) == 0u) { if (xb_ld(&bar[XB_TMO])) break; if (sp > XB_SPIN_CAP) { atomicAdd(&bar[XB_TMO], 1u); break; } }
    }
    nloc = mine > 0u ? mine : 1u; nx = cnt > 0u ? cnt : 1u;
}
__device__ __forceinline__ void xcd_barrier(const XcdBarrier& b) {
    asm volatile("s_waitcnt vmcnt(0)" ::: "memory");
    __syncthreads();
    if (threadIdx.x == 0) {
        unsigned* bar = b.bar;
        __builtin_amdgcn_s_waitcnt(0);
        unsigned nloc = b.st[0], nx = b.st[1];
        if (nloc == 0u) { xcd_barrier_complete(bar, b.x, nloc, nx); b.st[0] = nloc; b.st[1] = nx; }
        const unsigned old = xb_add(&bar[XB_XSUB(b.x)], 1u);
        const unsigned gen = old / nloc;
        if (old + 1u == (gen + 1u) * nloc) {
            __builtin_amdgcn_fence(__ATOMIC_RELEASE, "agent");
            asm volatile("s_waitcnt vmcnt(0)" ::: "memory");
            const unsigned og = xb_add(&bar[XB_TOP], 1u);
            const unsigned tg = og / nx;
            if (og + 1u == (tg + 1u) * nx) xb_add(&bar[XB_TOPGEN], 1u);
            else XB_SPIN(xb_ld(&bar[XB_TOPGEN]) == tg, bar);
            __builtin_amdgcn_fence(__ATOMIC_ACQUIRE, "agent");
            xb_add(&bar[XB_XGEN(b.x)], 1u);
            asm volatile("s_waitcnt vmcnt(0)" ::: "memory");
        } else {
            XB_SPIN(xb_ld(&bar[XB_XGEN(b.x)]) == gen, bar);
            __builtin_amdgcn_fence(__ATOMIC_ACQUIRE, "agent");
            asm volatile("s_waitcnt vmcnt(0)" ::: "memory");
        }
    }
    __syncthreads();
}

namespace pg8 {
constexpr int BM = 256, BK = 64, HALF = 128, HTB = HALF * BK * 2, STAGE_BYTES = 8 * HTB, NXCD = 8, WGM = 8;
__host__ __device__ __forceinline__ int lds_byte(int r, int c) { const int st = (r >> 4) * 2 + (c >> 5), rr = r & 15, cc = c & 31, ob = rr * 64 + cc * 2; return st * 1024 + (ob ^ (((ob >> 9) & 1) << 5)); }
__host__ __device__ __forceinline__ void stage_rc(int b, int& R, int& C) { const int st = b / 1024, sb = b % 1024, swz = sb ^ (((sb >> 9) & 1) << 5); R = (st >> 1) * 16 + swz / 64; C = (st & 1) * 32 + (swz % 64) / 2; }
__host__ __device__ __forceinline__ int perm32(int rho) { const int n = rho >> 4, i = rho & 15; return 8 * (i >> 2) + 4 * n + (i & 3); }
struct Unit { int pm, pn; const char* a; const char* b; };
struct GridOrder {
    int nM, nN, nwg, G, c;
    __device__ __forceinline__ void init(int nM_, int nN_, int G_, int c_) { nM = nM_; nN = nN_; nwg = nM * nN; G = G_; c = c_; }
    __device__ __forceinline__ bool tile(int i, int& pm, int& pn) const {
        const long L = (long)i * G + c; if (L >= nwg) return false;
        int wgid = (int)L; { const int q = nwg / NXCD, r = nwg % NXCD, xcd = wgid % NXCD, off = wgid / NXCD; wgid = (xcd < r ? xcd * (q + 1) : r * (q + 1) + (xcd - r) * q) + off; }
        const int nig = WGM * nN, gid = wgid / nig, fm = gid * WGM, gsz = (nM - fm) < WGM ? (nM - fm) : WGM;
        pm = fm + ((wgid % nig) % gsz); pn = (wgid % nig) / gsz; return true;
    }
};

template <class Epi, class Sched, bool ALIGN_EPI>
__device__ __forceinline__ void gemm_phase(LAS unsigned char* lds, const int K, const int lda, const int ldb, const Sched& S, const Epi& E) {
    int tid_ = threadIdx.x; asm volatile("" : "+v"(tid_));
    const int tid = tid_, wid = __builtin_amdgcn_readfirstlane(tid >> 6), lane = tid & 63, wr = wid >> 2, wc = wid & 3, fr = lane & 15, fq = lane >> 4;
    const int nt = K / BK;
    unsigned voffA[2], voffB[2];
#pragma unroll
    for (int i = 0; i < 2; ++i) { int R, C; stage_rc(tid * 16 + i * 8192, R, C); const int Rb = Epi::PERM ? ((R & ~31) + perm32(R & 31)) : R;
        voffA[i] = (unsigned)(R * lda + C) * 2u; voffB[i] = (unsigned)(Rb * ldb + C) * 2u; }
    const size_t kstep = (size_t)(BK * 2);
    const size_t hstepA = (size_t)HALF * lda * 2, hstepB = (size_t)HALF * ldb * 2;
    const unsigned ldsw = (unsigned)wid * 1024u;
    const int aoff = lds_byte(wr * 64 + fr, fq * 8), boff = lds_byte(wc * 32 + fr, fq * 8);
#define PG8_SA(b, h) (((b) * 2 + (h)) * HTB)
#define PG8_SB(b, h) ((4 + (b) * 2 + (h)) * HTB)
#define PG8_STAGE(bufoff, gbase, voff) do { _Pragma("unroll") for (int _i = 0; _i < 2; ++_i) \
        __builtin_amdgcn_global_load_lds((const unsigned*)((const char*)(gbase) + (voff)[_i]), (LAS unsigned*)(lds + (bufoff) + ldsw + _i * 8192), 16, 0, 0); } while (0)
#define PG8_LDA(dst, b, h) do { _Pragma("unroll") for (int m = 0; m < 4; ++m) _Pragma("unroll") for (int k = 0; k < 2; ++k) dst[m][k] = *(const LAS bf16x8*)(lds + PG8_SA(b, h) + aoff + m * 2048 + k * 1024); } while (0)
#define PG8_LDB(dst, b, h) do { _Pragma("unroll") for (int n = 0; n < 2; ++n) _Pragma("unroll") for (int k = 0; k < 2; ++k) dst[n][k] = *(const LAS bf16x8*)(lds + PG8_SB(b, h) + boff + n * 2048 + k * 1024); } while (0)
#define PG8_MMA(ai, bj, At, Bt) do { __builtin_amdgcn_s_setprio(1); _Pragma("unroll") for (int m = 0; m < 4; ++m) _Pragma("unroll") for (int n = 0; n < 2; ++n) _Pragma("unroll") for (int k = 0; k < 2; ++k) \
        acc[ai][bj][m][n] = __builtin_amdgcn_mfma_f32_16x16x32_bf16(Bt[n][k], At[m][k], acc[ai][bj][m][n], 0, 0, 0); __builtin_amdgcn_s_setprio(0); } while (0)
#define PG8_WAIT_V(n) asm volatile("s_waitcnt vmcnt(" #n ")" ::: "memory")
#define PG8_WAIT_L(n) asm volatile("s_waitcnt lgkmcnt(" #n ")" ::: "memory")
#define PG8_BAR __builtin_amdgcn_s_barrier()
#define PG8_SCHED __builtin_amdgcn_sched_barrier(0)
    Unit cur, nxt; int ui = 0;
    if (!S.next(0, cur)) return;
    f32x4 acc[2][2][4][2];
#pragma unroll
    for (int a = 0; a < 2; ++a)
#pragma unroll
        for (int b = 0; b < 2; ++b)
#pragma unroll
            for (int m = 0; m < 4; ++m)
#pragma unroll
                for (int n = 0; n < 2; ++n) acc[a][b][m][n] = (f32x4){0.f, 0.f, 0.f, 0.f};
    bf16x8 At[4][2], B0[2][2], B1[2][2];
    const char* cA = cur.a; const char* cB = cur.b;
    PG8_STAGE(PG8_SB(0, 0), cB, voffB); PG8_STAGE(PG8_SB(0, 1), cB + hstepB, voffB); PG8_STAGE(PG8_SA(0, 0), cA, voffA); PG8_STAGE(PG8_SA(0, 1), cA + hstepA, voffA);
    if (wr == 1) PG8_BAR;
    PG8_WAIT_V(2); PG8_BAR;
    PG8_STAGE(PG8_SB(1, 0), cB + kstep, voffB); PG8_STAGE(PG8_SA(1, 0), cA + kstep, voffA); PG8_STAGE(PG8_SB(1, 1), cB + hstepB + kstep, voffB);
    PG8_WAIT_V(6); PG8_BAR;
    for (;;) {
        const bool has_next = S.next(ui + 1, nxt);
        const char* nA = has_next ? nxt.a : cA; const char* nB = has_next ? nxt.b : cB;
#pragma nounroll
        for (int t = 0; t < nt; t += 2) {
            const bool last = (t == nt - 2);
            const char* a1 = cA + (size_t)(t + 1) * kstep;
            const char* a2 = last ? nA : cA + (size_t)(t + 2) * kstep; const char* b2 = last ? nB : cB + (size_t)(t + 2) * kstep;
            const char* a3 = a2 + kstep; const char* b3 = b2 + kstep;
            PG8_LDB(B0, 0, 0); PG8_LDB(B1, 0, 1); PG8_SCHED; PG8_LDA(At, 0, 0); PG8_STAGE(PG8_SA(1, 1), a1 + hstepA, voffA);
            PG8_WAIT_V(8); PG8_WAIT_L(0); PG8_BAR; PG8_MMA(0, 0, At, B0); PG8_MMA(0, 1, At, B1); PG8_BAR; PG8_SCHED;
            PG8_LDA(At, 0, 1); PG8_STAGE(PG8_SB(0, 0), b2, voffB); PG8_STAGE(PG8_SB(0, 1), b2 + hstepB, voffB); PG8_STAGE(PG8_SA(0, 0), a2, voffA);
            PG8_WAIT_V(8); PG8_WAIT_L(0); PG8_BAR; PG8_MMA(1, 0, At, B0); PG8_MMA(1, 1, At, B1); PG8_BAR; PG8_SCHED;
            PG8_LDB(B0, 1, 0); PG8_LDB(B1, 1, 1); PG8_SCHED; PG8_LDA(At, 1, 0); PG8_STAGE(PG8_SA(0, 1), a2 + hstepA, voffA);
            PG8_WAIT_V(8); PG8_WAIT_L(0); PG8_BAR; PG8_MMA(0, 0, At, B0); PG8_MMA(0, 1, At, B1); PG8_BAR; PG8_SCHED;
            PG8_LDA(At, 1, 1); PG8_STAGE(PG8_SB(1, 0), b3, voffB); PG8_STAGE(PG8_SB(1, 1), b3 + hstepB, voffB); PG8_STAGE(PG8_SA(1, 0), a3, voffA);
            PG8_WAIT_V(8); PG8_WAIT_L(0); PG8_BAR; PG8_MMA(1, 0, At, B0); PG8_MMA(1, 1, At, B1); PG8_BAR; PG8_SCHED;
        }
        if constexpr (ALIGN_EPI) { if (wr == 0) PG8_BAR; }
        E(acc, cur, wr, wc, fr, fq);
        if (!has_next) break;
#pragma unroll
        for (int a = 0; a < 2; ++a)
#pragma unroll
            for (int b = 0; b < 2; ++b)
#pragma unroll
                for (int m = 0; m < 4; ++m)
#pragma unroll
                    for (int n = 0; n < 2; ++n) acc[a][b][m][n] = (f32x4){0.f, 0.f, 0.f, 0.f};
        cur = nxt; cA = nA; cB = nB; ++ui;
        if constexpr (ALIGN_EPI) { if (wr == 1) PG8_BAR; }
    }
    PG8_WAIT_V(0);
    if constexpr (!ALIGN_EPI) { if (wr == 0) PG8_BAR; }
    PG8_BAR;
#undef PG8_SA
#undef PG8_SB
#undef PG8_STAGE
#undef PG8_LDA
#undef PG8_LDB
#undef PG8_MMA
#undef PG8_WAIT_V
#undef PG8_WAIT_L
#undef PG8_BAR
#undef PG8_SCHED
}
}
using pg8::Unit;

struct SchedGrid {
    pg8::GridOrder o; const char* A; const char* B; size_t at, bt;
    __device__ __forceinline__ bool next(int i, Unit& u) const { if (!o.tile(i, u.pm, u.pn)) return false; u.a = A + (size_t)u.pm * at; u.b = B + (size_t)u.pn * bt; return true; }
};
struct SchedPool {
    pg8::GridOrder o; const char* A; const char* B; size_t at, bt;
    __device__ __forceinline__ bool next(int i, Unit& u) const { if (!o.tile(i, u.pm, u.pn)) return false; u.a = A + (size_t)u.pm * at + (size_t)(u.pn >> 1) * 1024; u.b = B + (size_t)u.pn * bt; return true; }
};
struct SchedPJ {
    pg8::GridOrder o; const char* A; const char* B; size_t at, bt;
    __device__ __forceinline__ bool next(int i, Unit& u) const { if (!o.tile(i, u.pm, u.pn)) return false; u.a = A + (size_t)u.pm * at; u.b = B + (size_t)((u.pm >> 6) * 8 + u.pn) * bt; return true; }
};
struct SchedMoe {
    const LAS int* tile_e; int rt0, rt1, G, c; const char* A; const char* B; size_t at, bt, be;
    __device__ __forceinline__ bool next(int i, Unit& u) const {
        const int L = i * G + c, n = (rt1 - rt0) * 8; if (L >= n) return false;
        u.pm = rt0 + (L >> 3); u.pn = L & 7; const int e = tile_e[u.pm];
        u.a = A + (size_t)u.pm * at; u.b = B + (size_t)e * be + (size_t)u.pn * bt; return true; }
};

__device__ __forceinline__ void load_rstd(const float* ssp, int row0, int fq, float (&rs)[2][4]) {
#pragma unroll
    for (int ai = 0; ai < 2; ++ai)
#pragma unroll
        for (int m = 0; m < 4; ++m) {
            const float* sp = ssp + (size_t)(row0 + ai * 128 + m * 16) * 32 + fq * 8;
            const f32x4 a = *(const f32x4*)sp, b = *(const f32x4*)(sp + 4);
            float s = ((a[0] + a[1]) + (a[2] + a[3])) + ((b[0] + b[1]) + (b[2] + b[3]));
            s += __shfl_xor(s, 16); s += __shfl_xor(s, 32);
            rs[ai][m] = 1.0f / sqrtf(s * (1.0f / DM) + EPS);
        }
}
struct EpiInProj {
    static constexpr bool PERM = true;
    bf16* U; const float* ssp; const float* lbv;
    __device__ __forceinline__ void operator()(const f32x4 (&acc)[2][2][4][2], const Unit& u, int wr, int wc, int fr, int fq) const {
        const int row0 = u.pm * 256 + wr * 64 + fr;
        float rs[2][4]; load_rstd(ssp, row0, fq, rs);
        const int pn = u.pn;
        if (pn >= 20) {
            const int col0 = 5120 + (pn - 20) * 128 + wc * 32 + 8 * fq;
#pragma unroll
            for (int ai = 0; ai < 2; ++ai)
#pragma unroll
                for (int m = 0; m < 4; ++m) { const float r2 = rs[ai][m] * rs[ai][m];
                    const f32x4 a0 = acc[ai][0][m][0] * acc[ai][1][m][0] * r2, a1 = acc[ai][0][m][1] * acc[ai][1][m][1] * r2;
                    v4u w; w.x = cvt_pk_bf16(a0[0], a0[1]); w.y = cvt_pk_bf16(a0[2], a0[3]); w.z = cvt_pk_bf16(a1[0], a1[1]); w.w = cvt_pk_bf16(a1[2], a1[3]);
                    *(v4u*)(U + (size_t)(row0 + ai * 128 + m * 16) * UP + col0) = w; }
            return;
        }
        const int kind = pn >> 2;
        const int col0 = pn * 256 + wc * 32 + 8 * fq;
        f32x4 lb[2][2];
        if (kind == 1) {
#pragma unroll
            for (int bj = 0; bj < 2; ++bj)
#pragma unroll
                for (int n = 0; n < 2; ++n) lb[bj][n] = *(const f32x4*)(lbv + (col0 - 1024) + bj * 128 + 4 * n);
            asm volatile("" :: "v"(lb[0][0]), "v"(lb[0][1]), "v"(lb[1][0]), "v"(lb[1][1]));
        }
#pragma unroll
        for (int ai = 0; ai < 2; ++ai)
#pragma unroll
            for (int m = 0; m < 4; ++m) { bf16* rowp = U + (size_t)(row0 + ai * 128 + m * 16) * UP + col0; const float r = rs[ai][m];
#pragma unroll
                for (int bj = 0; bj < 2; ++bj) { f32x4 v0 = acc[ai][bj][m][0] * r, v1 = acc[ai][bj][m][1] * r;
                    if (kind == 0 || kind == 3) {
#pragma unroll
                        for (int j = 0; j < 4; ++j) { v0[j] = siluf_(v0[j]); v1[j] = siluf_(v1[j]); }
                    } else if (kind == 1) {
#pragma unroll
                        for (int j = 0; j < 4; ++j) { v0[j] = __logf(lb[bj][0][j] + (1.0f - lb[bj][0][j]) * sigmoidf_(v0[j])); v1[j] = __logf(lb[bj][1][j] + (1.0f - lb[bj][1][j]) * sigmoidf_(v1[j])); }
                    }
                    v4u w; w.x = cvt_pk_bf16(v0[0], v0[1]); w.y = cvt_pk_bf16(v0[2], v0[3]); w.z = cvt_pk_bf16(v1[0], v1[1]); w.w = cvt_pk_bf16(v1[2], v1[3]);
                    *(v4u*)(rowp + bj * 128) = w; } }
    }
};
struct EpiBf16Plain {
    static constexpr bool PERM = true;
    bf16* O; int ldc;
    __device__ __forceinline__ void operator()(const f32x4 (&acc)[2][2][4][2], const Unit& u, int wr, int wc, int fr, int fq) const {
        const int row0 = u.pm * 256 + wr * 64 + fr, col0 = u.pn * 256 + wc * 32 + 8 * fq;
#pragma unroll
        for (int ai = 0; ai < 2; ++ai)
#pragma unroll
            for (int m = 0; m < 4; ++m) { bf16* rowp = O + (size_t)(row0 + ai * 128 + m * 16) * ldc + col0;
#pragma unroll
                for (int bj = 0; bj < 2; ++bj) { const f32x4 v0 = acc[ai][bj][m][0], v1 = acc[ai][bj][m][1];
                    v4u w; w.x = cvt_pk_bf16(v0[0], v0[1]); w.y = cvt_pk_bf16(v0[2], v0[3]); w.z = cvt_pk_bf16(v1[0], v1[1]); w.w = cvt_pk_bf16(v1[2], v1[3]);
                    *(v4u*)(rowp + bj * 128) = w; } }
    }
};
template <bool ROWTAB> struct EpiSwiglu {
    static constexpr bool PERM = true;
    bf16* H; int ldc; const float* ssp; const float* rtab;
    __device__ __forceinline__ void operator()(const f32x4 (&acc)[2][2][4][2], const Unit& u, int wr, int wc, int fr, int fq) const {
        const int row0 = u.pm * 256 + wr * 64 + fr, col0 = u.pn * 128 + wc * 32 + 8 * fq;
        float rs[2][4];
        if constexpr (ROWTAB) {
#pragma unroll
            for (int ai = 0; ai < 2; ++ai)
#pragma unroll
                for (int m = 0; m < 4; ++m) rs[ai][m] = rtab[row0 + ai * 128 + m * 16];
        } else load_rstd(ssp, row0, fq, rs);
#pragma unroll
        for (int ai = 0; ai < 2; ++ai)
#pragma unroll
            for (int m = 0; m < 4; ++m) { const float r = rs[ai][m];
                f32x4 h0, h1;
#pragma unroll
                for (int j = 0; j < 4; ++j) { h0[j] = siluf_(acc[ai][0][m][0][j] * r) * (acc[ai][1][m][0][j] * r); h1[j] = siluf_(acc[ai][0][m][1][j] * r) * (acc[ai][1][m][1][j] * r); }
                v4u w; w.x = cvt_pk_bf16(h0[0], h0[1]); w.y = cvt_pk_bf16(h0[2], h0[3]); w.z = cvt_pk_bf16(h1[0], h1[1]); w.w = cvt_pk_bf16(h1[2], h1[3]);
                *(v4u*)(H + (size_t)(row0 + ai * 128 + m * 16) * ldc + col0) = w; }
    }
};
__device__ __forceinline__ void unpack8(const v4u w, f32x4& a, f32x4& b) { a[0] = bflo(w.x); a[1] = bfhi(w.x); a[2] = bflo(w.y); a[3] = bfhi(w.y); b[0] = bflo(w.z); b[1] = bfhi(w.z); b[2] = bflo(w.w); b[3] = bfhi(w.w); }
template <int MODE  , bool XF32> struct EpiResid {
    static constexpr bool PERM = true;
    const float* xf; const bf16* xold; bf16* xnew; float* ssp_out; const float* colscale; const float* ssp_in; const bf16* PJ;
    __device__ __forceinline__ void operator()(const f32x4 (&acc)[2][2][4][2], const Unit& u, int wr, int wc, int fr, int fq) const {
        const int row0 = u.pm * 256 + wr * 64 + fr, col0 = u.pn * 256 + wc * 32 + 8 * fq;
        float rs[2][4];
        if constexpr (MODE == 2) load_rstd(ssp_in, row0, fq, rs);
        f32x4 cs[2][2];
        if constexpr (MODE == 1) {
#pragma unroll
            for (int bj = 0; bj < 2; ++bj)
#pragma unroll
                for (int n = 0; n < 2; ++n) cs[bj][n] = *(const f32x4*)(colscale + col0 + bj * 128 + 4 * n);
        }
#pragma unroll
        for (int ai = 0; ai < 2; ++ai)
#pragma unroll
            for (int m = 0; m < 4; ++m) { const int row = row0 + ai * 128 + m * 16; const size_t off = (size_t)row * DM + col0; float ss = 0.f;
#pragma unroll
                for (int bj = 0; bj < 2; ++bj) { const size_t o = off + bj * 128; f32x4 v0 = acc[ai][bj][m][0], v1 = acc[ai][bj][m][1];
                    if constexpr (MODE == 1) { v0 = v0 * cs[bj][0]; v1 = v1 * cs[bj][1]; }
                    if constexpr (MODE == 2) { f32x4 p0, p1; unpack8(*(const v4u*)(PJ + o), p0, p1); const float r = rs[ai][m];
#pragma unroll
                        for (int j = 0; j < 4; ++j) { v0[j] = sigmoidf_(v0[j] * r) * p0[j]; v1[j] = sigmoidf_(v1[j] * r) * p1[j]; } }
                    f32x4 x0, x1;
                    if constexpr (XF32) { x0 = *(const f32x4*)(xf + o); x1 = *(const f32x4*)(xf + o + 4); } else unpack8(*(const v4u*)(xold + o), x0, x1);
                    x0 += v0; x1 += v1;
                    v4u w; w.x = cvt_pk_bf16(x0[0], x0[1]); w.y = cvt_pk_bf16(x0[2], x0[3]); w.z = cvt_pk_bf16(x1[0], x1[1]); w.w = cvt_pk_bf16(x1[2], x1[3]);
                    *(v4u*)(xnew + o) = w;
                    ss += ((x0[0] * x0[0] + x0[1] * x0[1]) + (x0[2] * x0[2] + x0[3] * x0[3])) + ((x1[0] * x1[0] + x1[1] * x1[1]) + (x1[2] * x1[2] + x1[3] * x1[3])); }
                ss += __shfl_xor(ss, 16); ss += __shfl_xor(ss, 32);
                if (fq == 0) ssp_out[(size_t)row * 32 + u.pn * 4 + wc] = ss;
            }
    }
};
template <bool RANK2> struct EpiMoeDown {
    static constexpr bool PERM = true;
    bf16* X; float* ssp_out; const int* tokc; const float* gwc;
    __device__ __forceinline__ void operator()(const f32x4 (&acc)[2][2][4][2], const Unit& u, int wr, int wc, int fr, int fq) const {
        const int row0 = u.pm * 256 + wr * 64 + fr, col0 = u.pn * 256 + wc * 32 + 8 * fq;
#pragma unroll
        for (int ai = 0; ai < 2; ++ai)
#pragma unroll
            for (int m = 0; m < 4; ++m) { const int cr = row0 + ai * 128 + m * 16; const int tok = tokc[cr]; const float gw = gwc[cr]; const bool ok = tok >= 0;
                const size_t off = (size_t)(ok ? tok : 0) * DM + col0; float ss = 0.f;
#pragma unroll
                for (int bj = 0; bj < 2; ++bj) { const size_t o = off + bj * 128;
                    if (ok) { f32x4 x0, x1; unpack8(*(const v4u*)(X + o), x0, x1); x0 += acc[ai][bj][m][0] * gw; x1 += acc[ai][bj][m][1] * gw;
                        v4u w; w.x = cvt_pk_bf16(x0[0], x0[1]); w.y = cvt_pk_bf16(x0[2], x0[3]); w.z = cvt_pk_bf16(x1[0], x1[1]); w.w = cvt_pk_bf16(x1[2], x1[3]);
                        *(v4u*)(X + o) = w;
                        if constexpr (RANK2) ss += ((x0[0] * x0[0] + x0[1] * x0[1]) + (x0[2] * x0[2] + x0[3] * x0[3])) + ((x1[0] * x1[0] + x1[1] * x1[1]) + (x1[2] * x1[2] + x1[3] * x1[3])); } }
                if constexpr (RANK2) { ss += __shfl_xor(ss, 16); ss += __shfl_xor(ss, 32);
                    if (fq == 0 && ok) ssp_out[(size_t)tok * 32 + u.pn * 4 + wc] = ss; }
            }
    }
};

struct Args { const float* in[24]; float* out; unsigned char* ws; };
struct Frame {
    LAS unsigned char* lds; volatile LAS unsigned* MISC; gu32* ctl;
    int tid, lane, wave, G, bx;
};

constexpr int TRP = 136;
__device__ __forceinline__ void tr_item(const float* W, int ldw, int k0, int scol0, bf16* WT, int ldt, int drow0, const float* gain, LAS unsigned char* scr, int lane) {
    f32x4 v[16];
    const float* src = W + (size_t)(k0 + (lane >> 4)) * ldw + scol0 + 4 * (lane & 15);
#pragma unroll
    for (int i = 0; i < 16; ++i) v[i] = *(const f32x4*)(src + (size_t)(4 * i) * ldw);
#pragma unroll
    for (int i = 0; i < 16; ++i) { const int kk = 4 * i + (lane >> 4); const float g = gain ? gain[k0 + kk] : 1.0f;
        v2u w; w.x = cvt_pk_bf16(v[i][0] * g, v[i][1] * g); w.y = cvt_pk_bf16(v[i][2] * g, v[i][3] * g);
        *(LAS v2u*)(scr + kk * TRP + 8 * (lane & 15)) = w; }
    LDS_WAIT(); asm volatile("" ::: "memory");
    const int c = lane & 7;
#pragma unroll
    for (int j = 0; j < 8; ++j) { const int n = (lane >> 3) + 8 * j; const LAS unsigned short* s = (const LAS unsigned short*)(scr + (8 * c) * TRP + 2 * n);
        v4u o; o.x = (unsigned)s[0] | ((unsigned)s[TRP / 2] << 16); o.y = (unsigned)s[2 * (TRP / 2)] | ((unsigned)s[3 * (TRP / 2)] << 16);
        o.z = (unsigned)s[4 * (TRP / 2)] | ((unsigned)s[5 * (TRP / 2)] << 16); o.w = (unsigned)s[6 * (TRP / 2)] | ((unsigned)s[7 * (TRP / 2)] << 16);
        *(GAS v4u*)(WT + (size_t)(drow0 + n) * ldt + k0 + 8 * c) = o; }
    LDS_WAIT(); asm volatile("" ::: "memory");
}
struct TrJob { const float* W0; const float* W1; int c0, c1, ldw, K, N, NP; bf16* WT; const float* gain; };
__device__ __forceinline__ int tr_items(const TrJob& J) { return (J.K / 64) * (J.NP ? J.NP * 4 : J.N / 64); }
__device__ __forceinline__ void tr_run(const TrJob& J, int it, LAS unsigned char* scr, int lane) {
    const int nnb = J.NP ? J.NP * 4 : J.N / 64, kb = it / nnb, nb = it % nnb;
    if (J.NP) { const int j = nb >> 2, q = nb & 3; const float* W = (q < 2) ? J.W0 : J.W1; const int sc = ((q < 2) ? J.c0 : J.c1) + 128 * j + 64 * (q & 1);
        tr_item(W, J.ldw, kb * 64, sc, J.WT, J.K, nb * 64, J.gain, scr, lane); }
    else tr_item(J.W0, J.ldw, kb * 64, J.c0 + nb * 64, J.WT, J.K, nb * 64, J.gain, scr, lane);
}
__device__ __forceinline__ int tr_job(const TrJob& J, int base, int wv, int nw, LAS unsigned char* scr, int lane) {
    const int nit = tr_items(J);
    int first = (wv - base % nw + nw) % nw;
    for (int it = first; it < nit; it += nw) tr_run(J, it, scr, lane);
    return base + nit;
}

constexpr int H_QT = 0, H_KT = 17408, H_QC = 34816, H_KH = 52224, H_VT = 70656, H_TOT = 89088, H_DEC = 93184, H_NRM = 93696, H_END = 94720;
constexpr int TP = 272  , CP = 144  ;
__device__ __forceinline__ f32x16 mfma32(bf16x8 a, bf16x8 b, f32x16 c) { return __builtin_amdgcn_mfma_f32_32x32x16_bf16(a, b, c, 0, 0, 0); }
__device__ __forceinline__ bf16x8 pack8(const f32x16& v, int o) {
    v4u w; w.x = cvt_pk_bf16(v[o + 0], v[o + 1]); w.y = cvt_pk_bf16(v[o + 2], v[o + 3]); w.z = cvt_pk_bf16(v[o + 4], v[o + 5]); w.w = cvt_pk_bf16(v[o + 6], v[o + 7]);
    return __builtin_bit_cast(bf16x8, w);
}
__device__ __forceinline__ bf16x8 ld2x8(const LAS unsigned char* p) {
    const v2u a = *(const LAS v2u*)p, b = *(const LAS v2u*)(p + 16); v4u w; w.x = a.x; w.y = a.y; w.z = b.x; w.w = b.y; return __builtin_bit_cast(bf16x8, w);
}
__device__ __forceinline__ void hgrn_phase(Frame& F, const bf16* U, bf16* A2, const float* hgain) {
    const int b = F.bx >> 3, h = F.bx & 7, w = F.wave, lane = F.lane;
    LAS unsigned char* L = F.lds;
    const int eb = w >> 1, tb = w & 1, r = lane & 31, hh = lane >> 5;
    f32x16 S[4];
#pragma unroll
    for (int d = 0; d < 4; ++d)
#pragma unroll
        for (int i = 0; i < 16; ++i) S[d][i] = 0.f;
    const size_t rowbase0 = (size_t)b * SEQ;
    unsigned lf_[8], qs_[8], v_[8], lf32_;
    v2u gs_[4], gsn_[4];
    const bf16* Ucol = U + h * HD + 2 * lane;
    f32x4 gn_[4];
#pragma unroll
    for (int q = 0; q < 4; ++q) gn_[q] = *(const f32x4*)(hgain + h * HD + 32 * eb + 8 * q + 4 * hh);
    const bf16* Ugs = U + 3072 + h * HD + 32 * eb + 4 * hh + (size_t)(32 * tb + r) * UP;
#define HG_LOADGS(dst, n) do { _Pragma("unroll") for (int q = 0; q < 4; ++q) dst[q] = *(const v2u*)(Ugs + (rowbase0 + (size_t)(n) * CHUNK) * UP + 8 * q); } while (0)
#define HG_LOAD(n) do { const bf16* p = Ucol + (rowbase0 + (size_t)(n) * CHUNK + 8 * w) * UP; \
        _Pragma("unroll") for (int j = 0; j < 8; ++j) { qs_[j] = *(const unsigned*)(p + (size_t)j * UP); lf_[j] = *(const unsigned*)(p + (size_t)j * UP + 1024); v_[j] = *(const unsigned*)(p + (size_t)j * UP + 2048); } \
        lf32_ = *(const unsigned*)(Ucol + (rowbase0 + (size_t)(n) * CHUNK + 32) * UP + 1024); } while (0)
    HG_LOAD(0); HG_LOADGS(gs_, 0);
    for (int n = 0; n < SEQ / CHUNK; ++n) {
        const size_t rowbase = rowbase0 + (size_t)n * CHUNK;
        float c0[8], c1[8];
        { float a0 = 0.f, a1 = 0.f;
#pragma unroll
          for (int j = 0; j < 8; ++j) { a0 += bflo(lf_[j]); a1 += bfhi(lf_[j]); c0[j] = a0; c1[j] = a1; }
          *(LAS f32x2*)(L + H_TOT + (w * 128 + 2 * lane) * 4) = (f32x2){a0, a1}; }
        LDS_BAR();
        { float pre0 = 0.f, pre1 = 0.f, ref0 = 0.f, ref1 = 0.f, last0 = 0.f, last1 = 0.f;
#pragma unroll
          for (int ww = 0; ww < 8; ++ww) { const f32x2 t = *(const LAS f32x2*)(L + H_TOT + (ww * 128 + 2 * lane) * 4);
              if (ww < w) { pre0 += t.x; pre1 += t.y; } if (ww < 4) { ref0 += t.x; ref1 += t.y; } last0 += t.x; last1 += t.y; }
          ref0 += bflo(lf32_); ref1 += bfhi(lf32_);
          const float eref0 = __expf(ref0), eref1 = __expf(ref1), elr0 = __expf(last0 - ref0), elr1 = __expf(last1 - ref1);
          if (w == 0) *(LAS f32x2*)(L + H_DEC + 2 * lane * 4) = (f32x2){__expf(last0), __expf(last1)};
          unsigned kh0[4], kh1[4], vt0[4], vt1[4];
#pragma unroll
          for (int j = 0; j < 8; ++j) {
              const float cum0 = pre0 + c0[j], cum1 = pre1 + c1[j];
              const float E10 = __expf(cum0 - ref0), E11 = __expf(cum1 - ref1), E20 = fast_rcp(E10), E21 = fast_rcp(E11);
              const float k0 = 1.0f - __expf(bflo(lf_[j])), k1 = 1.0f - __expf(bfhi(lf_[j]));
              const float q0 = bflo(qs_[j]), q1 = bfhi(qs_[j]);
              const float qt0 = q0 * E10, qt1 = q1 * E11, kt0 = k0 * E20, kt1 = k1 * E21;
              const int t = 8 * w + j;
              *(LAS unsigned*)(L + H_QT + t * TP + 4 * lane) = cvt_pk_bf16(qt0, qt1);
              *(LAS unsigned*)(L + H_KT + t * TP + 4 * lane) = cvt_pk_bf16(kt0, kt1);
              *(LAS unsigned*)(L + H_QC + t * TP + 4 * lane) = cvt_pk_bf16(qt0 * eref0, qt1 * eref1);
              const unsigned kk = cvt_pk_bf16(kt0 * elr0, kt1 * elr1);
              if (j & 1) { kh0[j >> 1] |= (kk << 16); kh1[j >> 1] |= (kk & 0xffff0000u); vt0[j >> 1] |= (v_[j] << 16); vt1[j >> 1] |= (v_[j] & 0xffff0000u); }
              else { kh0[j >> 1] = kk & 0xffffu; kh1[j >> 1] = kk >> 16; vt0[j >> 1] = v_[j] & 0xffffu; vt1[j >> 1] = v_[j] >> 16; }
          }
          *(LAS v4u*)(L + H_KH + (2 * lane) * CP + 16 * w) = (v4u){kh0[0], kh0[1], kh0[2], kh0[3]};
          *(LAS v4u*)(L + H_KH + (2 * lane + 1) * CP + 16 * w) = (v4u){kh1[0], kh1[1], kh1[2], kh1[3]};
          *(LAS v4u*)(L + H_VT + (2 * lane) * CP + 16 * w) = (v4u){vt0[0], vt0[1], vt0[2], vt0[3]};
          *(LAS v4u*)(L + H_VT + (2 * lane + 1) * CP + 16 * w) = (v4u){vt1[0], vt1[1], vt1[2], vt1[3]};
        }
        LDS_BAR();
        if (n + 1 < SEQ / CHUNK) { HG_LOAD(n + 1); HG_LOADGS(gsn_, n + 1); }
        f32x16 O;
#pragma unroll
        for (int i = 0; i < 16; ++i) O[i] = 0.f;
#pragma unroll
        for (int sb = 0; sb < 2; ++sb) {
            if (sb <= tb) {
                f32x16 P;
#pragma unroll
                for (int i = 0; i < 16; ++i) P[i] = 0.f;
#pragma unroll
                for (int ks = 0; ks < 8; ++ks) {
                    const bf16x8 a = *(const LAS bf16x8*)(L + H_KT + (32 * sb + r) * TP + (16 * ks + 8 * hh) * 2);
                    const bf16x8 bq = *(const LAS bf16x8*)(L + H_QT + (32 * tb + r) * TP + (16 * ks + 8 * hh) * 2);
                    P = mfma32(a, bq, P);
                }
                if (sb == tb) {
#pragma unroll
                    for (int i = 0; i < 16; ++i) { const int s = (i & 3) + 8 * (i >> 2) + 4 * hh; if (s > r) P[i] = 0.f; }
                }
#pragma unroll
                for (int k2 = 0; k2 < 2; ++k2) {
                    const bf16x8 av = ld2x8(L + H_VT + (32 * eb + r) * CP + (32 * sb + 16 * k2 + 4 * hh) * 2);
                    O = mfma32(av, pack8(P, 8 * k2), O);
                }
            }
        }
#pragma unroll
        for (int db = 0; db < 4; ++db)
#pragma unroll
            for (int k2 = 0; k2 < 2; ++k2) {
                const bf16x8 bq = ld2x8(L + H_QC + (32 * tb + r) * TP + (32 * db + 16 * k2 + 4 * hh) * 2);
                O = mfma32(pack8(S[db], 8 * k2), bq, O);
            }
#pragma unroll
        for (int db = 0; db < 4; ++db) {
#pragma unroll
            for (int q = 0; q < 4; ++q) { const f32x4 dc = *(const LAS f32x4*)(L + H_DEC + (32 * db + 8 * q + 4 * hh) * 4);
                S[db][4 * q + 0] *= dc[0]; S[db][4 * q + 1] *= dc[1]; S[db][4 * q + 2] *= dc[2]; S[db][4 * q + 3] *= dc[3]; }
#pragma unroll
            for (int ks = 0; ks < 4; ++ks) {
                const bf16x8 a = *(const LAS bf16x8*)(L + H_KH + (32 * db + r) * CP + (16 * ks + 8 * hh) * 2);
                const bf16x8 bv = *(const LAS bf16x8*)(L + H_VT + (32 * eb + r) * CP + (16 * ks + 8 * hh) * 2);
                S[db] = mfma32(a, bv, S[db]);
            }
        }
        float ssq = 0.f;
#pragma unroll
        for (int i = 0; i < 16; ++i) ssq += O[i] * O[i];
        ssq += __shfl_xor(ssq, 32);
        if (hh == 0) *(LAS float*)(L + H_NRM + (eb * 64 + 32 * tb + r) * 4) = ssq;
        LDS_BAR();
        { float tot = 0.f;
#pragma unroll
          for (int e4 = 0; e4 < 4; ++e4) tot += *(const LAS float*)(L + H_NRM + (e4 * 64 + 32 * tb + r) * 4);
          const float rstd = 1.0f / sqrtf(tot * (1.0f / HD) + EPS);
          const size_t row = rowbase + 32 * tb + r;
#pragma unroll
          for (int q = 0; q < 4; ++q) { const int e0 = 32 * eb + 8 * q + 4 * hh;
              const f32x4 gn = gn_[q]; const v2u gs = gs_[q];
              const float o0 = O[4 * q + 0] * rstd * gn[0] * bflo(gs.x), o1 = O[4 * q + 1] * rstd * gn[1] * bfhi(gs.x);
              const float o2 = O[4 * q + 2] * rstd * gn[2] * bflo(gs.y), o3 = O[4 * q + 3] * rstd * gn[3] * bfhi(gs.y);
              v2u wv; wv.x = cvt_pk_bf16(o0, o1); wv.y = cvt_pk_bf16(o2, o3);
              *(v2u*)(A2 + row * DM + h * HD + e0) = wv; }
        }
#pragma unroll
        for (int q = 0; q < 4; ++q) gs_[q] = gsn_[q];
    }
#undef HG_LOAD
#undef HG_LOADGS
}
__device__ __forceinline__ void conv_phase(Frame& F, const bf16* U, bf16* A2, const float* convw, int first_block) {
    const int nb = F.G - first_block, me = F.bx - first_block, c = 2 * F.tid;
    const float w00 = convw[c], w01 = convw[c + 1], w10 = convw[DC + c], w11 = convw[DC + c + 1], w20 = convw[2 * DC + c], w21 = convw[2 * DC + c + 1];
    for (int u = me; u < M / 32; u += nb) {
        const int R0 = u * 32, t0 = R0 % SEQ;
        const bf16* up = U + (size_t)R0 * UP;
        float a0 = 0.f, a1 = 0.f, b0 = 0.f, b1 = 0.f;
        if (t0 != 0) { const unsigned p2 = *(const unsigned*)(up - 2 * (size_t)UP + 5120 + c), p1 = *(const unsigned*)(up - (size_t)UP + 5120 + c);
            a0 = bflo(p2); a1 = bfhi(p2); b0 = bflo(p1); b1 = bfhi(p1); }
#pragma unroll 8
        for (int j = 0; j < 32; ++j) {
            const unsigned tt = *(const unsigned*)(up + (size_t)j * UP + 5120 + c), gb = *(const unsigned*)(up + (size_t)j * UP + 4096 + c);
            const float t0f = bflo(tt), t1f = bfhi(tt);
            const float y0 = bflo(gb) * (w00 * a0 + w10 * b0 + w20 * t0f), y1 = bfhi(gb) * (w01 * a1 + w11 * b1 + w21 * t1f);
            *(unsigned*)(A2 + (size_t)(R0 + j) * DM + DH + c) = cvt_pk_bf16(y0, y1);
            a0 = b0; a1 = b1; b0 = t0f; b1 = t1f;
        }
    }
}

#ifndef PH_ENABLE
#define PH_ENABLE 0xffffffffu
#endif
#define PH(k) (((PH_ENABLE) >> (k)) & 1u)
#ifndef PROBE_DUP
#define PROBE_DUP (-1)
#endif
#define REPS(k) ((PROBE_DUP) == (k) ? 2 : 1)
__global__ void __launch_bounds__(NWAVES * 64, 2) fwd_kernel(Args args) {
    extern __shared__ __attribute__((aligned(16))) unsigned char lds[];
    Frame F;
    F.lds = (LAS unsigned char*)lds;
    F.MISC = (volatile LAS unsigned*)(F.lds + MISC_OFF);
    F.tid = threadIdx.x; F.lane = F.tid & 63; F.wave = __builtin_amdgcn_readfirstlane(F.tid >> 6);
    F.G = gridDim.x; F.bx = blockIdx.x;
    unsigned char* ws = args.ws;
    F.ctl = (gu32*)(ws + WS_CTL);
    for (int u = F.tid; u < (LDS_BYTES - LDSCTL_OFF) / 4; u += NWAVES * 64) ((LAS unsigned*)(F.lds + LDSCTL_OFF))[u] = 0u;
    __syncthreads();
    XcdBarrier bar = xcd_barrier_post((unsigned*)(F.ctl + CW_BAR), F.MISC + 8);
#define GRID_BAR() xcd_barrier(bar)
#define REFRESH() do { int t_ = threadIdx.x; asm volatile("" : "+v"(t_)); F.tid = t_; F.lane = t_ & 63; F.wave = __builtin_amdgcn_readfirstlane(t_ >> 6); \
        int b_ = blockIdx.x; asm volatile("" : "+s"(b_)); F.bx = b_; gw = F.bx * NWAVES + F.wave; \
        kp_ = (const float* const __attribute__((address_space(4)))*)__builtin_amdgcn_kernarg_segment_ptr(); asm volatile("" : "+s"(kp_)); \
        ws_ = (unsigned char*)kp_[25]; X_ = (float*)kp_[24]; } while (0)
    const float* const __attribute__((address_space(4)))* kp_ = (const float* const __attribute__((address_space(4)))*)__builtin_amdgcn_kernarg_segment_ptr();
    unsigned char* ws_ = args.ws; float* X_ = args.out;
#define I_x (kp_[0])
#define I_p (kp_[1])
#define I_final_gain (kp_[2])
#define I_lb_table (kp_[3])
#define I_mix_norm_even (kp_[4])
#define I_w_in (kp_[5])
#define I_hgrn_gain (kp_[6])
#define I_conv_w (kp_[7])
#define I_w_out (kp_[8])
#define I_ffn_norm_even (kp_[9])
#define I_w_gate (kp_[10])
#define I_w_up (kp_[11])
#define I_w_down (kp_[12])
#define I_mix_norm_odd (kp_[13])
#define I_pool_w (kp_[14])
#define I_pool_scale (kp_[15])
#define I_ffn_norm_odd (kp_[16])
#define I_w_router (kp_[17])
#define I_w_gate_e (kp_[18])
#define I_w_up_e (kp_[19])
#define I_w_down_e (kp_[20])
#define I_ple_norm (kp_[21])
#define I_ple_gate_w (kp_[22])
#define I_ple_proj (kp_[23])
#define W_lbv ((float*)(ws_ + WS_LBV))
#define W_rs4 ((float*)(ws_ + WS_RS4))
#define W_topi ((int*)(ws_ + WS_TOP))
#define W_topw ((float*)(ws_ + WS_TOPW))
#define W_sspA ((float*)(ws_ + WS_SSPA))
#define W_sspB ((float*)(ws_ + WS_SSPB))
#define W_list ((int*)(ws_ + WS_LIST))
#define W_gwl ((float*)(ws_ + WS_GWL))
#define W_tokc ((int*)(ws_ + WS_TOKC))
#define W_gwc ((float*)(ws_ + WS_GWC))
#define W_rsc ((float*)(ws_ + WS_RSC))
#define W_Win_t ((bf16*)(ws_ + WS_WIN))
#define W_Wout_t ((bf16*)(ws_ + WS_WOUT))
#define W_Wgu_t ((bf16*)(ws_ + WS_WGU))
#define W_Wd_t ((bf16*)(ws_ + WS_WD))
#define W_Wpool_t ((bf16*)(ws_ + WS_WPOOL))
#define W_Wmgu_t ((bf16*)(ws_ + WS_WMGU))
#define W_Wmd_t ((bf16*)(ws_ + WS_WMD))
#define W_Wpg_t ((bf16*)(ws_ + WS_WPG))
#define W_Wpp_t ((bf16*)(ws_ + WS_WPP))
#define W_PB ((bf16*)(ws_ + WS_PB))
#define W_XB ((bf16*)(ws_ + WS_XB))
#define W_A2 ((bf16*)(ws_ + WS_A2))
#define W_PJ ((bf16*)(ws_ + WS_A2))
#define W_U ((bf16*)(ws_ + WS_BIG))
#define W_Hh ((bf16*)(ws_ + WS_BIG))
#define W_D1 ((bf16*)(ws_ + WS_BIG))
#define W_XG ((bf16*)(ws_ + WS_BIG))
#define W_HE ((bf16*)(ws_ + WS_HE))
#define W_X (X_)
#define W_XS0 ((bf16*)(ws_ + WS_XB))
#define W_XS1 ((bf16*)((unsigned char*)X_ + 64 * MiB))
#define W_XB0 ((bf16*)X_)
    int gw = F.bx * NWAVES + F.wave; const int NGW = F.G * NWAVES;

    for (int rep_ = 0; rep_ < REPS(0); ++rep_) { REFRESH();
        LAS unsigned char* scr = F.lds + F.wave * 16384;
        int base = 0;
        { const TrJob J{I_w_in, I_w_in, 0, 0, NIN, DM, 5120, 0, W_Win_t, I_mix_norm_even}; base = tr_job(J, base, gw, NGW, scr, F.lane); }
        { const TrJob J{I_w_in, I_w_in, 5120, 6144, NIN, DM, 0, 8, W_Win_t + (size_t)5120 * DM, I_mix_norm_even}; base = tr_job(J, base, gw, NGW, scr, F.lane); }
        for (int m = gw; m < M; m += NGW) {
            const GAS f32x4* xr = (const GAS f32x4*)(I_x + (size_t)m * DM) + F.lane; GAS v2u* o8 = (GAS v2u*)(W_XB0 + (size_t)m * DM) + F.lane; float s = 0.f;
#pragma unroll
            for (int j = 0; j < 8; ++j) { const f32x4 v = xr[64 * j]; s += (v[0] * v[0] + v[1] * v[1]) + (v[2] * v[2] + v[3] * v[3]); v2u w; w.x = cvt_pk_bf16(v[0], v[1]); w.y = cvt_pk_bf16(v[2], v[3]); o8[64 * j] = w; }
            s = wave_sum(s);
            if (F.lane < 32) W_sspA[(size_t)m * 32 + F.lane] = (F.lane == 0) ? s : 0.f;
        }
        if (F.bx == 0) for (int j = F.tid; j < DH; j += 512) { const float t0 = I_lb_table[j], t1 = I_lb_table[DH + j], t2 = I_lb_table[2 * DH + j]; const float mx = fmaxf(t0, fmaxf(t1, t2));
            const float e0 = __expf(t0 - mx), e1 = __expf(t1 - mx), e2 = __expf(t2 - mx); W_lbv[j] = e0 / (e0 + e1 + e2); }
    }
    GRID_BAR();
    const size_t TB2048 = (size_t)256 * DM * 2;
    for (int rep_ = 0; rep_ < (PH(1) ? REPS(1) : 0); ++rep_) { REFRESH();
        SchedGrid S; S.o.init(M / 256, NIN / 256, F.G, F.bx); S.A = (const char*)W_XB0; S.B = (const char*)W_Win_t; S.at = TB2048; S.bt = TB2048;
        EpiInProj E{W_U, W_sspA, W_lbv};
        pg8::gemm_phase<EpiInProj, SchedGrid, true>(F.lds, DM, DM, DM, S, E);
    }
    GRID_BAR();
    for (int rep_ = 0; rep_ < REPS(2); ++rep_) { REFRESH(); if (F.bx < BATCH * NH) { hgrn_phase(F, W_U, W_A2, I_hgrn_gain); if (PROBE_DUP == 20) hgrn_phase(F, W_U, W_A2, I_hgrn_gain); }
        else for (int rep2_ = 0; rep2_ < (PROBE_DUP == 21 ? 2 : 1); ++rep2_) {
            conv_phase(F, W_U, W_A2, I_conv_w, BATCH * NH);
            LDS_BAR();
            LAS unsigned char* scr = F.lds + F.wave * 16384;
            const int wv = (F.bx - BATCH * NH) * NWAVES + F.wave, nw = (F.G - BATCH * NH) * NWAVES; int base = 0;
            { const TrJob J{I_w_out, I_w_out, 0, 0, DM, DM, DM, 0, W_Wout_t, nullptr}; base = tr_job(J, base, wv, nw, scr, F.lane); }
            { const TrJob J{I_w_gate, I_w_up, 0, 0, DFF, DM, 0, DFF / 128, W_Wgu_t, I_ffn_norm_even}; base = tr_job(J, base, wv, nw, scr, F.lane); }
            { const TrJob J{I_w_down, I_w_down, 0, 0, DM, DFF, DM, 0, W_Wd_t, nullptr}; base = tr_job(J, base, wv, nw, scr, F.lane); }
            for (int i = 0; i < 2; ++i) { const TrJob J{I_ple_proj + (size_t)i * DPLE * DM, nullptr, 0, 0, DM, DPLE, DM, 0, W_Wpp_t + (size_t)i * DM * DPLE, nullptr}; base = tr_job(J, base, wv, nw, scr, F.lane); }
            for (int i = 0; i < 2; ++i) { const TrJob J{I_ple_gate_w + (size_t)i * DM * DM, nullptr, 0, 0, DM, DM, DM, 0, W_Wpg_t + (size_t)i * DM * DM, I_ple_norm + i * DM}; base = tr_job(J, base, wv, nw, scr, F.lane); }
            for (int g = 0; g < 4; ++g) { const TrJob J{I_pool_w + (size_t)g * 512 * 512, nullptr, 0, 0, 512, 512, 512, 0, W_Wpool_t + (size_t)512 * g * 512, I_mix_norm_odd + 512 * g}; base = tr_job(J, base, wv, nw, scr, F.lane); }
            for (int e = 0; e < NE; ++e) { const TrJob J{I_w_gate_e + (size_t)e * DM * DFE, I_w_up_e + (size_t)e * DM * DFE, 0, 0, DFE, DM, 0, DFE / 128, W_Wmgu_t + (size_t)e * 2048 * DM, I_ffn_norm_odd}; base = tr_job(J, base, wv, nw, scr, F.lane); }
            for (int e = 0; e < NE; ++e) { const TrJob J{I_w_down_e + (size_t)e * DFE * DM, nullptr, 0, 0, DM, DFE, DM, 0, W_Wmd_t + (size_t)e * DM * DFE, nullptr}; base = tr_job(J, base, wv, nw, scr, F.lane); }
            for (size_t i = (size_t)(F.bx - BATCH * NH) * 512 + F.tid; i < (size_t)2 * M * DPLE / 8; i += (size_t)(F.G - BATCH * NH) * 512) {
                const f32x4 a = ((const f32x4*)I_p)[2 * i], b2 = ((const f32x4*)I_p)[2 * i + 1];
                v4u w; w.x = cvt_pk_bf16(a[0], a[1]); w.y = cvt_pk_bf16(a[2], a[3]); w.z = cvt_pk_bf16(b2[0], b2[1]); w.w = cvt_pk_bf16(b2[2], b2[3]); ((v4u*)W_PB)[i] = w; }
        }
    }
    GRID_BAR();
    for (int rep_ = 0; rep_ < (PH(3) ? REPS(3) : 0); ++rep_) { REFRESH();
        SchedGrid S; S.o.init(M / 256, DM / 256, F.G, F.bx); S.A = (const char*)W_A2; S.B = (const char*)W_Wout_t; S.at = TB2048; S.bt = TB2048;
        EpiResid<0, true> E{I_x, nullptr, W_XS0, W_sspB, nullptr, nullptr, nullptr};
        pg8::gemm_phase<EpiResid<0, true>, SchedGrid, true>(F.lds, DM, DM, DM, S, E);
    }
    GRID_BAR();
    for (int rep_ = 0; rep_ < (PH(4) ? REPS(4) : 0); ++rep_) { REFRESH();
        SchedGrid S; S.o.init(M / 256, 2 * DFF / 256, F.G, F.bx); S.A = (const char*)W_XB; S.B = (const char*)W_Wgu_t; S.at = TB2048; S.bt = TB2048;
        EpiSwiglu<false> E{W_Hh, DFF, W_sspB, nullptr};
        pg8::gemm_phase<EpiSwiglu<false>, SchedGrid, true>(F.lds, DM, DM, DM, S, E);
        REFRESH();
        SchedGrid S2; S2.o.init(M / 256, DM / 256, F.G, F.bx); S2.A = (const char*)W_PB; S2.B = (const char*)W_Wpp_t; S2.at = (size_t)256 * DPLE * 2; S2.bt = (size_t)256 * DPLE * 2;
        EpiBf16Plain E2{W_PJ, DM};
        pg8::gemm_phase<EpiBf16Plain, SchedGrid, true>(F.lds, DPLE, DPLE, DPLE, S2, E2);
    }
    GRID_BAR();
    for (int rep_ = 0; rep_ < (PH(5) ? REPS(5) : 0); ++rep_) { REFRESH();
        SchedGrid S; S.o.init(M / 256, DM / 256, F.G, F.bx); S.A = (const char*)W_Hh; S.B = (const char*)W_Wd_t; S.at = (size_t)256 * DFF * 2; S.bt = (size_t)256 * DFF * 2;
        EpiResid<0, false> E{nullptr, W_XS0, W_XS0, W_sspA, nullptr, nullptr, nullptr};
        pg8::gemm_phase<EpiResid<0, false>, SchedGrid, true>(F.lds, DFF, DFF, DFF, S, E);
    }
    GRID_BAR();
    for (int rep_ = 0; rep_ < (PH(6) ? REPS(6) : 0); ++rep_) { REFRESH();
        SchedGrid S; S.o.init(M / 256, DM / 256, F.G, F.bx); S.A = (const char*)W_XB; S.B = (const char*)W_Wpg_t; S.at = TB2048; S.bt = TB2048;
        EpiResid<2, false> E{nullptr, W_XS0, W_XS1, W_sspB, nullptr, W_sspA, W_PJ};
        pg8::gemm_phase<EpiResid<2, false>, SchedGrid, true>(F.lds, DM, DM, DM, S, E);
    }
    GRID_BAR();
    for (int rep_ = 0; rep_ < (PH(7) ? REPS(7) : 0); ++rep_) { REFRESH();
        LAS float* rt = (LAS float*)F.lds;
        for (int seg = F.bx; seg < M / 64; seg += F.G) {
            const int R0 = seg * 64, t0 = R0 % SEQ;
            for (int i = F.wave; i < 80; i += NWAVES) { const int row = R0 - 16 + i; float v = 0.f;
                if (row >= 0 && F.lane < 32) v = W_sspB[(size_t)row * 32 + F.lane];
                v = wave_sum(v); if (F.lane == 0) rt[i] = 1.0f / sqrtf(v * (1.0f / DM) + EPS); }
            LDS_BAR();
            const int wdw = 2 << (F.tid >> 7);
            const bf16* xc = W_XS1 + (size_t)R0 * DM + 4 * F.tid;
#define LD4(ptr, sc) ({ const v2u q_ = *(const v2u*)(ptr); f32x4 r_; r_[0] = bflo(q_.x) * (sc); r_[1] = bfhi(q_.x) * (sc); r_[2] = bflo(q_.y) * (sc); r_[3] = bfhi(q_.y) * (sc); r_; })
            f32x4 Ssum = (f32x4){0.f, 0.f, 0.f, 0.f};
            for (int k = 1; k <= wdw; ++k) if (t0 - k >= 0) Ssum += LD4(xc - (size_t)k * DM, rt[16 - k]);
#pragma unroll 4
            for (int j = 0; j < 64; ++j) {
                const f32x4 hv = LD4(xc + (size_t)j * DM, rt[16 + j]);
                Ssum += hv;
                const int tp = t0 + j;
                if (tp - wdw >= 0) Ssum -= LD4(xc + (size_t)(j - wdw) * DM, rt[16 + j - wdw]);
                const float inv = 1.0f / (float)((tp + 1 < wdw) ? (tp + 1) : wdw);
                const f32x4 d = Ssum * inv - hv;
                v2u w; w.x = cvt_pk_bf16(d[0], d[1]); w.y = cvt_pk_bf16(d[2], d[3]);
                *(v2u*)(W_D1 + (size_t)(R0 + j) * DM + 4 * F.tid) = w;
            }
#undef LD4
            LDS_BAR();
        }
    }
    GRID_BAR();
    for (int rep_ = 0; rep_ < (PH(8) ? REPS(8) : 0); ++rep_) { REFRESH();
        SchedPool S; S.o.init(M / 256, DM / 256, F.G, F.bx); S.A = (const char*)W_D1; S.B = (const char*)W_Wpool_t; S.at = TB2048; S.bt = (size_t)256 * 512 * 2;
        EpiResid<1, false> E{nullptr, W_XS1, W_XS1, W_sspA, I_pool_scale, nullptr, nullptr};
        pg8::gemm_phase<EpiResid<1, false>, SchedPool, true>(F.lds, 512, DM, 512, S, E);
        REFRESH();
        SchedGrid S2; S2.o.init(M / 256, DM / 256, F.G, F.bx); S2.A = (const char*)(W_PB + (size_t)M * DPLE); S2.B = (const char*)(W_Wpp_t + (size_t)DM * DPLE); S2.at = (size_t)256 * DPLE * 2; S2.bt = (size_t)256 * DPLE * 2;
        EpiBf16Plain E2{W_PJ, DM};
        pg8::gemm_phase<EpiBf16Plain, SchedGrid, true>(F.lds, DPLE, DPLE, DPLE, S2, E2);
    }
    GRID_BAR();
    for (int rep_ = 0; rep_ < (PH(9) ? REPS(9) : 0); ++rep_) { REFRESH();
        LAS float* wr = (LAS float*)F.lds;
        LAS int* e12 = (LAS int*)(F.lds + 65536);
        LAS float* w12 = (LAS float*)(F.lds + 65536 + 512);
        for (int i = F.tid; i < DM * NE / 4; i += 512) { const int k = i >> 1, e0 = (i & 1) * 4; const f32x4 v = *(const f32x4*)(I_w_router + (size_t)k * NE + e0) * I_ffn_norm_odd[k];
            *(LAS f32x4*)(wr + (((k & 7) * 256 + (k >> 3)) * 8 + e0)) = v; }
        LDS_BAR();
        for (int seg = F.bx; seg < M / 64; seg += F.G) {
            for (int rr = 0; rr < 8; ++rr) {
                const int lrow = F.wave * 8 + rr, row = seg * 64 + lrow;
                const GAS v4u* xr = (const GAS v4u*)(W_XS1 + (size_t)row * DM) + F.lane;
                float acc[8]; float ss = 0.f;
#pragma unroll
                for (int e = 0; e < 8; ++e) acc[e] = 0.f;
#pragma unroll
                for (int c = 0; c < 4; ++c) { f32x4 xa, xb; unpack8(xr[64 * c], xa, xb);
                    ss += ((xa[0] * xa[0] + xa[1] * xa[1]) + (xa[2] * xa[2] + xa[3] * xa[3])) + ((xb[0] * xb[0] + xb[1] * xb[1]) + (xb[2] * xb[2] + xb[3] * xb[3]));
#pragma unroll
                    for (int kk = 0; kk < 8; ++kk) { const float xk = kk < 4 ? xa[kk & 3] : xb[kk & 3];
                        const LAS float* wp = wr + ((kk * 256 + c * 64 + F.lane) * 8); const f32x4 w0 = *(const LAS f32x4*)wp, w1 = *(const LAS f32x4*)(wp + 4);
                        acc[0] += xk * w0[0]; acc[1] += xk * w0[1]; acc[2] += xk * w0[2]; acc[3] += xk * w0[3];
                        acc[4] += xk * w1[0]; acc[5] += xk * w1[1]; acc[6] += xk * w1[2]; acc[7] += xk * w1[3]; } }
                ss = wave_sum(ss);
#pragma unroll
                for (int e = 0; e < 8; ++e) acc[e] = wave_sum(acc[e]);
                const float rstd = 1.0f / sqrtf(ss * (1.0f / DM) + EPS);
                int i1 = 0; float l1 = acc[0];
#pragma unroll
                for (int e = 1; e < 8; ++e) if (acc[e] > l1) { l1 = acc[e]; i1 = e; }
                int i2 = -1; float l2 = -3.0e38f;
#pragma unroll
                for (int e = 0; e < 8; ++e) if (e != i1 && acc[e] > l2) { l2 = acc[e]; i2 = e; }
                const float wt1 = 1.0f / (1.0f + __expf((l2 - l1) * rstd)), wt2 = 1.0f - wt1;
                if (F.lane == 0) { e12[2 * lrow] = i1; e12[2 * lrow + 1] = i2; w12[2 * lrow] = wt1; w12[2 * lrow + 1] = wt2; W_rs4[row] = rstd; }
            }
            LDS_BAR();
            if (F.wave == 0) {
                const int row = seg * 64 + F.lane; const int e1 = e12[2 * F.lane], e2 = e12[2 * F.lane + 1]; const float wt1 = w12[2 * F.lane], wt2 = w12[2 * F.lane + 1];
                unsigned long long mk[16]; int mycnt = 0;
#pragma unroll
                for (int g = 0; g < 16; ++g) { const bool pr = (g < 8) ? (e1 == g) : (e2 == g - 8); mk[g] = __ballot(pr); if (F.lane == g) mycnt = __popcll(mk[g]); }
                int base = 0;
                if (F.lane < 16) base = (int)__hip_atomic_fetch_add((unsigned*)(F.ctl + CW_MOE) + F.lane, (unsigned)mycnt, RLX_AGENT);
                const unsigned long long lt = (1ull << F.lane) - 1ull;
#pragma unroll
                for (int g = 0; g < 16; ++g) { const int bg = __shfl(base, g); const bool pr = (g < 8) ? (e1 == g) : (e2 == g - 8);
                    if (pr) { const int slot = bg + __popcll(mk[g] & lt); W_list[(size_t)g * M + slot] = row; W_gwl[(size_t)g * M + slot] = (g < 8) ? wt1 : wt2; } }
            }
            LDS_BAR();
        }
    }
    GRID_BAR();
    LAS int* tile_e = (LAS int*)(F.lds + LDSCTL_OFF + 1024);
    LAS int* gtab = (LAS int*)(F.lds + LDSCTL_OFF + 1024 + 640);
    for (int rep_ = 0; rep_ < (PH(10) ? REPS(10) : 0); ++rep_) { REFRESH();
        if (F.tid == 0) { int rowp = 0, ti = 0;
            for (int g = 0; g < 16; ++g) { const int c = (int)__hip_atomic_load((unsigned*)(F.ctl + CW_MOE) + g, RLX_AGENT); const int nt = (c + 255) >> 8;
                gtab[g] = rowp; gtab[17 + g] = c; for (int t = 0; t < nt; ++t) tile_e[ti++] = g & 7; rowp += nt * 256; if (g == 7) gtab[33] = ti; }
            gtab[16] = rowp; }
        LDS_BAR();
        const int rtot = gtab[16];
        for (int cr = gw; cr < rtot; cr += NGW) {
            int g = 0;
#pragma unroll
            for (int q = 1; q < 16; ++q) if (cr >= gtab[q]) g = q;
            const int slot = cr - gtab[g]; const bool valid = slot < gtab[17 + g];
            int tok = -1; float gwv = 0.f, rsv = 0.f;
            if (valid) { tok = W_list[(size_t)g * M + slot]; gwv = W_gwl[(size_t)g * M + slot]; rsv = W_rs4[tok]; }
            if (F.lane == 0) { W_tokc[cr] = tok; W_gwc[cr] = gwv; W_rsc[cr] = rsv; }
            v4u* dst = (v4u*)(W_XG + (size_t)cr * DM) + F.lane;
            if (valid) { const v4u* srcp = (const v4u*)(W_XS1 + (size_t)tok * DM) + F.lane;
#pragma unroll
                for (int j = 0; j < 4; ++j) dst[64 * j] = srcp[64 * j]; }
            else {
#pragma unroll
                for (int j = 0; j < 4; ++j) dst[64 * j] = (v4u){0u, 0u, 0u, 0u}; }
        }
    }
    GRID_BAR();
    const int RT = gtab[16] >> 8, RT1 = gtab[33];
    for (int rep_ = 0; rep_ < (PH(11) ? REPS(11) : 0); ++rep_) { REFRESH();
        SchedMoe S{tile_e, 0, RT, F.G, F.bx, (const char*)W_XG, (const char*)W_Wmgu_t, TB2048, TB2048, (size_t)2048 * DM * 2};
        EpiSwiglu<true> E{W_HE, DFE, nullptr, W_rsc};
        pg8::gemm_phase<EpiSwiglu<true>, SchedMoe, true>(F.lds, DM, DM, DM, S, E);
    }
    GRID_BAR();
    for (int rep_ = 0; rep_ < (PH(12) ? REPS(12) : 0); ++rep_) { REFRESH();
        SchedMoe S{tile_e, 0, RT1, F.G, F.bx, (const char*)W_HE, (const char*)W_Wmd_t, (size_t)256 * DFE * 2, (size_t)256 * DFE * 2, (size_t)DM * DFE * 2};
        EpiMoeDown<false> E{W_XS1, W_sspB, W_tokc, W_gwc};
        pg8::gemm_phase<EpiMoeDown<false>, SchedMoe, true>(F.lds, DFE, DFE, DFE, S, E);
    }
    GRID_BAR();
    for (int rep_ = 0; rep_ < (PH(13) ? REPS(13) : 0); ++rep_) { REFRESH();
        SchedMoe S{tile_e, RT1, RT, F.G, F.bx, (const char*)W_HE, (const char*)W_Wmd_t, (size_t)256 * DFE * 2, (size_t)256 * DFE * 2, (size_t)DM * DFE * 2};
        EpiMoeDown<true> E{W_XS1, W_sspB, W_tokc, W_gwc};
        pg8::gemm_phase<EpiMoeDown<true>, SchedMoe, true>(F.lds, DFE, DFE, DFE, S, E);
    }
    GRID_BAR();
    for (int rep_ = 0; rep_ < (PH(14) ? REPS(14) : 0); ++rep_) { REFRESH();
        SchedGrid S; S.o.init(M / 256, DM / 256, F.G, F.bx); S.A = (const char*)W_XS1; S.B = (const char*)(W_Wpg_t + (size_t)DM * DM); S.at = TB2048; S.bt = TB2048;
        EpiResid<2, false> E{nullptr, W_XS1, W_XS0, W_sspA, nullptr, W_sspB, W_PJ};
        pg8::gemm_phase<EpiResid<2, false>, SchedGrid, true>(F.lds, DM, DM, DM, S, E);
    }
    GRID_BAR();
    REFRESH();
    if (PH(15)) for (int m = gw; m < M; m += NGW) {
        float v = (F.lane < 32) ? W_sspA[(size_t)m * 32 + F.lane] : 0.f; v = wave_sum(v);
        const float rstd = 1.0f / sqrtf(v * (1.0f / DM) + EPS);
        const GAS v4u* xs = (const GAS v4u*)(W_XS0 + (size_t)m * DM) + F.lane; GAS f32x4* xo = (GAS f32x4*)(W_X + (size_t)m * DM) + 2 * F.lane; const f32x4* gp = (const f32x4*)I_final_gain + 2 * F.lane;
#pragma unroll
        for (int j = 0; j < 4; ++j) { f32x4 a, b; unpack8(xs[64 * j], a, b); xo[128 * j] = a * rstd * gp[128 * j]; xo[128 * j + 1] = b * rstd * gp[128 * j + 1]; }
    }
}

extern "C" void kernel_launch(void* const* d_in, const int* in_sizes, int n_in, void* d_out, int out_size, void* d_ws, size_t ws_size, hipStream_t stream) {
    (void)in_sizes; (void)out_size;
    static int grid = 0;
    if (grid == 0) {
        if (n_in != 24 || ws_size < WS_END) { fprintf(stderr, "kernel_launch: bad arguments (n_in %d, ws %zu)\n", n_in, ws_size); grid = -1; return; }
        int dev = 0, cus = 0, per_cu = 0;
        if (hipGetDevice(&dev) != hipSuccess || hipDeviceGetAttribute(&cus, hipDeviceAttributeMultiprocessorCount, dev) != hipSuccess) { grid = -1; return; }
        if (hipFuncSetAttribute((const void*)fwd_kernel, hipFuncAttributeMaxDynamicSharedMemorySize, LDS_BYTES) != hipSuccess) { grid = -1; return; }
        if (hipOccupancyMaxActiveBlocksPerMultiprocessor(&per_cu, (const void*)fwd_kernel, NWAVES * 64, LDS_BYTES) != hipSuccess || per_cu < 1) { fprintf(stderr, "kernel_launch: occupancy query says %d\n", per_cu); }
        (void)hipGetLastError();
        grid = cus;
    }
    if (grid < 0) return;
    if (hipMemsetAsync((char*)d_ws + WS_CTL, 0, CTL_ZERO_BYTES, stream) != hipSuccess) return;
    Args a{};
    for (int i = 0; i < 24; ++i) a.in[i] = (const float*)d_in[i];
    a.out = (float*)d_out; a.ws = (unsigned char*)d_ws;
    hipLaunchKernelGGL(fwd_kernel, dim3(grid), dim3(NWAVES * 64), LDS_BYTES, stream, a);
}
```

```cpp
#include <hip/hip_runtime.h>
#include <cstdio>
#include <cstdint>

constexpr int DM = 2048, BATCH = 8, SEQ = 2048, M = BATCH * SEQ;
constexpr int DH = 1024, NH = 8, HD = 128, CHUNK = 64, DC = 1024, DFF = 5632, NE = 8, DFE = 1024, DPLE = 256;
constexpr int NIN = 7168;
constexpr int UP = 6144;
constexpr float EPS = 1e-6f;
constexpr int NWAVES = 8;
#ifndef F8_GU
#define F8_GU 1
#endif
#ifndef F8_DN
#define F8_DN 0
#endif
#ifndef F8_MOE
#define F8_MOE 1
#endif
#ifndef F8_PLE1
#define F8_PLE1 1
#endif

constexpr size_t MiB = 1u << 20;
constexpr size_t WS_CTL = 0, CTL_ZERO_BYTES = 256 * 1024;
constexpr size_t WS_LBV = 1 * MiB;
constexpr size_t WS_RS4 = 1 * MiB + 64 * 1024;
constexpr size_t WS_TOP = 1 * MiB + 192 * 1024;
constexpr size_t WS_TOPW = 1 * MiB + 320 * 1024;
constexpr size_t WS_SSPA = 2 * MiB, WS_SSPB = 4 * MiB;
constexpr size_t WS_LIST = 6 * MiB;
constexpr size_t WS_GWL = 7 * MiB;
constexpr size_t WS_TOKC = 8 * MiB;
constexpr int RCAP = 36864;
constexpr size_t WS_GWC = WS_TOKC + (size_t)RCAP * 4, WS_RSC = WS_GWC + (size_t)RCAP * 4;
constexpr size_t WS_WIN = 10 * MiB;
constexpr size_t WS_WOUT = 38 * MiB;
constexpr size_t WS_WGU = 46 * MiB;
constexpr size_t WS_WD = 90 * MiB;
constexpr size_t WS_WPOOL = 112 * MiB;
constexpr size_t WS_WMGU = 114 * MiB;
constexpr size_t WS_WMD = 178 * MiB;
constexpr size_t WS_WPG = 210 * MiB;
constexpr size_t WS_WPP = 226 * MiB;
constexpr size_t WS_PB = 228 * MiB;
constexpr size_t WS_XB = 244 * MiB;
constexpr size_t WS_A2 = 308 * MiB;
constexpr size_t WS_BIG = 372 * MiB;
constexpr size_t WS_HE = 10 * MiB;
constexpr size_t WS_END = 564 * MiB;
static_assert(WS_BIG + (size_t)M * UP * 2 <= WS_END && WS_HE + (size_t)RCAP * DFE * 2 <= WS_WD, "ws map");
static_assert(WS_BIG + (size_t)RCAP * DM * 2 <= WS_END, "ws map XG");
constexpr int CW_BAR = 4096;
constexpr int CW_MOE = 16384;
constexpr int CW_DBG = 20000;

constexpr int RING_BYTES = 131072;
constexpr int LDSCTL_OFF = RING_BYTES, MISC_OFF = LDSCTL_OFF + 320;
constexpr int LDS_BYTES = 147456;

#define GAS __attribute__((address_space(1)))
#define LAS __attribute__((address_space(3)))
typedef unsigned short bf16;
typedef unsigned v4u __attribute__((ext_vector_type(4)));
typedef unsigned v2u __attribute__((ext_vector_type(2)));
typedef float f32x4 __attribute__((ext_vector_type(4)));
typedef float f32x2 __attribute__((ext_vector_type(2)));
typedef float f32x16 __attribute__((ext_vector_type(16)));
typedef short bf16x8 __attribute__((ext_vector_type(8)));
typedef short bf16x4 __attribute__((ext_vector_type(4)));
typedef GAS unsigned gu32;
#define RLX_AGENT __ATOMIC_RELAXED, __HIP_MEMORY_SCOPE_AGENT
#define LDS_WAIT() asm volatile("s_waitcnt lgkmcnt(0)" ::: "memory")
#define VM_WAIT() asm volatile("s_waitcnt vmcnt(0)" ::: "memory")
#define LDS_BAR() do { asm volatile("s_waitcnt lgkmcnt(0)" ::: "memory"); __builtin_amdgcn_s_barrier(); asm volatile("" ::: "memory"); } while (0)
__device__ __forceinline__ unsigned f2bf(float f) { unsigned u = __builtin_bit_cast(unsigned, f); return (u + 0x7fffu + ((u >> 16) & 1u)) >> 16; }
__device__ __forceinline__ unsigned pk2(float lo, float hi) { return f2bf(lo) | (f2bf(hi) << 16); }
__device__ __forceinline__ unsigned cvt_pk_bf16(float lo, float hi) { unsigned r; asm volatile("v_cvt_pk_bf16_f32 %0, %1, %2" : "=v"(r) : "v"(lo), "v"(hi)); return r; }
__device__ __forceinline__ float clamp8(float v) { return __builtin_amdgcn_fmed3f(v, -448.0f, 448.0f); }
__device__ __forceinline__ v2u pk8_fp8(const f32x4 a, const f32x4 b) {
    int w0 = 0, w1 = 0;
    w0 = __builtin_amdgcn_cvt_pk_fp8_f32(clamp8(a[0]), clamp8(a[1]), w0, false); w0 = __builtin_amdgcn_cvt_pk_fp8_f32(clamp8(a[2]), clamp8(a[3]), w0, true);
    w1 = __builtin_amdgcn_cvt_pk_fp8_f32(clamp8(b[0]), clamp8(b[1]), w1, false); w1 = __builtin_amdgcn_cvt_pk_fp8_f32(clamp8(b[2]), clamp8(b[3]), w1, true);
    v2u r; r.x = (unsigned)w0; r.y = (unsigned)w1; return r;
}
__device__ __forceinline__ float bflo(unsigned u) { return __builtin_bit_cast(float, u << 16); }
__device__ __forceinline__ float bfhi(unsigned u) { return __builtin_bit_cast(float, u & 0xffff0000u); }
__device__ __forceinline__ float fast_rcp(float x) { return __builtin_amdgcn_rcpf(x); }
__device__ __forceinline__ float sigmoidf_(float x) { return fast_rcp(1.0f + __expf(-x)); }
__device__ __forceinline__ float siluf_(float x) { return x * sigmoidf_(x); }
__device__ __forceinline__ float wave_sum(float v) {
#pragma unroll
    for (int o = 1; o < 64; o <<= 1) v += __shfl_xor(v, o);
    return v;
}

#define XB_TMO      128
#define XB_XCNT(j)  (256  + 64 * (j))
#define XB_XSUB(j)  (1280 + 64 * (j))
#define XB_XGEN(j)  (2304 + 64 * (j))
#define XB_TOP      3328
#define XB_TOPGEN   3392
#define XCD_BAR_WORDS 3456
#define XB_SPIN_CAP (1u << 18)
__device__ __forceinline__ unsigned xb_ld(unsigned* p)              { return __hip_atomic_load(p, __ATOMIC_RELAXED, __HIP_MEMORY_SCOPE_AGENT); }
__device__ __forceinline__ unsigned xb_add(unsigned* p, unsigned v) { return __hip_atomic_fetch_add(p, v, __ATOMIC_RELAXED, __HIP_MEMORY_SCOPE_AGENT); }
__device__ __forceinline__ unsigned xb_xcc_id() { return (unsigned)__builtin_amdgcn_s_getreg((3 << 11) | 20) & 0xFu; }
#define XB_SPIN(cond, bar) do { unsigned _sp = 0; while (cond) { __builtin_amdgcn_s_sleep(1); \
    if ((++_sp & 255u) == 0u) { if (xb_ld(&(bar)[XB_TMO])) break; if (_sp > XB_SPIN_CAP) { atomicAdd(&(bar)[XB_TMO], 1u); break; } } } } while (0)
struct XcdBarrier { unsigned* bar; unsigned x; volatile LAS unsigned* st; };
__device__ __forceinline__ XcdBarrier xcd_barrier_post(unsigned* bar, volatile LAS unsigned* st) {
    XcdBarrier b; b.bar = bar; b.x = xb_xcc_id(); b.st = st;
    if (threadIdx.x == 0) (void)xb_add(&bar[XB_XCNT(b.x)], 1u);
    return b;
}
__device__ __forceinline__ void xcd_barrier_complete(unsigned* bar, unsigned x, unsigned& nloc, unsigned& nx) {
    const unsigned G = gridDim.x * gridDim.y * gridDim.z;
    unsigned sum, cnt, mine, sp = 0u;
    for (;;) {
        sum = 0u; cnt = 0u; mine = 0u;
#pragma unroll
        for (unsigned j = 0; j < 16; ++j) { const unsigned c = xb_ld(&bar[XB_XCNT(j)]); sum += c; cnt += (c > 0u) ? 1u : 0u; mine = (j == x) ? c : mine; }
        if (sum == G) break;
        __builtin_amdgcn_s_sleep(1);
        if ((++sp & 255u) == 0u) { if (xb_ld(&bar[XB_TMO])) break; if (sp > XB_SPIN_CAP) { atomicAdd(&bar[XB_TMO], 1u); break; } }
    }
    nloc = mine > 0u ? mine : 1u; nx = cnt > 0u ? cnt : 1u;
}
__device__ __forceinline__ void xcd_barrier(const XcdBarrier& b) {
    asm volatile("s_waitcnt vmcnt(0)" ::: "memory");
    __syncthreads();
    if (threadIdx.x == 0) {
        unsigned* bar = b.bar;
        __builtin_amdgcn_s_waitcnt(0);
        unsigned nloc = b.st[0], nx = b.st[1];
        if (nloc == 0u) { xcd_barrier_complete(bar, b.x, nloc, nx); b.st[0] = nloc; b.st[1] = nx; }
        const unsigned old = xb_add(&bar[XB_XSUB(b.x)], 1u);
        const unsigned gen = old / nloc;
        if (old + 1u == (gen + 1u) * nloc) {
            __builtin_amdgcn_fence(__ATOMIC_RELEASE, "agent");
            asm volatile("s_waitcnt vmcnt(0)" ::: "memory");
            const unsigned og = xb_add(&bar[XB_TOP], 1u);
            const unsigned tg = og / nx;
            if (og + 1u == (tg + 1u) * nx) xb_add(&bar[XB_TOPGEN], 1u);
            else XB_SPIN(xb_ld(&bar[XB_TOPGEN]) == tg, bar);
            __builtin_amdgcn_fence(__ATOMIC_ACQUIRE, "agent");
            xb_add(&bar[XB_XGEN(b.x)], 1u);
            asm volatile("s_waitcnt vmcnt(0)" ::: "memory");
        } else {
            XB_SPIN(xb_ld(&bar[XB_XGEN(b.x)]) == gen, bar);
            __builtin_amdgcn_fence(__ATOMIC_ACQUIRE, "agent");
            asm volatile("s_waitcnt vmcnt(0)" ::: "memory");
        }
    }
    __syncthreads();
}

namespace pg8 {
constexpr int BM = 256, BK = 64, HALF = 128, HTB = HALF * BK * 2, STAGE_BYTES = 8 * HTB, NXCD = 8, WGM = 8;
__host__ __device__ __forceinline__ int lds_byte(int r, int c) { const int st = (r >> 4) * 2 + (c >> 5), rr = r & 15, cc = c & 31, ob = rr * 64 + cc * 2; return st * 1024 + (ob ^ (((ob >> 9) & 1) << 5)); }
__host__ __device__ __forceinline__ void stage_rc(int b, int& R, int& C) { const int st = b / 1024, sb = b % 1024, swz = sb ^ (((sb >> 9) & 1) << 5); R = (st >> 1) * 16 + swz / 64; C = (st & 1) * 32 + (swz % 64) / 2; }
__host__ __device__ __forceinline__ int perm32(int rho) { const int n = rho >> 4, i = rho & 15; return 8 * (i >> 2) + 4 * n + (i & 3); }
struct Unit { int pm, pn; const char* a; const char* b; };
typedef int v4i_t __attribute__((ext_vector_type(4)));
typedef int v8i_t __attribute__((ext_vector_type(8)));
__device__ __forceinline__ bf16x8 lo8(v8i_t v) { return __builtin_bit_cast(bf16x8, __builtin_shufflevector(v, v, 0, 1, 2, 3)); }
__device__ __forceinline__ bf16x8 hi8(v8i_t v) { return __builtin_bit_cast(bf16x8, __builtin_shufflevector(v, v, 4, 5, 6, 7)); }
__device__ __forceinline__ v8i_t cat8(bf16x8 lo, bf16x8 hi) { return __builtin_shufflevector(__builtin_bit_cast(v4i_t, lo), __builtin_bit_cast(v4i_t, hi), 0, 1, 2, 3, 4, 5, 6, 7); }
struct GridOrder {
    int nM, nN, nwg, G, c;
    __device__ __forceinline__ void init(int nM_, int nN_, int G_, int c_) { nM = nM_; nN = nN_; nwg = nM * nN; G = G_; c = c_; }
    __device__ __forceinline__ bool tile(int i, int& pm, int& pn) const {
        const long L = (long)i * G + c; if (L >= nwg) return false;
        int wgid = (int)L; { const int q = nwg / NXCD, r = nwg % NXCD, xcd = wgid % NXCD, off = wgid / NXCD; wgid = (xcd < r ? xcd * (q + 1) : r * (q + 1) + (xcd - r) * q) + off; }
        const int nig = WGM * nN, gid = wgid / nig, fm = gid * WGM, gsz = (nM - fm) < WGM ? (nM - fm) : WGM;
        pm = fm + ((wgid % nig) % gsz); pn = (wgid % nig) / gsz; return true;
    }
};

template <class Epi, class Sched, bool ALIGN_EPI, bool FP8 = false>
__device__ __forceinline__ void gemm_phase(LAS unsigned char* lds, const int K, const int lda, const int ldb, const Sched& S, const Epi& E) {
    int tid_ = threadIdx.x; asm volatile("" : "+v"(tid_));
    const int tid = tid_, wid = __builtin_amdgcn_readfirstlane(tid >> 6), lane = tid & 63, wr = wid >> 2, wc = wid & 3, fr = lane & 15, fq = lane >> 4;
    const int nt = K / BK;
    unsigned voffA[2], voffB[2];
#pragma unroll
    for (int i = 0; i < 2; ++i) { int R, C; stage_rc(tid * 16 + i * 8192, R, C); const int Rb = Epi::PERM ? ((R & ~31) + perm32(R & 31)) : R;
        voffA[i] = (unsigned)(R * lda + C) * 2u; voffB[i] = (unsigned)(Rb * ldb + C) * 2u; }
    const size_t kstep = (size_t)(BK * 2);
    const size_t hstepA = (size_t)HALF * lda * 2, hstepB = (size_t)HALF * ldb * 2;
    const unsigned ldsw = (unsigned)wid * 1024u;
    const int aoff = lds_byte(wr * 64 + fr, fq * 8), boff = lds_byte(wc * 32 + fr, fq * 8);
#define PG8_SA(b, h) (((b) * 2 + (h)) * HTB)
#define PG8_SB(b, h) ((4 + (b) * 2 + (h)) * HTB)
#define PG8_STAGE(bufoff, gbase, voff) do { _Pragma("unroll") for (int _i = 0; _i < 2; ++_i) \
        __builtin_amdgcn_global_load_lds((const unsigned*)((const char*)(gbase) + (voff)[_i]), (LAS unsigned*)(lds + (bufoff) + ldsw + _i * 8192), 16, 0, 0); } while (0)
#define PG8_LDA(dst, b, h) do { _Pragma("unroll") for (int m = 0; m < 4; ++m) { const bf16x8 lo_ = *(const LAS bf16x8*)(lds + PG8_SA(b, h) + aoff + m * 2048), hi_ = *(const LAS bf16x8*)(lds + PG8_SA(b, h) + aoff + m * 2048 + 1024); dst[m] = cat8(lo_, hi_); } } while (0)
#define PG8_LDB(dst, b, h) do { _Pragma("unroll") for (int n = 0; n < 2; ++n) { const bf16x8 lo_ = *(const LAS bf16x8*)(lds + PG8_SB(b, h) + boff + n * 2048), hi_ = *(const LAS bf16x8*)(lds + PG8_SB(b, h) + boff + n * 2048 + 1024); dst[n] = cat8(lo_, hi_); } } while (0)
#define PG8_MMA(ai, bj, At, Bt) do { __builtin_amdgcn_s_setprio(1); _Pragma("unroll") for (int m = 0; m < 4; ++m) _Pragma("unroll") for (int n = 0; n < 2; ++n) { \
        if constexpr (FP8) { asm volatile("v_mfma_scale_f32_16x16x128_f8f6f4 %0, %1, %2, %0, %3, %4 op_sel_hi:[0,0,0]" : "+v"(acc[ai][bj][m][n]) : "v"(Bt[n]), "v"(At[m]), "v"(sc_w), "v"(sc_x)); } \
        else { acc[ai][bj][m][n] = __builtin_amdgcn_mfma_f32_16x16x32_bf16(lo8(Bt[n]), lo8(At[m]), acc[ai][bj][m][n], 0, 0, 0); \
               acc[ai][bj][m][n] = __builtin_amdgcn_mfma_f32_16x16x32_bf16(hi8(Bt[n]), hi8(At[m]), acc[ai][bj][m][n], 0, 0, 0); } } __builtin_amdgcn_s_setprio(0); } while (0)
#define PG8_WAIT_V(n) asm volatile("s_waitcnt vmcnt(" #n ")" ::: "memory")
#define PG8_WAIT_L(n) asm volatile("s_waitcnt lgkmcnt(" #n ")" ::: "memory")
#define PG8_BAR __builtin_amdgcn_s_barrier()
#define PG8_SCHED __builtin_amdgcn_sched_barrier(0)
    Unit cur, nxt; int ui = 0;
    if (!S.next(0, cur)) return;
    f32x4 acc[2][2][4][2];
#pragma unroll
    for (int a = 0; a < 2; ++a)
#pragma unroll
        for (int b = 0; b < 2; ++b)
#pragma unroll
            for (int m = 0; m < 4; ++m)
#pragma unroll
                for (int n = 0; n < 2; ++n) acc[a][b][m][n] = (f32x4){0.f, 0.f, 0.f, 0.f};
    v8i_t At[4], B0[2], B1[2];
    const int sc_w = 0x79797979, sc_x = 0x7f7f7f7f;
    (void)sc_w; (void)sc_x;
    const char* cA = cur.a; const char* cB = cur.b;
    PG8_STAGE(PG8_SB(0, 0), cB, voffB); PG8_STAGE(PG8_SB(0, 1), cB + hstepB, voffB); PG8_STAGE(PG8_SA(0, 0), cA, voffA); PG8_STAGE(PG8_SA(0, 1), cA + hstepA, voffA);
    if (wr == 1) PG8_BAR;
    PG8_WAIT_V(2); PG8_BAR;
    PG8_STAGE(PG8_SB(1, 0), cB + kstep, voffB); PG8_STAGE(PG8_SA(1, 0), cA + kstep, voffA); PG8_STAGE(PG8_SB(1, 1), cB + hstepB + kstep, voffB);
    PG8_WAIT_V(6); PG8_BAR;
    for (;;) {
        const bool has_next = S.next(ui + 1, nxt);
        const char* nA = has_next ? nxt.a : cA; const char* nB = has_next ? nxt.b : cB;
#pragma nounroll
        for (int t = 0; t < nt; t += 2) {
            const bool last = (t == nt - 2);
            const char* a1 = cA + (size_t)(t + 1) * kstep;
            const char* a2 = last ? nA : cA + (size_t)(t + 2) * kstep; const char* b2 = last ? nB : cB + (size_t)(t + 2) * kstep;
            const char* a3 = a2 + kstep; const char* b3 = b2 + kstep;
            PG8_LDB(B0, 0, 0); PG8_LDB(B1, 0, 1); PG8_SCHED; PG8_LDA(At, 0, 0); PG8_STAGE(PG8_SA(1, 1), a1 + hstepA, voffA);
            PG8_WAIT_V(8); PG8_WAIT_L(0); PG8_BAR; PG8_MMA(0, 0, At, B0); PG8_MMA(0, 1, At, B1); PG8_BAR; PG8_SCHED;
            PG8_LDA(At, 0, 1); PG8_STAGE(PG8_SB(0, 0), b2, voffB); PG8_STAGE(PG8_SB(0, 1), b2 + hstepB, voffB); PG8_STAGE(PG8_SA(0, 0), a2, voffA);
            PG8_WAIT_V(8); PG8_WAIT_L(0); PG8_BAR; PG8_MMA(1, 0, At, B0); PG8_MMA(1, 1, At, B1); PG8_BAR; PG8_SCHED;
            PG8_LDB(B0, 1, 0); PG8_LDB(B1, 1, 1); PG8_SCHED; PG8_LDA(At, 1, 0); PG8_STAGE(PG8_SA(0, 1), a2 + hstepA, voffA);
            PG8_WAIT_V(8); PG8_WAIT_L(0); PG8_BAR; PG8_MMA(0, 0, At, B0); PG8_MMA(0, 1, At, B1); PG8_BAR; PG8_SCHED;
            PG8_LDA(At, 1, 1); PG8_STAGE(PG8_SB(1, 0), b3, voffB); PG8_STAGE(PG8_SB(1, 1), b3 + hstepB, voffB); PG8_STAGE(PG8_SA(1, 0), a3, voffA);
            PG8_WAIT_V(8); PG8_WAIT_L(0); PG8_BAR; PG8_MMA(1, 0, At, B0); PG8_MMA(1, 1, At, B1); PG8_BAR; PG8_SCHED;
        }
        if constexpr (ALIGN_EPI) { if (wr == 0) PG8_BAR; }
        if constexpr (FP8) asm volatile("s_nop 15\n\ts_nop 15" ::: "memory");
        E(acc, cur, wr, wc, fr, fq);
        if (!has_next) break;
#pragma unroll
        for (int a = 0; a < 2; ++a)
#pragma unroll
            for (int b = 0; b < 2; ++b)
#pragma unroll
                for (int m = 0; m < 4; ++m)
#pragma unroll
                    for (int n = 0; n < 2; ++n) acc[a][b][m][n] = (f32x4){0.f, 0.f, 0.f, 0.f};
        cur = nxt; cA = nA; cB = nB; ++ui;
        if constexpr (ALIGN_EPI) { if (wr == 1) PG8_BAR; }
    }
    PG8_WAIT_V(0);
    if constexpr (!ALIGN_EPI) { if (wr == 0) PG8_BAR; }
    PG8_BAR;
#undef PG8_SA
#undef PG8_SB
#undef PG8_STAGE
#undef PG8_LDA
#undef PG8_LDB
#undef PG8_MMA
#undef PG8_WAIT_V
#undef PG8_WAIT_L
#undef PG8_BAR
#undef PG8_SCHED
}
}
using pg8::Unit;

struct SchedGrid {
    pg8::GridOrder o; const char* A; const char* B; size_t at, bt;
    __device__ __forceinline__ bool next(int i, Unit& u) const { if (!o.tile(i, u.pm, u.pn)) return false; u.a = A + (size_t)u.pm * at; u.b = B + (size_t)u.pn * bt; return true; }
};
struct SchedPool {
    pg8::GridOrder o; const char* A; const char* B; size_t at, bt;
    __device__ __forceinline__ bool next(int i, Unit& u) const { if (!o.tile(i, u.pm, u.pn)) return false; u.a = A + (size_t)u.pm * at + (size_t)(u.pn >> 1) * 1024; u.b = B + (size_t)u.pn * bt; return true; }
};
struct SchedPJ {
    pg8::GridOrder o; const char* A; const char* B; size_t at, bt;
    __device__ __forceinline__ bool next(int i, Unit& u) const { if (!o.tile(i, u.pm, u.pn)) return false; u.a = A + (size_t)u.pm * at; u.b = B + (size_t)((u.pm >> 6) * 8 + u.pn) * bt; return true; }
};
struct SchedMoe {
    const LAS int* tile_e; int rt0, rt1, G, c; const char* A; const char* B; size_t at, bt, be;
    __device__ __forceinline__ bool next(int i, Unit& u) const {
        const int L = i * G + c, n = (rt1 - rt0) * 8; if (L >= n) return false;
        u.pm = rt0 + (L >> 3); u.pn = L & 7; const int e = tile_e[u.pm];
        u.a = A + (size_t)u.pm * at; u.b = B + (size_t)e * be + (size_t)u.pn * bt; return true; }
};

__device__ __forceinline__ void load_rstd(const float* ssp, int row0, int fq, float (&rs)[2][4]) {
#pragma unroll
    for (int ai = 0; ai < 2; ++ai)
#pragma unroll
        for (int m = 0; m < 4; ++m) {
            const float* sp = ssp + (size_t)(row0 + ai * 128 + m * 16) * 32 + fq * 8;
            const f32x4 a = *(const f32x4*)sp, b = *(const f32x4*)(sp + 4);
            float s = ((a[0] + a[1]) + (a[2] + a[3])) + ((b[0] + b[1]) + (b[2] + b[3]));
            s += __shfl_xor(s, 16); s += __shfl_xor(s, 32);
            rs[ai][m] = 1.0f / sqrtf(s * (1.0f / DM) + EPS);
        }
}
struct EpiInProj {
    static constexpr bool PERM = true;
    bf16* U; const float* ssp; const float* lbv;
    __device__ __forceinline__ void operator()(const f32x4 (&acc)[2][2][4][2], const Unit& u, int wr, int wc, int fr, int fq) const {
        const int row0 = u.pm * 256 + wr * 64 + fr;
        float rs[2][4]; load_rstd(ssp, row0, fq, rs);
        const int pn = u.pn;
        if (pn >= 20) {
            const int col0 = 5120 + (pn - 20) * 128 + wc * 32 + 8 * fq;
#pragma unroll
            for (int ai = 0; ai < 2; ++ai)
#pragma unroll
                for (int m = 0; m < 4; ++m) { const float r2 = rs[ai][m] * rs[ai][m];
                    const f32x4 a0 = acc[ai][0][m][0] * acc[ai][1][m][0] * r2, a1 = acc[ai][0][m][1] * acc[ai][1][m][1] * r2;
                    v4u w; w.x = cvt_pk_bf16(a0[0], a0[1]); w.y = cvt_pk_bf16(a0[2], a0[3]); w.z = cvt_pk_bf16(a1[0], a1[1]); w.w = cvt_pk_bf16(a1[2], a1[3]);
                    *(v4u*)(U + (size_t)(row0 + ai * 128 + m * 16) * UP + col0) = w; }
            return;
        }
        const int kind = pn >> 2;
        const int col0 = pn * 256 + wc * 32 + 8 * fq;
        f32x4 lb[2][2];
        if (kind == 1) {
#pragma unroll
            for (int bj = 0; bj < 2; ++bj)
#pragma unroll
                for (int n = 0; n < 2; ++n) lb[bj][n] = *(const f32x4*)(lbv + (col0 - 1024) + bj * 128 + 4 * n);
            asm volatile("" :: "v"(lb[0][0]), "v"(lb[0][1]), "v"(lb[1][0]), "v"(lb[1][1]));
        }
#pragma unroll
        for (int ai = 0; ai < 2; ++ai)
#pragma unroll
            for (int m = 0; m < 4; ++m) { bf16* rowp = U + (size_t)(row0 + ai * 128 + m * 16) * UP + col0; const float r = rs[ai][m];
#pragma unroll
                for (int bj = 0; bj < 2; ++bj) { f32x4 v0 = acc[ai][bj][m][0] * r, v1 = acc[ai][bj][m][1] * r;
                    if (kind == 0 || kind == 3) {
#pragma unroll
                        for (int j = 0; j < 4; ++j) { v0[j] = siluf_(v0[j]); v1[j] = siluf_(v1[j]); }
                    } else if (kind == 1) {
#pragma unroll
                        for (int j = 0; j < 4; ++j) { v0[j] = __builtin_amdgcn_logf(lb[bj][0][j] + (1.0f - lb[bj][0][j]) * sigmoidf_(v0[j])); v1[j] = __builtin_amdgcn_logf(lb[bj][1][j] + (1.0f - lb[bj][1][j]) * sigmoidf_(v1[j]));     }
                    }
                    v4u w; w.x = cvt_pk_bf16(v0[0], v0[1]); w.y = cvt_pk_bf16(v0[2], v0[3]); w.z = cvt_pk_bf16(v1[0], v1[1]); w.w = cvt_pk_bf16(v1[2], v1[3]);
                    *(v4u*)(rowp + bj * 128) = w; } }
    }
};
struct EpiBf16Plain {
    static constexpr bool PERM = true;
    bf16* O; int ldc;
    __device__ __forceinline__ void operator()(const f32x4 (&acc)[2][2][4][2], const Unit& u, int wr, int wc, int fr, int fq) const {
        const int row0 = u.pm * 256 + wr * 64 + fr, col0 = u.pn * 256 + wc * 32 + 8 * fq;
#pragma unroll
        for (int ai = 0; ai < 2; ++ai)
#pragma unroll
            for (int m = 0; m < 4; ++m) { bf16* rowp = O + (size_t)(row0 + ai * 128 + m * 16) * ldc + col0;
#pragma unroll
                for (int bj = 0; bj < 2; ++bj) { const f32x4 v0 = acc[ai][bj][m][0], v1 = acc[ai][bj][m][1];
                    v4u w; w.x = cvt_pk_bf16(v0[0], v0[1]); w.y = cvt_pk_bf16(v0[2], v0[3]); w.z = cvt_pk_bf16(v1[0], v1[1]); w.w = cvt_pk_bf16(v1[2], v1[3]);
                    *(v4u*)(rowp + bj * 128) = w; } }
    }
};
template <bool ROWTAB, bool F8> struct EpiSwiglu {
    static constexpr bool PERM = true;
    void* H; int ldc; const float* ssp; const float* rtab;
    __device__ __forceinline__ void operator()(const f32x4 (&acc)[2][2][4][2], const Unit& u, int wr, int wc, int fr, int fq) const {
        const int row0 = u.pm * 256 + wr * 64 + fr, col0 = u.pn * 128 + wc * 32 + 8 * fq;
        float rs[2][4];
        if constexpr (ROWTAB) {
#pragma unroll
            for (int ai = 0; ai < 2; ++ai)
#pragma unroll
                for (int m = 0; m < 4; ++m) rs[ai][m] = rtab[row0 + ai * 128 + m * 16];
        } else load_rstd(ssp, row0, fq, rs);
#pragma unroll
        for (int ai = 0; ai < 2; ++ai)
#pragma unroll
            for (int m = 0; m < 4; ++m) { const float r = rs[ai][m];
                f32x4 h0, h1;
#pragma unroll
                for (int j = 0; j < 4; ++j) { h0[j] = siluf_(acc[ai][0][m][0][j] * r) * (acc[ai][1][m][0][j] * r); h1[j] = siluf_(acc[ai][0][m][1][j] * r) * (acc[ai][1][m][1][j] * r); }
                const size_t o = (size_t)(row0 + ai * 128 + m * 16) * ldc + col0;
                if constexpr (F8) *(v2u*)((unsigned char*)H + o) = pk8_fp8(h0, h1);
                else { v4u w; w.x = cvt_pk_bf16(h0[0], h0[1]); w.y = cvt_pk_bf16(h0[2], h0[3]); w.z = cvt_pk_bf16(h1[0], h1[1]); w.w = cvt_pk_bf16(h1[2], h1[3]); *(v4u*)((bf16*)H + o) = w; } }
    }
};
__device__ __forceinline__ void unpack8(const v4u w, f32x4& a, f32x4& b) { a[0] = bflo(w.x); a[1] = bfhi(w.x); a[2] = bflo(w.y); a[3] = bfhi(w.y); b[0] = bflo(w.z); b[1] = bfhi(w.z); b[2] = bflo(w.w); b[3] = bfhi(w.w); }
template <int MODE  , bool XF32, bool F8C = false  > struct EpiResid {
    static constexpr bool PERM = true;
    const float* xf; const bf16* xold; bf16* xnew; float* ssp_out; const float* colscale; const float* ssp_in; const bf16* PJ; unsigned char* xq;
    __device__ __forceinline__ void operator()(const f32x4 (&acc)[2][2][4][2], const Unit& u, int wr, int wc, int fr, int fq) const {
        const int row0 = u.pm * 256 + wr * 64 + fr, col0 = u.pn * 256 + wc * 32 + 8 * fq;
        float rs[2][4];
        if constexpr (MODE == 2) load_rstd(ssp_in, row0, fq, rs);
        f32x4 cs[2][2];
        if constexpr (MODE == 1) {
#pragma unroll
            for (int bj = 0; bj < 2; ++bj)
#pragma unroll
                for (int n = 0; n < 2; ++n) cs[bj][n] = *(const f32x4*)(colscale + col0 + bj * 128 + 4 * n);
        }
#pragma unroll
        for (int am = 0; am < 4; ++am) { const int ai = am >> 1, mb = (am & 1) * 2;
            v4u xo[2][2], pj[2][2]; f32x4 xf0[2][2], xf1[2][2];
#pragma unroll
            for (int mm = 0; mm < 2; ++mm)
#pragma unroll
                for (int bj = 0; bj < 2; ++bj) { const size_t o = (size_t)(row0 + ai * 128 + (mb + mm) * 16) * DM + col0 + bj * 128;
                    if constexpr (XF32) { xf0[mm][bj] = *(const f32x4*)(xf + o); xf1[mm][bj] = *(const f32x4*)(xf + o + 4); } else xo[mm][bj] = *(const v4u*)(xold + o);
                    if constexpr (MODE == 2) pj[mm][bj] = *(const v4u*)(PJ + o); }
            asm volatile("" ::: "memory");
#pragma unroll
            for (int mm = 0; mm < 2; ++mm) { const int m = mb + mm; const int row = row0 + ai * 128 + m * 16; const size_t off = (size_t)row * DM + col0; float ss = 0.f;
#pragma unroll
                for (int bj = 0; bj < 2; ++bj) { const size_t o = off + bj * 128; f32x4 v0 = acc[ai][bj][m][0], v1 = acc[ai][bj][m][1];
                    if constexpr (MODE == 1) { v0 = v0 * cs[bj][0]; v1 = v1 * cs[bj][1]; }
                    if constexpr (MODE == 2) { f32x4 p0, p1; unpack8(pj[mm][bj], p0, p1); const float r = rs[ai][m];
#pragma unroll
                        for (int j = 0; j < 4; ++j) { v0[j] = sigmoidf_(v0[j] * r) * p0[j]; v1[j] = sigmoidf_(v1[j] * r) * p1[j]; } }
                    f32x4 x0, x1;
                    if constexpr (XF32) { x0 = xf0[mm][bj]; x1 = xf1[mm][bj]; } else unpack8(xo[mm][bj], x0, x1);
                    x0 += v0; x1 += v1;
                    v4u w; w.x = cvt_pk_bf16(x0[0], x0[1]); w.y = cvt_pk_bf16(x0[2], x0[3]); w.z = cvt_pk_bf16(x1[0], x1[1]); w.w = cvt_pk_bf16(x1[2], x1[3]);
                    *(v4u*)(xnew + o) = w;
                    if constexpr (F8C) *(v2u*)(xq + o) = pk8_fp8(x0, x1);
                    ss += ((x0[0] * x0[0] + x0[1] * x0[1]) + (x0[2] * x0[2] + x0[3] * x0[3])) + ((x1[0] * x1[0] + x1[1] * x1[1]) + (x1[2] * x1[2] + x1[3] * x1[3])); }
                ss += __shfl_xor(ss, 16); ss += __shfl_xor(ss, 32);
                if (fq == 0) ssp_out[(size_t)row * 32 + u.pn * 4 + wc] = ss;
            }
            asm volatile("" ::: "memory");
        }
    }
};
template <bool RANK2, bool F8C = false> struct EpiMoeDown {
    static constexpr bool PERM = true;
    bf16* X; float* ssp_out; const int* tokc; const float* gwc; unsigned char* xq;
    __device__ __forceinline__ void operator()(const f32x4 (&acc)[2][2][4][2], const Unit& u, int wr, int wc, int fr, int fq) const {
        const int row0 = u.pm * 256 + wr * 64 + fr, col0 = u.pn * 256 + wc * 32 + 8 * fq;
#pragma unroll
        for (int ai = 0; ai < 2; ++ai)
#pragma unroll
            for (int m = 0; m < 4; ++m) { const int cr = row0 + ai * 128 + m * 16; const int tok = tokc[cr]; const float gw = gwc[cr]; const bool ok = tok >= 0;
                const size_t off = (size_t)(ok ? tok : 0) * DM + col0; float ss = 0.f;
#pragma unroll
                for (int bj = 0; bj < 2; ++bj) { const size_t o = off + bj * 128;
                    if (ok) { f32x4 x0, x1; unpack8(*(const v4u*)(X + o), x0, x1); x0 += acc[ai][bj][m][0] * gw; x1 += acc[ai][bj][m][1] * gw;
                        v4u w; w.x = cvt_pk_bf16(x0[0], x0[1]); w.y = cvt_pk_bf16(x0[2], x0[3]); w.z = cvt_pk_bf16(x1[0], x1[1]); w.w = cvt_pk_bf16(x1[2], x1[3]);
                        *(v4u*)(X + o) = w;
                        if constexpr (RANK2 && F8C) *(v2u*)(xq + o) = pk8_fp8(x0, x1);
                        if constexpr (RANK2) ss += ((x0[0] * x0[0] + x0[1] * x0[1]) + (x0[2] * x0[2] + x0[3] * x0[3])) + ((x1[0] * x1[0] + x1[1] * x1[1]) + (x1[2] * x1[2] + x1[3] * x1[3])); } }
                if constexpr (RANK2) { ss += __shfl_xor(ss, 16); ss += __shfl_xor(ss, 32);
                    if (fq == 0 && ok) ssp_out[(size_t)tok * 32 + u.pn * 4 + wc] = ss; }
            }
    }
};

struct Args { const float* in[24]; float* out; unsigned char* ws; };
struct Frame {
    LAS unsigned char* lds; volatile LAS unsigned* MISC; gu32* ctl;
    int tid, lane, wave, G, bx;
};

constexpr int TRP = 136;
constexpr int TRP8 = 68;
struct TrJob { const float* W0; const float* W1; int c0, c1, ldw, K, N, NP; bf16* WT; const float* gain; int f8; };
__device__ __forceinline__ int tr_items(const TrJob& J) { return (J.K / 64) * (J.NP ? J.NP * 4 : J.N / 64); }
__device__ __forceinline__ void tr_map(const TrJob& J, int it, int& kb, int& nb) {
    const int nnb = J.NP ? J.NP * 4 : J.N / 64, sup = it >> 3, sub = it & 7, nsn = nnb >> 1;
    kb = (sup / nsn) * 4 + (sub >> 1); nb = (sup % nsn) * 2 + (sub & 1);
}
__device__ __forceinline__ void tr_src(const TrJob& J, int nb, const float*& W, int& sc) {
    W = J.W0; sc = J.c0 + nb * 64;
    if (J.NP) { const int j = nb >> 2, q = nb & 3; W = (q < 2) ? J.W0 : J.W1; sc = ((q < 2) ? J.c0 : J.c1) + 128 * j + 64 * (q & 1); }
}
__device__ __forceinline__ void tr_load(const TrJob& J, int it, f32x4 (&v)[16], float (&g)[16], int lane) {
    int kb, nb; tr_map(J, it, kb, nb); const float* W; int sc; tr_src(J, nb, W, sc);
    const float* src = W + (size_t)(kb * 64 + (lane >> 4)) * J.ldw + sc + 4 * (lane & 15);
#pragma unroll
    for (int i = 0; i < 16; ++i) v[i] = *(const f32x4*)(src + (size_t)(4 * i) * J.ldw);
    if (J.gain) {
#pragma unroll
        for (int i = 0; i < 16; ++i) g[i] = J.gain[kb * 64 + 4 * i + (lane >> 4)];
    } else {
#pragma unroll
        for (int i = 0; i < 16; ++i) g[i] = 1.0f;
    }
}
__device__ __forceinline__ void tr_store(const TrJob& J, int it, const f32x4 (&v)[16], const float (&gg)[16], LAS unsigned char* scr, int lane) {
    int kb, nb; tr_map(J, it, kb, nb); const int k0 = kb * 64, drow0 = nb * 64;
    if (J.f8) {
#pragma unroll
        for (int i = 0; i < 16; ++i) { const int kk = 4 * i + (lane >> 4); const float g = gg[i] * 64.0f;
            int w = 0; w = __builtin_amdgcn_cvt_pk_fp8_f32(v[i][0] * g, v[i][1] * g, w, false); w = __builtin_amdgcn_cvt_pk_fp8_f32(v[i][2] * g, v[i][3] * g, w, true);
            *(LAS int*)(scr + kk * TRP8 + 4 * (lane & 15)) = w; }
        LDS_WAIT(); asm volatile("" ::: "memory");
        const int c = lane & 3; unsigned char* WT = (unsigned char*)J.WT;
#pragma unroll
        for (int j = 0; j < 4; ++j) { const int n = (lane >> 2) + 16 * j; const LAS unsigned char* s = scr + (16 * c) * TRP8 + n;
            v4u o;
            o.x = (unsigned)s[0 * TRP8] | ((unsigned)s[1 * TRP8] << 8) | ((unsigned)s[2 * TRP8] << 16) | ((unsigned)s[3 * TRP8] << 24);
            o.y = (unsigned)s[4 * TRP8] | ((unsigned)s[5 * TRP8] << 8) | ((unsigned)s[6 * TRP8] << 16) | ((unsigned)s[7 * TRP8] << 24);
            o.z = (unsigned)s[8 * TRP8] | ((unsigned)s[9 * TRP8] << 8) | ((unsigned)s[10 * TRP8] << 16) | ((unsigned)s[11 * TRP8] << 24);
            o.w = (unsigned)s[12 * TRP8] | ((unsigned)s[13 * TRP8] << 8) | ((unsigned)s[14 * TRP8] << 16) | ((unsigned)s[15 * TRP8] << 24);
            *(GAS v4u*)(WT + (size_t)(drow0 + n) * J.K + k0 + 16 * c) = o; }
    } else {
#pragma unroll
        for (int i = 0; i < 16; ++i) { const int kk = 4 * i + (lane >> 4); const float g = gg[i];
            v2u w; w.x = cvt_pk_bf16(v[i][0] * g, v[i][1] * g); w.y = cvt_pk_bf16(v[i][2] * g, v[i][3] * g);
            *(LAS v2u*)(scr + kk * TRP + 8 * (lane & 15)) = w; }
        LDS_WAIT(); asm volatile("" ::: "memory");
        const int c = lane & 7;
#pragma unroll
        for (int j = 0; j < 8; ++j) { const int n = (lane >> 3) + 8 * j; const LAS unsigned short* s = (const LAS unsigned short*)(scr + (8 * c) * TRP + 2 * n);
            v4u o; o.x = (unsigned)s[0] | ((unsigned)s[TRP / 2] << 16); o.y = (unsigned)s[2 * (TRP / 2)] | ((unsigned)s[3 * (TRP / 2)] << 16);
            o.z = (unsigned)s[4 * (TRP / 2)] | ((unsigned)s[5 * (TRP / 2)] << 16); o.w = (unsigned)s[6 * (TRP / 2)] | ((unsigned)s[7 * (TRP / 2)] << 16);
            *(GAS v4u*)(J.WT + (size_t)(drow0 + n) * J.K + k0 + 8 * c) = o; }
    }
    LDS_WAIT(); asm volatile("" ::: "memory");
}
__device__ __forceinline__ int tr_job(const TrJob& J, int base, int wv, int nw, LAS unsigned char* scr, int lane) {
    const int nit = tr_items(J);
    int it = (wv - base % nw + nw) % nw;
    f32x4 va[16], vb[16]; float ga[16], gb[16];
    if (it < nit) tr_load(J, it, va, ga, lane);
    while (it < nit) {
        const int nx = it + nw;
        if (nx < nit) tr_load(J, nx, vb, gb, lane);
        tr_store(J, it, va, ga, scr, lane);
        if (nx >= nit) break;
        const int nx2 = nx + nw;
        if (nx2 < nit) tr_load(J, nx2, va, ga, lane);
        tr_store(J, nx, vb, gb, scr, lane);
        it = nx2;
    }
    return base + nit;
}

constexpr int H_QT = 0, H_KT = 17408, H_QC = 34816, H_KH = 52224, H_VT = 70656, H_TOT = 89088, H_DEC = 93184, H_NRM = 93696  , H_END = 95744;
constexpr int TP = 272  , CP = 144  ;
__device__ __forceinline__ f32x16 mfma32(bf16x8 a, bf16x8 b, f32x16 c) { return __builtin_amdgcn_mfma_f32_32x32x16_bf16(a, b, c, 0, 0, 0); }
__device__ __forceinline__ bf16x8 pack8(const f32x16& v, int o) {
    v4u w; w.x = cvt_pk_bf16(v[o + 0], v[o + 1]); w.y = cvt_pk_bf16(v[o + 2], v[o + 3]); w.z = cvt_pk_bf16(v[o + 4], v[o + 5]); w.w = cvt_pk_bf16(v[o + 6], v[o + 7]);
    return __builtin_bit_cast(bf16x8, w);
}
__device__ __forceinline__ bf16x8 ld2x8(const LAS unsigned char* p) {
    const v2u a = *(const LAS v2u*)p, b = *(const LAS v2u*)(p + 16); v4u w; w.x = a.x; w.y = a.y; w.z = b.x; w.w = b.y; return __builtin_bit_cast(bf16x8, w);
}
struct HgRegs { unsigned lf[8], qs[8], v[8], lf32; };
#define EX2(x) __builtin_amdgcn_exp2f(x)
__device__ __forceinline__ void hg_finish(LAS unsigned char* L, int nbuf, const f32x16& O, const v2u (&gs)[4], const f32x4 (&gn_)[4], bf16* A2o, int tb, int r) {
    float tot = 0.f;
#pragma unroll
    for (int e4 = 0; e4 < 4; ++e4) tot += *(const LAS float*)(L + H_NRM + nbuf * 1024 + (e4 * 64 + 32 * tb + r) * 4);
    const float rstd = 1.0f / sqrtf(tot * (1.0f / HD) + EPS);
#pragma unroll
    for (int q = 0; q < 4; ++q) {
        const f32x4 gn = gn_[q];
        const float o0 = O[4 * q + 0] * rstd * gn[0] * bflo(gs[q].x), o1 = O[4 * q + 1] * rstd * gn[1] * bfhi(gs[q].x);
        const float o2 = O[4 * q + 2] * rstd * gn[2] * bflo(gs[q].y), o3 = O[4 * q + 3] * rstd * gn[3] * bfhi(gs[q].y);
        v2u wv; wv.x = cvt_pk_bf16(o0, o1); wv.y = cvt_pk_bf16(o2, o3);
        *(v2u*)(A2o + 8 * q) = wv; }
}
__device__ __forceinline__ void hgrn_phase(Frame& F, const bf16* U, bf16* A2, const float* hgain) {
    const int b = F.bx >> 3, h = F.bx & 7, w = F.wave, lane = F.lane;
    LAS unsigned char* L = F.lds;
    const int eb = w >> 1, tb = w & 1, r = lane & 31, hh = lane >> 5;
    f32x16 S[4];
#pragma unroll
    for (int d = 0; d < 4; ++d)
#pragma unroll
        for (int i = 0; i < 16; ++i) S[d][i] = 0.f;
    const size_t rowbase0 = (size_t)b * SEQ;
    const bf16* Ucol = U + h * HD + 2 * lane;
    f32x4 gn_[4];
#pragma unroll
    for (int q = 0; q < 4; ++q) gn_[q] = *(const f32x4*)(hgain + h * HD + 32 * eb + 8 * q + 4 * hh);
    const bf16* Ugs = U + 3072 + h * HD + 32 * eb + 4 * hh + (rowbase0 + 32 * tb + r) * UP;
    bf16* A2o = A2 + (rowbase0 + 32 * tb + r) * DM + h * HD + 32 * eb + 4 * hh;
    HgRegs R; v2u gs_[4], gsp_[4];
    f32x16 Op;
#pragma unroll
    for (int i = 0; i < 16; ++i) Op[i] = 0.f;
#define HG_LOAD(n) do { const bf16* p = Ucol + (rowbase0 + (size_t)(n) * CHUNK + 8 * w) * UP; \
        _Pragma("unroll") for (int j = 0; j < 8; ++j) { R.qs[j] = *(const unsigned*)(p + (size_t)j * UP); R.lf[j] = *(const unsigned*)(p + (size_t)j * UP + 1024); R.v[j] = *(const unsigned*)(p + (size_t)j * UP + 2048); } \
        R.lf32 = *(const unsigned*)(Ucol + (rowbase0 + (size_t)(n) * CHUNK + 32) * UP + 1024); \
        _Pragma("unroll") for (int q = 0; q < 4; ++q) gs_[q] = *(const v2u*)(Ugs + (size_t)(n) * CHUNK * UP + 8 * q); } while (0)
    HG_LOAD(0);
    for (int n = 0; n < SEQ / CHUNK; ++n) {
        f32x2 c[8];
        { f32x2 a = (f32x2){0.f, 0.f};
#pragma unroll
          for (int j = 0; j < 8; ++j) { a += (f32x2){bflo(R.lf[j]), bfhi(R.lf[j])}; c[j] = a; }
          *(LAS f32x2*)(L + H_TOT + (w * 128 + 2 * lane) * 4) = a; }
        LDS_BAR();
        if (n > 0) hg_finish(L, (n - 1) & 1, Op, gsp_, gn_, A2o + (size_t)(n - 1) * CHUNK * DM, tb, r);
        { f32x2 pre = (f32x2){0.f, 0.f}, ref = pre, last = pre;
#pragma unroll
          for (int ww = 0; ww < 8; ++ww) { const f32x2 t = *(const LAS f32x2*)(L + H_TOT + (ww * 128 + 2 * lane) * 4);
              if (ww < w) pre += t; if (ww < 4) ref += t; last += t; }
          ref += (f32x2){bflo(R.lf32), bfhi(R.lf32)};
          const f32x2 lr = last - ref;
          const f32x2 eref = (f32x2){EX2(ref.x), EX2(ref.y)}, elr = (f32x2){EX2(lr.x), EX2(lr.y)};
          if (w == 0) *(LAS f32x2*)(L + H_DEC + 2 * lane * 4) = (f32x2){EX2(last.x), EX2(last.y)};
          unsigned kh0[4], kh1[4], vt0[4], vt1[4];
#pragma unroll
          for (int j = 0; j < 8; ++j) {
              const f32x2 d1 = (pre + c[j]) - ref;
              const f32x2 E1 = (f32x2){EX2(d1.x), EX2(d1.y)}, E2 = (f32x2){fast_rcp(E1.x), fast_rcp(E1.y)};
              const f32x2 fv = (f32x2){EX2(bflo(R.lf[j])), EX2(bfhi(R.lf[j]))};
              const f32x2 kq = (f32x2){1.0f, 1.0f} - fv, q = (f32x2){bflo(R.qs[j]), bfhi(R.qs[j])};
              const f32x2 qt = q * E1, kt = kq * E2, qc = qt * eref, kh = kt * elr;
              const int t = 8 * w + j;
              *(LAS unsigned*)(L + H_QT + t * TP + 4 * lane) = cvt_pk_bf16(qt.x, qt.y);
              *(LAS unsigned*)(L + H_KT + t * TP + 4 * lane) = cvt_pk_bf16(kt.x, kt.y);
              *(LAS unsigned*)(L + H_QC + t * TP + 4 * lane) = cvt_pk_bf16(qc.x, qc.y);
              const unsigned kk = cvt_pk_bf16(kh.x, kh.y);
              if (j & 1) { kh0[j >> 1] |= (kk << 16); kh1[j >> 1] |= (kk & 0xffff0000u); vt0[j >> 1] |= (R.v[j] << 16); vt1[j >> 1] |= (R.v[j] & 0xffff0000u); }
              else { kh0[j >> 1] = kk & 0xffffu; kh1[j >> 1] = kk >> 16; vt0[j >> 1] = R.v[j] & 0xffffu; vt1[j >> 1] = R.v[j] >> 16; }
          }
          *(LAS v4u*)(L + H_KH + (2 * lane) * CP + 16 * w) = (v4u){kh0[0], kh0[1], kh0[2], kh0[3]};
          *(LAS v4u*)(L + H_KH + (2 * lane + 1) * CP + 16 * w) = (v4u){kh1[0], kh1[1], kh1[2], kh1[3]};
          *(LAS v4u*)(L + H_VT + (2 * lane) * CP + 16 * w) = (v4u){vt0[0], vt0[1], vt0[2], vt0[3]};
          *(LAS v4u*)(L + H_VT + (2 * lane + 1) * CP + 16 * w) = (v4u){vt1[0], vt1[1], vt1[2], vt1[3]};
        }
        LDS_BAR();
#pragma unroll
        for (int q = 0; q < 4; ++q) gsp_[q] = gs_[q];
        if (n + 1 < SEQ / CHUNK) HG_LOAD(n + 1);
        f32x16 O;
#pragma unroll
        for (int i = 0; i < 16; ++i) O[i] = 0.f;
#pragma unroll
        for (int sb = 0; sb < 2; ++sb) {
            if (sb <= tb) {
                f32x16 P;
#pragma unroll
                for (int i = 0; i < 16; ++i) P[i] = 0.f;
                bf16x8 fa[8], fb[8];
#pragma unroll
                for (int ks = 0; ks < 8; ++ks) { fa[ks] = *(const LAS bf16x8*)(L + H_KT + (32 * sb + r) * TP + (16 * ks + 8 * hh) * 2); fb[ks] = *(const LAS bf16x8*)(L + H_QT + (32 * tb + r) * TP + (16 * ks + 8 * hh) * 2); }
#pragma unroll
                for (int ks = 0; ks < 8; ++ks) P = mfma32(fa[ks], fb[ks], P);
                if (sb == tb) {
#pragma unroll
                    for (int i = 0; i < 16; ++i) { const int s = (i & 3) + 8 * (i >> 2) + 4 * hh; if (s > r) P[i] = 0.f; }
                }
#pragma unroll
                for (int k2 = 0; k2 < 2; ++k2) {
                    const bf16x8 av = ld2x8(L + H_VT + (32 * eb + r) * CP + (32 * sb + 16 * k2 + 4 * hh) * 2);
                    O = mfma32(av, pack8(P, 8 * k2), O);
                }
            }
        }
        { bf16x8 fq[8];
#pragma unroll
          for (int i = 0; i < 8; ++i) fq[i] = ld2x8(L + H_QC + (32 * tb + r) * TP + (32 * (i >> 1) + 16 * (i & 1) + 4 * hh) * 2);
#pragma unroll
          for (int i = 0; i < 8; ++i) O = mfma32(pack8(S[i >> 1], 8 * (i & 1)), fq[i], O); }
        { bf16x8 fv[4];
#pragma unroll
          for (int ks = 0; ks < 4; ++ks) fv[ks] = *(const LAS bf16x8*)(L + H_VT + (32 * eb + r) * CP + (16 * ks + 8 * hh) * 2);
#pragma unroll
          for (int db = 0; db < 4; ++db) {
              bf16x8 fk[4];
#pragma unroll
              for (int ks = 0; ks < 4; ++ks) fk[ks] = *(const LAS bf16x8*)(L + H_KH + (32 * db + r) * CP + (16 * ks + 8 * hh) * 2);
#pragma unroll
              for (int q = 0; q < 4; ++q) { const f32x4 dc = *(const LAS f32x4*)(L + H_DEC + (32 * db + 8 * q + 4 * hh) * 4);
                  S[db][4 * q + 0] *= dc[0]; S[db][4 * q + 1] *= dc[1]; S[db][4 * q + 2] *= dc[2]; S[db][4 * q + 3] *= dc[3]; }
#pragma unroll
              for (int ks = 0; ks < 4; ++ks) S[db] = mfma32(fk[ks], fv[ks], S[db]);
          } }
        float ssq = 0.f;
#pragma unroll
        for (int i = 0; i < 16; ++i) ssq += O[i] * O[i];
        ssq += __shfl_xor(ssq, 32);
        if (hh == 0) *(LAS float*)(L + H_NRM + (n & 1) * 1024 + (eb * 64 + 32 * tb + r) * 4) = ssq;
        Op = O;
    }
    LDS_BAR();
    hg_finish(L, (SEQ / CHUNK - 1) & 1, Op, gsp_, gn_, A2o + (size_t)(SEQ / CHUNK - 1) * CHUNK * DM, tb, r);
#undef HG_LOAD
}
#undef EX2
__device__ __forceinline__ void conv_phase(Frame& F, const bf16* U, bf16* A2, const float* convw, int first_block) {
    const int nb = F.G - first_block, me = F.bx - first_block, c = 2 * F.tid;
    const float w00 = convw[c], w01 = convw[c + 1], w10 = convw[DC + c], w11 = convw[DC + c + 1], w20 = convw[2 * DC + c], w21 = convw[2 * DC + c + 1];
    for (int u = me; u < M / 32; u += nb) {
        const int R0 = u * 32, t0 = R0 % SEQ;
        const bf16* up = U + (size_t)R0 * UP;
        float a0 = 0.f, a1 = 0.f, b0 = 0.f, b1 = 0.f;
        if (t0 != 0) { const unsigned p2 = *(const unsigned*)(up - 2 * (size_t)UP + 5120 + c), p1 = *(const unsigned*)(up - (size_t)UP + 5120 + c);
            a0 = bflo(p2); a1 = bfhi(p2); b0 = bflo(p1); b1 = bfhi(p1); }
#pragma unroll 8
        for (int j = 0; j < 32; ++j) {
            const unsigned tt = *(const unsigned*)(up + (size_t)j * UP + 5120 + c), gb = *(const unsigned*)(up + (size_t)j * UP + 4096 + c);
            const float t0f = bflo(tt), t1f = bfhi(tt);
            const float y0 = bflo(gb) * (w00 * a0 + w10 * b0 + w20 * t0f), y1 = bfhi(gb) * (w01 * a1 + w11 * b1 + w21 * t1f);
            *(unsigned*)(A2 + (size_t)(R0 + j) * DM + DH + c) = cvt_pk_bf16(y0, y1);
            a0 = b0; a1 = b1; b0 = t0f; b1 = t1f;
        }
    }
}

#ifndef PH_ENABLE
#define PH_ENABLE 0xffffffffu
#endif
#define PH(k) (((PH_ENABLE) >> (k)) & 1u)
#ifndef PROBE_DUP
#define PROBE_DUP (-1)
#endif
#define REPS(k) ((PROBE_DUP) == (k) ? 2 : 1)
__global__ void __launch_bounds__(NWAVES * 64, 2) fwd_kernel(Args args) {
    extern __shared__ __attribute__((aligned(16))) unsigned char lds[];
    Frame F;
    F.lds = (LAS unsigned char*)lds;
    F.MISC = (volatile LAS unsigned*)(F.lds + MISC_OFF);
    F.tid = threadIdx.x; F.lane = F.tid & 63; F.wave = __builtin_amdgcn_readfirstlane(F.tid >> 6);
    F.G = gridDim.x; F.bx = blockIdx.x;
    unsigned char* ws = args.ws;
    F.ctl = (gu32*)(ws + WS_CTL);
    for (int u = F.tid; u < (LDS_BYTES - LDSCTL_OFF) / 4; u += NWAVES * 64) ((LAS unsigned*)(F.lds + LDSCTL_OFF))[u] = 0u;
    __syncthreads();
    XcdBarrier bar = xcd_barrier_post((unsigned*)(F.ctl + CW_BAR), F.MISC + 8);
#define GRID_BAR() xcd_barrier(bar)
#define REFRESH() do { int t_ = threadIdx.x; asm volatile("" : "+v"(t_)); F.tid = t_; F.lane = t_ & 63; F.wave = __builtin_amdgcn_readfirstlane(t_ >> 6); \
        int b_ = blockIdx.x; asm volatile("" : "+s"(b_)); F.bx = b_; gw = F.bx * NWAVES + F.wave; \
        kp_ = (const float* const __attribute__((address_space(4)))*)__builtin_amdgcn_kernarg_segment_ptr(); asm volatile("" : "+s"(kp_)); \
        ws_ = (unsigned char*)kp_[25]; X_ = (float*)kp_[24]; } while (0)
    const float* const __attribute__((address_space(4)))* kp_ = (const float* const __attribute__((address_space(4)))*)__builtin_amdgcn_kernarg_segment_ptr();
    unsigned char* ws_ = args.ws; float* X_ = args.out;
#define I_x (kp_[0])
#define I_p (kp_[1])
#define I_final_gain (kp_[2])
#define I_lb_table (kp_[3])
#define I_mix_norm_even (kp_[4])
#define I_w_in (kp_[5])
#define I_hgrn_gain (kp_[6])
#define I_conv_w (kp_[7])
#define I_w_out (kp_[8])
#define I_ffn_norm_even (kp_[9])
#define I_w_gate (kp_[10])
#define I_w_up (kp_[11])
#define I_w_down (kp_[12])
#define I_mix_norm_odd (kp_[13])
#define I_pool_w (kp_[14])
#define I_pool_scale (kp_[15])
#define I_ffn_norm_odd (kp_[16])
#define I_w_router (kp_[17])
#define I_w_gate_e (kp_[18])
#define I_w_up_e (kp_[19])
#define I_w_down_e (kp_[20])
#define I_ple_norm (kp_[21])
#define I_ple_gate_w (kp_[22])
#define I_ple_proj (kp_[23])
#define W_lbv ((float*)(ws_ + WS_LBV))
#define W_rs4 ((float*)(ws_ + WS_RS4))
#define W_topi ((int*)(ws_ + WS_TOP))
#define W_topw ((float*)(ws_ + WS_TOPW))
#define W_sspA ((float*)(ws_ + WS_SSPA))
#define W_sspB ((float*)(ws_ + WS_SSPB))
#define W_list ((int*)(ws_ + WS_LIST))
#define W_gwl ((float*)(ws_ + WS_GWL))
#define W_tokc ((int*)(ws_ + WS_TOKC))
#define W_gwc ((float*)(ws_ + WS_GWC))
#define W_rsc ((float*)(ws_ + WS_RSC))
#define W_Win_t ((bf16*)(ws_ + WS_WIN))
#define W_Wout_t ((bf16*)(ws_ + WS_WOUT))
#define W_Wgu_t ((bf16*)(ws_ + WS_WGU))
#define W_Wd_t ((bf16*)(ws_ + WS_WD))
#define W_Wpool_t ((bf16*)(ws_ + WS_WPOOL))
#define W_Wmgu_t ((bf16*)(ws_ + WS_WMGU))
#define W_Wmd_t ((bf16*)(ws_ + WS_WMD))
#define W_Wpg_t ((bf16*)(ws_ + WS_WPG))
#define W_Wpp_t ((bf16*)(ws_ + WS_WPP))
#define W_PB ((bf16*)(ws_ + WS_PB))
#define W_XB ((bf16*)(ws_ + WS_XB))
#define W_A2 ((bf16*)(ws_ + WS_A2))
#define W_PJ ((bf16*)(ws_ + WS_A2))
#define W_U ((bf16*)(ws_ + WS_BIG))
#define W_Hh ((bf16*)(ws_ + WS_BIG))
#define W_D1 ((bf16*)(ws_ + WS_BIG))
#define W_XG ((bf16*)(ws_ + WS_BIG))
#define W_HE ((bf16*)(ws_ + WS_HE))
#define W_X (X_)
#define W_XS0 ((bf16*)(ws_ + WS_XB))
#define W_XQ ((unsigned char*)X_)
#define W_XS1 ((bf16*)((unsigned char*)X_ + 64 * MiB))
#define W_XB0 ((bf16*)X_)
    int gw = F.bx * NWAVES + F.wave; const int NGW = F.G * NWAVES;

#ifndef CONV_MODE
#define CONV_MODE 0
#endif
#define CONVERT_REST(FIRSTB) do { \
            LDS_BAR(); \
            LAS unsigned char* scr = F.lds + F.wave * 16384; \
            const int wv = (F.bx - (FIRSTB)) * NWAVES + F.wave, nw = (F.G - (FIRSTB)) * NWAVES; int base = 0; \
            { const TrJob J{I_w_out, I_w_out, 0, 0, DM, DM, DM, 0, W_Wout_t, nullptr, 0}; base = tr_job(J, base, wv, nw, scr, F.lane); } \
            { const TrJob J{I_w_gate, I_w_up, 0, 0, DFF, DM, 0, DFF / 128, W_Wgu_t, I_ffn_norm_even, F8_GU}; base = tr_job(J, base, wv, nw, scr, F.lane); } \
            { const TrJob J{I_w_down, I_w_down, 0, 0, DM, DFF, DM, 0, W_Wd_t, nullptr, F8_DN}; base = tr_job(J, base, wv, nw, scr, F.lane); } \
            for (int i = 0; i < 2; ++i) { const TrJob J{I_ple_proj + (size_t)i * DPLE * DM, nullptr, 0, 0, DM, DPLE, DM, 0, W_Wpp_t + (size_t)i * DM * DPLE, nullptr, 0}; base = tr_job(J, base, wv, nw, scr, F.lane); } \
            for (int i = 0; i < 2; ++i) { const TrJob J{I_ple_gate_w + (size_t)i * DM * DM, nullptr, 0, 0, DM, DM, DM, 0, W_Wpg_t + (size_t)i * DM * DM, I_ple_norm + i * DM, (i == 1 && F8_PLE1) ? 1 : 0}; base = tr_job(J, base, wv, nw, scr, F.lane); } \
            for (int g = 0; g < 4; ++g) { const TrJob J{I_pool_w + (size_t)g * 512 * 512, nullptr, 0, 0, 512, 512, 512, 0, W_Wpool_t + (size_t)512 * g * 512, I_mix_norm_odd + 512 * g, 0}; base = tr_job(J, base, wv, nw, scr, F.lane); } \
            for (int e = 0; e < NE; ++e) { const TrJob J{I_w_gate_e + (size_t)e * DM * DFE, I_w_up_e + (size_t)e * DM * DFE, 0, 0, DFE, DM, 0, DFE / 128, W_Wmgu_t + (size_t)e * 2048 * DM / (F8_MOE ? 2 : 1), I_ffn_norm_odd, F8_MOE}; base = tr_job(J, base, wv, nw, scr, F.lane); } \
            for (int e = 0; e < NE; ++e) { const TrJob J{I_w_down_e + (size_t)e * DFE * DM, nullptr, 0, 0, DM, DFE, DM, 0, W_Wmd_t + (size_t)e * DM * DFE / (F8_MOE ? 2 : 1), nullptr, F8_MOE}; base = tr_job(J, base, wv, nw, scr, F.lane); } \
            for (size_t i = (size_t)(F.bx - (FIRSTB)) * 512 + F.tid; i < (size_t)2 * M * DPLE / 8; i += (size_t)(F.G - (FIRSTB)) * 512) { \
                const f32x4 a = ((const f32x4*)I_p)[2 * i], b2 = ((const f32x4*)I_p)[2 * i + 1]; \
                v4u w; w.x = cvt_pk_bf16(a[0], a[1]); w.y = cvt_pk_bf16(a[2], a[3]); w.z = cvt_pk_bf16(b2[0], b2[1]); w.w = cvt_pk_bf16(b2[2], b2[3]); ((v4u*)W_PB)[i] = w; } \
        } while (0)
    for (int rep_ = 0; rep_ < REPS(0); ++rep_) { REFRESH();
        LAS unsigned char* scr = F.lds + F.wave * 16384;
        int base = 0;
        { const TrJob J{I_w_in, I_w_in, 0, 0, NIN, DM, 5120, 0, W_Win_t, I_mix_norm_even, 0}; base = tr_job(J, base, gw, NGW, scr, F.lane); }
        { const TrJob J{I_w_in, I_w_in, 5120, 6144, NIN, DM, 0, 8, W_Win_t + (size_t)5120 * DM, I_mix_norm_even, 0}; base = tr_job(J, base, gw, NGW, scr, F.lane); }
        for (int m = gw; m < M; m += NGW) {
            const GAS f32x4* xr = (const GAS f32x4*)(I_x + (size_t)m * DM) + F.lane; GAS v2u* o8 = (GAS v2u*)(W_XB0 + (size_t)m * DM) + F.lane; float s = 0.f;
#pragma unroll
            for (int j = 0; j < 8; ++j) { const f32x4 v = xr[64 * j]; s += (v[0] * v[0] + v[1] * v[1]) + (v[2] * v[2] + v[3] * v[3]); v2u w; w.x = cvt_pk_bf16(v[0], v[1]); w.y = cvt_pk_bf16(v[2], v[3]); o8[64 * j] = w; }
            s = wave_sum(s);
            if (F.lane < 32) W_sspA[(size_t)m * 32 + F.lane] = (F.lane == 0) ? s : 0.f;
        }
        if (F.bx == 0) for (int j = F.tid; j < DH; j += 512) { const float t0 = I_lb_table[j], t1 = I_lb_table[DH + j], t2 = I_lb_table[2 * DH + j]; const float mx = fmaxf(t0, fmaxf(t1, t2));
            const float e0 = __expf(t0 - mx), e1 = __expf(t1 - mx), e2 = __expf(t2 - mx); W_lbv[j] = e0 / (e0 + e1 + e2); }
    }
    GRID_BAR();
    const size_t TB2048 = (size_t)256 * DM * 2;
    for (int rep_ = 0; rep_ < (PH(1) ? REPS(1) : 0); ++rep_) { REFRESH();
        SchedGrid S; S.o.init(M / 256, NIN / 256, F.G, F.bx); S.A = (const char*)W_XB0; S.B = (const char*)W_Win_t; S.at = TB2048; S.bt = TB2048;
        EpiInProj E{W_U, W_sspA, W_lbv};
        pg8::gemm_phase<EpiInProj, SchedGrid, true>(F.lds, DM, DM, DM, S, E);
    }
    GRID_BAR();
    for (int rep_ = 0; rep_ < REPS(2); ++rep_) { REFRESH(); if (F.bx < BATCH * NH) { hgrn_phase(F, W_U, W_A2, I_hgrn_gain); if (PROBE_DUP == 20) hgrn_phase(F, W_U, W_A2, I_hgrn_gain); }
        else for (int rep2_ = 0; rep2_ < (PROBE_DUP == 21 ? 2 : 1); ++rep2_) {
            conv_phase(F, W_U, W_A2, I_conv_w, BATCH * NH);
            if (CONV_MODE == 0) CONVERT_REST(BATCH * NH);
        }
    }
    GRID_BAR();
    if (CONV_MODE == 1) { for (int rep_ = 0; rep_ < REPS(16); ++rep_) { REFRESH(); CONVERT_REST(0); } GRID_BAR(); }
    for (int rep_ = 0; rep_ < (PH(3) ? REPS(3) : 0); ++rep_) { REFRESH();
        SchedGrid S; S.o.init(M / 256, DM / 256, F.G, F.bx); S.A = (const char*)W_A2; S.B = (const char*)W_Wout_t; S.at = TB2048; S.bt = TB2048;
        EpiResid<0, true, F8_GU> E{I_x, nullptr, W_XS0, W_sspB, nullptr, nullptr, nullptr, W_XQ};
        pg8::gemm_phase<EpiResid<0, true, F8_GU>, SchedGrid, true>(F.lds, DM, DM, DM, S, E);
    }
    GRID_BAR();
    for (int rep_ = 0; rep_ < (PH(4) ? REPS(4) : 0); ++rep_) { REFRESH();
        constexpr int EB = F8_GU ? 1 : 2;
        SchedGrid S; S.o.init(M / 256, 2 * DFF / 256, F.G, F.bx); S.A = F8_GU ? (const char*)W_XQ : (const char*)W_XS0; S.B = (const char*)W_Wgu_t; S.at = (size_t)256 * DM * EB; S.bt = (size_t)256 * DM * EB;
        EpiSwiglu<false, F8_DN> E{W_Hh, DFF, W_sspB, nullptr};
        pg8::gemm_phase<EpiSwiglu<false, F8_DN>, SchedGrid, true, F8_GU>(F.lds, DM * EB / 2, DM * EB / 2, DM * EB / 2, S, E);
        REFRESH();
        SchedGrid S2; S2.o.init(M / 256, DM / 256, F.G, F.bx); S2.A = (const char*)W_PB; S2.B = (const char*)W_Wpp_t; S2.at = (size_t)256 * DPLE * 2; S2.bt = (size_t)256 * DPLE * 2;
        EpiBf16Plain E2{W_PJ, DM};
        pg8::gemm_phase<EpiBf16Plain, SchedGrid, true>(F.lds, DPLE, DPLE, DPLE, S2, E2);
    }
    GRID_BAR();
    for (int rep_ = 0; rep_ < (PH(5) ? REPS(5) : 0); ++rep_) { REFRESH();
        SchedGrid S; S.o.init(M / 256, DM / 256, F.G, F.bx); constexpr int EB = F8_DN ? 1 : 2; S.A = (const char*)W_Hh; S.B = (const char*)W_Wd_t; S.at = (size_t)256 * DFF * EB; S.bt = (size_t)256 * DFF * EB;
        EpiResid<0, false> E{nullptr, W_XS0, W_XS0, W_sspA, nullptr, nullptr, nullptr, nullptr};
        pg8::gemm_phase<EpiResid<0, false>, SchedGrid, true, F8_DN>(F.lds, DFF * EB / 2, DFF * EB / 2, DFF * EB / 2, S, E);
    }
    GRID_BAR();
    for (int rep_ = 0; rep_ < (PH(6) ? REPS(6) : 0); ++rep_) { REFRESH();
        SchedGrid S; S.o.init(M / 256, DM / 256, F.G, F.bx); S.A = (const char*)W_XB; S.B = (const char*)W_Wpg_t; S.at = TB2048; S.bt = TB2048;
        EpiResid<2, false> E{nullptr, W_XS0, W_XS1, W_sspB, nullptr, W_sspA, W_PJ, nullptr};
        pg8::gemm_phase<EpiResid<2, false>, SchedGrid, true>(F.lds, DM, DM, DM, S, E);
    }
    GRID_BAR();
    for (int rep_ = 0; rep_ < (PH(7) ? REPS(7) : 0); ++rep_) { REFRESH();
        LAS float* rt = (LAS float*)F.lds;
        for (int seg = F.bx; seg < M / 64; seg += F.G) {
            const int R0 = seg * 64, t0 = R0 % SEQ;
            for (int i = F.wave; i < 80; i += NWAVES) { const int row = R0 - 16 + i; float v = 0.f;
                if (row >= 0 && F.lane < 32) v = W_sspB[(size_t)row * 32 + F.lane];
                v = wave_sum(v); if (F.lane == 0) rt[i] = 1.0f / sqrtf(v * (1.0f / DM) + EPS); }
            LDS_BAR();
            const int wdw = 2 << (F.tid >> 7);
            const bf16* xc = W_XS1 + (size_t)R0 * DM + 4 * F.tid;
#define LD4(ptr, sc) ({ const v2u q_ = *(const v2u*)(ptr); f32x4 r_; r_[0] = bflo(q_.x) * (sc); r_[1] = bfhi(q_.x) * (sc); r_[2] = bflo(q_.y) * (sc); r_[3] = bfhi(q_.y) * (sc); r_; })
            f32x4 Ssum = (f32x4){0.f, 0.f, 0.f, 0.f};
            for (int k = 1; k <= wdw; ++k) if (t0 - k >= 0) Ssum += LD4(xc - (size_t)k * DM, rt[16 - k]);
#pragma unroll 4
            for (int j = 0; j < 64; ++j) {
                const f32x4 hv = LD4(xc + (size_t)j * DM, rt[16 + j]);
                Ssum += hv;
                const int tp = t0 + j;
                if (tp - wdw >= 0) Ssum -= LD4(xc + (size_t)(j - wdw) * DM, rt[16 + j - wdw]);
                const float inv = 1.0f / (float)((tp + 1 < wdw) ? (tp + 1) : wdw);
                const f32x4 d = Ssum * inv - hv;
                v2u w; w.x = cvt_pk_bf16(d[0], d[1]); w.y = cvt_pk_bf16(d[2], d[3]);
                *(v2u*)(W_D1 + (size_t)(R0 + j) * DM + 4 * F.tid) = w;
            }
#undef LD4
            LDS_BAR();
        }
    }
    GRID_BAR();
    for (int rep_ = 0; rep_ < (PH(8) ? REPS(8) : 0); ++rep_) { REFRESH();
        SchedPool S; S.o.init(M / 256, DM / 256, F.G, F.bx); S.A = (const char*)W_D1; S.B = (const char*)W_Wpool_t; S.at = TB2048; S.bt = (size_t)256 * 512 * 2;
        EpiResid<1, false, F8_MOE> E{nullptr, W_XS1, W_XS1, W_sspA, I_pool_scale, nullptr, nullptr, W_XQ};
        pg8::gemm_phase<EpiResid<1, false, F8_MOE>, SchedPool, true>(F.lds, 512, DM, 512, S, E);
        REFRESH();
        SchedGrid S2; S2.o.init(M / 256, DM / 256, F.G, F.bx); S2.A = (const char*)(W_PB + (size_t)M * DPLE); S2.B = (const char*)(W_Wpp_t + (size_t)DM * DPLE); S2.at = (size_t)256 * DPLE * 2; S2.bt = (size_t)256 * DPLE * 2;
        EpiBf16Plain E2{W_PJ, DM};
        pg8::gemm_phase<EpiBf16Plain, SchedGrid, true>(F.lds, DPLE, DPLE, DPLE, S2, E2);
    }
    GRID_BAR();
    for (int rep_ = 0; rep_ < (PH(9) ? REPS(9) : 0); ++rep_) { REFRESH();
        LAS float* wr = (LAS float*)F.lds;
        LAS int* e12 = (LAS int*)(F.lds + 65536);
        LAS float* w12 = (LAS float*)(F.lds + 65536 + 512);
        for (int i = F.tid; i < DM * NE / 4; i += 512) { const int k = i >> 1, e0 = (i & 1) * 4; const f32x4 v = *(const f32x4*)(I_w_router + (size_t)k * NE + e0) * I_ffn_norm_odd[k];
            *(LAS f32x4*)(wr + (((k & 7) * 256 + (k >> 3)) * 8 + e0)) = v; }
        LDS_BAR();
        for (int seg = F.bx; seg < M / 64; seg += F.G) {
            for (int rr = 0; rr < 8; ++rr) {
                const int lrow = F.wave * 8 + rr, row = seg * 64 + lrow;
                const GAS v4u* xr = (const GAS v4u*)(W_XS1 + (size_t)row * DM) + F.lane;
                float acc[8]; float ss = 0.f;
#pragma unroll
                for (int e = 0; e < 8; ++e) acc[e] = 0.f;
#pragma unroll
                for (int c = 0; c < 4; ++c) { f32x4 xa, xb; unpack8(xr[64 * c], xa, xb);
                    ss += ((xa[0] * xa[0] + xa[1] * xa[1]) + (xa[2] * xa[2] + xa[3] * xa[3])) + ((xb[0] * xb[0] + xb[1] * xb[1]) + (xb[2] * xb[2] + xb[3] * xb[3]));
#pragma unroll
                    for (int kk = 0; kk < 8; ++kk) { const float xk = kk < 4 ? xa[kk & 3] : xb[kk & 3];
                        const LAS float* wp = wr + ((kk * 256 + c * 64 + F.lane) * 8); const f32x4 w0 = *(const LAS f32x4*)wp, w1 = *(const LAS f32x4*)(wp + 4);
                        acc[0] += xk * w0[0]; acc[1] += xk * w0[1]; acc[2] += xk * w0[2]; acc[3] += xk * w0[3];
                        acc[4] += xk * w1[0]; acc[5] += xk * w1[1]; acc[6] += xk * w1[2]; acc[7] += xk * w1[3]; } }
                ss = wave_sum(ss);
#pragma unroll
                for (int e = 0; e < 8; ++e) acc[e] = wave_sum(acc[e]);
                const float rstd = 1.0f / sqrtf(ss * (1.0f / DM) + EPS);
                int i1 = 0; float l1 = acc[0];
#pragma unroll
                for (int e = 1; e < 8; ++e) if (acc[e] > l1) { l1 = acc[e]; i1 = e; }
                int i2 = -1; float l2 = -3.0e38f;
#pragma unroll
                for (int e = 0; e < 8; ++e) if (e != i1 && acc[e] > l2) { l2 = acc[e]; i2 = e; }
                const float wt1 = 1.0f / (1.0f + __expf((l2 - l1) * rstd)), wt2 = 1.0f - wt1;
                if (F.lane == 0) { e12[2 * lrow] = i1; e12[2 * lrow + 1] = i2; w12[2 * lrow] = wt1; w12[2 * lrow + 1] = wt2; W_rs4[row] = rstd; }
            }
            LDS_BAR();
            if (F.wave == 0) {
                const int row = seg * 64 + F.lane; const int e1 = e12[2 * F.lane], e2 = e12[2 * F.lane + 1]; const float wt1 = w12[2 * F.lane], wt2 = w12[2 * F.lane + 1];
                unsigned long long mk[16]; int mycnt = 0;
#pragma unroll
                for (int g = 0; g < 16; ++g) { const bool pr = (g < 8) ? (e1 == g) : (e2 == g - 8); mk[g] = __ballot(pr); if (F.lane == g) mycnt = __popcll(mk[g]); }
                int base = 0;
                if (F.lane < 16) base = (int)__hip_atomic_fetch_add((unsigned*)(F.ctl + CW_MOE) + F.lane, (unsigned)mycnt, RLX_AGENT);
                const unsigned long long lt = (1ull << F.lane) - 1ull;
#pragma unroll
                for (int g = 0; g < 16; ++g) { const int bg = __shfl(base, g); const bool pr = (g < 8) ? (e1 == g) : (e2 == g - 8);
                    if (pr) { const int slot = bg + __popcll(mk[g] & lt); W_list[(size_t)g * M + slot] = row; W_gwl[(size_t)g * M + slot] = (g < 8) ? wt1 : wt2; } }
            }
            LDS_BAR();
        }
    }
    GRID_BAR();
    LAS int* tile_e = (LAS int*)(F.lds + LDSCTL_OFF + 1024);
    LAS int* gtab = (LAS int*)(F.lds + LDSCTL_OFF + 1024 + 640);
    for (int rep_ = 0; rep_ < (PH(10) ? REPS(10) : 0); ++rep_) { REFRESH();
        if (F.tid == 0) { int rowp = 0, ti = 0;
            for (int g = 0; g < 16; ++g) { const int c = (int)__hip_atomic_load((unsigned*)(F.ctl + CW_MOE) + g, RLX_AGENT); const int nt = (c + 255) >> 8;
                gtab[g] = rowp; gtab[17 + g] = c; for (int t = 0; t < nt; ++t) tile_e[ti++] = g & 7; rowp += nt * 256; if (g == 7) gtab[33] = ti; }
            gtab[16] = rowp; }
        LDS_BAR();
        const int rtot = gtab[16];
        for (int cr = gw; cr < rtot; cr += NGW) {
            int g = 0;
#pragma unroll
            for (int q = 1; q < 16; ++q) if (cr >= gtab[q]) g = q;
            const int slot = cr - gtab[g]; const bool valid = slot < gtab[17 + g];
            int tok = -1; float gwv = 0.f, rsv = 0.f;
            if (valid) { tok = W_list[(size_t)g * M + slot]; gwv = W_gwl[(size_t)g * M + slot]; rsv = W_rs4[tok]; }
            if (F.lane == 0) { W_tokc[cr] = tok; W_gwc[cr] = gwv; W_rsc[cr] = rsv; }
            if constexpr (F8_MOE) {
                v4u* dst = (v4u*)((unsigned char*)W_XG + (size_t)cr * DM) + F.lane;
                if (valid) { const v4u* srcp = (const v4u*)(W_XQ + (size_t)tok * DM) + F.lane; dst[0] = srcp[0]; dst[64] = srcp[64]; }
                else { dst[0] = (v4u){0u, 0u, 0u, 0u}; dst[64] = (v4u){0u, 0u, 0u, 0u}; }
            } else {
            v4u* dst = (v4u*)(W_XG + (size_t)cr * DM) + F.lane;
            if (valid) { const v4u* srcp = (const v4u*)(W_XS1 + (size_t)tok * DM) + F.lane;
#pragma unroll
                for (int j = 0; j < 4; ++j) dst[64 * j] = srcp[64 * j]; }
            else {
#pragma unroll
                for (int j = 0; j < 4; ++j) dst[64 * j] = (v4u){0u, 0u, 0u, 0u}; }
            }
        }
    }
    GRID_BAR();
    const int RT = gtab[16] >> 8, RT1 = gtab[33];
    for (int rep_ = 0; rep_ < (PH(11) ? REPS(11) : 0); ++rep_) { REFRESH();
        constexpr int EB = F8_MOE ? 1 : 2;
        SchedMoe S{tile_e, 0, RT, F.G, F.bx, (const char*)W_XG, (const char*)W_Wmgu_t, (size_t)256 * DM * EB, (size_t)256 * DM * EB, (size_t)2048 * DM * EB};
        EpiSwiglu<true, F8_MOE> E{W_HE, DFE, nullptr, W_rsc};
        pg8::gemm_phase<EpiSwiglu<true, F8_MOE>, SchedMoe, true, F8_MOE>(F.lds, DM * EB / 2, DM * EB / 2, DM * EB / 2, S, E);
    }
    GRID_BAR();
    for (int rep_ = 0; rep_ < (PH(12) ? REPS(12) : 0); ++rep_) { REFRESH();
        constexpr int EB = F8_MOE ? 1 : 2;
        SchedMoe S{tile_e, 0, RT1, F.G, F.bx, (const char*)W_HE, (const char*)W_Wmd_t, (size_t)256 * DFE * EB, (size_t)256 * DFE * EB, (size_t)DM * DFE * EB};
        EpiMoeDown<false> E{W_XS1, W_sspB, W_tokc, W_gwc, nullptr};
        pg8::gemm_phase<EpiMoeDown<false>, SchedMoe, true, F8_MOE>(F.lds, DFE * EB / 2, DFE * EB / 2, DFE * EB / 2, S, E);
    }
    GRID_BAR();
    for (int rep_ = 0; rep_ < (PH(13) ? REPS(13) : 0); ++rep_) { REFRESH();
        constexpr int EB = F8_MOE ? 1 : 2;
        SchedMoe S{tile_e, RT1, RT, F.G, F.bx, (const char*)W_HE, (const char*)W_Wmd_t, (size_t)256 * DFE * EB, (size_t)256 * DFE * EB, (size_t)DM * DFE * EB};
        EpiMoeDown<true, F8_PLE1> E{W_XS1, W_sspB, W_tokc, W_gwc, W_XQ};
        pg8::gemm_phase<EpiMoeDown<true, F8_PLE1>, SchedMoe, true, F8_MOE>(F.lds, DFE * EB / 2, DFE * EB / 2, DFE * EB / 2, S, E);
    }
    GRID_BAR();
    for (int rep_ = 0; rep_ < (PH(14) ? REPS(14) : 0); ++rep_) { REFRESH();
        SchedGrid S; S.o.init(M / 256, DM / 256, F.G, F.bx); constexpr int EB = F8_PLE1 ? 1 : 2; S.A = F8_PLE1 ? (const char*)W_XQ : (const char*)W_XS1; S.B = (const char*)(W_Wpg_t + (size_t)DM * DM); S.at = (size_t)256 * DM * EB; S.bt = (size_t)256 * DM * EB;
        EpiResid<2, false> E{nullptr, W_XS1, W_XS0, W_sspA, nullptr, W_sspB, W_PJ, nullptr};
        pg8::gemm_phase<EpiResid<2, false>, SchedGrid, true, F8_PLE1>(F.lds, DM * EB / 2, DM * EB / 2, DM * EB / 2, S, E);
    }
    GRID_BAR();
    REFRESH();
    if (PH(15)) for (int m = gw; m < M; m += NGW) {
        float v = (F.lane < 32) ? W_sspA[(size_t)m * 32 + F.lane] : 0.f; v = wave_sum(v);
        const float rstd = 1.0f / sqrtf(v * (1.0f / DM) + EPS);
        const GAS v4u* xs = (const GAS v4u*)(W_XS0 + (size_t)m * DM) + F.lane; GAS f32x4* xo = (GAS f32x4*)(W_X + (size_t)m * DM) + 2 * F.lane; const f32x4* gp = (const f32x4*)I_final_gain + 2 * F.lane;
#pragma unroll
        for (int j = 0; j < 4; ++j) { f32x4 a, b; unpack8(xs[64 * j], a, b); xo[128 * j] = a * rstd * gp[128 * j]; xo[128 * j + 1] = b * rstd * gp[128 * j + 1]; }
    }
}

extern "C" void kernel_launch(void* const* d_in, const int* in_sizes, int n_in, void* d_out, int out_size, void* d_ws, size_t ws_size, hipStream_t stream) {
    (void)in_sizes; (void)out_size;
    static int grid = 0;
    if (grid == 0) {
        if (n_in != 24 || ws_size < WS_END) { fprintf(stderr, "kernel_launch: bad arguments (n_in %d, ws %zu)\n", n_in, ws_size); grid = -1; return; }
        int dev = 0, cus = 0, per_cu = 0;
        if (hipGetDevice(&dev) != hipSuccess || hipDeviceGetAttribute(&cus, hipDeviceAttributeMultiprocessorCount, dev) != hipSuccess) { grid = -1; return; }
        if (hipFuncSetAttribute((const void*)fwd_kernel, hipFuncAttributeMaxDynamicSharedMemorySize, LDS_BYTES) != hipSuccess) { grid = -1; return; }
        if (hipOccupancyMaxActiveBlocksPerMultiprocessor(&per_cu, (const void*)fwd_kernel, NWAVES * 64, LDS_BYTES) != hipSuccess || per_cu < 1) { fprintf(stderr, "kernel_launch: occupancy query says %d\n", per_cu); }
        (void)hipGetLastError();
        grid = cus;
    }
    if (grid < 0) return;
    if (hipMemsetAsync((char*)d_ws + WS_CTL, 0, CTL_ZERO_BYTES, stream) != hipSuccess) return;
    Args a{};
    for (int i = 0; i < 24; ++i) a.in[i] = (const float*)d_in[i];
    a.out = (float*)d_out; a.ws = (unsigned char*)d_ws;
    hipLaunchKernelGGL(fwd_kernel, dim3(grid), dim3(NWAVES * 64), LDS_BYTES, stream, a);
}
```

```cpp
#include <hip/hip_runtime.h>
#include <cstdio>
#include <cstdint>

constexpr int DM = 2048, BATCH = 8, SEQ = 2048, M = BATCH * SEQ;
constexpr int DH = 1024, NH = 8, HD = 128, CHUNK = 64, DC = 1024, DFF = 5632, NE = 8, DFE = 1024, DPLE = 256;
constexpr int NIN = 7168;
constexpr int UP = 6144;
constexpr float EPS = 1e-6f;
constexpr int NWAVES = 8;
#ifndef F8_GU
#define F8_GU 1
#endif
#ifndef F8_DN
#define F8_DN 1
#endif
#ifndef F8_MOE
#define F8_MOE 1
#endif
#ifndef F8_PLE1
#define F8_PLE1 1
#endif

constexpr size_t MiB = 1u << 20;
constexpr size_t WS_CTL = 0, CTL_ZERO_BYTES = 256 * 1024;
constexpr size_t WS_LBV = 1 * MiB;
constexpr size_t WS_RS4 = 1 * MiB + 64 * 1024;
constexpr size_t WS_TOP = 1 * MiB + 192 * 1024;
constexpr size_t WS_TOPW = 1 * MiB + 320 * 1024;
constexpr size_t WS_SSPA = 2 * MiB, WS_SSPB = 4 * MiB;
constexpr size_t WS_LIST = 6 * MiB;
constexpr size_t WS_GWL = 7 * MiB;
constexpr size_t WS_TOKC = 8 * MiB;
constexpr int RCAP = 36864;
constexpr size_t WS_GWC = WS_TOKC + (size_t)RCAP * 4, WS_RSC = WS_GWC + (size_t)RCAP * 4;
constexpr size_t WS_WIN = 10 * MiB;
constexpr size_t WS_WOUT = 38 * MiB;
constexpr size_t WS_WGU = 46 * MiB;
constexpr size_t WS_WD = 90 * MiB;
constexpr size_t WS_WPOOL = 112 * MiB;
constexpr size_t WS_WMGU = 114 * MiB;
constexpr size_t WS_WMD = 178 * MiB;
constexpr size_t WS_WPG = 210 * MiB;
constexpr size_t WS_WPP = 226 * MiB;
constexpr size_t WS_PB = 228 * MiB;
constexpr size_t WS_XB = 244 * MiB;
constexpr size_t WS_A2 = 308 * MiB;
constexpr size_t WS_BIG = 372 * MiB;
constexpr size_t WS_HE = 10 * MiB;
constexpr size_t WS_END = 564 * MiB;
static_assert(WS_BIG + (size_t)M * UP * 2 <= WS_END && WS_HE + (size_t)RCAP * DFE * 2 <= WS_WD, "ws map");
static_assert(WS_BIG + (size_t)RCAP * DM * 2 <= WS_END, "ws map XG");
constexpr int CW_BAR = 4096;
constexpr int CW_MOE = 16384;
constexpr int CW_DBG = 20000;

constexpr int RING_BYTES = 131072;
constexpr int LDSCTL_OFF = RING_BYTES, MISC_OFF = LDSCTL_OFF + 320;
constexpr int LDS_BYTES = 147456;

#define GAS __attribute__((address_space(1)))
#define LAS __attribute__((address_space(3)))
typedef unsigned short bf16;
typedef unsigned v4u __attribute__((ext_vector_type(4)));
typedef unsigned v2u __attribute__((ext_vector_type(2)));
typedef float f32x4 __attribute__((ext_vector_type(4)));
typedef float f32x2 __attribute__((ext_vector_type(2)));
typedef float f32x16 __attribute__((ext_vector_type(16)));
typedef short bf16x8 __attribute__((ext_vector_type(8)));
typedef short bf16x4 __attribute__((ext_vector_type(4)));
typedef GAS unsigned gu32;
#define RLX_AGENT __ATOMIC_RELAXED, __HIP_MEMORY_SCOPE_AGENT
#define LDS_WAIT() asm volatile("s_waitcnt lgkmcnt(0)" ::: "memory")
#define VM_WAIT() asm volatile("s_waitcnt vmcnt(0)" ::: "memory")
#define LDS_BAR() do { asm volatile("s_waitcnt lgkmcnt(0)" ::: "memory"); __builtin_amdgcn_s_barrier(); asm volatile("" ::: "memory"); } while (0)
__device__ __forceinline__ unsigned f2bf(float f) { unsigned u = __builtin_bit_cast(unsigned, f); return (u + 0x7fffu + ((u >> 16) & 1u)) >> 16; }
__device__ __forceinline__ unsigned pk2(float lo, float hi) { return f2bf(lo) | (f2bf(hi) << 16); }
__device__ __forceinline__ unsigned cvt_pk_bf16(float lo, float hi) { unsigned r; asm volatile("v_cvt_pk_bf16_f32 %0, %1, %2" : "=v"(r) : "v"(lo), "v"(hi)); return r; }
__device__ __forceinline__ float clamp8(float v) { return __builtin_amdgcn_fmed3f(v, -448.0f, 448.0f); }
__device__ __forceinline__ v2u pk8_fp8(const f32x4 a, const f32x4 b) {
    int w0 = 0, w1 = 0;
    w0 = __builtin_amdgcn_cvt_pk_fp8_f32(clamp8(a[0]), clamp8(a[1]), w0, false); w0 = __builtin_amdgcn_cvt_pk_fp8_f32(clamp8(a[2]), clamp8(a[3]), w0, true);
    w1 = __builtin_amdgcn_cvt_pk_fp8_f32(clamp8(b[0]), clamp8(b[1]), w1, false); w1 = __builtin_amdgcn_cvt_pk_fp8_f32(clamp8(b[2]), clamp8(b[3]), w1, true);
    v2u r; r.x = (unsigned)w0; r.y = (unsigned)w1; return r;
}
__device__ __forceinline__ float bflo(unsigned u) { return __builtin_bit_cast(float, u << 16); }
__device__ __forceinline__ float bfhi(unsigned u) { return __builtin_bit_cast(float, u & 0xffff0000u); }
__device__ __forceinline__ float fast_rcp(float x) { return __builtin_amdgcn_rcpf(x); }
__device__ __forceinline__ float sigmoidf_(float x) { return fast_rcp(1.0f + __expf(-x)); }
__device__ __forceinline__ float siluf_(float x) { return x * sigmoidf_(x); }
__device__ __forceinline__ float wave_sum(float v) {
#pragma unroll
    for (int o = 1; o < 64; o <<= 1) v += __shfl_xor(v, o);
    return v;
}

#define XB_TMO      128
#define XB_XCNT(j)  (256  + 64 * (j))
#define XB_XSUB(j)  (1280 + 64 * (j))
#define XB_XGEN(j)  (2304 + 64 * (j))
#define XB_TOP      3328
#define XB_TOPGEN   3392
#define XCD_BAR_WORDS 3456
#define XB_SPIN_CAP (1u << 18)
__device__ __forceinline__ unsigned xb_ld(unsigned* p)              { return __hip_atomic_load(p, __ATOMIC_RELAXED, __HIP_MEMORY_SCOPE_AGENT); }
__device__ __forceinline__ unsigned xb_add(unsigned* p, unsigned v) { return __hip_atomic_fetch_add(p, v, __ATOMIC_RELAXED, __HIP_MEMORY_SCOPE_AGENT); }
__device__ __forceinline__ unsigned xb_xcc_id() { return (unsigned)__builtin_amdgcn_s_getreg((3 << 11) | 20) & 0xFu; }
#define XB_SPIN(cond, bar) do { unsigned _sp = 0; while (cond) { __builtin_amdgcn_s_sleep(1); \
    if ((++_sp & 255u) == 0u) { if (xb_ld(&(bar)[XB_TMO])) break; if (_sp > XB_SPIN_CAP) { atomicAdd(&(bar)[XB_TMO], 1u); break; } } } } while (0)
struct XcdBarrier { unsigned* bar; unsigned x; volatile LAS unsigned* st; };
__device__ __forceinline__ XcdBarrier xcd_barrier_post(unsigned* bar, volatile LAS unsigned* st) {
    XcdBarrier b; b.bar = bar; b.x = xb_xcc_id(); b.st = st;
    if (threadIdx.x == 0) (void)xb_add(&bar[XB_XCNT(b.x)], 1u);
    return b;
}
__device__ __forceinline__ void xcd_barrier_complete(unsigned* bar, unsigned x, unsigned& nloc, unsigned& nx) {
    const unsigned G = gridDim.x * gridDim.y * gridDim.z;
    unsigned sum, cnt, mine, sp = 0u;
    for (;;) {
        sum = 0u; cnt = 0u; mine = 0u;
#pragma unroll
        for (unsigned j = 0; j < 16; ++j) { const unsigned c = xb_ld(&bar[XB_XCNT(j)]); sum += c; cnt += (c > 0u) ? 1u : 0u; mine = (j == x) ? c : mine; }
        if (sum == G) break;
        __builtin_amdgcn_s_sleep(1);
        if ((++sp & 255u) == 0u) { if (xb_ld(&bar[XB_TMO])) break; if (sp > XB_SPIN_CAP) { atomicAdd(&bar[XB_TMO], 1u); break; } }
    }
    nloc = mine > 0u ? mine : 1u; nx = cnt > 0u ? cnt : 1u;
}
__device__ __forceinline__ void xcd_barrier(const XcdBarrier& b) {
    asm volatile("s_waitcnt vmcnt(0)" ::: "memory");
    __syncthreads();
    if (threadIdx.x == 0) {
        unsigned* bar = b.bar;
        __builtin_amdgcn_s_waitcnt(0);
        unsigned nloc = b.st[0], nx = b.st[1];
        if (nloc == 0u) { xcd_barrier_complete(bar, b.x, nloc, nx); b.st[0] = nloc; b.st[1] = nx; }
        const unsigned old = xb_add(&bar[XB_XSUB(b.x)], 1u);
        const unsigned gen = old / nloc;
        if (old + 1u == (gen + 1u) * nloc) {
            __builtin_amdgcn_fence(__ATOMIC_RELEASE, "agent");
            asm volatile("s_waitcnt vmcnt(0)" ::: "memory");
            const unsigned og = xb_add(&bar[XB_TOP], 1u);
            const unsigned tg = og / nx;
            if (og + 1u == (tg + 1u) * nx) xb_add(&bar[XB_TOPGEN], 1u);
            else XB_SPIN(xb_ld(&bar[XB_TOPGEN]) == tg, bar);
            __builtin_amdgcn_fence(__ATOMIC_ACQUIRE, "agent");
            xb_add(&bar[XB_XGEN(b.x)], 1u);
            asm volatile("s_waitcnt vmcnt(0)" ::: "memory");
        } else {
            XB_SPIN(xb_ld(&bar[XB_XGEN(b.x)]) == gen, bar);
            __builtin_amdgcn_fence(__ATOMIC_ACQUIRE, "agent");
            asm volatile("s_waitcnt vmcnt(0)" ::: "memory");
        }
    }
    __syncthreads();
}

namespace pg8 {
constexpr int BM = 256, BK = 64, HALF = 128, HTB = HALF * BK * 2, STAGE_BYTES = 8 * HTB, NXCD = 8, WGM = 8;
__host__ __device__ __forceinline__ int lds_byte(int r, int c) { const int st = (r >> 4) * 2 + (c >> 5), rr = r & 15, cc = c & 31, ob = rr * 64 + cc * 2; return st * 1024 + (ob ^ (((ob >> 9) & 1) << 5)); }
__host__ __device__ __forceinline__ void stage_rc(int b, int& R, int& C) { const int st = b / 1024, sb = b % 1024, swz = sb ^ (((sb >> 9) & 1) << 5); R = (st >> 1) * 16 + swz / 64; C = (st & 1) * 32 + (swz % 64) / 2; }
__host__ __device__ __forceinline__ int perm32(int rho) { const int n = rho >> 4, i = rho & 15; return 8 * (i >> 2) + 4 * n + (i & 3); }
struct Unit { int pm, pn; const char* a; const char* b; const int* rows; int nvalid; };
typedef int v4i_t __attribute__((ext_vector_type(4)));
typedef int v8i_t __attribute__((ext_vector_type(8)));
__device__ __forceinline__ bf16x8 lo8(v8i_t v) { return __builtin_bit_cast(bf16x8, __builtin_shufflevector(v, v, 0, 1, 2, 3)); }
__device__ __forceinline__ bf16x8 hi8(v8i_t v) { return __builtin_bit_cast(bf16x8, __builtin_shufflevector(v, v, 4, 5, 6, 7)); }
__device__ __forceinline__ v8i_t cat8(bf16x8 lo, bf16x8 hi) { return __builtin_shufflevector(__builtin_bit_cast(v4i_t, lo), __builtin_bit_cast(v4i_t, hi), 0, 1, 2, 3, 4, 5, 6, 7); }
struct GridOrder {
    int nM, nN, nwg, G, c;
    __device__ __forceinline__ void init(int nM_, int nN_, int G_, int c_) { nM = nM_; nN = nN_; nwg = nM * nN; G = G_; c = c_; }
    __device__ __forceinline__ bool tile(int i, int& pm, int& pn) const {
        const long L = (long)i * G + c; if (L >= nwg) return false;
        int wgid = (int)L; { const int q = nwg / NXCD, r = nwg % NXCD, xcd = wgid % NXCD, off = wgid / NXCD; wgid = (xcd < r ? xcd * (q + 1) : r * (q + 1) + (xcd - r) * q) + off; }
        const int nig = WGM * nN, gid = wgid / nig, fm = gid * WGM, gsz = (nM - fm) < WGM ? (nM - fm) : WGM;
        pm = fm + ((wgid % nig) % gsz); pn = (wgid % nig) / gsz; return true;
    }
};

template <class Epi, class Sched, bool ALIGN_EPI, bool FP8 = false, bool GATHER = false>
__device__ __forceinline__ void gemm_phase(LAS unsigned char* lds, const int K, const int lda, const int ldb, const Sched& S, const Epi& E) {
    int tid_ = threadIdx.x; asm volatile("" : "+v"(tid_));
    const int tid = tid_, wid = __builtin_amdgcn_readfirstlane(tid >> 6), lane = tid & 63, wr = wid >> 2, wc = wid & 3, fr = lane & 15, fq = lane >> 4;
    const int nt = K / BK;
    unsigned voffA[2], voffB[2];
#pragma unroll
    for (int i = 0; i < 2; ++i) { int R, C; stage_rc(tid * 16 + i * 8192, R, C); const int Rb = Epi::PERM ? ((R & ~31) + perm32(R & 31)) : R;
        voffA[i] = (unsigned)(R * lda + C) * 2u; voffB[i] = (unsigned)(Rb * ldb + C) * 2u; }
    unsigned vG[2][2]; int tkn[2][2];
#pragma unroll
    for (int i = 0; i < 2; ++i) { vG[0][i] = vG[1][i] = 0u; tkn[0][i] = tkn[1][i] = 0; }
    const size_t kstep = (size_t)(BK * 2);
    const size_t hstepA = (size_t)HALF * lda * 2, hstepB = (size_t)HALF * ldb * 2;
    const unsigned ldsw = (unsigned)wid * 1024u;
    const int aoff = lds_byte(wr * 64 + fr, fq * 8), boff = lds_byte(wc * 32 + fr, fq * 8);
#define PG8_SA(b, h) (((b) * 2 + (h)) * HTB)
#define PG8_SB(b, h) ((4 + (b) * 2 + (h)) * HTB)
#define PG8_STAGE(bufoff, gbase, voff) do { _Pragma("unroll") for (int _i = 0; _i < 2; ++_i) \
        __builtin_amdgcn_global_load_lds((const unsigned*)((const char*)(gbase) + (voff)[_i]), (LAS unsigned*)(lds + (bufoff) + ldsw + _i * 8192), 16, 0, 0); } while (0)
#define PG8_STAGEA(bufoff, gk, h) do { if constexpr (GATHER) { PG8_STAGE(bufoff, gk, vG[h]); } else { PG8_STAGE(bufoff, (gk) + (h) * hstepA, voffA); } } while (0)
#define PG8_TOKLOAD(u, tk) do { _Pragma("unroll") for (int _h = 0; _h < 2; ++_h) _Pragma("unroll") for (int _i = 0; _i < 2; ++_i) { int gR_, gC_; stage_rc(tid * 16 + _i * 8192, gR_, gC_); const int row_ = _h * HALF + gR_; tk[_h][_i] = (u).rows[row_ < (u).nvalid ? row_ : (u).nvalid - 1]; }     } while (0)
#define PG8_TOKSET(tk) do { _Pragma("unroll") for (int _h = 0; _h < 2; ++_h) _Pragma("unroll") for (int _i = 0; _i < 2; ++_i) { int gR_, gC_; stage_rc(tid * 16 + _i * 8192, gR_, gC_); vG[_h][_i] = (unsigned)tk[_h][_i] * (unsigned)(lda * 2) + (unsigned)gC_ * 2u; } } while (0)
#define PG8_LDA(dst, b, h) do { _Pragma("unroll") for (int m = 0; m < 4; ++m) { const bf16x8 lo_ = *(const LAS bf16x8*)(lds + PG8_SA(b, h) + aoff + m * 2048), hi_ = *(const LAS bf16x8*)(lds + PG8_SA(b, h) + aoff + m * 2048 + 1024); dst[m] = cat8(lo_, hi_); } } while (0)
#define PG8_LDB(dst, b, h) do { _Pragma("unroll") for (int n = 0; n < 2; ++n) { const bf16x8 lo_ = *(const LAS bf16x8*)(lds + PG8_SB(b, h) + boff + n * 2048), hi_ = *(const LAS bf16x8*)(lds + PG8_SB(b, h) + boff + n * 2048 + 1024); dst[n] = cat8(lo_, hi_); } } while (0)
#define PG8_MMA(ai, bj, At, Bt) do { __builtin_amdgcn_s_setprio(1); _Pragma("unroll") for (int m = 0; m < 4; ++m) _Pragma("unroll") for (int n = 0; n < 2; ++n) { \
        if constexpr (FP8) { asm volatile("v_mfma_scale_f32_16x16x128_f8f6f4 %0, %1, %2, %0, %3, %4 op_sel_hi:[0,0,0]" : "+v"(acc[ai][bj][m][n]) : "v"(Bt[n]), "v"(At[m]), "v"(sc_w), "v"(sc_x)); } \
        else { acc[ai][bj][m][n] = __builtin_amdgcn_mfma_f32_16x16x32_bf16(lo8(Bt[n]), lo8(At[m]), acc[ai][bj][m][n], 0, 0, 0); \
               acc[ai][bj][m][n] = __builtin_amdgcn_mfma_f32_16x16x32_bf16(hi8(Bt[n]), hi8(At[m]), acc[ai][bj][m][n], 0, 0, 0); } } __builtin_amdgcn_s_setprio(0); } while (0)
#define PG8_WAIT_V(n) asm volatile("s_waitcnt vmcnt(" #n ")" ::: "memory")
#define PG8_WAIT_L(n) asm volatile("s_waitcnt lgkmcnt(" #n ")" ::: "memory")
#define PG8_BAR __builtin_amdgcn_s_barrier()
#define PG8_SCHED __builtin_amdgcn_sched_barrier(0)
    Unit cur, nxt; int ui = 0;
    if (!S.next(0, cur)) return;
    f32x4 acc[2][2][4][2];
#pragma unroll
    for (int a = 0; a < 2; ++a)
#pragma unroll
        for (int b = 0; b < 2; ++b)
#pragma unroll
            for (int m = 0; m < 4; ++m)
#pragma unroll
                for (int n = 0; n < 2; ++n) acc[a][b][m][n] = (f32x4){0.f, 0.f, 0.f, 0.f};
    v8i_t At[4], B0[2], B1[2];
    const int sc_w = 0x79797979, sc_x = 0x7f7f7f7f;
    (void)sc_w; (void)sc_x;
    const char* cA = cur.a; const char* cB = cur.b;
    if constexpr (GATHER) { PG8_TOKLOAD(cur, tkn); PG8_TOKSET(tkn); }
    PG8_STAGE(PG8_SB(0, 0), cB, voffB); PG8_STAGE(PG8_SB(0, 1), cB + hstepB, voffB); PG8_STAGEA(PG8_SA(0, 0), cA, 0); PG8_STAGEA(PG8_SA(0, 1), cA, 1);
    if (wr == 1) PG8_BAR;
    PG8_WAIT_V(2); PG8_BAR;
    PG8_STAGE(PG8_SB(1, 0), cB + kstep, voffB); PG8_STAGEA(PG8_SA(1, 0), cA + kstep, 0); PG8_STAGE(PG8_SB(1, 1), cB + hstepB + kstep, voffB);
    PG8_WAIT_V(6); PG8_BAR;
    for (;;) {
        const bool has_next = S.next(ui + 1, nxt);
        const char* nA = has_next ? nxt.a : cA; const char* nB = has_next ? nxt.b : cB;
#pragma nounroll
        for (int t = 0; t < nt; t += 2) {
            const bool last = (t == nt - 2);
            const char* a1 = cA + (size_t)(t + 1) * kstep;
            const char* a2 = last ? nA : cA + (size_t)(t + 2) * kstep; const char* b2 = last ? nB : cB + (size_t)(t + 2) * kstep;
            const char* a3 = a2 + kstep; const char* b3 = b2 + kstep;
            if constexpr (GATHER) { if (has_next && t == nt - 4) PG8_TOKLOAD(nxt, tkn); }
            PG8_LDB(B0, 0, 0); PG8_LDB(B1, 0, 1); PG8_SCHED; PG8_LDA(At, 0, 0); PG8_STAGEA(PG8_SA(1, 1), a1, 1);
            if constexpr (GATHER) { if (last && has_next) PG8_TOKSET(tkn); }
            PG8_WAIT_V(8); PG8_WAIT_L(0); PG8_BAR; PG8_MMA(0, 0, At, B0); PG8_MMA(0, 1, At, B1); PG8_BAR; PG8_SCHED;
            PG8_LDA(At, 0, 1); PG8_STAGE(PG8_SB(0, 0), b2, voffB); PG8_STAGE(PG8_SB(0, 1), b2 + hstepB, voffB); PG8_STAGEA(PG8_SA(0, 0), a2, 0);
            PG8_WAIT_V(8); PG8_WAIT_L(0); PG8_BAR; PG8_MMA(1, 0, At, B0); PG8_MMA(1, 1, At, B1); PG8_BAR; PG8_SCHED;
            PG8_LDB(B0, 1, 0); PG8_LDB(B1, 1, 1); PG8_SCHED; PG8_LDA(At, 1, 0); PG8_STAGEA(PG8_SA(0, 1), a2, 1);
            PG8_WAIT_V(8); PG8_WAIT_L(0); PG8_BAR; PG8_MMA(0, 0, At, B0); PG8_MMA(0, 1, At, B1); PG8_BAR; PG8_SCHED;
            PG8_LDA(At, 1, 1); PG8_STAGE(PG8_SB(1, 0), b3, voffB); PG8_STAGE(PG8_SB(1, 1), b3 + hstepB, voffB); PG8_STAGEA(PG8_SA(1, 0), a3, 0);
            PG8_WAIT_V(8); PG8_WAIT_L(0); PG8_BAR; PG8_MMA(1, 0, At, B0); PG8_MMA(1, 1, At, B1); PG8_BAR; PG8_SCHED;
        }
        if constexpr (ALIGN_EPI) { if (wr == 0) PG8_BAR; }
        if constexpr (FP8) asm volatile("s_nop 15\n\ts_nop 15" ::: "memory");
        E(acc, cur, wr, wc, fr, fq);
        if (!has_next) break;
#pragma unroll
        for (int a = 0; a < 2; ++a)
#pragma unroll
            for (int b = 0; b < 2; ++b)
#pragma unroll
                for (int m = 0; m < 4; ++m)
#pragma unroll
                    for (int n = 0; n < 2; ++n) acc[a][b][m][n] = (f32x4){0.f, 0.f, 0.f, 0.f};
        cur = nxt; cA = nA; cB = nB; ++ui;
        if constexpr (ALIGN_EPI) { if (wr == 1) PG8_BAR; }
    }
    PG8_WAIT_V(0);
    if constexpr (!ALIGN_EPI) { if (wr == 0) PG8_BAR; }
    PG8_BAR;
#undef PG8_SA
#undef PG8_SB
#undef PG8_STAGE
#undef PG8_STAGEA
#undef PG8_TOKLOAD
#undef PG8_TOKSET
#undef PG8_LDA
#undef PG8_LDB
#undef PG8_MMA
#undef PG8_WAIT_V
#undef PG8_WAIT_L
#undef PG8_BAR
#undef PG8_SCHED
}
}
using pg8::Unit;

struct SchedGrid {
    pg8::GridOrder o; const char* A; const char* B; size_t at, bt;
    __device__ __forceinline__ bool next(int i, Unit& u) const { if (!o.tile(i, u.pm, u.pn)) return false; u.a = A + (size_t)u.pm * at; u.b = B + (size_t)u.pn * bt; return true; }
};
struct SchedPool {
    pg8::GridOrder o; const char* A; const char* B; size_t at, bt;
    __device__ __forceinline__ bool next(int i, Unit& u) const { if (!o.tile(i, u.pm, u.pn)) return false; u.a = A + (size_t)u.pm * at + (size_t)(u.pn >> 1) * 1024; u.b = B + (size_t)u.pn * bt; return true; }
};
struct SchedPJ {
    pg8::GridOrder o; const char* A; const char* B; size_t at, bt;
    __device__ __forceinline__ bool next(int i, Unit& u) const { if (!o.tile(i, u.pm, u.pn)) return false; u.a = A + (size_t)u.pm * at; u.b = B + (size_t)((u.pm >> 6) * 8 + u.pn) * bt; return true; }
};
struct SchedMoe {
    const LAS int* tile_e; const LAS int* tile_g; const LAS int* tile_s0; const LAS int* gcnt; int rt0, rt1, G, c; const char* A; const char* B; size_t at, bt, be; const int* list; bool gather;
    __device__ __forceinline__ bool next(int i, Unit& u) const {
        const int L = i * G + c, n = (rt1 - rt0) * 8; if (L >= n) return false;
        u.pm = rt0 + (L >> 3); u.pn = L & 7; const int e = tile_e[u.pm], g = tile_g[u.pm], s0 = tile_s0[u.pm];
        u.a = gather ? A : A + (size_t)u.pm * at; u.b = B + (size_t)e * be + (size_t)u.pn * bt;
        u.rows = list + (size_t)g * M + s0; u.nvalid = gcnt[g] - s0; return true; }
};

__device__ __forceinline__ void load_rstd(const float* ssp, int row0, int fq, float (&rs)[2][4]) {
#pragma unroll
    for (int ai = 0; ai < 2; ++ai)
#pragma unroll
        for (int m = 0; m < 4; ++m) {
            const float* sp = ssp + (size_t)(row0 + ai * 128 + m * 16) * 32 + fq * 8;
            const f32x4 a = *(const f32x4*)sp, b = *(const f32x4*)(sp + 4);
            float s = ((a[0] + a[1]) + (a[2] + a[3])) + ((b[0] + b[1]) + (b[2] + b[3]));
            s += __shfl_xor(s, 16); s += __shfl_xor(s, 32);
            rs[ai][m] = 1.0f / sqrtf(s * (1.0f / DM) + EPS);
        }
}
struct EpiInProj {
    static constexpr bool PERM = true;
    bf16* U; const float* ssp; const float* lbv;
    __device__ __forceinline__ void operator()(const f32x4 (&acc)[2][2][4][2], const Unit& u, int wr, int wc, int fr, int fq) const {
        const int row0 = u.pm * 256 + wr * 64 + fr;
        float rs[2][4]; load_rstd(ssp, row0, fq, rs);
        const int pn = u.pn;
        if (pn >= 20) {
            const int col0 = 5120 + (pn - 20) * 128 + wc * 32 + 8 * fq;
#pragma unroll
            for (int ai = 0; ai < 2; ++ai)
#pragma unroll
                for (int m = 0; m < 4; ++m) { const float r2 = rs[ai][m] * rs[ai][m];
                    const f32x4 a0 = acc[ai][0][m][0] * acc[ai][1][m][0] * r2, a1 = acc[ai][0][m][1] * acc[ai][1][m][1] * r2;
                    v4u w; w.x = cvt_pk_bf16(a0[0], a0[1]); w.y = cvt_pk_bf16(a0[2], a0[3]); w.z = cvt_pk_bf16(a1[0], a1[1]); w.w = cvt_pk_bf16(a1[2], a1[3]);
                    *(v4u*)(U + (size_t)(row0 + ai * 128 + m * 16) * UP + col0) = w; }
            return;
        }
        const int kind = pn >> 2;
        const int col0 = pn * 256 + wc * 32 + 8 * fq;
        f32x4 lb[2][2];
        if (kind == 1) {
#pragma unroll
            for (int bj = 0; bj < 2; ++bj)
#pragma unroll
                for (int n = 0; n < 2; ++n) lb[bj][n] = *(const f32x4*)(lbv + (col0 - 1024) + bj * 128 + 4 * n);
            asm volatile("" :: "v"(lb[0][0]), "v"(lb[0][1]), "v"(lb[1][0]), "v"(lb[1][1]));
        }
#pragma unroll
        for (int ai = 0; ai < 2; ++ai)
#pragma unroll
            for (int m = 0; m < 4; ++m) { bf16* rowp = U + (size_t)(row0 + ai * 128 + m * 16) * UP + col0; const float r = rs[ai][m];
#pragma unroll
                for (int bj = 0; bj < 2; ++bj) { f32x4 v0 = acc[ai][bj][m][0] * r, v1 = acc[ai][bj][m][1] * r;
                    if (kind == 0 || kind == 3) {
#pragma unroll
                        for (int j = 0; j < 4; ++j) { v0[j] = siluf_(v0[j]); v1[j] = siluf_(v1[j]); }
                    } else if (kind == 1) {
#pragma unroll
                        for (int j = 0; j < 4; ++j) { v0[j] = __builtin_amdgcn_logf(lb[bj][0][j] + (1.0f - lb[bj][0][j]) * sigmoidf_(v0[j])); v1[j] = __builtin_amdgcn_logf(lb[bj][1][j] + (1.0f - lb[bj][1][j]) * sigmoidf_(v1[j]));     }
                    }
                    v4u w; w.x = cvt_pk_bf16(v0[0], v0[1]); w.y = cvt_pk_bf16(v0[2], v0[3]); w.z = cvt_pk_bf16(v1[0], v1[1]); w.w = cvt_pk_bf16(v1[2], v1[3]);
                    *(v4u*)(rowp + bj * 128) = w; } }
    }
};
struct EpiBf16Plain {
    static constexpr bool PERM = true;
    bf16* O; int ldc;
    __device__ __forceinline__ void operator()(const f32x4 (&acc)[2][2][4][2], const Unit& u, int wr, int wc, int fr, int fq) const {
        const int row0 = u.pm * 256 + wr * 64 + fr, col0 = u.pn * 256 + wc * 32 + 8 * fq;
#pragma unroll
        for (int ai = 0; ai < 2; ++ai)
#pragma unroll
            for (int m = 0; m < 4; ++m) { bf16* rowp = O + (size_t)(row0 + ai * 128 + m * 16) * ldc + col0;
#pragma unroll
                for (int bj = 0; bj < 2; ++bj) { const f32x4 v0 = acc[ai][bj][m][0], v1 = acc[ai][bj][m][1];
                    v4u w; w.x = cvt_pk_bf16(v0[0], v0[1]); w.y = cvt_pk_bf16(v0[2], v0[3]); w.z = cvt_pk_bf16(v1[0], v1[1]); w.w = cvt_pk_bf16(v1[2], v1[3]);
                    *(v4u*)(rowp + bj * 128) = w; } }
    }
};
template <bool ROWTAB, bool F8> struct EpiSwiglu {
    static constexpr bool PERM = true;
    void* H; int ldc; const float* ssp; const float* rtab; const int* list;
    __device__ __forceinline__ void operator()(const f32x4 (&acc)[2][2][4][2], const Unit& u, int wr, int wc, int fr, int fq) const {
        if constexpr (ROWTAB) asm volatile("" : "+v"(fr), "+v"(fq));
        const int row0 = u.pm * 256 + wr * 64 + fr, col0 = u.pn * 128 + wc * 32 + 8 * fq;
        float rs[2][4];
        if constexpr (ROWTAB) {
            const float* rt_ = rtab + (u.rows - list);
#pragma unroll
            for (int ai = 0; ai < 2; ++ai)
#pragma unroll
                for (int m = 0; m < 4; ++m) { const int rl = wr * 64 + fr + ai * 128 + m * 16; const float v_ = rt_[rl < u.nvalid ? rl : u.nvalid - 1]; rs[ai][m] = rl < u.nvalid ? v_ : 0.f; }
        } else load_rstd(ssp, row0, fq, rs);
#pragma unroll
        for (int ai = 0; ai < 2; ++ai)
#pragma unroll
            for (int m = 0; m < 4; ++m) { const float r = rs[ai][m];
                f32x4 h0, h1;
#pragma unroll
                for (int j = 0; j < 4; ++j) { h0[j] = siluf_(acc[ai][0][m][0][j] * r) * (acc[ai][1][m][0][j] * r); h1[j] = siluf_(acc[ai][0][m][1][j] * r) * (acc[ai][1][m][1][j] * r); }
                const size_t o = (size_t)(row0 + ai * 128 + m * 16) * ldc + col0;
                if constexpr (F8) *(v2u*)((unsigned char*)H + o) = pk8_fp8(h0, h1);
                else { v4u w; w.x = cvt_pk_bf16(h0[0], h0[1]); w.y = cvt_pk_bf16(h0[2], h0[3]); w.z = cvt_pk_bf16(h1[0], h1[1]); w.w = cvt_pk_bf16(h1[2], h1[3]); *(v4u*)((bf16*)H + o) = w; } }
    }
};
__device__ __forceinline__ void unpack8(const v4u w, f32x4& a, f32x4& b) { a[0] = bflo(w.x); a[1] = bfhi(w.x); a[2] = bflo(w.y); a[3] = bfhi(w.y); b[0] = bflo(w.z); b[1] = bfhi(w.z); b[2] = bflo(w.w); b[3] = bfhi(w.w); }
template <int MODE  , bool XF32, bool F8C = false  > struct EpiResid {
    static constexpr bool PERM = true;
    const float* xf; const bf16* xold; bf16* xnew; float* ssp_out; const float* colscale; const float* ssp_in; const bf16* PJ; unsigned char* xq;
    static constexpr int NG = (MODE == 2) ? 1 : 2, NS = 8 / NG;
    struct Q { v4u xo[NG][2], pj[NG][2]; f32x4 xf0[NG][2], xf1[NG][2]; };
    __device__ __forceinline__ void qload(Q& q, int st, int row0, int col0) const {
#pragma unroll
        for (int mm = 0; mm < NG; ++mm)
#pragma unroll
            for (int bj = 0; bj < 2; ++bj) { const int g = st * NG + mm, ai = g >> 2, m = g & 3; const size_t o = (size_t)(row0 + ai * 128 + m * 16) * DM + col0 + bj * 128;
                if constexpr (XF32) { q.xf0[mm][bj] = *(const f32x4*)(xf + o); q.xf1[mm][bj] = *(const f32x4*)(xf + o + 4); } else q.xo[mm][bj] = *(const v4u*)(xold + o);
                if constexpr (MODE == 2) q.pj[mm][bj] = *(const v4u*)(PJ + o); }
    }
    __device__ __forceinline__ void operator()(const f32x4 (&acc)[2][2][4][2], const Unit& u, int wr, int wc, int fr, int fq) const {
        const int row0 = u.pm * 256 + wr * 64 + fr, col0 = u.pn * 256 + wc * 32 + 8 * fq;
        Q qa, qb;
        qload(qa, 0, row0, col0);
        float rs[2][4];
        if constexpr (MODE == 2) load_rstd(ssp_in, row0, fq, rs);
        f32x4 cs[2][2];
        if constexpr (MODE == 1) {
#pragma unroll
            for (int bj = 0; bj < 2; ++bj)
#pragma unroll
                for (int n = 0; n < 2; ++n) cs[bj][n] = *(const f32x4*)(colscale + col0 + bj * 128 + 4 * n);
        }
#pragma unroll
        for (int st = 0; st < NS; ++st) {
            Q& q = (st & 1) ? qb : qa;
            if (st + 1 < NS) qload((st & 1) ? qa : qb, st + 1, row0, col0);
            asm volatile("" ::: "memory");
#pragma unroll
            for (int mm = 0; mm < NG; ++mm) { const int g = st * NG + mm, ai = g >> 2, m = g & 3; const int row = row0 + ai * 128 + m * 16; const size_t off = (size_t)row * DM + col0; float ss = 0.f;
#pragma unroll
                for (int bj = 0; bj < 2; ++bj) { const size_t o = off + bj * 128; f32x4 v0 = acc[ai][bj][m][0], v1 = acc[ai][bj][m][1];
                    if constexpr (MODE == 1) { v0 = v0 * cs[bj][0]; v1 = v1 * cs[bj][1]; }
                    if constexpr (MODE == 2) { f32x4 p0, p1; unpack8(q.pj[mm][bj], p0, p1); const float r = rs[ai][m];
#pragma unroll
                        for (int j = 0; j < 4; ++j) { v0[j] = sigmoidf_(v0[j] * r) * p0[j]; v1[j] = sigmoidf_(v1[j] * r) * p1[j]; } }
                    f32x4 x0, x1;
                    if constexpr (XF32) { x0 = q.xf0[mm][bj]; x1 = q.xf1[mm][bj]; } else unpack8(q.xo[mm][bj], x0, x1);
                    x0 += v0; x1 += v1;
                    v4u w; w.x = cvt_pk_bf16(x0[0], x0[1]); w.y = cvt_pk_bf16(x0[2], x0[3]); w.z = cvt_pk_bf16(x1[0], x1[1]); w.w = cvt_pk_bf16(x1[2], x1[3]);
                    *(v4u*)(xnew + o) = w;
                    if constexpr (F8C) *(v2u*)(xq + o) = pk8_fp8(x0, x1);
                    ss += ((x0[0] * x0[0] + x0[1] * x0[1]) + (x0[2] * x0[2] + x0[3] * x0[3])) + ((x1[0] * x1[0] + x1[1] * x1[1]) + (x1[2] * x1[2] + x1[3] * x1[3])); }
                ss += __shfl_xor(ss, 16); ss += __shfl_xor(ss, 32);
                if (fq == 0) ssp_out[(size_t)row * 32 + u.pn * 4 + wc] = ss;
            }
            asm volatile("" ::: "memory");
        }
    }
};
template <bool RANK2, bool F8C = false> struct EpiMoeDown {
    static constexpr bool PERM = true;
    bf16* X; float* ssp_out; const int* list; const float* gwl; unsigned char* xq;
    __device__ __forceinline__ void operator()(const f32x4 (&acc)[2][2][4][2], const Unit& u, int wr, int wc, int fr, int fq) const {
        asm volatile("" : "+v"(fr), "+v"(fq));
        const int col0 = u.pn * 256 + wc * 32 + 8 * fq;
#pragma unroll
        for (int ai = 0; ai < 2; ++ai)
#pragma unroll
            for (int m = 0; m < 4; ++m) { const int rl = wr * 64 + fr + ai * 128 + m * 16; const bool ok = rl < u.nvalid; const int rc_ = ok ? rl : u.nvalid - 1; const int tok = u.rows[rc_]; const float gw = gwl[(u.rows - list) + rc_];
                const size_t off = (size_t)(ok ? tok : 0) * DM + col0; float ss = 0.f;
#pragma unroll
                for (int bj = 0; bj < 2; ++bj) { const size_t o = off + bj * 128;
                    if (ok) { f32x4 x0, x1; unpack8(*(const v4u*)(X + o), x0, x1); x0 += acc[ai][bj][m][0] * gw; x1 += acc[ai][bj][m][1] * gw;
                        v4u w; w.x = cvt_pk_bf16(x0[0], x0[1]); w.y = cvt_pk_bf16(x0[2], x0[3]); w.z = cvt_pk_bf16(x1[0], x1[1]); w.w = cvt_pk_bf16(x1[2], x1[3]);
                        *(v4u*)(X + o) = w;
                        if constexpr (RANK2 && F8C) *(v2u*)(xq + o) = pk8_fp8(x0, x1);
                        if constexpr (RANK2) ss += ((x0[0] * x0[0] + x0[1] * x0[1]) + (x0[2] * x0[2] + x0[3] * x0[3])) + ((x1[0] * x1[0] + x1[1] * x1[1]) + (x1[2] * x1[2] + x1[3] * x1[3])); } }
                if constexpr (RANK2) { ss += __shfl_xor(ss, 16); ss += __shfl_xor(ss, 32);
                    if (fq == 0 && ok) ssp_out[(size_t)tok * 32 + u.pn * 4 + wc] = ss; }
                if (m & 1) asm volatile("" ::: "memory");
            }
    }
};

template <class EE> struct EpiTwice { static constexpr bool PERM = EE::PERM; EE e;
    __device__ __forceinline__ void operator()(const f32x4 (&acc)[2][2][4][2], const Unit& u, int wr, int wc, int fr, int fq) const { int n_ = 2; asm volatile("" : "+s"(n_));
#pragma nounroll
        for (int k_ = 0; k_ < n_; ++k_) { e(acc, u, wr, wc, fr, fq); asm volatile("" ::: "memory"); } } };
struct Args { const float* in[24]; float* out; unsigned char* ws; };
struct Frame {
    LAS unsigned char* lds; volatile LAS unsigned* MISC; gu32* ctl;
    int tid, lane, wave, G, bx;
};

constexpr int TRP = 136;
constexpr int TRP8 = 68;
struct TrJob { const float* W0; const float* W1; int c0, c1, ldw, K, N, NP; bf16* WT; const float* gain; int f8; };
__device__ __forceinline__ int tr_items(const TrJob& J) { return (J.K / 64) * (J.NP ? J.NP * 4 : J.N / 64); }
__device__ __forceinline__ void tr_map(const TrJob& J, int it, int& kb, int& nb) {
    const int nnb = J.NP ? J.NP * 4 : J.N / 64, sup = it >> 3, sub = it & 7, nsn = nnb >> 1;
    kb = (sup / nsn) * 4 + (sub >> 1); nb = (sup % nsn) * 2 + (sub & 1);
}
__device__ __forceinline__ void tr_src(const TrJob& J, int nb, const float*& W, int& sc) {
    W = J.W0; sc = J.c0 + nb * 64;
    if (J.NP) { const int j = nb >> 2, q = nb & 3; W = (q < 2) ? J.W0 : J.W1; sc = ((q < 2) ? J.c0 : J.c1) + 128 * j + 64 * (q & 1); }
}
__device__ __forceinline__ void tr_load(const TrJob& J, int it, f32x4 (&v)[16], float (&g)[16], int lane) {
    int kb, nb; tr_map(J, it, kb, nb); const float* W; int sc; tr_src(J, nb, W, sc);
    const float* src = W + (size_t)(kb * 64 + (lane >> 4)) * J.ldw + sc + 4 * (lane & 15);
#pragma unroll
    for (int i = 0; i < 16; ++i) v[i] = *(const f32x4*)(src + (size_t)(4 * i) * J.ldw);
    if (J.gain) {
#pragma unroll
        for (int i = 0; i < 16; ++i) g[i] = J.gain[kb * 64 + 4 * i + (lane >> 4)];
    } else {
#pragma unroll
        for (int i = 0; i < 16; ++i) g[i] = 1.0f;
    }
}
__device__ __forceinline__ void tr_store(const TrJob& J, int it, const f32x4 (&v)[16], const float (&gg)[16], LAS unsigned char* scr, int lane) {
    int kb, nb; tr_map(J, it, kb, nb); const int k0 = kb * 64, drow0 = nb * 64;
    if (J.f8) {
#pragma unroll
        for (int i = 0; i < 16; ++i) { const int kk = 4 * i + (lane >> 4); const float g = gg[i] * 64.0f;
            int w = 0; w = __builtin_amdgcn_cvt_pk_fp8_f32(v[i][0] * g, v[i][1] * g, w, false); w = __builtin_amdgcn_cvt_pk_fp8_f32(v[i][2] * g, v[i][3] * g, w, true);
            *(LAS int*)(scr + kk * TRP8 + 4 * (lane & 15)) = w; }
        LDS_WAIT(); asm volatile("" ::: "memory");
        const int c = lane & 3; unsigned char* WT = (unsigned char*)J.WT;
#pragma unroll
        for (int j = 0; j < 4; ++j) { const int n = (lane >> 2) + 16 * j; const LAS unsigned char* s = scr + (16 * c) * TRP8 + n;
            v4u o;
            o.x = (unsigned)s[0 * TRP8] | ((unsigned)s[1 * TRP8] << 8) | ((unsigned)s[2 * TRP8] << 16) | ((unsigned)s[3 * TRP8] << 24);
            o.y = (unsigned)s[4 * TRP8] | ((unsigned)s[5 * TRP8] << 8) | ((unsigned)s[6 * TRP8] << 16) | ((unsigned)s[7 * TRP8] << 24);
            o.z = (unsigned)s[8 * TRP8] | ((unsigned)s[9 * TRP8] << 8) | ((unsigned)s[10 * TRP8] << 16) | ((unsigned)s[11 * TRP8] << 24);
            o.w = (unsigned)s[12 * TRP8] | ((unsigned)s[13 * TRP8] << 8) | ((unsigned)s[14 * TRP8] << 16) | ((unsigned)s[15 * TRP8] << 24);
            *(GAS v4u*)(WT + (size_t)(drow0 + n) * J.K + k0 + 16 * c) = o; }
    } else {
#pragma unroll
        for (int i = 0; i < 16; ++i) { const int kk = 4 * i + (lane >> 4); const float g = gg[i];
            v2u w; w.x = cvt_pk_bf16(v[i][0] * g, v[i][1] * g); w.y = cvt_pk_bf16(v[i][2] * g, v[i][3] * g);
            *(LAS v2u*)(scr + kk * TRP + 8 * (lane & 15)) = w; }
        LDS_WAIT(); asm volatile("" ::: "memory");
        const int c = lane & 7;
#pragma unroll
        for (int j = 0; j < 8; ++j) { const int n = (lane >> 3) + 8 * j; const LAS unsigned short* s = (const LAS unsigned short*)(scr + (8 * c) * TRP + 2 * n);
            v4u o; o.x = (unsigned)s[0] | ((unsigned)s[TRP / 2] << 16); o.y = (unsigned)s[2 * (TRP / 2)] | ((unsigned)s[3 * (TRP / 2)] << 16);
            o.z = (unsigned)s[4 * (TRP / 2)] | ((unsigned)s[5 * (TRP / 2)] << 16); o.w = (unsigned)s[6 * (TRP / 2)] | ((unsigned)s[7 * (TRP / 2)] << 16);
            *(GAS v4u*)(J.WT + (size_t)(drow0 + n) * J.K + k0 + 8 * c) = o; }
    }
    LDS_WAIT(); asm volatile("" ::: "memory");
}
__device__ __forceinline__ int tr_job(const TrJob& J, int base, int wv, int nw, LAS unsigned char* scr, int lane) {
    const int nit = tr_items(J);
    int it = (wv - base % nw + nw) % nw;
    f32x4 va[16], vb[16]; float ga[16], gb[16];
    if (it < nit) tr_load(J, it, va, ga, lane);
    while (it < nit) {
        const int nx = it + nw;
        if (nx < nit) tr_load(J, nx, vb, gb, lane);
        tr_store(J, it, va, ga, scr, lane);
        if (nx >= nit) break;
        const int nx2 = nx + nw;
        if (nx2 < nit) tr_load(J, nx2, va, ga, lane);
        tr_store(J, nx, vb, gb, scr, lane);
        it = nx2;
    }
    return base + nit;
}

constexpr int H_QT = 0, H_KT = 17408, H_QC = 34816, H_KH = 52224, H_VT = 70656, H_TOT = 89088, H_DEC = 93184, H_NRM = 93696  , H_END = 95744;
constexpr int TP = 272  , CP = 144  ;
__device__ __forceinline__ f32x16 mfma32(bf16x8 a, bf16x8 b, f32x16 c) { return __builtin_amdgcn_mfma_f32_32x32x16_bf16(a, b, c, 0, 0, 0); }
__device__ __forceinline__ bf16x8 pack8(const f32x16& v, int o) {
    v4u w; w.x = cvt_pk_bf16(v[o + 0], v[o + 1]); w.y = cvt_pk_bf16(v[o + 2], v[o + 3]); w.z = cvt_pk_bf16(v[o + 4], v[o + 5]); w.w = cvt_pk_bf16(v[o + 6], v[o + 7]);
    return __builtin_bit_cast(bf16x8, w);
}
__device__ __forceinline__ bf16x8 ld2x8(const LAS unsigned char* p) {
    const v2u a = *(const LAS v2u*)p, b = *(const LAS v2u*)(p + 16); v4u w; w.x = a.x; w.y = a.y; w.z = b.x; w.w = b.y; return __builtin_bit_cast(bf16x8, w);
}
struct HgRegs { unsigned lf[8], qs[8], v[8], lf32; };
#define EX2(x) __builtin_amdgcn_exp2f(x)
__device__ __forceinline__ void hg_finish(LAS unsigned char* L, int nbuf, const f32x16& O, const v2u (&gs)[4], const f32x4 (&gn_)[4], bf16* A2o, int tb, int r) {
    float tot = 0.f;
#pragma unroll
    for (int e4 = 0; e4 < 4; ++e4) tot += *(const LAS float*)(L + H_NRM + nbuf * 1024 + (e4 * 64 + 32 * tb + r) * 4);
    const float rstd = 1.0f / sqrtf(tot * (1.0f / HD) + EPS);
#pragma unroll
    for (int q = 0; q < 4; ++q) {
        const f32x4 gn = gn_[q];
        const float o0 = O[4 * q + 0] * rstd * gn[0] * bflo(gs[q].x), o1 = O[4 * q + 1] * rstd * gn[1] * bfhi(gs[q].x);
        const float o2 = O[4 * q + 2] * rstd * gn[2] * bflo(gs[q].y), o3 = O[4 * q + 3] * rstd * gn[3] * bfhi(gs[q].y);
        v2u wv; wv.x = cvt_pk_bf16(o0, o1); wv.y = cvt_pk_bf16(o2, o3);
        *(v2u*)(A2o + 8 * q) = wv; }
}
__device__ __forceinline__ void hgrn_phase(Frame& F, const bf16* U, bf16* A2, const float* hgain) {
    const int b = F.bx >> 3, h = F.bx & 7, w = F.wave, lane = F.lane;
    LAS unsigned char* L = F.lds;
    const int eb = w >> 1, tb = w & 1, r = lane & 31, hh = lane >> 5;
    f32x16 S[4];
#pragma unroll
    for (int d = 0; d < 4; ++d)
#pragma unroll
        for (int i = 0; i < 16; ++i) S[d][i] = 0.f;
    const size_t rowbase0 = (size_t)b * SEQ;
    const bf16* Ucol = U + h * HD + 2 * lane;
    f32x4 gn_[4];
#pragma unroll
    for (int q = 0; q < 4; ++q) gn_[q] = *(const f32x4*)(hgain + h * HD + 32 * eb + 8 * q + 4 * hh);
    const bf16* Ugs = U + 3072 + h * HD + 32 * eb + 4 * hh + (rowbase0 + 32 * tb + r) * UP;
    bf16* A2o = A2 + (rowbase0 + 32 * tb + r) * DM + h * HD + 32 * eb + 4 * hh;
    HgRegs R; v2u gs_[4], gsp_[4];
    f32x16 Op;
#pragma unroll
    for (int i = 0; i < 16; ++i) Op[i] = 0.f;
#define HG_LOAD(n) do { const bf16* p = Ucol + (rowbase0 + (size_t)(n) * CHUNK + 8 * w) * UP; \
        _Pragma("unroll") for (int j = 0; j < 8; ++j) { R.qs[j] = *(const unsigned*)(p + (size_t)j * UP); R.lf[j] = *(const unsigned*)(p + (size_t)j * UP + 1024); R.v[j] = *(const unsigned*)(p + (size_t)j * UP + 2048); } \
        R.lf32 = *(const unsigned*)(Ucol + (rowbase0 + (size_t)(n) * CHUNK + 32) * UP + 1024); \
        _Pragma("unroll") for (int q = 0; q < 4; ++q) gs_[q] = *(const v2u*)(Ugs + (size_t)(n) * CHUNK * UP + 8 * q); } while (0)
    HG_LOAD(0);
    for (int n = 0; n < SEQ / CHUNK; ++n) {
        f32x2 c[8];
        { f32x2 a = (f32x2){0.f, 0.f};
#pragma unroll
          for (int j = 0; j < 8; ++j) { a += (f32x2){bflo(R.lf[j]), bfhi(R.lf[j])}; c[j] = a; }
          *(LAS f32x2*)(L + H_TOT + (w * 128 + 2 * lane) * 4) = a; }
        LDS_BAR();
        if (n > 0) hg_finish(L, (n - 1) & 1, Op, gsp_, gn_, A2o + (size_t)(n - 1) * CHUNK * DM, tb, r);
        { f32x2 pre = (f32x2){0.f, 0.f}, ref = pre, last = pre;
#pragma unroll
          for (int ww = 0; ww < 8; ++ww) { const f32x2 t = *(const LAS f32x2*)(L + H_TOT + (ww * 128 + 2 * lane) * 4);
              if (ww < w) pre += t; if (ww < 4) ref += t; last += t; }
          ref += (f32x2){bflo(R.lf32), bfhi(R.lf32)};
          const f32x2 lr = last - ref;
          const f32x2 eref = (f32x2){EX2(ref.x), EX2(ref.y)}, elr = (f32x2){EX2(lr.x), EX2(lr.y)};
          if (w == 0) *(LAS f32x2*)(L + H_DEC + 2 * lane * 4) = (f32x2){EX2(last.x), EX2(last.y)};
          unsigned kh0[4], kh1[4], vt0[4], vt1[4];
#pragma unroll
          for (int j = 0; j < 8; ++j) {
              const f32x2 d1 = (pre + c[j]) - ref;
              const f32x2 E1 = (f32x2){EX2(d1.x), EX2(d1.y)}, E2 = (f32x2){fast_rcp(E1.x), fast_rcp(E1.y)};
              const f32x2 fv = (f32x2){EX2(bflo(R.lf[j])), EX2(bfhi(R.lf[j]))};
              const f32x2 kq = (f32x2){1.0f, 1.0f} - fv, q = (f32x2){bflo(R.qs[j]), bfhi(R.qs[j])};
              const f32x2 qt = q * E1, kt = kq * E2, qc = qt * eref, kh = kt * elr;
              const int t = 8 * w + j;
              *(LAS unsigned*)(L + H_QT + t * TP + 4 * lane) = cvt_pk_bf16(qt.x, qt.y);
              *(LAS unsigned*)(L + H_KT + t * TP + 4 * lane) = cvt_pk_bf16(kt.x, kt.y);
              *(LAS unsigned*)(L + H_QC + t * TP + 4 * lane) = cvt_pk_bf16(qc.x, qc.y);
              const unsigned kk = cvt_pk_bf16(kh.x, kh.y);
              if (j & 1) { kh0[j >> 1] |= (kk << 16); kh1[j >> 1] |= (kk & 0xffff0000u); vt0[j >> 1] |= (R.v[j] << 16); vt1[j >> 1] |= (R.v[j] & 0xffff0000u); }
              else { kh0[j >> 1] = kk & 0xffffu; kh1[j >> 1] = kk >> 16; vt0[j >> 1] = R.v[j] & 0xffffu; vt1[j >> 1] = R.v[j] >> 16; }
          }
          *(LAS v4u*)(L + H_KH + (2 * lane) * CP + 16 * w) = (v4u){kh0[0], kh0[1], kh0[2], kh0[3]};
          *(LAS v4u*)(L + H_KH + (2 * lane + 1) * CP + 16 * w) = (v4u){kh1[0], kh1[1], kh1[2], kh1[3]};
          *(LAS v4u*)(L + H_VT + (2 * lane) * CP + 16 * w) = (v4u){vt0[0], vt0[1], vt0[2], vt0[3]};
          *(LAS v4u*)(L + H_VT + (2 * lane + 1) * CP + 16 * w) = (v4u){vt1[0], vt1[1], vt1[2], vt1[3]};
        }
        LDS_BAR();
#pragma unroll
        for (int q = 0; q < 4; ++q) gsp_[q] = gs_[q];
        if (n + 1 < SEQ / CHUNK) HG_LOAD(n + 1);
        f32x16 O;
#pragma unroll
        for (int i = 0; i < 16; ++i) O[i] = 0.f;
#pragma unroll
        for (int sb = 0; sb < 2; ++sb) {
            if (sb <= tb) {
                f32x16 P;
#pragma unroll
                for (int i = 0; i < 16; ++i) P[i] = 0.f;
#pragma unroll
                for (int kh = 0; kh < 2; ++kh) {
                    bf16x8 fa[4], fb[4];
#pragma unroll
                    for (int k4 = 0; k4 < 4; ++k4) { const int ks = 4 * kh + k4; fa[k4] = *(const LAS bf16x8*)(L + H_KT + (32 * sb + r) * TP + (16 * ks + 8 * hh) * 2); fb[k4] = *(const LAS bf16x8*)(L + H_QT + (32 * tb + r) * TP + (16 * ks + 8 * hh) * 2); }
#pragma unroll
                    for (int k4 = 0; k4 < 4; ++k4) P = mfma32(fa[k4], fb[k4], P);
                }
                if (sb == tb) {
#pragma unroll
                    for (int i = 0; i < 16; ++i) { const int s = (i & 3) + 8 * (i >> 2) + 4 * hh; if (s > r) P[i] = 0.f; }
                }
#pragma unroll
                for (int k2 = 0; k2 < 2; ++k2) {
                    const bf16x8 av = ld2x8(L + H_VT + (32 * eb + r) * CP + (32 * sb + 16 * k2 + 4 * hh) * 2);
                    O = mfma32(av, pack8(P, 8 * k2), O);
                }
            }
        }
        { bf16x8 fq[8];
#pragma unroll
          for (int i = 0; i < 8; ++i) fq[i] = ld2x8(L + H_QC + (32 * tb + r) * TP + (32 * (i >> 1) + 16 * (i & 1) + 4 * hh) * 2);
#pragma unroll
          for (int i = 0; i < 8; ++i) O = mfma32(pack8(S[i >> 1], 8 * (i & 1)), fq[i], O); }
        { bf16x8 fv[4];
#pragma unroll
          for (int ks = 0; ks < 4; ++ks) fv[ks] = *(const LAS bf16x8*)(L + H_VT + (32 * eb + r) * CP + (16 * ks + 8 * hh) * 2);
#pragma unroll
          for (int db = 0; db < 4; ++db) {
              bf16x8 fk[4];
#pragma unroll
              for (int ks = 0; ks < 4; ++ks) fk[ks] = *(const LAS bf16x8*)(L + H_KH + (32 * db + r) * CP + (16 * ks + 8 * hh) * 2);
#pragma unroll
              for (int q = 0; q < 4; ++q) { const f32x4 dc = *(const LAS f32x4*)(L + H_DEC + (32 * db + 8 * q + 4 * hh) * 4);
                  S[db][4 * q + 0] *= dc[0]; S[db][4 * q + 1] *= dc[1]; S[db][4 * q + 2] *= dc[2]; S[db][4 * q + 3] *= dc[3]; }
#pragma unroll
              for (int ks = 0; ks < 4; ++ks) S[db] = mfma32(fk[ks], fv[ks], S[db]);
          } }
        float ssq = 0.f;
#pragma unroll
        for (int i = 0; i < 16; ++i) ssq += O[i] * O[i];
        ssq += __shfl_xor(ssq, 32);
        if (hh == 0) *(LAS float*)(L + H_NRM + (n & 1) * 1024 + (eb * 64 + 32 * tb + r) * 4) = ssq;
        Op = O;
    }
    LDS_BAR();
    hg_finish(L, (SEQ / CHUNK - 1) & 1, Op, gsp_, gn_, A2o + (size_t)(SEQ / CHUNK - 1) * CHUNK * DM, tb, r);
#undef HG_LOAD
}
#undef EX2
__device__ __forceinline__ void conv_phase(Frame& F, const bf16* U, bf16* A2, const float* convw, int first_block) {
    const int nb = F.G - first_block, me = F.bx - first_block, c = 2 * F.tid;
    const float w00 = convw[c], w01 = convw[c + 1], w10 = convw[DC + c], w11 = convw[DC + c + 1], w20 = convw[2 * DC + c], w21 = convw[2 * DC + c + 1];
    for (int u = me; u < M / 32; u += nb) {
        const int R0 = u * 32, t0 = R0 % SEQ;
        const bf16* up = U + (size_t)R0 * UP;
        float a0 = 0.f, a1 = 0.f, b0 = 0.f, b1 = 0.f;
        if (t0 != 0) { const unsigned p2 = *(const unsigned*)(up - 2 * (size_t)UP + 5120 + c), p1 = *(const unsigned*)(up - (size_t)UP + 5120 + c);
            a0 = bflo(p2); a1 = bfhi(p2); b0 = bflo(p1); b1 = bfhi(p1); }
#pragma unroll 8
        for (int j = 0; j < 32; ++j) {
            const unsigned tt = *(const unsigned*)(up + (size_t)j * UP + 5120 + c), gb = *(const unsigned*)(up + (size_t)j * UP + 4096 + c);
            const float t0f = bflo(tt), t1f = bfhi(tt);
            const float y0 = bflo(gb) * (w00 * a0 + w10 * b0 + w20 * t0f), y1 = bfhi(gb) * (w01 * a1 + w11 * b1 + w21 * t1f);
            *(unsigned*)(A2 + (size_t)(R0 + j) * DM + DH + c) = cvt_pk_bf16(y0, y1);
            a0 = b0; a1 = b1; b0 = t0f; b1 = t1f;
        }
    }
}

#ifndef PH_ENABLE
#define PH_ENABLE 0xffffffffu
#endif
#define PH(k) (((PH_ENABLE) >> (k)) & 1u)
#ifndef PROBE_DUP
#define PROBE_DUP (-1)
#endif
#define REPS(k) ((PROBE_DUP) == (k) ? 2 : 1)
__global__ void __launch_bounds__(NWAVES * 64, 2) fwd_kernel(Args args) {
    extern __shared__ __attribute__((aligned(16))) unsigned char lds[];
    Frame F;
    F.lds = (LAS unsigned char*)lds;
    F.MISC = (volatile LAS unsigned*)(F.lds + MISC_OFF);
    F.tid = threadIdx.x; F.lane = F.tid & 63; F.wave = __builtin_amdgcn_readfirstlane(F.tid >> 6);
    F.G = gridDim.x; F.bx = blockIdx.x;
    unsigned char* ws = args.ws;
    F.ctl = (gu32*)(ws + WS_CTL);
    for (int u = F.tid; u < (LDS_BYTES - LDSCTL_OFF) / 4; u += NWAVES * 64) ((LAS unsigned*)(F.lds + LDSCTL_OFF))[u] = 0u;
    __syncthreads();
    XcdBarrier bar = xcd_barrier_post((unsigned*)(F.ctl + CW_BAR), F.MISC + 8);
#define GRID_BAR() do { xcd_barrier(bar); if (PROBE_DUP == 99) xcd_barrier(bar); } while (0)
#define REFRESH() do { int t_ = threadIdx.x; asm volatile("" : "+v"(t_)); F.tid = t_; F.lane = t_ & 63; F.wave = __builtin_amdgcn_readfirstlane(t_ >> 6); \
        int b_ = blockIdx.x; asm volatile("" : "+s"(b_)); F.bx = b_; gw = F.bx * NWAVES + F.wave; \
        kp_ = (const float* const __attribute__((address_space(4)))*)__builtin_amdgcn_kernarg_segment_ptr(); asm volatile("" : "+s"(kp_)); \
        ws_ = (unsigned char*)kp_[25]; X_ = (float*)kp_[24]; } while (0)
    const float* const __attribute__((address_space(4)))* kp_ = (const float* const __attribute__((address_space(4)))*)__builtin_amdgcn_kernarg_segment_ptr();
    unsigned char* ws_ = args.ws; float* X_ = args.out;
#define I_x (kp_[0])
#define I_p (kp_[1])
#define I_final_gain (kp_[2])
#define I_lb_table (kp_[3])
#define I_mix_norm_even (kp_[4])
#define I_w_in (kp_[5])
#define I_hgrn_gain (kp_[6])
#define I_conv_w (kp_[7])
#define I_w_out (kp_[8])
#define I_ffn_norm_even (kp_[9])
#define I_w_gate (kp_[10])
#define I_w_up (kp_[11])
#define I_w_down (kp_[12])
#define I_mix_norm_odd (kp_[13])
#define I_pool_w (kp_[14])
#define I_pool_scale (kp_[15])
#define I_ffn_norm_odd (kp_[16])
#define I_w_router (kp_[17])
#define I_w_gate_e (kp_[18])
#define I_w_up_e (kp_[19])
#define I_w_down_e (kp_[20])
#define I_ple_norm (kp_[21])
#define I_ple_gate_w (kp_[22])
#define I_ple_proj (kp_[23])
#define W_lbv ((float*)(ws_ + WS_LBV))
#define W_rs4 ((float*)(ws_ + WS_RS4))
#define W_topi ((int*)(ws_ + WS_TOP))
#define W_topw ((float*)(ws_ + WS_TOPW))
#define W_sspA ((float*)(ws_ + WS_SSPA))
#define W_sspB ((float*)(ws_ + WS_SSPB))
#define W_list ((int*)(ws_ + WS_LIST))
#define W_gwl ((float*)(ws_ + WS_GWL))
#define W_rsl ((float*)(ws_ + WS_TOKC))
#define W_tokc ((int*)(ws_ + WS_TOKC))
#define W_gwc ((float*)(ws_ + WS_GWC))
#define W_rsc ((float*)(ws_ + WS_RSC))
#define W_Win_t ((bf16*)(ws_ + WS_WIN))
#define W_Wout_t ((bf16*)(ws_ + WS_WOUT))
#define W_Wgu_t ((bf16*)(ws_ + WS_WGU))
#define W_Wd_t ((bf16*)(ws_ + WS_WD))
#define W_Wpool_t ((bf16*)(ws_ + WS_WPOOL))
#define W_Wmgu_t ((bf16*)(ws_ + WS_WMGU))
#define W_Wmd_t ((bf16*)(ws_ + WS_WMD))
#define W_Wpg_t ((bf16*)(ws_ + WS_WPG))
#define W_Wpp_t ((bf16*)(ws_ + WS_WPP))
#define W_PB ((bf16*)(ws_ + WS_PB))
#define W_XB ((bf16*)(ws_ + WS_XB))
#define W_A2 ((bf16*)(ws_ + WS_A2))
#define W_PJ ((bf16*)(ws_ + WS_A2))
#define W_U ((bf16*)(ws_ + WS_BIG))
#define W_Hh ((bf16*)(ws_ + WS_BIG))
#define W_D1 ((bf16*)(ws_ + WS_BIG))
#define W_XG ((bf16*)(ws_ + WS_BIG))
#define W_HE ((bf16*)(ws_ + WS_HE))
#define W_X (X_)
#define W_XS0 ((bf16*)(ws_ + WS_XB))
#define W_XQ ((unsigned char*)X_)
#define W_XQ1 ((unsigned char*)X_ + 64 * MiB)
#define W_XS1 ((bf16*)((unsigned char*)X_ + 64 * MiB))
#define W_XB0 ((bf16*)X_)
    int gw = F.bx * NWAVES + F.wave; const int NGW = F.G * NWAVES;

#ifndef CONV_MODE
#define CONV_MODE 0
#endif
#define CONVERT_REST(FIRSTB) do { \
            LDS_BAR(); \
            LAS unsigned char* scr = F.lds + F.wave * 16384; \
            const int wv = (F.bx - (FIRSTB)) * NWAVES + F.wave, nw = (F.G - (FIRSTB)) * NWAVES; int base = 0; \
            { const TrJob J{I_w_out, I_w_out, 0, 0, DM, DM, DM, 0, W_Wout_t, nullptr, 0}; base = tr_job(J, base, wv, nw, scr, F.lane); } \
            { const TrJob J{I_w_gate, I_w_up, 0, 0, DFF, DM, 0, DFF / 128, W_Wgu_t, I_ffn_norm_even, F8_GU}; base = tr_job(J, base, wv, nw, scr, F.lane); } \
            { const TrJob J{I_w_down, I_w_down, 0, 0, DM, DFF, DM, 0, W_Wd_t, nullptr, F8_DN}; base = tr_job(J, base, wv, nw, scr, F.lane); } \
            for (int i = 0; i < 2; ++i) { const TrJob J{I_ple_proj + (size_t)i * DPLE * DM, nullptr, 0, 0, DM, DPLE, DM, 0, W_Wpp_t + (size_t)i * DM * DPLE, nullptr, 0}; base = tr_job(J, base, wv, nw, scr, F.lane); } \
            for (int i = 0; i < 2; ++i) { const TrJob J{I_ple_gate_w + (size_t)i * DM * DM, nullptr, 0, 0, DM, DM, DM, 0, W_Wpg_t + (size_t)i * DM * DM, I_ple_norm + i * DM, (i == 1 && F8_PLE1) ? 1 : 0}; base = tr_job(J, base, wv, nw, scr, F.lane); } \
            for (int g = 0; g < 4; ++g) { const TrJob J{I_pool_w + (size_t)g * 512 * 512, nullptr, 0, 0, 512, 512, 512, 0, W_Wpool_t + (size_t)512 * g * 512, I_mix_norm_odd + 512 * g, 0}; base = tr_job(J, base, wv, nw, scr, F.lane); } \
            for (int e = 0; e < NE; ++e) { const TrJob J{I_w_gate_e + (size_t)e * DM * DFE, I_w_up_e + (size_t)e * DM * DFE, 0, 0, DFE, DM, 0, DFE / 128, W_Wmgu_t + (size_t)e * 2048 * DM / (F8_MOE ? 2 : 1), I_ffn_norm_odd, F8_MOE}; base = tr_job(J, base, wv, nw, scr, F.lane); } \
            for (int e = 0; e < NE; ++e) { const TrJob J{I_w_down_e + (size_t)e * DFE * DM, nullptr, 0, 0, DM, DFE, DM, 0, W_Wmd_t + (size_t)e * DM * DFE / (F8_MOE ? 2 : 1), nullptr, F8_MOE}; base = tr_job(J, base, wv, nw, scr, F.lane); } \
            for (size_t i = (size_t)(F.bx - (FIRSTB)) * 512 + F.tid; i < (size_t)2 * M * DPLE / 8; i += (size_t)(F.G - (FIRSTB)) * 512) { \
                const f32x4 a = ((const f32x4*)I_p)[2 * i], b2 = ((const f32x4*)I_p)[2 * i + 1]; \
                v4u w; w.x = cvt_pk_bf16(a[0], a[1]); w.y = cvt_pk_bf16(a[2], a[3]); w.z = cvt_pk_bf16(b2[0], b2[1]); w.w = cvt_pk_bf16(b2[2], b2[3]); ((v4u*)W_PB)[i] = w; } \
        } while (0)
    for (int rep_ = 0; rep_ < REPS(0); ++rep_) { REFRESH();
        LAS unsigned char* scr = F.lds + F.wave * 16384;
        int base = 0;
        { const TrJob J{I_w_in, I_w_in, 0, 0, NIN, DM, 5120, 0, W_Win_t, I_mix_norm_even, 0}; base = tr_job(J, base, gw, NGW, scr, F.lane); }
        { const TrJob J{I_w_in, I_w_in, 5120, 6144, NIN, DM, 0, 8, W_Win_t + (size_t)5120 * DM, I_mix_norm_even, 0}; base = tr_job(J, base, gw, NGW, scr, F.lane); }
        for (int m = gw; m < M; m += NGW) {
            const GAS f32x4* xr = (const GAS f32x4*)(I_x + (size_t)m * DM) + F.lane; GAS v2u* o8 = (GAS v2u*)(W_XB0 + (size_t)m * DM) + F.lane; float s = 0.f;
#pragma unroll
            for (int j = 0; j < 8; ++j) { const f32x4 v = xr[64 * j]; s += (v[0] * v[0] + v[1] * v[1]) + (v[2] * v[2] + v[3] * v[3]); v2u w; w.x = cvt_pk_bf16(v[0], v[1]); w.y = cvt_pk_bf16(v[2], v[3]); o8[64 * j] = w; }
            s = wave_sum(s);
            if (F.lane < 32) W_sspA[(size_t)m * 32 + F.lane] = (F.lane == 0) ? s : 0.f;
        }
        if (F.bx == 0) for (int j = F.tid; j < DH; j += 512) { const float t0 = I_lb_table[j], t1 = I_lb_table[DH + j], t2 = I_lb_table[2 * DH + j]; const float mx = fmaxf(t0, fmaxf(t1, t2));
            const float e0 = __expf(t0 - mx), e1 = __expf(t1 - mx), e2 = __expf(t2 - mx); W_lbv[j] = e0 / (e0 + e1 + e2); }
    }
    GRID_BAR();
    const size_t TB2048 = (size_t)256 * DM * 2;
    for (int rep_ = 0; rep_ < (PH(1) ? REPS(1) : 0); ++rep_) { REFRESH();
        SchedGrid S; S.o.init(M / 256, NIN / 256, F.G, F.bx); S.A = (const char*)W_XB0; S.B = (const char*)W_Win_t; S.at = TB2048; S.bt = TB2048;
        EpiInProj E{W_U, W_sspA, W_lbv};
        pg8::gemm_phase<EpiInProj, SchedGrid, true>(F.lds, DM, DM, DM, S, E);
    }
    GRID_BAR();
    for (int rep_ = 0; rep_ < REPS(2); ++rep_) { REFRESH(); if (F.bx < BATCH * NH) { hgrn_phase(F, W_U, W_A2, I_hgrn_gain); if (PROBE_DUP == 20) hgrn_phase(F, W_U, W_A2, I_hgrn_gain); }
        else for (int rep2_ = 0; rep2_ < (PROBE_DUP == 21 ? 2 : 1); ++rep2_) {
            conv_phase(F, W_U, W_A2, I_conv_w, BATCH * NH);
            if (CONV_MODE == 0) CONVERT_REST(BATCH * NH);
        }
    }
    GRID_BAR();
    if (CONV_MODE == 1) { for (int rep_ = 0; rep_ < REPS(16); ++rep_) { REFRESH(); CONVERT_REST(0); } GRID_BAR(); }
    for (int rep_ = 0; rep_ < (PH(3) ? REPS(3) : 0); ++rep_) { REFRESH();
        SchedGrid S; S.o.init(M / 256, DM / 256, F.G, F.bx); S.A = (const char*)W_A2; S.B = (const char*)W_Wout_t; S.at = TB2048; S.bt = TB2048;
        EpiResid<0, false, F8_GU> E{nullptr, W_XB0, W_XS0, W_sspB, nullptr, nullptr, nullptr, W_XQ1};
        pg8::gemm_phase<EpiResid<0, false, F8_GU>, SchedGrid, true>(F.lds, DM, DM, DM, S, E);
    }
    GRID_BAR();
    for (int rep_ = 0; rep_ < (PH(4) ? REPS(4) : 0); ++rep_) { REFRESH();
        constexpr int EB = F8_GU ? 1 : 2;
        SchedGrid S; S.o.init(M / 256, 2 * DFF / 256, F.G, F.bx); S.A = F8_GU ? (const char*)W_XQ1 : (const char*)W_XS0; S.B = (const char*)W_Wgu_t; S.at = (size_t)256 * DM * EB; S.bt = (size_t)256 * DM * EB;
        EpiSwiglu<false, F8_DN> E{W_Hh, DFF, W_sspB, nullptr, nullptr};
        pg8::gemm_phase<EpiSwiglu<false, F8_DN>, SchedGrid, true, F8_GU>(F.lds, DM * EB / 2, DM * EB / 2, DM * EB / 2, S, E);
        REFRESH();
        SchedGrid S2; S2.o.init(M / 256, DM / 256, F.G, F.bx); S2.A = (const char*)W_PB; S2.B = (const char*)W_Wpp_t; S2.at = (size_t)256 * DPLE * 2; S2.bt = (size_t)256 * DPLE * 2;
        EpiBf16Plain E2{W_PJ, DM};
        pg8::gemm_phase<EpiBf16Plain, SchedGrid, true>(F.lds, DPLE, DPLE, DPLE, S2, E2);
    }
    GRID_BAR();
    for (int rep_ = 0; rep_ < (PH(5) ? REPS(5) : 0); ++rep_) { REFRESH();
        SchedGrid S; S.o.init(M / 256, DM / 256, F.G, F.bx); constexpr int EB = F8_DN ? 1 : 2; S.A = (const char*)W_Hh; S.B = (const char*)W_Wd_t; S.at = (size_t)256 * DFF * EB; S.bt = (size_t)256 * DFF * EB;
        EpiResid<0, false> E{nullptr, W_XS0, W_XS0, W_sspA, nullptr, nullptr, nullptr, nullptr};
        pg8::gemm_phase<EpiResid<0, false>, SchedGrid, true, F8_DN>(F.lds, DFF * EB / 2, DFF * EB / 2, DFF * EB / 2, S, E);
    }
    GRID_BAR();
    for (int rep_ = 0; rep_ < (PH(6) ? REPS(6) : 0); ++rep_) { REFRESH();
        SchedGrid S; S.o.init(M / 256, DM / 256, F.G, F.bx); S.A = (const char*)W_XB; S.B = (const char*)W_Wpg_t; S.at = TB2048; S.bt = TB2048;
        EpiResid<2, false> E{nullptr, W_XS0, W_XS1, W_sspB, nullptr, W_sspA, W_PJ, nullptr};
        pg8::gemm_phase<EpiResid<2, false>, SchedGrid, true>(F.lds, DM, DM, DM, S, E);
    }
    GRID_BAR();
    for (int rep_ = 0; rep_ < (PH(7) ? REPS(7) : 0); ++rep_) { REFRESH();
        LAS float* rt = (LAS float*)F.lds;
        for (int seg = F.bx; seg < M / 64; seg += F.G) {
            const int R0 = seg * 64, t0 = R0 % SEQ;
            for (int i = F.wave; i < 80; i += NWAVES) { const int row = R0 - 16 + i; float v = 0.f;
                if (row >= 0 && F.lane < 32) v = W_sspB[(size_t)row * 32 + F.lane];
                v = wave_sum(v); if (F.lane == 0) rt[i] = 1.0f / sqrtf(v * (1.0f / DM) + EPS); }
            LDS_BAR();
            const int wdw = 2 << (F.tid >> 7);
            const bf16* xc = W_XS1 + (size_t)R0 * DM + 4 * F.tid;
#define LD4(ptr, sc) ({ const v2u q_ = *(const v2u*)(ptr); f32x4 r_; r_[0] = bflo(q_.x) * (sc); r_[1] = bfhi(q_.x) * (sc); r_[2] = bflo(q_.y) * (sc); r_[3] = bfhi(q_.y) * (sc); r_; })
            f32x4 Ssum = (f32x4){0.f, 0.f, 0.f, 0.f};
            for (int k = 1; k <= wdw; ++k) if (t0 - k >= 0) Ssum += LD4(xc - (size_t)k * DM, rt[16 - k]);
#pragma unroll 4
            for (int j = 0; j < 64; ++j) {
                const f32x4 hv = LD4(xc + (size_t)j * DM, rt[16 + j]);
                Ssum += hv;
                const int tp = t0 + j;
                if (tp - wdw >= 0) Ssum -= LD4(xc + (size_t)(j - wdw) * DM, rt[16 + j - wdw]);
                const float inv = 1.0f / (float)((tp + 1 < wdw) ? (tp + 1) : wdw);
                const f32x4 d = Ssum * inv - hv;
                v2u w; w.x = cvt_pk_bf16(d[0], d[1]); w.y = cvt_pk_bf16(d[2], d[3]);
                *(v2u*)(W_D1 + (size_t)(R0 + j) * DM + 4 * F.tid) = w;
            }
#undef LD4
            LDS_BAR();
        }
    }
    GRID_BAR();
    for (int rep_ = 0; rep_ < (PH(8) ? REPS(8) : 0); ++rep_) { REFRESH();
        SchedPool S; S.o.init(M / 256, DM / 256, F.G, F.bx); S.A = (const char*)W_D1; S.B = (const char*)W_Wpool_t; S.at = TB2048; S.bt = (size_t)256 * 512 * 2;
        EpiResid<1, false, F8_MOE> E{nullptr, W_XS1, W_XS1, W_sspA, I_pool_scale, nullptr, nullptr, W_XQ};
        pg8::gemm_phase<EpiResid<1, false, F8_MOE>, SchedPool, true>(F.lds, 512, DM, 512, S, E);
        REFRESH();
        SchedGrid S2; S2.o.init(M / 256, DM / 256, F.G, F.bx); S2.A = (const char*)(W_PB + (size_t)M * DPLE); S2.B = (const char*)(W_Wpp_t + (size_t)DM * DPLE); S2.at = (size_t)256 * DPLE * 2; S2.bt = (size_t)256 * DPLE * 2;
        EpiBf16Plain E2{W_PJ, DM};
        pg8::gemm_phase<EpiBf16Plain, SchedGrid, true>(F.lds, DPLE, DPLE, DPLE, S2, E2);
    }
    GRID_BAR();
    for (int rep_ = 0; rep_ < (PH(9) ? REPS(9) : 0); ++rep_) { REFRESH();
        LAS float* wr = (LAS float*)F.lds;
        LAS int* e12 = (LAS int*)(F.lds + 65536);
        LAS float* w12 = (LAS float*)(F.lds + 65536 + 512);
        LAS float* rs1 = (LAS float*)(F.lds + 65536 + 1024);
        for (int i = F.tid; i < DM * NE / 4; i += 512) { const int k = i >> 1, e0 = (i & 1) * 4; const f32x4 v = *(const f32x4*)(I_w_router + (size_t)k * NE + e0) * I_ffn_norm_odd[k];
            *(LAS f32x4*)(wr + (((k & 7) * 256 + (k >> 3)) * 8 + e0)) = v; }
        LDS_BAR();
        for (int seg = F.bx; seg < M / 64; seg += F.G) {
            for (int rr = 0; rr < 8; ++rr) {
                const int lrow = F.wave * 8 + rr, row = seg * 64 + lrow;
                const GAS v4u* xr = (const GAS v4u*)(W_XS1 + (size_t)row * DM) + F.lane;
                float acc[8]; float ss = 0.f;
#pragma unroll
                for (int e = 0; e < 8; ++e) acc[e] = 0.f;
#pragma unroll
                for (int c = 0; c < 4; ++c) { f32x4 xa, xb; unpack8(xr[64 * c], xa, xb);
                    ss += ((xa[0] * xa[0] + xa[1] * xa[1]) + (xa[2] * xa[2] + xa[3] * xa[3])) + ((xb[0] * xb[0] + xb[1] * xb[1]) + (xb[2] * xb[2] + xb[3] * xb[3]));
#pragma unroll
                    for (int kk = 0; kk < 8; ++kk) { const float xk = kk < 4 ? xa[kk & 3] : xb[kk & 3];
                        const LAS float* wp = wr + ((kk * 256 + c * 64 + F.lane) * 8); const f32x4 w0 = *(const LAS f32x4*)wp, w1 = *(const LAS f32x4*)(wp + 4);
                        acc[0] += xk * w0[0]; acc[1] += xk * w0[1]; acc[2] += xk * w0[2]; acc[3] += xk * w0[3];
                        acc[4] += xk * w1[0]; acc[5] += xk * w1[1]; acc[6] += xk * w1[2]; acc[7] += xk * w1[3]; } }
                ss = wave_sum(ss);
#pragma unroll
                for (int e = 0; e < 8; ++e) acc[e] = wave_sum(acc[e]);
                const float rstd = 1.0f / sqrtf(ss * (1.0f / DM) + EPS);
                int i1 = 0; float l1 = acc[0];
#pragma unroll
                for (int e = 1; e < 8; ++e) if (acc[e] > l1) { l1 = acc[e]; i1 = e; }
                int i2 = -1; float l2 = -3.0e38f;
#pragma unroll
                for (int e = 0; e < 8; ++e) if (e != i1 && acc[e] > l2) { l2 = acc[e]; i2 = e; }
                const float wt1 = 1.0f / (1.0f + __expf((l2 - l1) * rstd)), wt2 = 1.0f - wt1;
                if (F.lane == 0) { e12[2 * lrow] = i1; e12[2 * lrow + 1] = i2; w12[2 * lrow] = wt1; w12[2 * lrow + 1] = wt2; rs1[lrow] = rstd; }
            }
            LDS_BAR();
            if (F.wave == 0) {
                const int row = seg * 64 + F.lane; const int e1 = e12[2 * F.lane], e2 = e12[2 * F.lane + 1]; const float wt1 = w12[2 * F.lane], wt2 = w12[2 * F.lane + 1], rsv = rs1[F.lane];
                unsigned long long mk[16]; int mycnt = 0;
#pragma unroll
                for (int g = 0; g < 16; ++g) { const bool pr = (g < 8) ? (e1 == g) : (e2 == g - 8); mk[g] = __ballot(pr); if (F.lane == g) mycnt = __popcll(mk[g]); }
                int base = 0;
                if (F.lane < 16) base = (int)__hip_atomic_fetch_add((unsigned*)(F.ctl + CW_MOE) + F.lane, (unsigned)mycnt, RLX_AGENT);
                const unsigned long long lt = (1ull << F.lane) - 1ull;
#pragma unroll
                for (int g = 0; g < 16; ++g) { const int bg = __shfl(base, g); const bool pr = (g < 8) ? (e1 == g) : (e2 == g - 8);
                    if (pr) { const int slot = bg + __popcll(mk[g] & lt); W_list[(size_t)g * M + slot] = row; W_gwl[(size_t)g * M + slot] = (g < 8) ? wt1 : wt2; W_rsl[(size_t)g * M + slot] = rsv; } }
            }
            LDS_BAR();
        }
    }
    GRID_BAR();
    LAS int* tile_e = (LAS int*)(F.lds + LDSCTL_OFF + 1024);
    LAS int* tile_g = (LAS int*)(F.lds + LDSCTL_OFF + 1024 + 640);
    LAS int* tile_s0 = (LAS int*)(F.lds + LDSCTL_OFF + 1024 + 1280);
    LAS int* gtab = (LAS int*)(F.lds + LDSCTL_OFF + 1024 + 1920);
    for (int rep_ = 0; rep_ < (PH(11) ? REPS(11) : 0); ++rep_) { REFRESH();
        if (F.tid == 0) { int ti = 0;
            for (int g = 0; g < 16; ++g) { const int c = (int)__hip_atomic_load((unsigned*)(F.ctl + CW_MOE) + g, RLX_AGENT); const int nt = (c + 255) >> 8;
                gtab[g] = c; for (int t = 0; t < nt; ++t) { tile_e[ti] = g & 7; tile_g[ti] = g; tile_s0[ti] = t * 256; ++ti; } if (g == 7) gtab[17] = ti; }
            gtab[16] = ti; }
        LDS_BAR();
        constexpr int EB = F8_MOE ? 1 : 2;
        SchedMoe S{tile_e, tile_g, tile_s0, gtab, 0, gtab[16], F.G, F.bx, F8_MOE ? (const char*)W_XQ : (const char*)W_XS1, (const char*)W_Wmgu_t, 0, (size_t)256 * DM * EB, (size_t)2048 * DM * EB, W_list, true};
        EpiSwiglu<true, F8_MOE> E{W_HE, DFE, nullptr, W_rsl, W_list};
        pg8::gemm_phase<EpiSwiglu<true, F8_MOE>, SchedMoe, true, F8_MOE, true>(F.lds, DM * EB / 2, DM * EB / 2, DM * EB / 2, S, E);
    }
    GRID_BAR();
    for (int rep_ = 0; rep_ < (PH(12) ? REPS(12) : 0); ++rep_) { REFRESH();
        constexpr int EB = F8_MOE ? 1 : 2;
        SchedMoe S{tile_e, tile_g, tile_s0, gtab, 0, gtab[17], F.G, F.bx, (const char*)W_HE, (const char*)W_Wmd_t, (size_t)256 * DFE * EB, (size_t)256 * DFE * EB, (size_t)DM * DFE * EB, W_list, false};
        EpiMoeDown<false> E{W_XS1, W_sspB, W_list, W_gwl, nullptr};
        pg8::gemm_phase<EpiMoeDown<false>, SchedMoe, true, F8_MOE>(F.lds, DFE * EB / 2, DFE * EB / 2, DFE * EB / 2, S, E);
    }
    GRID_BAR();
    for (int rep_ = 0; rep_ < (PH(13) ? REPS(13) : 0); ++rep_) { REFRESH();
        constexpr int EB = F8_MOE ? 1 : 2;
        SchedMoe S{tile_e, tile_g, tile_s0, gtab, gtab[17], gtab[16], F.G, F.bx, (const char*)W_HE, (const char*)W_Wmd_t, (size_t)256 * DFE * EB, (size_t)256 * DFE * EB, (size_t)DM * DFE * EB, W_list, false};
        EpiMoeDown<true, F8_PLE1> E{W_XS1, W_sspB, W_list, W_gwl, W_XQ};
        pg8::gemm_phase<EpiMoeDown<true, F8_PLE1>, SchedMoe, true, F8_MOE>(F.lds, DFE * EB / 2, DFE * EB / 2, DFE * EB / 2, S, E);
    }
    GRID_BAR();
    for (int rep_ = 0; rep_ < (PH(14) ? REPS(14) : 0); ++rep_) { REFRESH();
        SchedGrid S; S.o.init(M / 256, DM / 256, F.G, F.bx); constexpr int EB = F8_PLE1 ? 1 : 2; S.A = F8_PLE1 ? (const char*)W_XQ : (const char*)W_XS1; S.B = (const char*)(W_Wpg_t + (size_t)DM * DM); S.at = (size_t)256 * DM * EB; S.bt = (size_t)256 * DM * EB;
        EpiResid<2, false> E{nullptr, W_XS1, W_XS0, W_sspA, nullptr, W_sspB, W_PJ, nullptr};
        pg8::gemm_phase<EpiResid<2, false>, SchedGrid, true, F8_PLE1>(F.lds, DM * EB / 2, DM * EB / 2, DM * EB / 2, S, E);
    }
    GRID_BAR();
    REFRESH();
    if (PH(15)) for (int m = gw; m < M; m += NGW) {
        float v = (F.lane < 32) ? W_sspA[(size_t)m * 32 + F.lane] : 0.f; v = wave_sum(v);
        const float rstd = 1.0f / sqrtf(v * (1.0f / DM) + EPS);
        const GAS v4u* xs = (const GAS v4u*)(W_XS0 + (size_t)m * DM) + F.lane; GAS f32x4* xo = (GAS f32x4*)(W_X + (size_t)m * DM) + 2 * F.lane; const f32x4* gp = (const f32x4*)I_final_gain + 2 * F.lane;
#pragma unroll
        for (int j = 0; j < 4; ++j) { f32x4 a, b; unpack8(xs[64 * j], a, b); xo[128 * j] = a * rstd * gp[128 * j]; xo[128 * j + 1] = b * rstd * gp[128 * j + 1]; }
    }
}

extern "C" void kernel_launch(void* const* d_in, const int* in_sizes, int n_in, void* d_out, int out_size, void* d_ws, size_t ws_size, hipStream_t stream) {
    (void)in_sizes; (void)out_size;
    static int grid = 0;
    if (grid == 0) {
        if (n_in != 24 || ws_size < WS_END) { fprintf(stderr, "kernel_launch: bad arguments (n_in %d, ws %zu)\n", n_in, ws_size); grid = -1; return; }
        int dev = 0, cus = 0, per_cu = 0;
        if (hipGetDevice(&dev) != hipSuccess || hipDeviceGetAttribute(&cus, hipDeviceAttributeMultiprocessorCount, dev) != hipSuccess) { grid = -1; return; }
        if (hipFuncSetAttribute((const void*)fwd_kernel, hipFuncAttributeMaxDynamicSharedMemorySize, LDS_BYTES) != hipSuccess) { grid = -1; return; }
        if (hipOccupancyMaxActiveBlocksPerMultiprocessor(&per_cu, (const void*)fwd_kernel, NWAVES * 64, LDS_BYTES) != hipSuccess || per_cu < 1) { fprintf(stderr, "kernel_launch: occupancy query says %d\n", per_cu); }
        (void)hipGetLastError();
        grid = cus;
    }
    if (grid < 0) return;
    if (hipMemsetAsync((char*)d_ws + WS_CTL, 0, CTL_ZERO_BYTES, stream) != hipSuccess) return;
    Args a{};
    for (int i = 0; i < 24; ++i) a.in[i] = (const float*)d_in[i];
    a.out = (float*)d_out; a.ws = (unsigned char*)d_ws;
    hipLaunchKernelGGL(fwd_kernel, dim3(grid), dim3(NWAVES * 64), LDS_BYTES, stream, a);
}
```

```cpp
#include <hip/hip_runtime.h>
#include <cstdio>
#include <cstdint>

constexpr int DM = 2048, BATCH = 8, SEQ = 2048, M = BATCH * SEQ;
constexpr int DH = 1024, NH = 8, HD = 128, CHUNK = 64, DC = 1024, DFF = 5632, NE = 8, DFE = 1024, DPLE = 256;
constexpr int NIN = 7168;
constexpr int UP = 6144;
constexpr float EPS = 1e-6f;
constexpr int NWAVES = 8;
#ifndef F8_GU
#define F8_GU 1
#endif
#ifndef F8_DN
#define F8_DN 1
#endif
#ifndef F8_MOE
#define F8_MOE 1
#endif
#ifndef F8_PLE1
#define F8_PLE1 1
#endif

constexpr size_t MiB = 1u << 20;
constexpr size_t WS_CTL = 0, CTL_ZERO_BYTES = 256 * 1024;
constexpr size_t WS_LBV = 1 * MiB;
constexpr size_t WS_RS4 = 1 * MiB + 64 * 1024;
constexpr size_t WS_TOP = 1 * MiB + 192 * 1024;
constexpr size_t WS_TOPW = 1 * MiB + 320 * 1024;
constexpr size_t WS_SSPA = 2 * MiB, WS_SSPB = 4 * MiB;
constexpr size_t WS_LIST = 6 * MiB;
constexpr size_t WS_GWL = 7 * MiB;
constexpr size_t WS_TOKC = 8 * MiB;
constexpr int RCAP = 36864;
constexpr size_t WS_GWC = WS_TOKC + (size_t)RCAP * 4, WS_RSC = WS_GWC + (size_t)RCAP * 4;
constexpr size_t WS_WIN = 10 * MiB;
constexpr size_t WS_WOUT = 38 * MiB;
constexpr size_t WS_WGU = 46 * MiB;
constexpr size_t WS_WD = 90 * MiB;
constexpr size_t WS_WPOOL = 112 * MiB;
constexpr size_t WS_WMGU = 114 * MiB;
constexpr size_t WS_WMD = 178 * MiB;
constexpr size_t WS_WPG = 210 * MiB;
constexpr size_t WS_WPP = 226 * MiB;
constexpr size_t WS_PB = 228 * MiB;
constexpr size_t WS_XB = 244 * MiB;
constexpr size_t WS_A2 = 308 * MiB;
constexpr size_t WS_BIG = 372 * MiB;
constexpr size_t WS_HE = 10 * MiB;
constexpr size_t WS_END = 564 * MiB;
static_assert(WS_BIG + (size_t)M * UP * 2 <= WS_END && WS_HE + (size_t)RCAP * DFE * 2 <= WS_WD, "ws map");
static_assert(WS_BIG + (size_t)RCAP * DM * 2 <= WS_END, "ws map XG");
constexpr int CW_BAR = 4096;
constexpr int CW_MOE = 16384;
constexpr int CW_DBG = 20000;

constexpr int RING_BYTES = 131072;
constexpr int LDSCTL_OFF = RING_BYTES, MISC_OFF = LDSCTL_OFF + 320;
constexpr int LDS_BYTES = 147456;

#define GAS __attribute__((address_space(1)))
#define LAS __attribute__((address_space(3)))
typedef unsigned short bf16;
typedef unsigned v4u __attribute__((ext_vector_type(4)));
typedef unsigned v2u __attribute__((ext_vector_type(2)));
typedef float f32x4 __attribute__((ext_vector_type(4)));
typedef float f32x2 __attribute__((ext_vector_type(2)));
typedef float f32x16 __attribute__((ext_vector_type(16)));
typedef short bf16x8 __attribute__((ext_vector_type(8)));
typedef short bf16x4 __attribute__((ext_vector_type(4)));
typedef GAS unsigned gu32;
#define RLX_AGENT __ATOMIC_RELAXED, __HIP_MEMORY_SCOPE_AGENT
#define LDS_WAIT() asm volatile("s_waitcnt lgkmcnt(0)" ::: "memory")
#define VM_WAIT() asm volatile("s_waitcnt vmcnt(0)" ::: "memory")
#define LDS_BAR() do { asm volatile("s_waitcnt lgkmcnt(0)" ::: "memory"); __builtin_amdgcn_s_barrier(); asm volatile("" ::: "memory"); } while (0)
__device__ __forceinline__ unsigned f2bf(float f) { unsigned u = __builtin_bit_cast(unsigned, f); return (u + 0x7fffu + ((u >> 16) & 1u)) >> 16; }
__device__ __forceinline__ unsigned pk2(float lo, float hi) { return f2bf(lo) | (f2bf(hi) << 16); }
__device__ __forceinline__ unsigned cvt_pk_bf16(float lo, float hi) { unsigned r; asm volatile("v_cvt_pk_bf16_f32 %0, %1, %2" : "=v"(r) : "v"(lo), "v"(hi)); return r; }
__device__ __forceinline__ float clamp8(float v) { return __builtin_amdgcn_fmed3f(v, -448.0f, 448.0f); }
__device__ __forceinline__ v2u pk8_fp8(const f32x4 a, const f32x4 b) {
    int w0 = 0, w1 = 0;
    w0 = __builtin_amdgcn_cvt_pk_fp8_f32(clamp8(a[0]), clamp8(a[1]), w0, false); w0 = __builtin_amdgcn_cvt_pk_fp8_f32(clamp8(a[2]), clamp8(a[3]), w0, true);
    w1 = __builtin_amdgcn_cvt_pk_fp8_f32(clamp8(b[0]), clamp8(b[1]), w1, false); w1 = __builtin_amdgcn_cvt_pk_fp8_f32(clamp8(b[2]), clamp8(b[3]), w1, true);
    v2u r; r.x = (unsigned)w0; r.y = (unsigned)w1; return r;
}
__device__ __forceinline__ float bflo(unsigned u) { return __builtin_bit_cast(float, u << 16); }
__device__ __forceinline__ float bfhi(unsigned u) { return __builtin_bit_cast(float, u & 0xffff0000u); }
__device__ __forceinline__ float fast_rcp(float x) { return __builtin_amdgcn_rcpf(x); }
__device__ __forceinline__ float sigmoidf_(float x) { return fast_rcp(1.0f + __expf(-x)); }
__device__ __forceinline__ float siluf_(float x) { return x * sigmoidf_(x); }
__device__ __forceinline__ float wave_sum(float v) {
#pragma unroll
    for (int o = 1; o < 64; o <<= 1) v += __shfl_xor(v, o);
    return v;
}

#define XB_TMO      128
#define XB_XCNT(j)  (256  + 64 * (j))
#define XB_XSUB(j)  (1280 + 64 * (j))
#define XB_XGEN(j)  (2304 + 64 * (j))
#define XB_TOP      3328
#define XB_TOPGEN   3392
#define XCD_BAR_WORDS 3456
#define XB_SPIN_CAP (1u << 18)
__device__ __forceinline__ unsigned xb_ld(unsigned* p)              { return __hip_atomic_load(p, __ATOMIC_RELAXED, __HIP_MEMORY_SCOPE_AGENT); }
__device__ __forceinline__ unsigned xb_add(unsigned* p, unsigned v) { return __hip_atomic_fetch_add(p, v, __ATOMIC_RELAXED, __HIP_MEMORY_SCOPE_AGENT); }
__device__ __forceinline__ unsigned xb_xcc_id() { return (unsigned)__builtin_amdgcn_s_getreg((3 << 11) | 20) & 0xFu; }
#define XB_SPIN(cond, bar) do { unsigned _sp = 0; while (cond) { __builtin_amdgcn_s_sleep(1); \
    if ((++_sp & 255u) == 0u) { if (xb_ld(&(bar)[XB_TMO])) break; if (_sp > XB_SPIN_CAP) { atomicAdd(&(bar)[XB_TMO], 1u); break; } } } } while (0)
struct XcdBarrier { unsigned* bar; unsigned x; volatile LAS unsigned* st; };
__device__ __forceinline__ XcdBarrier xcd_barrier_post(unsigned* bar, volatile LAS unsigned* st) {
    XcdBarrier b; b.bar = bar; b.x = xb_xcc_id(); b.st = st;
    if (threadIdx.x == 0) (void)xb_add(&bar[XB_XCNT(b.x)], 1u);
    return b;
}
__device__ __forceinline__ void xcd_barrier_complete(unsigned* bar, unsigned x, unsigned& nloc, unsigned& nx) {
    const unsigned G = gridDim.x * gridDim.y * gridDim.z;
    unsigned sum, cnt, mine, sp = 0u;
    for (;;) {
        sum = 0u; cnt = 0u; mine = 0u;
#pragma unroll
        for (unsigned j = 0; j < 16; ++j) { const unsigned c = xb_ld(&bar[XB_XCNT(j)]); sum += c; cnt += (c > 0u) ? 1u : 0u; mine = (j == x) ? c : mine; }
        if (sum == G) break;
        __builtin_amdgcn_s_sleep(1);
        if ((++sp & 255u) == 0u) { if (xb_ld(&bar[XB_TMO])) break; if (sp > XB_SPIN_CAP) { atomicAdd(&bar[XB_TMO], 1u); break; } }
    }
    nloc = mine > 0u ? mine : 1u; nx = cnt > 0u ? cnt : 1u;
}
__device__ __forceinline__ void xcd_barrier(const XcdBarrier& b) {
    asm volatile("s_waitcnt vmcnt(0)" ::: "memory");
    __syncthreads();
    if (threadIdx.x == 0) {
        unsigned* bar = b.bar;
        __builtin_amdgcn_s_waitcnt(0);
        unsigned nloc = b.st[0], nx = b.st[1];
        if (nloc == 0u) { xcd_barrier_complete(bar, b.x, nloc, nx); b.st[0] = nloc; b.st[1] = nx; }
        const unsigned old = xb_add(&bar[XB_XSUB(b.x)], 1u);
        const unsigned gen = old / nloc;
        if (old + 1u == (gen + 1u) * nloc) {
            __builtin_amdgcn_fence(__ATOMIC_RELEASE, "agent");
            asm volatile("s_waitcnt vmcnt(0)" ::: "memory");
            const unsigned og = xb_add(&bar[XB_TOP], 1u);
            const unsigned tg = og / nx;
            if (og + 1u == (tg + 1u) * nx) xb_add(&bar[XB_TOPGEN], 1u);
            else XB_SPIN(xb_ld(&bar[XB_TOPGEN]) == tg, bar);
            __builtin_amdgcn_fence(__ATOMIC_ACQUIRE, "agent");
            xb_add(&bar[XB_XGEN(b.x)], 1u);
            asm volatile("s_waitcnt vmcnt(0)" ::: "memory");
        } else {
            XB_SPIN(xb_ld(&bar[XB_XGEN(b.x)]) == gen, bar);
            __builtin_amdgcn_fence(__ATOMIC_ACQUIRE, "agent");
            asm volatile("s_waitcnt vmcnt(0)" ::: "memory");
        }
    }
    __syncthreads();
}

namespace pg8 {
constexpr int BM = 256, BK = 64, HALF = 128, HTB = HALF * BK * 2, STAGE_BYTES = 8 * HTB, NXCD = 8, WGM = 8;
__host__ __device__ __forceinline__ int lds_byte(int r, int c) { const int st = (r >> 4) * 2 + (c >> 5), rr = r & 15, cc = c & 31, ob = rr * 64 + cc * 2; return st * 1024 + (ob ^ (((ob >> 9) & 1) << 5)); }
__host__ __device__ __forceinline__ void stage_rc(int b, int& R, int& C) { const int st = b / 1024, sb = b % 1024, swz = sb ^ (((sb >> 9) & 1) << 5); R = (st >> 1) * 16 + swz / 64; C = (st & 1) * 32 + (swz % 64) / 2; }
__host__ __device__ __forceinline__ int perm32(int rho) { const int n = rho >> 4, i = rho & 15; return 8 * (i >> 2) + 4 * n + (i & 3); }
struct Unit { int pm, pn; const char* a; const char* b; const int* rows; int nvalid; };
typedef int v4i_t __attribute__((ext_vector_type(4)));
typedef int v8i_t __attribute__((ext_vector_type(8)));
__device__ __forceinline__ bf16x8 lo8(v8i_t v) { return __builtin_bit_cast(bf16x8, __builtin_shufflevector(v, v, 0, 1, 2, 3)); }
__device__ __forceinline__ bf16x8 hi8(v8i_t v) { return __builtin_bit_cast(bf16x8, __builtin_shufflevector(v, v, 4, 5, 6, 7)); }
__device__ __forceinline__ v8i_t cat8(bf16x8 lo, bf16x8 hi) { return __builtin_shufflevector(__builtin_bit_cast(v4i_t, lo), __builtin_bit_cast(v4i_t, hi), 0, 1, 2, 3, 4, 5, 6, 7); }
struct GridOrder {
    int nM, nN, nwg, G, c;
    __device__ __forceinline__ void init(int nM_, int nN_, int G_, int c_) { nM = nM_; nN = nN_; nwg = nM * nN; G = G_; c = c_; }
    __device__ __forceinline__ bool tile(int i, int& pm, int& pn) const {
        const long L = (long)i * G + c; if (L >= nwg) return false;
        int wgid = (int)L; { const int q = nwg / NXCD, r = nwg % NXCD, xcd = wgid % NXCD, off = wgid / NXCD; wgid = (xcd < r ? xcd * (q + 1) : r * (q + 1) + (xcd - r) * q) + off; }
        const int nig = WGM * nN, gid = wgid / nig, fm = gid * WGM, gsz = (nM - fm) < WGM ? (nM - fm) : WGM;
        pm = fm + ((wgid % nig) % gsz); pn = (wgid % nig) / gsz; return true;
    }
};

template <class Epi, class Sched, bool ALIGN_EPI, bool FP8 = false, bool GATHER = false>
__device__ __forceinline__ void gemm_phase(LAS unsigned char* lds, const int K, const int lda, const int ldb, const Sched& S, const Epi& E) {
    int tid_ = threadIdx.x; asm volatile("" : "+v"(tid_));
    const int tid = tid_, wid = __builtin_amdgcn_readfirstlane(tid >> 6), lane = tid & 63, wr = wid >> 2, wc = wid & 3, fr = lane & 15, fq = lane >> 4;
    const int nt = K / BK;
    unsigned voffA[2], voffB[2];
#pragma unroll
    for (int i = 0; i < 2; ++i) { int R, C; stage_rc(tid * 16 + i * 8192, R, C); const int Rb = Epi::PERM ? ((R & ~31) + perm32(R & 31)) : R;
        voffA[i] = (unsigned)(R * lda + C) * 2u; voffB[i] = (unsigned)(Rb * ldb + C) * 2u; }
    unsigned vG[2][2]; int tkn[2][2];
#pragma unroll
    for (int i = 0; i < 2; ++i) { vG[0][i] = vG[1][i] = 0u; tkn[0][i] = tkn[1][i] = 0; }
    const size_t kstep = (size_t)(BK * 2);
    const size_t hstepA = (size_t)HALF * lda * 2, hstepB = (size_t)HALF * ldb * 2;
    const unsigned ldsw = (unsigned)wid * 1024u;
    const int aoff = lds_byte(wr * 64 + fr, fq * 8), boff = lds_byte(wc * 32 + fr, fq * 8);
#define PG8_SA(b, h) (((b) * 2 + (h)) * HTB)
#define PG8_SB(b, h) ((4 + (b) * 2 + (h)) * HTB)
#define PG8_STAGE(bufoff, gbase, voff) do { _Pragma("unroll") for (int _i = 0; _i < 2; ++_i) \
        __builtin_amdgcn_global_load_lds((const unsigned*)((const char*)(gbase) + (voff)[_i]), (LAS unsigned*)(lds + (bufoff) + ldsw + _i * 8192), 16, 0, 0); } while (0)
#define PG8_STAGEA(bufoff, gk, h) do { if constexpr (GATHER) { PG8_STAGE(bufoff, gk, vG[h]); } else { PG8_STAGE(bufoff, (gk) + (h) * hstepA, voffA); } } while (0)
#define PG8_TOKLOAD(u, tk) do { _Pragma("unroll") for (int _h = 0; _h < 2; ++_h) _Pragma("unroll") for (int _i = 0; _i < 2; ++_i) { int gR_, gC_; stage_rc(tid * 16 + _i * 8192, gR_, gC_); const int row_ = _h * HALF + gR_; tk[_h][_i] = (u).rows[row_ < (u).nvalid ? row_ : (u).nvalid - 1]; }     } while (0)
#define PG8_TOKSET(tk) do { _Pragma("unroll") for (int _h = 0; _h < 2; ++_h) _Pragma("unroll") for (int _i = 0; _i < 2; ++_i) { int gR_, gC_; stage_rc(tid * 16 + _i * 8192, gR_, gC_); vG[_h][_i] = (unsigned)tk[_h][_i] * (unsigned)(lda * 2) + (unsigned)gC_ * 2u; } } while (0)
#define PG8_LDA(dst, b, h) do { _Pragma("unroll") for (int m = 0; m < 4; ++m) { const bf16x8 lo_ = *(const LAS bf16x8*)(lds + PG8_SA(b, h) + aoff + m * 2048), hi_ = *(const LAS bf16x8*)(lds + PG8_SA(b, h) + aoff + m * 2048 + 1024); dst[m] = cat8(lo_, hi_); } } while (0)
#define PG8_LDB(dst, b, h) do { _Pragma("unroll") for (int n = 0; n < 2; ++n) { const bf16x8 lo_ = *(const LAS bf16x8*)(lds + PG8_SB(b, h) + boff + n * 2048), hi_ = *(const LAS bf16x8*)(lds + PG8_SB(b, h) + boff + n * 2048 + 1024); dst[n] = cat8(lo_, hi_); } } while (0)
#define PG8_MMA(ai, bj, At, Bt) do { __builtin_amdgcn_s_setprio(1); _Pragma("unroll") for (int m = 0; m < 4; ++m) _Pragma("unroll") for (int n = 0; n < 2; ++n) { \
        if constexpr (FP8) { asm volatile("v_mfma_scale_f32_16x16x128_f8f6f4 %0, %1, %2, %0, %3, %4 op_sel_hi:[0,0,0]" : "+v"(acc[ai][bj][m][n]) : "v"(Bt[n]), "v"(At[m]), "v"(sc_w), "v"(sc_x)); } \
        else { acc[ai][bj][m][n] = __builtin_amdgcn_mfma_f32_16x16x32_bf16(lo8(Bt[n]), lo8(At[m]), acc[ai][bj][m][n], 0, 0, 0); \
               acc[ai][bj][m][n] = __builtin_amdgcn_mfma_f32_16x16x32_bf16(hi8(Bt[n]), hi8(At[m]), acc[ai][bj][m][n], 0, 0, 0); } } __builtin_amdgcn_s_setprio(0); } while (0)
#define PG8_WAIT_V(n) asm volatile("s_waitcnt vmcnt(" #n ")" ::: "memory")
#define PG8_WAIT_L(n) asm volatile("s_waitcnt lgkmcnt(" #n ")" ::: "memory")
#define PG8_BAR __builtin_amdgcn_s_barrier()
#define PG8_SCHED __builtin_amdgcn_sched_barrier(0)
    Unit cur, nxt; int ui = 0;
    if (!S.next(0, cur)) return;
    f32x4 acc[2][2][4][2];
#pragma unroll
    for (int a = 0; a < 2; ++a)
#pragma unroll
        for (int b = 0; b < 2; ++b)
#pragma unroll
            for (int m = 0; m < 4; ++m)
#pragma unroll
                for (int n = 0; n < 2; ++n) acc[a][b][m][n] = (f32x4){0.f, 0.f, 0.f, 0.f};
    v8i_t At[4], B0[2], B1[2];
    const int sc_w = 0x79797979, sc_x = 0x7f7f7f7f;
    (void)sc_w; (void)sc_x;
    const char* cA = cur.a; const char* cB = cur.b;
    if constexpr (GATHER) { PG8_TOKLOAD(cur, tkn); PG8_TOKSET(tkn); }
    PG8_STAGE(PG8_SB(0, 0), cB, voffB); PG8_STAGE(PG8_SB(0, 1), cB + hstepB, voffB); PG8_STAGEA(PG8_SA(0, 0), cA, 0); PG8_STAGEA(PG8_SA(0, 1), cA, 1);
    if (wr == 1) PG8_BAR;
    PG8_WAIT_V(2); PG8_BAR;
    PG8_STAGE(PG8_SB(1, 0), cB + kstep, voffB); PG8_STAGEA(PG8_SA(1, 0), cA + kstep, 0); PG8_STAGE(PG8_SB(1, 1), cB + hstepB + kstep, voffB);
    PG8_WAIT_V(6); PG8_BAR;
    for (;;) {
        const bool has_next = S.next(ui + 1, nxt);
        const char* nA = has_next ? nxt.a : cA; const char* nB = has_next ? nxt.b : cB;
#pragma nounroll
        for (int t = 0; t < nt; t += 2) {
            const bool last = (t == nt - 2);
            const char* a1 = cA + (size_t)(t + 1) * kstep;
            const char* a2 = last ? nA : cA + (size_t)(t + 2) * kstep; const char* b2 = last ? nB : cB + (size_t)(t + 2) * kstep;
            const char* a3 = a2 + kstep; const char* b3 = b2 + kstep;
            if constexpr (GATHER) { if (has_next && t == nt - 4) PG8_TOKLOAD(nxt, tkn); }
            PG8_LDB(B0, 0, 0); PG8_LDB(B1, 0, 1); PG8_SCHED; PG8_LDA(At, 0, 0); PG8_STAGEA(PG8_SA(1, 1), a1, 1);
            if constexpr (GATHER) { if (last && has_next) PG8_TOKSET(tkn); }
            PG8_WAIT_V(8); PG8_WAIT_L(0); PG8_BAR; PG8_MMA(0, 0, At, B0); PG8_MMA(0, 1, At, B1); PG8_BAR; PG8_SCHED;
            PG8_LDA(At, 0, 1); PG8_STAGE(PG8_SB(0, 0), b2, voffB); PG8_STAGE(PG8_SB(0, 1), b2 + hstepB, voffB); PG8_STAGEA(PG8_SA(0, 0), a2, 0);
            PG8_WAIT_V(8); PG8_WAIT_L(0); PG8_BAR; PG8_MMA(1, 0, At, B0); PG8_MMA(1, 1, At, B1); PG8_BAR; PG8_SCHED;
            PG8_LDB(B0, 1, 0); PG8_LDB(B1, 1, 1); PG8_SCHED; PG8_LDA(At, 1, 0); PG8_STAGEA(PG8_SA(0, 1), a2, 1);
            PG8_WAIT_V(8); PG8_WAIT_L(0); PG8_BAR; PG8_MMA(0, 0, At, B0); PG8_MMA(0, 1, At, B1); PG8_BAR; PG8_SCHED;
            PG8_LDA(At, 1, 1); PG8_STAGE(PG8_SB(1, 0), b3, voffB); PG8_STAGE(PG8_SB(1, 1), b3 + hstepB, voffB); PG8_STAGEA(PG8_SA(1, 0), a3, 0);
            PG8_WAIT_V(8); PG8_WAIT_L(0); PG8_BAR; PG8_MMA(1, 0, At, B0); PG8_MMA(1, 1, At, B1); PG8_BAR; PG8_SCHED;
        }
        if constexpr (ALIGN_EPI) { if (wr == 0) PG8_BAR; }
        if constexpr (FP8) asm volatile("s_nop 15\n\ts_nop 15" ::: "memory");
        E(acc, cur, wr, wc, fr, fq);
        if (!has_next) break;
#pragma unroll
        for (int a = 0; a < 2; ++a)
#pragma unroll
            for (int b = 0; b < 2; ++b)
#pragma unroll
                for (int m = 0; m < 4; ++m)
#pragma unroll
                    for (int n = 0; n < 2; ++n) acc[a][b][m][n] = (f32x4){0.f, 0.f, 0.f, 0.f};
        cur = nxt; cA = nA; cB = nB; ++ui;
        if constexpr (ALIGN_EPI) { if (wr == 1) PG8_BAR; }
    }
    PG8_WAIT_V(0);
    if constexpr (!ALIGN_EPI) { if (wr == 0) PG8_BAR; }
    PG8_BAR;
#undef PG8_SA
#undef PG8_SB
#undef PG8_STAGE
#undef PG8_STAGEA
#undef PG8_TOKLOAD
#undef PG8_TOKSET
#undef PG8_LDA
#undef PG8_LDB
#undef PG8_MMA
#undef PG8_WAIT_V
#undef PG8_WAIT_L
#undef PG8_BAR
#undef PG8_SCHED
}
}
using pg8::Unit;

struct SchedGrid {
    pg8::GridOrder o; const char* A; const char* B; size_t at, bt;
    __device__ __forceinline__ bool next(int i, Unit& u) const { if (!o.tile(i, u.pm, u.pn)) return false; u.a = A + (size_t)u.pm * at; u.b = B + (size_t)u.pn * bt; return true; }
};
struct SchedPool {
    pg8::GridOrder o; const char* A; const char* B; size_t at, bt;
    __device__ __forceinline__ bool next(int i, Unit& u) const { if (!o.tile(i, u.pm, u.pn)) return false; u.a = A + (size_t)u.pm * at + (size_t)(u.pn >> 1) * 1024; u.b = B + (size_t)u.pn * bt; return true; }
};
struct SchedPJ {
    pg8::GridOrder o; const char* A; const char* B; size_t at, bt;
    __device__ __forceinline__ bool next(int i, Unit& u) const { if (!o.tile(i, u.pm, u.pn)) return false; u.a = A + (size_t)u.pm * at; u.b = B + (size_t)((u.pm >> 6) * 8 + u.pn) * bt; return true; }
};
struct SchedMoe {
    const LAS int* tile_e; const LAS int* tile_g; const LAS int* tile_s0; const LAS int* gcnt; int rt0, rt1, G, c; const char* A; const char* B; size_t at, bt, be; const int* list; bool gather;
    __device__ __forceinline__ bool next(int i, Unit& u) const {
        const int L = i * G + c, n = (rt1 - rt0) * 8; if (L >= n) return false;
        u.pm = rt0 + (L >> 3); u.pn = L & 7; const int e = tile_e[u.pm], g = tile_g[u.pm], s0 = tile_s0[u.pm];
        u.a = gather ? A : A + (size_t)u.pm * at; u.b = B + (size_t)e * be + (size_t)u.pn * bt;
        u.rows = list + (size_t)g * M + s0; u.nvalid = gcnt[g] - s0; return true; }
};

struct SchedFill {
    int lo, hi, nN, rank, nlight; const char* A; const char* B; size_t at, bt;
    __device__ __forceinline__ bool next(int i, Unit& u) const {
        if (rank < 0) return false; const int k = lo + rank + i * nlight; if (k >= hi) return false;
        u.pm = k / nN; u.pn = k % nN; u.a = A + (size_t)u.pm * at; u.b = B + (size_t)u.pn * bt; u.rows = nullptr; u.nvalid = 0; return true; }
};
__device__ __forceinline__ void load_rstd(const float* ssp, int row0, int fq, float (&rs)[2][4]) {
#pragma unroll
    for (int ai = 0; ai < 2; ++ai)
#pragma unroll
        for (int m = 0; m < 4; ++m) {
            const float* sp = ssp + (size_t)(row0 + ai * 128 + m * 16) * 32 + fq * 8;
            const f32x4 a = *(const f32x4*)sp, b = *(const f32x4*)(sp + 4);
            float s = ((a[0] + a[1]) + (a[2] + a[3])) + ((b[0] + b[1]) + (b[2] + b[3]));
            s += __shfl_xor(s, 16); s += __shfl_xor(s, 32);
            rs[ai][m] = 1.0f / sqrtf(s * (1.0f / DM) + EPS);
        }
}
struct EpiInProj {
    static constexpr bool PERM = true;
    bf16* U; const float* ssp; const float* lbv;
    __device__ __forceinline__ void operator()(const f32x4 (&acc)[2][2][4][2], const Unit& u, int wr, int wc, int fr, int fq) const {
        const int row0 = u.pm * 256 + wr * 64 + fr;
        float rs[2][4]; load_rstd(ssp, row0, fq, rs);
        const int pn = u.pn;
        if (pn >= 20) {
            const int col0 = 5120 + (pn - 20) * 128 + wc * 32 + 8 * fq;
#pragma unroll
            for (int ai = 0; ai < 2; ++ai)
#pragma unroll
                for (int m = 0; m < 4; ++m) { const float r2 = rs[ai][m] * rs[ai][m];
                    const f32x4 a0 = acc[ai][0][m][0] * acc[ai][1][m][0] * r2, a1 = acc[ai][0][m][1] * acc[ai][1][m][1] * r2;
                    v4u w; w.x = cvt_pk_bf16(a0[0], a0[1]); w.y = cvt_pk_bf16(a0[2], a0[3]); w.z = cvt_pk_bf16(a1[0], a1[1]); w.w = cvt_pk_bf16(a1[2], a1[3]);
                    *(v4u*)(U + (size_t)(row0 + ai * 128 + m * 16) * UP + col0) = w; }
            return;
        }
        const int kind = pn >> 2;
        const int col0 = pn * 256 + wc * 32 + 8 * fq;
        f32x4 lb[2][2];
        if (kind == 1) {
#pragma unroll
            for (int bj = 0; bj < 2; ++bj)
#pragma unroll
                for (int n = 0; n < 2; ++n) lb[bj][n] = *(const f32x4*)(lbv + (col0 - 1024) + bj * 128 + 4 * n);
            asm volatile("" :: "v"(lb[0][0]), "v"(lb[0][1]), "v"(lb[1][0]), "v"(lb[1][1]));
        }
#pragma unroll
        for (int ai = 0; ai < 2; ++ai)
#pragma unroll
            for (int m = 0; m < 4; ++m) { bf16* rowp = U + (size_t)(row0 + ai * 128 + m * 16) * UP + col0; const float r = rs[ai][m];
#pragma unroll
                for (int bj = 0; bj < 2; ++bj) { f32x4 v0 = acc[ai][bj][m][0] * r, v1 = acc[ai][bj][m][1] * r;
                    if (kind == 0 || kind == 3) {
#pragma unroll
                        for (int j = 0; j < 4; ++j) { v0[j] = siluf_(v0[j]); v1[j] = siluf_(v1[j]); }
                    } else if (kind == 1) {
#pragma unroll
                        for (int j = 0; j < 4; ++j) { v0[j] = __builtin_amdgcn_logf(lb[bj][0][j] + (1.0f - lb[bj][0][j]) * sigmoidf_(v0[j])); v1[j] = __builtin_amdgcn_logf(lb[bj][1][j] + (1.0f - lb[bj][1][j]) * sigmoidf_(v1[j]));     }
                    }
                    v4u w; w.x = cvt_pk_bf16(v0[0], v0[1]); w.y = cvt_pk_bf16(v0[2], v0[3]); w.z = cvt_pk_bf16(v1[0], v1[1]); w.w = cvt_pk_bf16(v1[2], v1[3]);
                    *(v4u*)(rowp + bj * 128) = w; } }
    }
};
struct EpiBf16Plain {
    static constexpr bool PERM = true;
    bf16* O; int ldc;
    __device__ __forceinline__ void operator()(const f32x4 (&acc)[2][2][4][2], const Unit& u, int wr, int wc, int fr, int fq) const {
        const int row0 = u.pm * 256 + wr * 64 + fr, col0 = u.pn * 256 + wc * 32 + 8 * fq;
#pragma unroll
        for (int ai = 0; ai < 2; ++ai)
#pragma unroll
            for (int m = 0; m < 4; ++m) { bf16* rowp = O + (size_t)(row0 + ai * 128 + m * 16) * ldc + col0;
#pragma unroll
                for (int bj = 0; bj < 2; ++bj) { const f32x4 v0 = acc[ai][bj][m][0], v1 = acc[ai][bj][m][1];
                    v4u w; w.x = cvt_pk_bf16(v0[0], v0[1]); w.y = cvt_pk_bf16(v0[2], v0[3]); w.z = cvt_pk_bf16(v1[0], v1[1]); w.w = cvt_pk_bf16(v1[2], v1[3]);
                    *(v4u*)(rowp + bj * 128) = w; } }
    }
};
template <bool ROWTAB, bool F8> struct EpiSwiglu {
    static constexpr bool PERM = true;
    void* H; int ldc; const float* ssp; const float* rtab; const int* list;
    __device__ __forceinline__ void operator()(const f32x4 (&acc)[2][2][4][2], const Unit& u, int wr, int wc, int fr, int fq) const {
        if constexpr (ROWTAB) asm volatile("" : "+v"(fr), "+v"(fq));
        const int row0 = u.pm * 256 + wr * 64 + fr, col0 = u.pn * 128 + wc * 32 + 8 * fq;
        float rs[2][4];
        if constexpr (ROWTAB) {
            const float* rt_ = rtab + (u.rows - list);
#pragma unroll
            for (int ai = 0; ai < 2; ++ai)
#pragma unroll
                for (int m = 0; m < 4; ++m) { const int rl = wr * 64 + fr + ai * 128 + m * 16; const float v_ = rt_[rl < u.nvalid ? rl : u.nvalid - 1]; rs[ai][m] = rl < u.nvalid ? v_ : 0.f; }
        } else load_rstd(ssp, row0, fq, rs);
#pragma unroll
        for (int ai = 0; ai < 2; ++ai)
#pragma unroll
            for (int m = 0; m < 4; ++m) { const float r = rs[ai][m];
                f32x4 h0, h1;
#pragma unroll
                for (int j = 0; j < 4; ++j) { h0[j] = siluf_(acc[ai][0][m][0][j] * r) * (acc[ai][1][m][0][j] * r); h1[j] = siluf_(acc[ai][0][m][1][j] * r) * (acc[ai][1][m][1][j] * r); }
                const size_t o = (size_t)(row0 + ai * 128 + m * 16) * ldc + col0;
                if constexpr (F8) *(v2u*)((unsigned char*)H + o) = pk8_fp8(h0, h1);
                else { v4u w; w.x = cvt_pk_bf16(h0[0], h0[1]); w.y = cvt_pk_bf16(h0[2], h0[3]); w.z = cvt_pk_bf16(h1[0], h1[1]); w.w = cvt_pk_bf16(h1[2], h1[3]); *(v4u*)((bf16*)H + o) = w; } }
    }
};
__device__ __forceinline__ void unpack8(const v4u w, f32x4& a, f32x4& b) { a[0] = bflo(w.x); a[1] = bfhi(w.x); a[2] = bflo(w.y); a[3] = bfhi(w.y); b[0] = bflo(w.z); b[1] = bfhi(w.z); b[2] = bflo(w.w); b[3] = bfhi(w.w); }
template <int MODE  , bool XF32, bool F8C = false  > struct EpiResid {
    static constexpr bool PERM = true;
    const float* xf; const bf16* xold; bf16* xnew; float* ssp_out; const float* colscale; const float* ssp_in; const bf16* PJ; unsigned char* xq;
    static constexpr int NG = (MODE == 2) ? 1 : 2, NS = 8 / NG;
    struct Q { v4u xo[NG][2], pj[NG][2]; f32x4 xf0[NG][2], xf1[NG][2]; };
    __device__ __forceinline__ void qload(Q& q, int st, int row0, int col0) const {
#pragma unroll
        for (int mm = 0; mm < NG; ++mm)
#pragma unroll
            for (int bj = 0; bj < 2; ++bj) { const int g = st * NG + mm, ai = g >> 2, m = g & 3; const size_t o = (size_t)(row0 + ai * 128 + m * 16) * DM + col0 + bj * 128;
                if constexpr (XF32) { q.xf0[mm][bj] = *(const f32x4*)(xf + o); q.xf1[mm][bj] = *(const f32x4*)(xf + o + 4); } else q.xo[mm][bj] = *(const v4u*)(xold + o);
                if constexpr (MODE == 2) q.pj[mm][bj] = *(const v4u*)(PJ + o); }
    }
    __device__ __forceinline__ void operator()(const f32x4 (&acc)[2][2][4][2], const Unit& u, int wr, int wc, int fr, int fq) const {
        const int row0 = u.pm * 256 + wr * 64 + fr, col0 = u.pn * 256 + wc * 32 + 8 * fq;
        Q qa, qb;
        qload(qa, 0, row0, col0);
        float rs[2][4];
        if constexpr (MODE == 2) load_rstd(ssp_in, row0, fq, rs);
        f32x4 cs[2][2];
        if constexpr (MODE == 1) {
#pragma unroll
            for (int bj = 0; bj < 2; ++bj)
#pragma unroll
                for (int n = 0; n < 2; ++n) cs[bj][n] = *(const f32x4*)(colscale + col0 + bj * 128 + 4 * n);
        }
#pragma unroll
        for (int st = 0; st < NS; ++st) {
            Q& q = (st & 1) ? qb : qa;
            if (st + 1 < NS) qload((st & 1) ? qa : qb, st + 1, row0, col0);
            asm volatile("" ::: "memory");
#pragma unroll
            for (int mm = 0; mm < NG; ++mm) { const int g = st * NG + mm, ai = g >> 2, m = g & 3; const int row = row0 + ai * 128 + m * 16; const size_t off = (size_t)row * DM + col0; float ss = 0.f;
#pragma unroll
                for (int bj = 0; bj < 2; ++bj) { const size_t o = off + bj * 128; f32x4 v0 = acc[ai][bj][m][0], v1 = acc[ai][bj][m][1];
                    if constexpr (MODE == 1) { v0 = v0 * cs[bj][0]; v1 = v1 * cs[bj][1]; }
                    if constexpr (MODE == 2) { f32x4 p0, p1; unpack8(q.pj[mm][bj], p0, p1); const float r = rs[ai][m];
#pragma unroll
                        for (int j = 0; j < 4; ++j) { v0[j] = sigmoidf_(v0[j] * r) * p0[j]; v1[j] = sigmoidf_(v1[j] * r) * p1[j]; } }
                    f32x4 x0, x1;
                    if constexpr (XF32) { x0 = q.xf0[mm][bj]; x1 = q.xf1[mm][bj]; } else unpack8(q.xo[mm][bj], x0, x1);
                    x0 += v0; x1 += v1;
                    v4u w; w.x = cvt_pk_bf16(x0[0], x0[1]); w.y = cvt_pk_bf16(x0[2], x0[3]); w.z = cvt_pk_bf16(x1[0], x1[1]); w.w = cvt_pk_bf16(x1[2], x1[3]);
                    *(v4u*)(xnew + o) = w;
                    if constexpr (F8C) *(v2u*)(xq + o) = pk8_fp8(x0, x1);
                    ss += ((x0[0] * x0[0] + x0[1] * x0[1]) + (x0[2] * x0[2] + x0[3] * x0[3])) + ((x1[0] * x1[0] + x1[1] * x1[1]) + (x1[2] * x1[2] + x1[3] * x1[3])); }
                ss += __shfl_xor(ss, 16); ss += __shfl_xor(ss, 32);
                if (fq == 0) ssp_out[(size_t)row * 32 + u.pn * 4 + wc] = ss;
            }
            asm volatile("" ::: "memory");
        }
    }
};
template <bool RANK2, bool F8C = false> struct EpiMoeDown {
    static constexpr bool PERM = true;
    bf16* X; float* ssp_out; const int* list; const float* gwl; unsigned char* xq;
    __device__ __forceinline__ void operator()(const f32x4 (&acc)[2][2][4][2], const Unit& u, int wr, int wc, int fr, int fq) const {
        asm volatile("" : "+v"(fr), "+v"(fq));
        const int col0 = u.pn * 256 + wc * 32 + 8 * fq;
#pragma unroll
        for (int ai = 0; ai < 2; ++ai)
#pragma unroll
            for (int m = 0; m < 4; ++m) { const int rl = wr * 64 + fr + ai * 128 + m * 16; const bool ok = rl < u.nvalid; const int rc_ = ok ? rl : u.nvalid - 1; const int tok = u.rows[rc_]; const float gw = gwl[(u.rows - list) + rc_];
                const size_t off = (size_t)(ok ? tok : 0) * DM + col0; float ss = 0.f;
#pragma unroll
                for (int bj = 0; bj < 2; ++bj) { const size_t o = off + bj * 128;
                    if (ok) { f32x4 x0, x1; unpack8(*(const v4u*)(X + o), x0, x1); x0 += acc[ai][bj][m][0] * gw; x1 += acc[ai][bj][m][1] * gw;
                        v4u w; w.x = cvt_pk_bf16(x0[0], x0[1]); w.y = cvt_pk_bf16(x0[2], x0[3]); w.z = cvt_pk_bf16(x1[0], x1[1]); w.w = cvt_pk_bf16(x1[2], x1[3]);
                        *(v4u*)(X + o) = w;
                        if constexpr (RANK2 && F8C) *(v2u*)(xq + o) = pk8_fp8(x0, x1);
                        if constexpr (RANK2) ss += ((x0[0] * x0[0] + x0[1] * x0[1]) + (x0[2] * x0[2] + x0[3] * x0[3])) + ((x1[0] * x1[0] + x1[1] * x1[1]) + (x1[2] * x1[2] + x1[3] * x1[3])); } }
                if constexpr (RANK2) { ss += __shfl_xor(ss, 16); ss += __shfl_xor(ss, 32);
                    if (fq == 0 && ok) ssp_out[(size_t)tok * 32 + u.pn * 4 + wc] = ss; }
                if (m & 1) asm volatile("" ::: "memory");
            }
    }
};

template <class EE> struct EpiTwice { static constexpr bool PERM = EE::PERM; EE e;
    __device__ __forceinline__ void operator()(const f32x4 (&acc)[2][2][4][2], const Unit& u, int wr, int wc, int fr, int fq) const { int n_ = 2; asm volatile("" : "+s"(n_));
#pragma nounroll
        for (int k_ = 0; k_ < n_; ++k_) { e(acc, u, wr, wc, fr, fq); asm volatile("" ::: "memory"); } } };
struct Args { const float* in[24]; float* out; unsigned char* ws; };
struct Frame {
    LAS unsigned char* lds; volatile LAS unsigned* MISC; gu32* ctl;
    int tid, lane, wave, G, bx;
};

constexpr int TRP = 136;
constexpr int TRP8 = 68;
struct TrJob { const float* W0; const float* W1; int c0, c1, ldw, K, N, NP; bf16* WT; const float* gain; int f8; };
__device__ __forceinline__ int tr_items(const TrJob& J) { return (J.K / 64) * (J.NP ? J.NP * 4 : J.N / 64); }
__device__ __forceinline__ void tr_map(const TrJob& J, int it, int& kb, int& nb) {
    const int nnb = J.NP ? J.NP * 4 : J.N / 64, sup = it >> 3, sub = it & 7, nsn = nnb >> 1;
    kb = (sup / nsn) * 4 + (sub >> 1); nb = (sup % nsn) * 2 + (sub & 1);
}
__device__ __forceinline__ void tr_src(const TrJob& J, int nb, const float*& W, int& sc) {
    W = J.W0; sc = J.c0 + nb * 64;
    if (J.NP) { const int j = nb >> 2, q = nb & 3; W = (q < 2) ? J.W0 : J.W1; sc = ((q < 2) ? J.c0 : J.c1) + 128 * j + 64 * (q & 1); }
}
__device__ __forceinline__ void tr_load(const TrJob& J, int it, f32x4 (&v)[16], float (&g)[16], int lane) {
    int kb, nb; tr_map(J, it, kb, nb); const float* W; int sc; tr_src(J, nb, W, sc);
    const float* src = W + (size_t)(kb * 64 + (lane >> 4)) * J.ldw + sc + 4 * (lane & 15);
#pragma unroll
    for (int i = 0; i < 16; ++i) v[i] = *(const f32x4*)(src + (size_t)(4 * i) * J.ldw);
    if (J.gain) {
#pragma unroll
        for (int i = 0; i < 16; ++i) g[i] = J.gain[kb * 64 + 4 * i + (lane >> 4)];
    } else {
#pragma unroll
        for (int i = 0; i < 16; ++i) g[i] = 1.0f;
    }
}
__device__ __forceinline__ void tr_store(const TrJob& J, int it, const f32x4 (&v)[16], const float (&gg)[16], LAS unsigned char* scr, int lane) {
    int kb, nb; tr_map(J, it, kb, nb); const int k0 = kb * 64, drow0 = nb * 64;
    if (J.f8) {
#pragma unroll
        for (int i = 0; i < 16; ++i) { const int kk = 4 * i + (lane >> 4); const float g = gg[i] * 64.0f;
            int w = 0; w = __builtin_amdgcn_cvt_pk_fp8_f32(v[i][0] * g, v[i][1] * g, w, false); w = __builtin_amdgcn_cvt_pk_fp8_f32(v[i][2] * g, v[i][3] * g, w, true);
            *(LAS int*)(scr + kk * TRP8 + 4 * (lane & 15)) = w; }
        LDS_WAIT(); asm volatile("" ::: "memory");
        const int c = lane & 3; unsigned char* WT = (unsigned char*)J.WT;
#pragma unroll
        for (int j = 0; j < 4; ++j) { const int n = (lane >> 2) + 16 * j; const LAS unsigned char* s = scr + (16 * c) * TRP8 + n;
            v4u o;
            o.x = (unsigned)s[0 * TRP8] | ((unsigned)s[1 * TRP8] << 8) | ((unsigned)s[2 * TRP8] << 16) | ((unsigned)s[3 * TRP8] << 24);
            o.y = (unsigned)s[4 * TRP8] | ((unsigned)s[5 * TRP8] << 8) | ((unsigned)s[6 * TRP8] << 16) | ((unsigned)s[7 * TRP8] << 24);
            o.z = (unsigned)s[8 * TRP8] | ((unsigned)s[9 * TRP8] << 8) | ((unsigned)s[10 * TRP8] << 16) | ((unsigned)s[11 * TRP8] << 24);
            o.w = (unsigned)s[12 * TRP8] | ((unsigned)s[13 * TRP8] << 8) | ((unsigned)s[14 * TRP8] << 16) | ((unsigned)s[15 * TRP8] << 24);
            *(GAS v4u*)(WT + (size_t)(drow0 + n) * J.K + k0 + 16 * c) = o; }
    } else {
#pragma unroll
        for (int i = 0; i < 16; ++i) { const int kk = 4 * i + (lane >> 4); const float g = gg[i];
            v2u w; w.x = cvt_pk_bf16(v[i][0] * g, v[i][1] * g); w.y = cvt_pk_bf16(v[i][2] * g, v[i][3] * g);
            *(LAS v2u*)(scr + kk * TRP + 8 * (lane & 15)) = w; }
        LDS_WAIT(); asm volatile("" ::: "memory");
        const int c = lane & 7;
#pragma unroll
        for (int j = 0; j < 8; ++j) { const int n = (lane >> 3) + 8 * j; const LAS unsigned short* s = (const LAS unsigned short*)(scr + (8 * c) * TRP + 2 * n);
            v4u o; o.x = (unsigned)s[0] | ((unsigned)s[TRP / 2] << 16); o.y = (unsigned)s[2 * (TRP / 2)] | ((unsigned)s[3 * (TRP / 2)] << 16);
            o.z = (unsigned)s[4 * (TRP / 2)] | ((unsigned)s[5 * (TRP / 2)] << 16); o.w = (unsigned)s[6 * (TRP / 2)] | ((unsigned)s[7 * (TRP / 2)] << 16);
            *(GAS v4u*)(J.WT + (size_t)(drow0 + n) * J.K + k0 + 8 * c) = o; }
    }
    LDS_WAIT(); asm volatile("" ::: "memory");
}
__device__ __forceinline__ int tr_job(const TrJob& J, int base, int wv, int nw, LAS unsigned char* scr, int lane) {
    const int nit = tr_items(J);
    int it = (wv - base % nw + nw) % nw;
    f32x4 va[16], vb[16]; float ga[16], gb[16];
    if (it < nit) tr_load(J, it, va, ga, lane);
    while (it < nit) {
        const int nx = it + nw;
        if (nx < nit) tr_load(J, nx, vb, gb, lane);
        tr_store(J, it, va, ga, scr, lane);
        if (nx >= nit) break;
        const int nx2 = nx + nw;
        if (nx2 < nit) tr_load(J, nx2, va, ga, lane);
        tr_store(J, nx, vb, gb, scr, lane);
        it = nx2;
    }
    return base + nit;
}

constexpr int H_QT = 0, H_KT = 17408, H_QC = 34816, H_KH = 52224, H_VT = 70656, H_TOT = 89088, H_DEC = 93184, H_NRM = 93696  , H_END = 95744;
constexpr int TP = 272  , CP = 144  ;
__device__ __forceinline__ f32x16 mfma32(bf16x8 a, bf16x8 b, f32x16 c) { return __builtin_amdgcn_mfma_f32_32x32x16_bf16(a, b, c, 0, 0, 0); }
__device__ __forceinline__ bf16x8 pack8(const f32x16& v, int o) {
    v4u w; w.x = cvt_pk_bf16(v[o + 0], v[o + 1]); w.y = cvt_pk_bf16(v[o + 2], v[o + 3]); w.z = cvt_pk_bf16(v[o + 4], v[o + 5]); w.w = cvt_pk_bf16(v[o + 6], v[o + 7]);
    return __builtin_bit_cast(bf16x8, w);
}
__device__ __forceinline__ bf16x8 ld2x8(const LAS unsigned char* p) {
    const v2u a = *(const LAS v2u*)p, b = *(const LAS v2u*)(p + 16); v4u w; w.x = a.x; w.y = a.y; w.z = b.x; w.w = b.y; return __builtin_bit_cast(bf16x8, w);
}
struct HgRegs { unsigned lf[8], qs[8], v[8], lf32; };
#define EX2(x) __builtin_amdgcn_exp2f(x)
__device__ __forceinline__ void hg_finish(LAS unsigned char* L, int nbuf, const f32x16& O, const v2u (&gs)[4], const f32x4 (&gn_)[4], bf16* A2o, int tb, int r) {
    float tot = 0.f;
#pragma unroll
    for (int e4 = 0; e4 < 4; ++e4) tot += *(const LAS float*)(L + H_NRM + nbuf * 1024 + (e4 * 64 + 32 * tb + r) * 4);
    const float rstd = 1.0f / sqrtf(tot * (1.0f / HD) + EPS);
#pragma unroll
    for (int q = 0; q < 4; ++q) {
        const f32x4 gn = gn_[q];
        const float o0 = O[4 * q + 0] * rstd * gn[0] * bflo(gs[q].x), o1 = O[4 * q + 1] * rstd * gn[1] * bfhi(gs[q].x);
        const float o2 = O[4 * q + 2] * rstd * gn[2] * bflo(gs[q].y), o3 = O[4 * q + 3] * rstd * gn[3] * bfhi(gs[q].y);
        v2u wv; wv.x = cvt_pk_bf16(o0, o1); wv.y = cvt_pk_bf16(o2, o3);
        *(v2u*)(A2o + 8 * q) = wv; }
}
__device__ __forceinline__ void hgrn_phase(Frame& F, const bf16* U, bf16* A2, const float* hgain) {
    const int b = F.bx >> 3, h = F.bx & 7, w = F.wave, lane = F.lane;
    LAS unsigned char* L = F.lds;
    const int eb = w >> 1, tb = w & 1, r = lane & 31, hh = lane >> 5;
    f32x16 S[4];
#pragma unroll
    for (int d = 0; d < 4; ++d)
#pragma unroll
        for (int i = 0; i < 16; ++i) S[d][i] = 0.f;
    const size_t rowbase0 = (size_t)b * SEQ;
    const bf16* Ucol = U + h * HD + 2 * lane;
    f32x4 gn_[4];
#pragma unroll
    for (int q = 0; q < 4; ++q) gn_[q] = *(const f32x4*)(hgain + h * HD + 32 * eb + 8 * q + 4 * hh);
    const bf16* Ugs = U + 3072 + h * HD + 32 * eb + 4 * hh + (rowbase0 + 32 * tb + r) * UP;
    bf16* A2o = A2 + (rowbase0 + 32 * tb + r) * DM + h * HD + 32 * eb + 4 * hh;
    HgRegs R; v2u gs_[4], gsp_[4];
    f32x16 Op;
#pragma unroll
    for (int i = 0; i < 16; ++i) Op[i] = 0.f;
#define HG_LOAD(n) do { const bf16* p = Ucol + (rowbase0 + (size_t)(n) * CHUNK + 8 * w) * UP; \
        _Pragma("unroll") for (int j = 0; j < 8; ++j) { R.qs[j] = *(const unsigned*)(p + (size_t)j * UP); R.lf[j] = *(const unsigned*)(p + (size_t)j * UP + 1024); R.v[j] = *(const unsigned*)(p + (size_t)j * UP + 2048); } \
        R.lf32 = *(const unsigned*)(Ucol + (rowbase0 + (size_t)(n) * CHUNK + 32) * UP + 1024); \
        _Pragma("unroll") for (int q = 0; q < 4; ++q) gs_[q] = *(const v2u*)(Ugs + (size_t)(n) * CHUNK * UP + 8 * q); } while (0)
    HG_LOAD(0);
    for (int n = 0; n < SEQ / CHUNK; ++n) {
        f32x2 c[8];
        { f32x2 a = (f32x2){0.f, 0.f};
#pragma unroll
          for (int j = 0; j < 8; ++j) { a += (f32x2){bflo(R.lf[j]), bfhi(R.lf[j])}; c[j] = a; }
          *(LAS f32x2*)(L + H_TOT + (w * 128 + 2 * lane) * 4) = a; }
        LDS_BAR();
        if (n > 0) hg_finish(L, (n - 1) & 1, Op, gsp_, gn_, A2o + (size_t)(n - 1) * CHUNK * DM, tb, r);
        { f32x2 pre = (f32x2){0.f, 0.f}, ref = pre, last = pre;
#pragma unroll
          for (int ww = 0; ww < 8; ++ww) { const f32x2 t = *(const LAS f32x2*)(L + H_TOT + (ww * 128 + 2 * lane) * 4);
              if (ww < w) pre += t; if (ww < 4) ref += t; last += t; }
          ref += (f32x2){bflo(R.lf32), bfhi(R.lf32)};
          const f32x2 lr = last - ref;
          const f32x2 eref = (f32x2){EX2(ref.x), EX2(ref.y)}, elr = (f32x2){EX2(lr.x), EX2(lr.y)};
          if (w == 0) *(LAS f32x2*)(L + H_DEC + 2 * lane * 4) = (f32x2){EX2(last.x), EX2(last.y)};
          unsigned kh0[4], kh1[4], vt0[4], vt1[4];
#pragma unroll
          for (int j = 0; j < 8; ++j) {
              const f32x2 d1 = (pre + c[j]) - ref;
              const f32x2 E1 = (f32x2){EX2(d1.x), EX2(d1.y)}, E2 = (f32x2){fast_rcp(E1.x), fast_rcp(E1.y)};
              const f32x2 fv = (f32x2){EX2(bflo(R.lf[j])), EX2(bfhi(R.lf[j]))};
              const f32x2 kq = (f32x2){1.0f, 1.0f} - fv, q = (f32x2){bflo(R.qs[j]), bfhi(R.qs[j])};
              const f32x2 qt = q * E1, kt = kq * E2, qc = qt * eref, kh = kt * elr;
              const int t = 8 * w + j;
              *(LAS unsigned*)(L + H_QT + t * TP + 4 * lane) = cvt_pk_bf16(qt.x, qt.y);
              *(LAS unsigned*)(L + H_KT + t * TP + 4 * lane) = cvt_pk_bf16(kt.x, kt.y);
              *(LAS unsigned*)(L + H_QC + t * TP + 4 * lane) = cvt_pk_bf16(qc.x, qc.y);
              const unsigned kk = cvt_pk_bf16(kh.x, kh.y);
              if (j & 1) { kh0[j >> 1] |= (kk << 16); kh1[j >> 1] |= (kk & 0xffff0000u); vt0[j >> 1] |= (R.v[j] << 16); vt1[j >> 1] |= (R.v[j] & 0xffff0000u); }
              else { kh0[j >> 1] = kk & 0xffffu; kh1[j >> 1] = kk >> 16; vt0[j >> 1] = R.v[j] & 0xffffu; vt1[j >> 1] = R.v[j] >> 16; }
          }
          *(LAS v4u*)(L + H_KH + (2 * lane) * CP + 16 * w) = (v4u){kh0[0], kh0[1], kh0[2], kh0[3]};
          *(LAS v4u*)(L + H_KH + (2 * lane + 1) * CP + 16 * w) = (v4u){kh1[0], kh1[1], kh1[2], kh1[3]};
          *(LAS v4u*)(L + H_VT + (2 * lane) * CP + 16 * w) = (v4u){vt0[0], vt0[1], vt0[2], vt0[3]};
          *(LAS v4u*)(L + H_VT + (2 * lane + 1) * CP + 16 * w) = (v4u){vt1[0], vt1[1], vt1[2], vt1[3]};
        }
        LDS_BAR();
#pragma unroll
        for (int q = 0; q < 4; ++q) gsp_[q] = gs_[q];
        if (n + 1 < SEQ / CHUNK) HG_LOAD(n + 1);
        f32x16 O;
#pragma unroll
        for (int i = 0; i < 16; ++i) O[i] = 0.f;
#pragma unroll
        for (int sb = 0; sb < 2; ++sb) {
            if (sb <= tb) {
                f32x16 P;
#pragma unroll
                for (int i = 0; i < 16; ++i) P[i] = 0.f;
#pragma unroll
                for (int kh = 0; kh < 2; ++kh) {
                    bf16x8 fa[4], fb[4];
#pragma unroll
                    for (int k4 = 0; k4 < 4; ++k4) { const int ks = 4 * kh + k4; fa[k4] = *(const LAS bf16x8*)(L + H_KT + (32 * sb + r) * TP + (16 * ks + 8 * hh) * 2); fb[k4] = *(const LAS bf16x8*)(L + H_QT + (32 * tb + r) * TP + (16 * ks + 8 * hh) * 2); }
#pragma unroll
                    for (int k4 = 0; k4 < 4; ++k4) P = mfma32(fa[k4], fb[k4], P);
                }
                if (sb == tb) {
#pragma unroll
                    for (int i = 0; i < 16; ++i) { const int s = (i & 3) + 8 * (i >> 2) + 4 * hh; if (s > r) P[i] = 0.f; }
                }
#pragma unroll
                for (int k2 = 0; k2 < 2; ++k2) {
                    const bf16x8 av = ld2x8(L + H_VT + (32 * eb + r) * CP + (32 * sb + 16 * k2 + 4 * hh) * 2);
                    O = mfma32(av, pack8(P, 8 * k2), O);
                }
            }
        }
        { bf16x8 fq[8];
#pragma unroll
          for (int i = 0; i < 8; ++i) fq[i] = ld2x8(L + H_QC + (32 * tb + r) * TP + (32 * (i >> 1) + 16 * (i & 1) + 4 * hh) * 2);
#pragma unroll
          for (int i = 0; i < 8; ++i) O = mfma32(pack8(S[i >> 1], 8 * (i & 1)), fq[i], O); }
        { bf16x8 fv[4];
#pragma unroll
          for (int ks = 0; ks < 4; ++ks) fv[ks] = *(const LAS bf16x8*)(L + H_VT + (32 * eb + r) * CP + (16 * ks + 8 * hh) * 2);
#pragma unroll
          for (int db = 0; db < 4; ++db) {
              bf16x8 fk[4];
#pragma unroll
              for (int ks = 0; ks < 4; ++ks) fk[ks] = *(const LAS bf16x8*)(L + H_KH + (32 * db + r) * CP + (16 * ks + 8 * hh) * 2);
#pragma unroll
              for (int q = 0; q < 4; ++q) { const f32x4 dc = *(const LAS f32x4*)(L + H_DEC + (32 * db + 8 * q + 4 * hh) * 4);
                  S[db][4 * q + 0] *= dc[0]; S[db][4 * q + 1] *= dc[1]; S[db][4 * q + 2] *= dc[2]; S[db][4 * q + 3] *= dc[3]; }
#pragma unroll
              for (int ks = 0; ks < 4; ++ks) S[db] = mfma32(fk[ks], fv[ks], S[db]);
          } }
        float ssq = 0.f;
#pragma unroll
        for (int i = 0; i < 16; ++i) ssq += O[i] * O[i];
        ssq += __shfl_xor(ssq, 32);
        if (hh == 0) *(LAS float*)(L + H_NRM + (n & 1) * 1024 + (eb * 64 + 32 * tb + r) * 4) = ssq;
        Op = O;
    }
    LDS_BAR();
    hg_finish(L, (SEQ / CHUNK - 1) & 1, Op, gsp_, gn_, A2o + (size_t)(SEQ / CHUNK - 1) * CHUNK * DM, tb, r);
#undef HG_LOAD
}
#undef EX2
__device__ __forceinline__ void conv_phase(Frame& F, const bf16* U, bf16* A2, const float* convw, int first_block) {
    const int nb = F.G - first_block, me = F.bx - first_block, c = 2 * F.tid;
    const float w00 = convw[c], w01 = convw[c + 1], w10 = convw[DC + c], w11 = convw[DC + c + 1], w20 = convw[2 * DC + c], w21 = convw[2 * DC + c + 1];
    for (int u = me; u < M / 32; u += nb) {
        const int R0 = u * 32, t0 = R0 % SEQ;
        const bf16* up = U + (size_t)R0 * UP;
        float a0 = 0.f, a1 = 0.f, b0 = 0.f, b1 = 0.f;
        if (t0 != 0) { const unsigned p2 = *(const unsigned*)(up - 2 * (size_t)UP + 5120 + c), p1 = *(const unsigned*)(up - (size_t)UP + 5120 + c);
            a0 = bflo(p2); a1 = bfhi(p2); b0 = bflo(p1); b1 = bfhi(p1); }
#pragma unroll 8
        for (int j = 0; j < 32; ++j) {
            const unsigned tt = *(const unsigned*)(up + (size_t)j * UP + 5120 + c), gb = *(const unsigned*)(up + (size_t)j * UP + 4096 + c);
            const float t0f = bflo(tt), t1f = bfhi(tt);
            const float y0 = bflo(gb) * (w00 * a0 + w10 * b0 + w20 * t0f), y1 = bfhi(gb) * (w01 * a1 + w11 * b1 + w21 * t1f);
            *(unsigned*)(A2 + (size_t)(R0 + j) * DM + DH + c) = cvt_pk_bf16(y0, y1);
            a0 = b0; a1 = b1; b0 = t0f; b1 = t1f;
        }
    }
}

#ifndef PH_ENABLE
#define PH_ENABLE 0xffffffffu
#endif
#define PH(k) (((PH_ENABLE) >> (k)) & 1u)
#ifndef PROBE_DUP
#define PROBE_DUP (-1)
#endif
#define REPS(k) ((PROBE_DUP) == (k) ? 2 : 1)
__global__ void __launch_bounds__(NWAVES * 64, 2) fwd_kernel(Args args) {
    extern __shared__ __attribute__((aligned(16))) unsigned char lds[];
    Frame F;
    F.lds = (LAS unsigned char*)lds;
    F.MISC = (volatile LAS unsigned*)(F.lds + MISC_OFF);
    F.tid = threadIdx.x; F.lane = F.tid & 63; F.wave = __builtin_amdgcn_readfirstlane(F.tid >> 6);
    F.G = gridDim.x; F.bx = blockIdx.x;
    unsigned char* ws = args.ws;
    F.ctl = (gu32*)(ws + WS_CTL);
    for (int u = F.tid; u < (LDS_BYTES - LDSCTL_OFF) / 4; u += NWAVES * 64) ((LAS unsigned*)(F.lds + LDSCTL_OFF))[u] = 0u;
    __syncthreads();
    XcdBarrier bar = xcd_barrier_post((unsigned*)(F.ctl + CW_BAR), F.MISC + 8);
#define GRID_BAR() do { xcd_barrier(bar); if (PROBE_DUP == 99) xcd_barrier(bar); } while (0)
#define REFRESH() do { int t_ = threadIdx.x; asm volatile("" : "+v"(t_)); F.tid = t_; F.lane = t_ & 63; F.wave = __builtin_amdgcn_readfirstlane(t_ >> 6); \
        int b_ = blockIdx.x; asm volatile("" : "+s"(b_)); F.bx = b_; gw = F.bx * NWAVES + F.wave; \
        kp_ = (const float* const __attribute__((address_space(4)))*)__builtin_amdgcn_kernarg_segment_ptr(); asm volatile("" : "+s"(kp_)); \
        ws_ = (unsigned char*)kp_[25]; X_ = (float*)kp_[24]; } while (0)
    const float* const __attribute__((address_space(4)))* kp_ = (const float* const __attribute__((address_space(4)))*)__builtin_amdgcn_kernarg_segment_ptr();
    unsigned char* ws_ = args.ws; float* X_ = args.out;
#define I_x (kp_[0])
#define I_p (kp_[1])
#define I_final_gain (kp_[2])
#define I_lb_table (kp_[3])
#define I_mix_norm_even (kp_[4])
#define I_w_in (kp_[5])
#define I_hgrn_gain (kp_[6])
#define I_conv_w (kp_[7])
#define I_w_out (kp_[8])
#define I_ffn_norm_even (kp_[9])
#define I_w_gate (kp_[10])
#define I_w_up (kp_[11])
#define I_w_down (kp_[12])
#define I_mix_norm_odd (kp_[13])
#define I_pool_w (kp_[14])
#define I_pool_scale (kp_[15])
#define I_ffn_norm_odd (kp_[16])
#define I_w_router (kp_[17])
#define I_w_gate_e (kp_[18])
#define I_w_up_e (kp_[19])
#define I_w_down_e (kp_[20])
#define I_ple_norm (kp_[21])
#define I_ple_gate_w (kp_[22])
#define I_ple_proj (kp_[23])
#define W_lbv ((float*)(ws_ + WS_LBV))
#define W_rs4 ((float*)(ws_ + WS_RS4))
#define W_topi ((int*)(ws_ + WS_TOP))
#define W_topw ((float*)(ws_ + WS_TOPW))
#define W_sspA ((float*)(ws_ + WS_SSPA))
#define W_sspB ((float*)(ws_ + WS_SSPB))
#define W_list ((int*)(ws_ + WS_LIST))
#define W_gwl ((float*)(ws_ + WS_GWL))
#define W_rsl ((float*)(ws_ + WS_TOKC))
#define W_tokc ((int*)(ws_ + WS_TOKC))
#define W_gwc ((float*)(ws_ + WS_GWC))
#define W_rsc ((float*)(ws_ + WS_RSC))
#define W_Win_t ((bf16*)(ws_ + WS_WIN))
#define W_Wout_t ((bf16*)(ws_ + WS_WOUT))
#define W_Wgu_t ((bf16*)(ws_ + WS_WGU))
#define W_Wd_t ((bf16*)(ws_ + WS_WD))
#define W_Wpool_t ((bf16*)(ws_ + WS_WPOOL))
#define W_Wmgu_t ((bf16*)(ws_ + WS_WMGU))
#define W_Wmd_t ((bf16*)(ws_ + WS_WMD))
#define W_Wpg_t ((bf16*)(ws_ + WS_WPG))
#define W_Wpp_t ((bf16*)(ws_ + WS_WPP))
#define W_PB ((bf16*)(ws_ + WS_PB))
#define W_XB ((bf16*)(ws_ + WS_XB))
#define W_A2 ((bf16*)(ws_ + WS_A2))
#define W_PJ ((bf16*)(ws_ + WS_A2))
#define W_U ((bf16*)(ws_ + WS_BIG))
#define W_Hh ((bf16*)(ws_ + WS_BIG))
#define W_D1 ((bf16*)(ws_ + WS_BIG))
#define W_XG ((bf16*)(ws_ + WS_BIG))
#define W_HE ((bf16*)(ws_ + WS_HE))
#define W_X (X_)
#define W_XS0 ((bf16*)(ws_ + WS_XB))
#define W_XQ ((unsigned char*)X_)
#define W_XQ1 ((unsigned char*)X_ + 64 * MiB)
#define W_XS1 ((bf16*)((unsigned char*)X_ + 64 * MiB))
#define W_XB0 ((bf16*)X_)
    int gw = F.bx * NWAVES + F.wave; const int NGW = F.G * NWAVES;

#ifndef CONV_MODE
#define CONV_MODE 0
#endif
#define CONVERT_REST(FIRSTB) do { \
            LDS_BAR(); \
            LAS unsigned char* scr = F.lds + F.wave * 16384; \
            const int wv = (F.bx - (FIRSTB)) * NWAVES + F.wave, nw = (F.G - (FIRSTB)) * NWAVES; int base = 0; \
            { const TrJob J{I_w_out, I_w_out, 0, 0, DM, DM, DM, 0, W_Wout_t, nullptr, 0}; base = tr_job(J, base, wv, nw, scr, F.lane); } \
            { const TrJob J{I_w_gate, I_w_up, 0, 0, DFF, DM, 0, DFF / 128, W_Wgu_t, I_ffn_norm_even, F8_GU}; base = tr_job(J, base, wv, nw, scr, F.lane); } \
            { const TrJob J{I_w_down, I_w_down, 0, 0, DM, DFF, DM, 0, W_Wd_t, nullptr, F8_DN}; base = tr_job(J, base, wv, nw, scr, F.lane); } \
            for (int i = 0; i < 2; ++i) { const TrJob J{I_ple_proj + (size_t)i * DPLE * DM, nullptr, 0, 0, DM, DPLE, DM, 0, W_Wpp_t + (size_t)i * DM * DPLE, nullptr, 0}; base = tr_job(J, base, wv, nw, scr, F.lane); } \
            for (int i = 0; i < 2; ++i) { const TrJob J{I_ple_gate_w + (size_t)i * DM * DM, nullptr, 0, 0, DM, DM, DM, 0, W_Wpg_t + (size_t)i * DM * DM, I_ple_norm + i * DM, (i == 1 && F8_PLE1) ? 1 : 0}; base = tr_job(J, base, wv, nw, scr, F.lane); } \
            for (int g = 0; g < 4; ++g) { const TrJob J{I_pool_w + (size_t)g * 512 * 512, nullptr, 0, 0, 512, 512, 512, 0, W_Wpool_t + (size_t)512 * g * 512, I_mix_norm_odd + 512 * g, 0}; base = tr_job(J, base, wv, nw, scr, F.lane); } \
            for (int e = 0; e < NE; ++e) { const TrJob J{I_w_gate_e + (size_t)e * DM * DFE, I_w_up_e + (size_t)e * DM * DFE, 0, 0, DFE, DM, 0, DFE / 128, W_Wmgu_t + (size_t)e * 2048 * DM / (F8_MOE ? 2 : 1), I_ffn_norm_odd, F8_MOE}; base = tr_job(J, base, wv, nw, scr, F.lane); } \
            for (int e = 0; e < NE; ++e) { const TrJob J{I_w_down_e + (size_t)e * DFE * DM, nullptr, 0, 0, DM, DFE, DM, 0, W_Wmd_t + (size_t)e * DM * DFE / (F8_MOE ? 2 : 1), nullptr, F8_MOE}; base = tr_job(J, base, wv, nw, scr, F.lane); } \
            for (size_t i = (size_t)(F.bx - (FIRSTB)) * 512 + F.tid; i < (size_t)2 * M * DPLE / 8; i += (size_t)(F.G - (FIRSTB)) * 512) { \
                const f32x4 a = ((const f32x4*)I_p)[2 * i], b2 = ((const f32x4*)I_p)[2 * i + 1]; \
                v4u w; w.x = cvt_pk_bf16(a[0], a[1]); w.y = cvt_pk_bf16(a[2], a[3]); w.z = cvt_pk_bf16(b2[0], b2[1]); w.w = cvt_pk_bf16(b2[2], b2[3]); ((v4u*)W_PB)[i] = w; } \
        } while (0)
    for (int rep_ = 0; rep_ < REPS(0); ++rep_) { REFRESH();
        LAS unsigned char* scr = F.lds + F.wave * 16384;
        int base = 0;
        { const TrJob J{I_w_in, I_w_in, 0, 0, NIN, DM, 5120, 0, W_Win_t, I_mix_norm_even, 0}; base = tr_job(J, base, gw, NGW, scr, F.lane); }
        { const TrJob J{I_w_in, I_w_in, 5120, 6144, NIN, DM, 0, 8, W_Win_t + (size_t)5120 * DM, I_mix_norm_even, 0}; base = tr_job(J, base, gw, NGW, scr, F.lane); }
        for (int m = gw; m < M; m += NGW) {
            const GAS f32x4* xr = (const GAS f32x4*)(I_x + (size_t)m * DM) + F.lane; GAS v2u* o8 = (GAS v2u*)(W_XB0 + (size_t)m * DM) + F.lane; float s = 0.f;
#pragma unroll
            for (int j = 0; j < 8; ++j) { const f32x4 v = xr[64 * j]; s += (v[0] * v[0] + v[1] * v[1]) + (v[2] * v[2] + v[3] * v[3]); v2u w; w.x = cvt_pk_bf16(v[0], v[1]); w.y = cvt_pk_bf16(v[2], v[3]); o8[64 * j] = w; }
            s = wave_sum(s);
            if (F.lane < 32) W_sspA[(size_t)m * 32 + F.lane] = (F.lane == 0) ? s : 0.f;
        }
        if (F.bx == 0) for (int j = F.tid; j < DH; j += 512) { const float t0 = I_lb_table[j], t1 = I_lb_table[DH + j], t2 = I_lb_table[2 * DH + j]; const float mx = fmaxf(t0, fmaxf(t1, t2));
            const float e0 = __expf(t0 - mx), e1 = __expf(t1 - mx), e2 = __expf(t2 - mx); W_lbv[j] = e0 / (e0 + e1 + e2); }
    }
    GRID_BAR();
    const size_t TB2048 = (size_t)256 * DM * 2;
    for (int rep_ = 0; rep_ < (PH(1) ? REPS(1) : 0); ++rep_) { REFRESH();
        SchedGrid S; S.o.init(M / 256, NIN / 256, F.G, F.bx); S.A = (const char*)W_XB0; S.B = (const char*)W_Win_t; S.at = TB2048; S.bt = TB2048;
        EpiInProj E{W_U, W_sspA, W_lbv};
        pg8::gemm_phase<EpiInProj, SchedGrid, true>(F.lds, DM, DM, DM, S, E);
    }
    GRID_BAR();
    for (int rep_ = 0; rep_ < REPS(2); ++rep_) { REFRESH(); if (F.bx < BATCH * NH) { hgrn_phase(F, W_U, W_A2, I_hgrn_gain); if (PROBE_DUP == 20) hgrn_phase(F, W_U, W_A2, I_hgrn_gain); }
        else for (int rep2_ = 0; rep2_ < (PROBE_DUP == 21 ? 2 : 1); ++rep2_) {
            conv_phase(F, W_U, W_A2, I_conv_w, BATCH * NH);
            if (CONV_MODE == 0) CONVERT_REST(BATCH * NH);
        }
    }
    GRID_BAR();
    if (CONV_MODE == 1) { for (int rep_ = 0; rep_ < REPS(16); ++rep_) { REFRESH(); CONVERT_REST(0); } GRID_BAR(); }
    for (int rep_ = 0; rep_ < (PH(3) ? REPS(3) : 0); ++rep_) { REFRESH();
        SchedGrid S; S.o.init(M / 256, DM / 256, F.G, F.bx); S.A = (const char*)W_A2; S.B = (const char*)W_Wout_t; S.at = TB2048; S.bt = TB2048;
        EpiResid<0, false, F8_GU> E{nullptr, W_XB0, W_XS0, W_sspB, nullptr, nullptr, nullptr, W_XQ1};
        pg8::gemm_phase<EpiResid<0, false, F8_GU>, SchedGrid, true>(F.lds, DM, DM, DM, S, E);
    }
    GRID_BAR();
    for (int rep_ = 0; rep_ < (PH(4) ? REPS(4) : 0); ++rep_) { REFRESH();
        constexpr int EB = F8_GU ? 1 : 2;
        SchedGrid S; S.o.init(M / 256, 2 * DFF / 256, F.G, F.bx); S.A = F8_GU ? (const char*)W_XQ1 : (const char*)W_XS0; S.B = (const char*)W_Wgu_t; S.at = (size_t)256 * DM * EB; S.bt = (size_t)256 * DM * EB;
        EpiSwiglu<false, F8_DN> E{W_Hh, DFF, W_sspB, nullptr, nullptr};
        pg8::gemm_phase<EpiSwiglu<false, F8_DN>, SchedGrid, true, F8_GU>(F.lds, DM * EB / 2, DM * EB / 2, DM * EB / 2, S, E);
        REFRESH();
        SchedGrid S2; S2.o.init(M / 256, DM / 256, F.G, F.bx); S2.A = (const char*)W_PB; S2.B = (const char*)W_Wpp_t; S2.at = (size_t)256 * DPLE * 2; S2.bt = (size_t)256 * DPLE * 2;
        EpiBf16Plain E2{W_PJ, DM};
        pg8::gemm_phase<EpiBf16Plain, SchedGrid, true>(F.lds, DPLE, DPLE, DPLE, S2, E2);
    }
    GRID_BAR();
    for (int rep_ = 0; rep_ < (PH(5) ? REPS(5) : 0); ++rep_) { REFRESH();
        SchedGrid S; S.o.init(M / 256, DM / 256, F.G, F.bx); constexpr int EB = F8_DN ? 1 : 2; S.A = (const char*)W_Hh; S.B = (const char*)W_Wd_t; S.at = (size_t)256 * DFF * EB; S.bt = (size_t)256 * DFF * EB;
        EpiResid<0, false> E{nullptr, W_XS0, W_XS0, W_sspA, nullptr, nullptr, nullptr, nullptr};
        pg8::gemm_phase<EpiResid<0, false>, SchedGrid, true, F8_DN>(F.lds, DFF * EB / 2, DFF * EB / 2, DFF * EB / 2, S, E);
    }
    GRID_BAR();
    for (int rep_ = 0; rep_ < (PH(6) ? REPS(6) : 0); ++rep_) { REFRESH();
        SchedGrid S; S.o.init(M / 256, DM / 256, F.G, F.bx); S.A = (const char*)W_XB; S.B = (const char*)W_Wpg_t; S.at = TB2048; S.bt = TB2048;
        EpiResid<2, false> E{nullptr, W_XS0, W_XS1, W_sspB, nullptr, W_sspA, W_PJ, nullptr};
        pg8::gemm_phase<EpiResid<2, false>, SchedGrid, true>(F.lds, DM, DM, DM, S, E);
    }
    GRID_BAR();
    for (int rep_ = 0; rep_ < (PH(7) ? REPS(7) : 0); ++rep_) { REFRESH();
        LAS float* rt = (LAS float*)F.lds;
        for (int seg = F.bx; seg < M / 64; seg += F.G) {
            const int R0 = seg * 64, t0 = R0 % SEQ;
            for (int i = F.wave; i < 80; i += NWAVES) { const int row = R0 - 16 + i; float v = 0.f;
                if (row >= 0 && F.lane < 32) v = W_sspB[(size_t)row * 32 + F.lane];
                v = wave_sum(v); if (F.lane == 0) rt[i] = 1.0f / sqrtf(v * (1.0f / DM) + EPS); }
            LDS_BAR();
            const int wdw = 2 << (F.tid >> 7);
            const bf16* xc = W_XS1 + (size_t)R0 * DM + 4 * F.tid;
#define LD4(ptr, sc) ({ const v2u q_ = *(const v2u*)(ptr); f32x4 r_; r_[0] = bflo(q_.x) * (sc); r_[1] = bfhi(q_.x) * (sc); r_[2] = bflo(q_.y) * (sc); r_[3] = bfhi(q_.y) * (sc); r_; })
            f32x4 Ssum = (f32x4){0.f, 0.f, 0.f, 0.f};
            for (int k = 1; k <= wdw; ++k) if (t0 - k >= 0) Ssum += LD4(xc - (size_t)k * DM, rt[16 - k]);
#pragma unroll 4
            for (int j = 0; j < 64; ++j) {
                const f32x4 hv = LD4(xc + (size_t)j * DM, rt[16 + j]);
                Ssum += hv;
                const int tp = t0 + j;
                if (tp - wdw >= 0) Ssum -= LD4(xc + (size_t)(j - wdw) * DM, rt[16 + j - wdw]);
                const float inv = 1.0f / (float)((tp + 1 < wdw) ? (tp + 1) : wdw);
                const f32x4 d = Ssum * inv - hv;
                v2u w; w.x = cvt_pk_bf16(d[0], d[1]); w.y = cvt_pk_bf16(d[2], d[3]);
                *(v2u*)(W_D1 + (size_t)(R0 + j) * DM + 4 * F.tid) = w;
            }
#undef LD4
            LDS_BAR();
        }
    }
    GRID_BAR();
    for (int rep_ = 0; rep_ < (PH(8) ? REPS(8) : 0); ++rep_) { REFRESH();
        SchedPool S; S.o.init(M / 256, DM / 256, F.G, F.bx); S.A = (const char*)W_D1; S.B = (const char*)W_Wpool_t; S.at = TB2048; S.bt = (size_t)256 * 512 * 2;
        EpiResid<1, false, F8_MOE> E{nullptr, W_XS1, W_XS1, W_sspA, I_pool_scale, nullptr, nullptr, W_XQ};
        pg8::gemm_phase<EpiResid<1, false, F8_MOE>, SchedPool, true>(F.lds, 512, DM, 512, S, E);
    }
    GRID_BAR();
    for (int rep_ = 0; rep_ < (PH(9) ? REPS(9) : 0); ++rep_) { REFRESH();
        LAS float* wr = (LAS float*)F.lds;
        LAS int* e12 = (LAS int*)(F.lds + 65536);
        LAS float* w12 = (LAS float*)(F.lds + 65536 + 512);
        LAS float* rs1 = (LAS float*)(F.lds + 65536 + 1024);
        for (int i = F.tid; i < DM * NE / 4; i += 512) { const int k = i >> 1, e0 = (i & 1) * 4; const f32x4 v = *(const f32x4*)(I_w_router + (size_t)k * NE + e0) * I_ffn_norm_odd[k];
            *(LAS f32x4*)(wr + (((k & 7) * 256 + (k >> 3)) * 8 + e0)) = v; }
        LDS_BAR();
        for (int seg = F.bx; seg < M / 64; seg += F.G) {
            v4u xcur[4], xnxt[4];
            { const GAS v4u* xr0 = (const GAS v4u*)(W_XS1 + (size_t)(seg * 64 + F.wave * 8) * DM) + F.lane;
#pragma unroll
              for (int c = 0; c < 4; ++c) xcur[c] = xr0[64 * c]; }
            for (int rr = 0; rr < 8; ++rr) {
                const int lrow = F.wave * 8 + rr, row = seg * 64 + lrow;
                if (rr < 7) { const GAS v4u* xr1 = (const GAS v4u*)(W_XS1 + (size_t)(row + 1) * DM) + F.lane;
#pragma unroll
                    for (int c = 0; c < 4; ++c) xnxt[c] = xr1[64 * c]; }
                float acc[8]; float ss = 0.f;
#pragma unroll
                for (int e = 0; e < 8; ++e) acc[e] = 0.f;
#pragma unroll
                for (int c = 0; c < 4; ++c) { f32x4 xa, xb; unpack8(xcur[c], xa, xb);
                    ss += ((xa[0] * xa[0] + xa[1] * xa[1]) + (xa[2] * xa[2] + xa[3] * xa[3])) + ((xb[0] * xb[0] + xb[1] * xb[1]) + (xb[2] * xb[2] + xb[3] * xb[3]));
#pragma unroll
                    for (int kk = 0; kk < 8; ++kk) { const float xk = kk < 4 ? xa[kk & 3] : xb[kk & 3];
                        const LAS float* wp = wr + ((kk * 256 + c * 64 + F.lane) * 8); const f32x4 w0 = *(const LAS f32x4*)wp, w1 = *(const LAS f32x4*)(wp + 4);
                        acc[0] += xk * w0[0]; acc[1] += xk * w0[1]; acc[2] += xk * w0[2]; acc[3] += xk * w0[3];
                        acc[4] += xk * w1[0]; acc[5] += xk * w1[1]; acc[6] += xk * w1[2]; acc[7] += xk * w1[3]; } }
                ss = wave_sum(ss);
#pragma unroll
                for (int e = 0; e < 8; ++e) acc[e] = wave_sum(acc[e]);
                const float rstd = 1.0f / sqrtf(ss * (1.0f / DM) + EPS);
                int i1 = 0; float l1 = acc[0];
#pragma unroll
                for (int e = 1; e < 8; ++e) if (acc[e] > l1) { l1 = acc[e]; i1 = e; }
                int i2 = -1; float l2 = -3.0e38f;
#pragma unroll
                for (int e = 0; e < 8; ++e) if (e != i1 && acc[e] > l2) { l2 = acc[e]; i2 = e; }
                const float wt1 = 1.0f / (1.0f + __expf((l2 - l1) * rstd)), wt2 = 1.0f - wt1;
                if (F.lane == 0) { e12[2 * lrow] = i1; e12[2 * lrow + 1] = i2; w12[2 * lrow] = wt1; w12[2 * lrow + 1] = wt2; rs1[lrow] = rstd; }
#pragma unroll
                for (int c = 0; c < 4; ++c) xcur[c] = xnxt[c];
            }
            LDS_BAR();
            if (F.wave == 0) {
                const int row = seg * 64 + F.lane; const int e1 = e12[2 * F.lane], e2 = e12[2 * F.lane + 1]; const float wt1 = w12[2 * F.lane], wt2 = w12[2 * F.lane + 1], rsv = rs1[F.lane];
                unsigned long long mk[16]; int mycnt = 0;
#pragma unroll
                for (int g = 0; g < 16; ++g) { const bool pr = (g < 8) ? (e1 == g) : (e2 == g - 8); mk[g] = __ballot(pr); if (F.lane == g) mycnt = __popcll(mk[g]); }
                int base = 0;
                if (F.lane < 16) base = (int)__hip_atomic_fetch_add((unsigned*)(F.ctl + CW_MOE) + F.lane, (unsigned)mycnt, RLX_AGENT);
                const unsigned long long lt = (1ull << F.lane) - 1ull;
#pragma unroll
                for (int g = 0; g < 16; ++g) { const int bg = __shfl(base, g); const bool pr = (g < 8) ? (e1 == g) : (e2 == g - 8);
                    if (pr) { const int slot = bg + __popcll(mk[g] & lt); W_list[(size_t)g * M + slot] = row; W_gwl[(size_t)g * M + slot] = (g < 8) ? wt1 : wt2; W_rsl[(size_t)g * M + slot] = rsv; } }
            }
            LDS_BAR();
        }
    }
    GRID_BAR();
    LAS int* tile_e = (LAS int*)(F.lds + LDSCTL_OFF + 1024);
    LAS int* tile_g = (LAS int*)(F.lds + LDSCTL_OFF + 1024 + 640);
    LAS int* tile_s0 = (LAS int*)(F.lds + LDSCTL_OFF + 1024 + 1280);
    LAS int* gtab = (LAS int*)(F.lds + LDSCTL_OFF + 1024 + 1920);
    for (int rep_ = 0; rep_ < (PH(11) ? REPS(11) : 0); ++rep_) { REFRESH();
        if (F.tid == 0) { int ti = 0;
            for (int g = 0; g < 16; ++g) { const int c = (int)__hip_atomic_load((unsigned*)(F.ctl + CW_MOE) + g, RLX_AGENT); const int nt = (c + 255) >> 8;
                gtab[g] = c; for (int t = 0; t < nt; ++t) { tile_e[ti] = g & 7; tile_g[ti] = g; tile_s0[ti] = t * 256; ++ti; } if (g == 7) gtab[17] = ti; }
            gtab[16] = ti; }
        LDS_BAR();
        constexpr int EB = F8_MOE ? 1 : 2;
        SchedMoe S{tile_e, tile_g, tile_s0, gtab, 0, gtab[16], F.G, F.bx, F8_MOE ? (const char*)W_XQ : (const char*)W_XS1, (const char*)W_Wmgu_t, 0, (size_t)256 * DM * EB, (size_t)2048 * DM * EB, W_list, true};
        EpiSwiglu<true, F8_MOE> E{W_HE, DFE, nullptr, W_rsl, W_list};
        pg8::gemm_phase<EpiSwiglu<true, F8_MOE>, SchedMoe, true, F8_MOE, true>(F.lds, DM * EB / 2, DM * EB / 2, DM * EB / 2, S, E);
    }
    GRID_BAR();
    for (int rep_ = 0; rep_ < (PH(12) ? REPS(12) : 0); ++rep_) { REFRESH();
        constexpr int EB = F8_MOE ? 1 : 2;
        SchedMoe S{tile_e, tile_g, tile_s0, gtab, 0, gtab[17], F.G, F.bx, (const char*)W_HE, (const char*)W_Wmd_t, (size_t)256 * DFE * EB, (size_t)256 * DFE * EB, (size_t)DM * DFE * EB, W_list, false};
        EpiMoeDown<false> E{W_XS1, W_sspB, W_list, W_gwl, nullptr};
        pg8::gemm_phase<EpiMoeDown<false>, SchedMoe, true, F8_MOE>(F.lds, DFE * EB / 2, DFE * EB / 2, DFE * EB / 2, S, E);
        REFRESH();
        { const int rem = (gtab[17] * 8) % F.G; SchedFill S2{0, 256, DM / 256, F.bx >= rem ? F.bx - rem : -1, F.G - rem, (const char*)(W_PB + (size_t)M * DPLE), (const char*)(W_Wpp_t + (size_t)DM * DPLE), (size_t)256 * DPLE * 2, (size_t)256 * DPLE * 2};
          EpiBf16Plain E2{W_PJ, DM};
          pg8::gemm_phase<EpiBf16Plain, SchedFill, true>(F.lds, DPLE, DPLE, DPLE, S2, E2); }
    }
    GRID_BAR();
    for (int rep_ = 0; rep_ < (PH(13) ? REPS(13) : 0); ++rep_) { REFRESH();
        constexpr int EB = F8_MOE ? 1 : 2;
        SchedMoe S{tile_e, tile_g, tile_s0, gtab, gtab[17], gtab[16], F.G, F.bx, (const char*)W_HE, (const char*)W_Wmd_t, (size_t)256 * DFE * EB, (size_t)256 * DFE * EB, (size_t)DM * DFE * EB, W_list, false};
        EpiMoeDown<true, F8_PLE1> E{W_XS1, W_sspB, W_list, W_gwl, W_XQ};
        pg8::gemm_phase<EpiMoeDown<true, F8_PLE1>, SchedMoe, true, F8_MOE>(F.lds, DFE * EB / 2, DFE * EB / 2, DFE * EB / 2, S, E);
        REFRESH();
        { const int rem = ((gtab[16] - gtab[17]) * 8) % F.G; SchedFill S2{256, 512, DM / 256, F.bx >= rem ? F.bx - rem : -1, F.G - rem, (const char*)(W_PB + (size_t)M * DPLE), (const char*)(W_Wpp_t + (size_t)DM * DPLE), (size_t)256 * DPLE * 2, (size_t)256 * DPLE * 2};
          EpiBf16Plain E2{W_PJ, DM};
          pg8::gemm_phase<EpiBf16Plain, SchedFill, true>(F.lds, DPLE, DPLE, DPLE, S2, E2); }
    }
    GRID_BAR();
    for (int rep_ = 0; rep_ < (PH(14) ? REPS(14) : 0); ++rep_) { REFRESH();
        SchedGrid S; S.o.init(M / 256, DM / 256, F.G, F.bx); constexpr int EB = F8_PLE1 ? 1 : 2; S.A = F8_PLE1 ? (const char*)W_XQ : (const char*)W_XS1; S.B = (const char*)(W_Wpg_t + (size_t)DM * DM); S.at = (size_t)256 * DM * EB; S.bt = (size_t)256 * DM * EB;
        EpiResid<2, false> E{nullptr, W_XS1, W_XS0, W_sspA, nullptr, W_sspB, W_PJ, nullptr};
        pg8::gemm_phase<EpiResid<2, false>, SchedGrid, true, F8_PLE1>(F.lds, DM * EB / 2, DM * EB / 2, DM * EB / 2, S, E);
    }
    GRID_BAR();
    REFRESH();
    if (PH(15)) for (int m0 = gw; m0 < M; m0 += 4 * NGW) {
        v4u xv[4][4]; float sv[4];
#pragma unroll
        for (int q = 0; q < 4; ++q) { const int m = m0 + q * NGW; if (m < M) { const GAS v4u* xs = (const GAS v4u*)(W_XS0 + (size_t)m * DM) + F.lane;
#pragma unroll
                for (int j = 0; j < 4; ++j) xv[q][j] = xs[64 * j];
                sv[q] = (F.lane < 32) ? W_sspA[(size_t)m * 32 + F.lane] : 0.f; } }
#pragma unroll
        for (int q = 0; q < 4; ++q) { const int m = m0 + q * NGW; if (m < M) {
                const float rstd = 1.0f / sqrtf(wave_sum(sv[q]) * (1.0f / DM) + EPS);
                GAS f32x4* xo = (GAS f32x4*)(W_X + (size_t)m * DM) + 2 * F.lane; const f32x4* gp = (const f32x4*)I_final_gain + 2 * F.lane;
#pragma unroll
                for (int j = 0; j < 4; ++j) { f32x4 a, b; unpack8(xv[q][j], a, b); xo[128 * j] = a * rstd * gp[128 * j]; xo[128 * j + 1] = b * rstd * gp[128 * j + 1]; } } }
    }
}

extern "C" void kernel_launch(void* const* d_in, const int* in_sizes, int n_in, void* d_out, int out_size, void* d_ws, size_t ws_size, hipStream_t stream) {
    (void)in_sizes; (void)out_size;
    static int grid = 0;
    if (grid == 0) {
        if (n_in != 24 || ws_size < WS_END) { fprintf(stderr, "kernel_launch: bad arguments (n_in %d, ws %zu)\n", n_in, ws_size); grid = -1; return; }
        int dev = 0, cus = 0, per_cu = 0;
        if (hipGetDevice(&dev) != hipSuccess || hipDeviceGetAttribute(&cus, hipDeviceAttributeMultiprocessorCount, dev) != hipSuccess) { grid = -1; return; }
        if (hipFuncSetAttribute((const void*)fwd_kernel, hipFuncAttributeMaxDynamicSharedMemorySize, LDS_BYTES) != hipSuccess) { grid = -1; return; }
        if (hipOccupancyMaxActiveBlocksPerMultiprocessor(&per_cu, (const void*)fwd_kernel, NWAVES * 64, LDS_BYTES) != hipSuccess || per_cu < 1) { fprintf(stderr, "kernel_launch: occupancy query says %d\n", per_cu); }
        (void)hipGetLastError();
        grid = cus;
    }
    if (grid < 0) return;
    if (hipMemsetAsync((char*)d_ws + WS_CTL, 0, CTL_ZERO_BYTES, stream) != hipSuccess) return;
    Args a{};
    for (int i = 0; i < 24; ++i) a.in[i] = (const float*)d_in[i];
    a.out = (float*)d_out; a.ws = (unsigned char*)d_ws;
    hipLaunchKernelGGL(fwd_kernel, dim3(grid), dim3(NWAVES * 64), LDS_BYTES, stream, a);
}
```

```cpp
#include <hip/hip_runtime.h>
#include <cstdio>
#include <cstdint>

constexpr int DM = 2048, BATCH = 8, SEQ = 2048, M = BATCH * SEQ;
constexpr int DH = 1024, NH = 8, HD = 128, CHUNK = 64, DC = 1024, DFF = 5632, NE = 8, DFE = 1024, DPLE = 256;
constexpr int NIN = 7168;
constexpr int UP = 6144;
constexpr float EPS = 1e-6f;
constexpr int NWAVES = 8;
#ifndef RS_TABLE
#define RS_TABLE 1
#endif
#ifndef F8_GU
#define F8_GU 1
#endif
#ifndef F8_DN
#define F8_DN 1
#endif
#ifndef F8_MOE
#define F8_MOE 1
#endif
#ifndef F8_PLE1
#define F8_PLE1 1
#endif

constexpr size_t MiB = 1u << 20;
constexpr size_t WS_CTL = 0, CTL_ZERO_BYTES = 256 * 1024;
constexpr size_t WS_LBV = 1 * MiB;
constexpr size_t WS_RS4 = 1 * MiB + 64 * 1024;
constexpr size_t WS_TOP = 1 * MiB + 192 * 1024;
constexpr size_t WS_TOPW = 1 * MiB + 320 * 1024;
constexpr size_t WS_SSPA = 2 * MiB, WS_SSPB = 4 * MiB;
constexpr size_t WS_LIST = 6 * MiB;
constexpr size_t WS_GWL = 7 * MiB;
constexpr size_t WS_TOKC = 8 * MiB;
constexpr int RCAP = 36864;
constexpr size_t WS_GWC = WS_TOKC + (size_t)RCAP * 4, WS_RSC = WS_GWC + (size_t)RCAP * 4;
constexpr size_t WS_WIN = 10 * MiB;
constexpr size_t WS_WOUT = 38 * MiB;
constexpr size_t WS_WGU = 46 * MiB;
constexpr size_t WS_WD = 90 * MiB;
constexpr size_t WS_WPOOL = 112 * MiB;
constexpr size_t WS_WMGU = 114 * MiB;
constexpr size_t WS_WMD = 178 * MiB;
constexpr size_t WS_WPG = 210 * MiB;
constexpr size_t WS_WPP = 226 * MiB;
constexpr size_t WS_PB = 228 * MiB;
constexpr size_t WS_XB = 244 * MiB;
constexpr size_t WS_A2 = 308 * MiB;
constexpr size_t WS_BIG = 372 * MiB;
constexpr size_t WS_HE = 10 * MiB;
constexpr size_t WS_END = 564 * MiB;
static_assert(WS_BIG + (size_t)M * UP * 2 <= WS_END && WS_HE + (size_t)RCAP * DFE * 2 <= WS_WD, "ws map");
static_assert(WS_BIG + (size_t)RCAP * DM * 2 <= WS_END, "ws map XG");
constexpr int CW_BAR = 4096;
constexpr int CW_MOE = 16384;
constexpr int CW_DBG = 20000;

constexpr int RING_BYTES = 131072;
constexpr int LDSCTL_OFF = RING_BYTES, MISC_OFF = LDSCTL_OFF + 320;
constexpr int LDS_BYTES = 147456;

#define GAS __attribute__((address_space(1)))
#define LAS __attribute__((address_space(3)))
typedef unsigned short bf16;
typedef unsigned v4u __attribute__((ext_vector_type(4)));
typedef unsigned v2u __attribute__((ext_vector_type(2)));
typedef float f32x4 __attribute__((ext_vector_type(4)));
typedef float f32x2 __attribute__((ext_vector_type(2)));
typedef float f32x16 __attribute__((ext_vector_type(16)));
typedef short bf16x8 __attribute__((ext_vector_type(8)));
typedef short bf16x4 __attribute__((ext_vector_type(4)));
typedef GAS unsigned gu32;
#define RLX_AGENT __ATOMIC_RELAXED, __HIP_MEMORY_SCOPE_AGENT
#define LDS_WAIT() asm volatile("s_waitcnt lgkmcnt(0)" ::: "memory")
#define VM_WAIT() asm volatile("s_waitcnt vmcnt(0)" ::: "memory")
#define LDS_BAR() do { asm volatile("s_waitcnt lgkmcnt(0)" ::: "memory"); __builtin_amdgcn_s_barrier(); asm volatile("" ::: "memory"); } while (0)
__device__ __forceinline__ unsigned f2bf(float f) { unsigned u = __builtin_bit_cast(unsigned, f); return (u + 0x7fffu + ((u >> 16) & 1u)) >> 16; }
__device__ __forceinline__ unsigned pk2(float lo, float hi) { return f2bf(lo) | (f2bf(hi) << 16); }
__device__ __forceinline__ unsigned cvt_pk_bf16(float lo, float hi) { unsigned r; asm volatile("v_cvt_pk_bf16_f32 %0, %1, %2" : "=v"(r) : "v"(lo), "v"(hi)); return r; }
__device__ __forceinline__ float clamp8(float v) { return __builtin_amdgcn_fmed3f(v, -448.0f, 448.0f); }
__device__ __forceinline__ v2u pk8_fp8(const f32x4 a, const f32x4 b) {
    int w0 = 0, w1 = 0;
    w0 = __builtin_amdgcn_cvt_pk_fp8_f32(clamp8(a[0]), clamp8(a[1]), w0, false); w0 = __builtin_amdgcn_cvt_pk_fp8_f32(clamp8(a[2]), clamp8(a[3]), w0, true);
    w1 = __builtin_amdgcn_cvt_pk_fp8_f32(clamp8(b[0]), clamp8(b[1]), w1, false); w1 = __builtin_amdgcn_cvt_pk_fp8_f32(clamp8(b[2]), clamp8(b[3]), w1, true);
    v2u r; r.x = (unsigned)w0; r.y = (unsigned)w1; return r;
}
__device__ __forceinline__ float bflo(unsigned u) { return __builtin_bit_cast(float, u << 16); }
__device__ __forceinline__ float bfhi(unsigned u) { return __builtin_bit_cast(float, u & 0xffff0000u); }
__device__ __forceinline__ float fast_rcp(float x) { return __builtin_amdgcn_rcpf(x); }
__device__ __forceinline__ float sigmoidf_(float x) { return fast_rcp(1.0f + __expf(-x)); }
__device__ __forceinline__ float siluf_(float x) { return x * sigmoidf_(x); }
__device__ __forceinline__ float wave_sum(float v) {
#pragma unroll
    for (int o = 1; o < 64; o <<= 1) v += __shfl_xor(v, o);
    return v;
}

#define XB_TMO      128
#define XB_XCNT(j)  (256  + 64 * (j))
#define XB_XSUB(j)  (1280 + 64 * (j))
#define XB_XGEN(j)  (2304 + 64 * (j))
#define XB_TOP      3328
#define XB_TOPGEN   3392
#define XCD_BAR_WORDS 3456
#define XB_SPIN_CAP (1u << 18)
__device__ __forceinline__ unsigned xb_ld(unsigned* p)              { return __hip_atomic_load(p, __ATOMIC_RELAXED, __HIP_MEMORY_SCOPE_AGENT); }
__device__ __forceinline__ unsigned xb_add(unsigned* p, unsigned v) { return __hip_atomic_fetch_add(p, v, __ATOMIC_RELAXED, __HIP_MEMORY_SCOPE_AGENT); }
__device__ __forceinline__ unsigned xb_xcc_id() { return (unsigned)__builtin_amdgcn_s_getreg((3 << 11) | 20) & 0xFu; }
#define XB_SPIN(cond, bar) do { unsigned _sp = 0; while (cond) { __builtin_amdgcn_s_sleep(1); \
    if ((++_sp & 255u) == 0u) { if (xb_ld(&(bar)[XB_TMO])) break; if (_sp > XB_SPIN_CAP) { atomicAdd(&(bar)[XB_TMO], 1u); break; } } } } while (0)
struct XcdBarrier { unsigned* bar; unsigned x; volatile LAS unsigned* st; };
__device__ __forceinline__ XcdBarrier xcd_barrier_post(unsigned* bar, volatile LAS unsigned* st) {
    XcdBarrier b; b.bar = bar; b.x = xb_xcc_id(); b.st = st;
    if (threadIdx.x == 0) (void)xb_add(&bar[XB_XCNT(b.x)], 1u);
    return b;
}
__device__ __forceinline__ void xcd_barrier_complete(unsigned* bar, unsigned x, unsigned& nloc, unsigned& nx) {
    const unsigned G = gridDim.x * gridDim.y * gridDim.z;
    unsigned sum, cnt, mine, sp = 0u;
    for (;;) {
        sum = 0u; cnt = 0u; mine = 0u;
#pragma unroll
        for (unsigned j = 0; j < 16; ++j) { const unsigned c = xb_ld(&bar[XB_XCNT(j)]); sum += c; cnt += (c > 0u) ? 1u : 0u; mine = (j == x) ? c : mine; }
        if (sum == G) break;
        __builtin_amdgcn_s_sleep(1);
        if ((++sp & 255u) == 0u) { if (xb_ld(&bar[XB_TMO])) break; if (sp > XB_SPIN_CAP) { atomicAdd(&bar[XB_TMO], 1u); break; } }
    }
    nloc = mine > 0u ? mine : 1u; nx = cnt > 0u ? cnt : 1u;
}
__device__ __forceinline__ void xcd_barrier(const XcdBarrier& b) {
    asm volatile("s_waitcnt vmcnt(0)" ::: "memory");
    __syncthreads();
    if (threadIdx.x == 0) {
        unsigned* bar = b.bar;
        __builtin_amdgcn_s_waitcnt(0);
        unsigned nloc = b.st[0], nx = b.st[1];
        if (nloc == 0u) { xcd_barrier_complete(bar, b.x, nloc, nx); b.st[0] = nloc; b.st[1] = nx; }
        const unsigned old = xb_add(&bar[XB_XSUB(b.x)], 1u);
        const unsigned gen = old / nloc;
        if (old + 1u == (gen + 1u) * nloc) {
            __builtin_amdgcn_fence(__ATOMIC_RELEASE, "agent");
            asm volatile("s_waitcnt vmcnt(0)" ::: "memory");
            const unsigned og = xb_add(&bar[XB_TOP], 1u);
            const unsigned tg = og / nx;
            if (og + 1u == (tg + 1u) * nx) xb_add(&bar[XB_TOPGEN], 1u);
            else XB_SPIN(xb_ld(&bar[XB_TOPGEN]) == tg, bar);
            __builtin_amdgcn_fence(__ATOMIC_ACQUIRE, "agent");
            xb_add(&bar[XB_XGEN(b.x)], 1u);
            asm volatile("s_waitcnt vmcnt(0)" ::: "memory");
        } else {
            XB_SPIN(xb_ld(&bar[XB_XGEN(b.x)]) == gen, bar);
            __builtin_amdgcn_fence(__ATOMIC_ACQUIRE, "agent");
            asm volatile("s_waitcnt vmcnt(0)" ::: "memory");
        }
    }
    __syncthreads();
}

namespace pg8 {
constexpr int BM = 256, BK = 64, HALF = 128, HTB = HALF * BK * 2, STAGE_BYTES = 8 * HTB, NXCD = 8, WGM = 8;
__host__ __device__ __forceinline__ int lds_byte(int r, int c) { const int st = (r >> 4) * 2 + (c >> 5), rr = r & 15, cc = c & 31, ob = rr * 64 + cc * 2; return st * 1024 + (ob ^ (((ob >> 9) & 1) << 5)); }
__host__ __device__ __forceinline__ void stage_rc(int b, int& R, int& C) { const int st = b / 1024, sb = b % 1024, swz = sb ^ (((sb >> 9) & 1) << 5); R = (st >> 1) * 16 + swz / 64; C = (st & 1) * 32 + (swz % 64) / 2; }
__host__ __device__ __forceinline__ int perm32(int rho) { const int n = rho >> 4, i = rho & 15; return 8 * (i >> 2) + 4 * n + (i & 3); }
struct Unit { int pm, pn; const char* a; const char* b; const int* rows; int nvalid; int ord; };
typedef int v4i_t __attribute__((ext_vector_type(4)));
typedef int v8i_t __attribute__((ext_vector_type(8)));
__device__ __forceinline__ bf16x8 lo8(v8i_t v) { return __builtin_bit_cast(bf16x8, __builtin_shufflevector(v, v, 0, 1, 2, 3)); }
__device__ __forceinline__ bf16x8 hi8(v8i_t v) { return __builtin_bit_cast(bf16x8, __builtin_shufflevector(v, v, 4, 5, 6, 7)); }
__device__ __forceinline__ v8i_t cat8(bf16x8 lo, bf16x8 hi) { return __builtin_shufflevector(__builtin_bit_cast(v4i_t, lo), __builtin_bit_cast(v4i_t, hi), 0, 1, 2, 3, 4, 5, 6, 7); }
struct GridOrder {
    int nM, nN, nwg, G, c;
    __device__ __forceinline__ void init(int nM_, int nN_, int G_, int c_) { nM = nM_; nN = nN_; nwg = nM * nN; G = G_; c = c_; }
    __device__ __forceinline__ bool tile(int i, int& pm, int& pn) const {
        const long L = (long)i * G + c; if (L >= nwg) return false;
        int wgid = (int)L; { const int q = nwg / NXCD, r = nwg % NXCD, xcd = wgid % NXCD, off = wgid / NXCD; wgid = (xcd < r ? xcd * (q + 1) : r * (q + 1) + (xcd - r) * q) + off; }
        const int nig = WGM * nN, gid = wgid / nig, fm = gid * WGM, gsz = (nM - fm) < WGM ? (nM - fm) : WGM;
        pm = fm + ((wgid % nig) % gsz); pn = (wgid % nig) / gsz; return true;
    }
};

template <class Epi, class Sched, bool ALIGN_EPI, bool FP8 = false, bool GATHER = false>
__device__ __forceinline__ void gemm_phase(LAS unsigned char* lds, const int K, const int lda, const int ldb, const Sched& S, const Epi& E) {
    int tid_ = threadIdx.x; asm volatile("" : "+v"(tid_));
    const int tid = tid_, wid = __builtin_amdgcn_readfirstlane(tid >> 6), lane = tid & 63, wr = wid >> 2, wc = wid & 3, fr = lane & 15, fq = lane >> 4;
    const int nt = K / BK;
    unsigned voffA[2], voffB[2];
#pragma unroll
    for (int i = 0; i < 2; ++i) { int R, C; stage_rc(tid * 16 + i * 8192, R, C); const int Rb = Epi::PERM ? ((R & ~31) + perm32(R & 31)) : R;
        voffA[i] = (unsigned)(R * lda + C) * 2u; voffB[i] = (unsigned)(Rb * ldb + C) * 2u; }
    unsigned vG[2][2]; int tkn[2][2];
#pragma unroll
    for (int i = 0; i < 2; ++i) { vG[0][i] = vG[1][i] = 0u; tkn[0][i] = tkn[1][i] = 0; }
    const size_t kstep = (size_t)(BK * 2);
    const size_t hstepA = (size_t)HALF * lda * 2, hstepB = (size_t)HALF * ldb * 2;
    const unsigned ldsw = (unsigned)wid * 1024u;
    const int aoff = lds_byte(wr * 64 + fr, fq * 8), boff = lds_byte(wc * 32 + fr, fq * 8);
#define PG8_SA(b, h) (((b) * 2 + (h)) * HTB)
#define PG8_SB(b, h) ((4 + (b) * 2 + (h)) * HTB)
#define PG8_STAGE(bufoff, gbase, voff) do { _Pragma("unroll") for (int _i = 0; _i < 2; ++_i) \
        __builtin_amdgcn_global_load_lds((const unsigned*)((const char*)(gbase) + (voff)[_i]), (LAS unsigned*)(lds + (bufoff) + ldsw + _i * 8192), 16, 0, 0); } while (0)
#define PG8_STAGEA(bufoff, gk, h) do { if constexpr (GATHER) { PG8_STAGE(bufoff, gk, vG[h]); } else { PG8_STAGE(bufoff, (gk) + (h) * hstepA, voffA); } } while (0)
#define PG8_TOKLOAD(u, tk) do { _Pragma("unroll") for (int _h = 0; _h < 2; ++_h) _Pragma("unroll") for (int _i = 0; _i < 2; ++_i) { int gR_, gC_; stage_rc(tid * 16 + _i * 8192, gR_, gC_); const int row_ = _h * HALF + gR_; tk[_h][_i] = (u).rows[row_ < (u).nvalid ? row_ : (u).nvalid - 1]; }     } while (0)
#define PG8_TOKSET(tk) do { _Pragma("unroll") for (int _h = 0; _h < 2; ++_h) _Pragma("unroll") for (int _i = 0; _i < 2; ++_i) { int gR_, gC_; stage_rc(tid * 16 + _i * 8192, gR_, gC_); vG[_h][_i] = (unsigned)tk[_h][_i] * (unsigned)(lda * 2) + (unsigned)gC_ * 2u; } } while (0)
#define PG8_LDA(dst, b, h) do { _Pragma("unroll") for (int m = 0; m < 4; ++m) { const bf16x8 lo_ = *(const LAS bf16x8*)(lds + PG8_SA(b, h) + aoff + m * 2048), hi_ = *(const LAS bf16x8*)(lds + PG8_SA(b, h) + aoff + m * 2048 + 1024); dst[m] = cat8(lo_, hi_); } } while (0)
#define PG8_LDB(dst, b, h) do { _Pragma("unroll") for (int n = 0; n < 2; ++n) { const bf16x8 lo_ = *(const LAS bf16x8*)(lds + PG8_SB(b, h) + boff + n * 2048), hi_ = *(const LAS bf16x8*)(lds + PG8_SB(b, h) + boff + n * 2048 + 1024); dst[n] = cat8(lo_, hi_); } } while (0)
#define PG8_MMA(ai, bj, At, Bt) do { __builtin_amdgcn_s_setprio(1); _Pragma("unroll") for (int m = 0; m < 4; ++m) _Pragma("unroll") for (int n = 0; n < 2; ++n) { \
        if constexpr (FP8) { asm volatile("v_mfma_scale_f32_16x16x128_f8f6f4 %0, %1, %2, %0, %3, %4 op_sel_hi:[0,0,0]" : "+v"(acc[ai][bj][m][n]) : "v"(Bt[n]), "v"(At[m]), "v"(sc_w), "v"(sc_x)); } \
        else { acc[ai][bj][m][n] = __builtin_amdgcn_mfma_f32_16x16x32_bf16(lo8(Bt[n]), lo8(At[m]), acc[ai][bj][m][n], 0, 0, 0); \
               acc[ai][bj][m][n] = __builtin_amdgcn_mfma_f32_16x16x32_bf16(hi8(Bt[n]), hi8(At[m]), acc[ai][bj][m][n], 0, 0, 0); } } __builtin_amdgcn_s_setprio(0); } while (0)
#define PG8_WAIT_V(n) asm volatile("s_waitcnt vmcnt(" #n ")" ::: "memory")
#define PG8_WAIT_L(n) asm volatile("s_waitcnt lgkmcnt(" #n ")" ::: "memory")
#define PG8_BAR __builtin_amdgcn_s_barrier()
#define PG8_SCHED __builtin_amdgcn_sched_barrier(0)
    Unit cur, nxt; int ui = 0;
    if (!S.next(0, cur)) return;
    cur.ord = 0;
    f32x4 acc[2][2][4][2];
#pragma unroll
    for (int a = 0; a < 2; ++a)
#pragma unroll
        for (int b = 0; b < 2; ++b)
#pragma unroll
            for (int m = 0; m < 4; ++m)
#pragma unroll
                for (int n = 0; n < 2; ++n) acc[a][b][m][n] = (f32x4){0.f, 0.f, 0.f, 0.f};
    v8i_t At[4], B0[2], B1[2];
    const int sc_w = 0x79797979, sc_x = 0x7f7f7f7f;
    (void)sc_w; (void)sc_x;
    const char* cA = cur.a; const char* cB = cur.b;
    if constexpr (GATHER) { PG8_TOKLOAD(cur, tkn); PG8_TOKSET(tkn); }
    PG8_STAGE(PG8_SB(0, 0), cB, voffB); PG8_STAGE(PG8_SB(0, 1), cB + hstepB, voffB); PG8_STAGEA(PG8_SA(0, 0), cA, 0); PG8_STAGEA(PG8_SA(0, 1), cA, 1);
    if (wr == 1) PG8_BAR;
    PG8_WAIT_V(2); PG8_BAR;
    PG8_STAGE(PG8_SB(1, 0), cB + kstep, voffB); PG8_STAGEA(PG8_SA(1, 0), cA + kstep, 0); PG8_STAGE(PG8_SB(1, 1), cB + hstepB + kstep, voffB);
    PG8_WAIT_V(6); PG8_BAR;
    for (;;) {
        const bool has_next = S.next(ui + 1, nxt); nxt.ord = ui + 1;
        const char* nA = has_next ? nxt.a : cA; const char* nB = has_next ? nxt.b : cB;
#pragma nounroll
        for (int t = 0; t < nt; t += 2) {
            const bool last = (t == nt - 2);
            const char* a1 = cA + (size_t)(t + 1) * kstep;
            const char* a2 = last ? nA : cA + (size_t)(t + 2) * kstep; const char* b2 = last ? nB : cB + (size_t)(t + 2) * kstep;
            const char* a3 = a2 + kstep; const char* b3 = b2 + kstep;
            if constexpr (GATHER) { if (has_next && t == nt - 4) PG8_TOKLOAD(nxt, tkn); }
            PG8_LDB(B0, 0, 0); PG8_LDB(B1, 0, 1); PG8_SCHED; PG8_LDA(At, 0, 0); PG8_STAGEA(PG8_SA(1, 1), a1, 1);
            if constexpr (GATHER) { if (last && has_next) PG8_TOKSET(tkn); }
            PG8_WAIT_V(8); PG8_WAIT_L(0); PG8_BAR; PG8_MMA(0, 0, At, B0); PG8_MMA(0, 1, At, B1); PG8_BAR; PG8_SCHED;
            PG8_LDA(At, 0, 1); PG8_STAGE(PG8_SB(0, 0), b2, voffB); PG8_STAGE(PG8_SB(0, 1), b2 + hstepB, voffB); PG8_STAGEA(PG8_SA(0, 0), a2, 0);
            PG8_WAIT_V(8); PG8_WAIT_L(0); PG8_BAR; PG8_MMA(1, 0, At, B0); PG8_MMA(1, 1, At, B1); PG8_BAR; PG8_SCHED;
            PG8_LDB(B0, 1, 0); PG8_LDB(B1, 1, 1); PG8_SCHED; PG8_LDA(At, 1, 0); PG8_STAGEA(PG8_SA(0, 1), a2, 1);
            PG8_WAIT_V(8); PG8_WAIT_L(0); PG8_BAR; PG8_MMA(0, 0, At, B0); PG8_MMA(0, 1, At, B1); PG8_BAR; PG8_SCHED;
            PG8_LDA(At, 1, 1); PG8_STAGE(PG8_SB(1, 0), b3, voffB); PG8_STAGE(PG8_SB(1, 1), b3 + hstepB, voffB); PG8_STAGEA(PG8_SA(1, 0), a3, 0);
            PG8_WAIT_V(8); PG8_WAIT_L(0); PG8_BAR; PG8_MMA(1, 0, At, B0); PG8_MMA(1, 1, At, B1); PG8_BAR; PG8_SCHED;
        }
        if constexpr (ALIGN_EPI) { if (wr == 0) PG8_BAR; }
        if constexpr (FP8) asm volatile("s_nop 15\n\ts_nop 15" ::: "memory");
        E(acc, cur, wr, wc, fr, fq);
        if (!has_next) break;
#pragma unroll
        for (int a = 0; a < 2; ++a)
#pragma unroll
            for (int b = 0; b < 2; ++b)
#pragma unroll
                for (int m = 0; m < 4; ++m)
#pragma unroll
                    for (int n = 0; n < 2; ++n) acc[a][b][m][n] = (f32x4){0.f, 0.f, 0.f, 0.f};
        cur = nxt; cA = nA; cB = nB; ++ui;
        if constexpr (ALIGN_EPI) { if (wr == 1) PG8_BAR; }
    }
    PG8_WAIT_V(0);
    if constexpr (!ALIGN_EPI) { if (wr == 0) PG8_BAR; }
    PG8_BAR;
#undef PG8_SA
#undef PG8_SB
#undef PG8_STAGE
#undef PG8_STAGEA
#undef PG8_TOKLOAD
#undef PG8_TOKSET
#undef PG8_LDA
#undef PG8_LDB
#undef PG8_MMA
#undef PG8_WAIT_V
#undef PG8_WAIT_L
#undef PG8_BAR
#undef PG8_SCHED
}
}
using pg8::Unit;

struct SchedGrid {
    pg8::GridOrder o; const char* A; const char* B; size_t at, bt;
    __device__ __forceinline__ bool next(int i, Unit& u) const { if (!o.tile(i, u.pm, u.pn)) return false; u.a = A + (size_t)u.pm * at; u.b = B + (size_t)u.pn * bt; return true; }
};
struct SchedPool {
    pg8::GridOrder o; const char* A; const char* B; size_t at, bt;
    __device__ __forceinline__ bool next(int i, Unit& u) const { if (!o.tile(i, u.pm, u.pn)) return false; u.a = A + (size_t)u.pm * at + (size_t)(u.pn >> 1) * 1024; u.b = B + (size_t)u.pn * bt; return true; }
};
struct SchedPJ {
    pg8::GridOrder o; const char* A; const char* B; size_t at, bt;
    __device__ __forceinline__ bool next(int i, Unit& u) const { if (!o.tile(i, u.pm, u.pn)) return false; u.a = A + (size_t)u.pm * at; u.b = B + (size_t)((u.pm >> 6) * 8 + u.pn) * bt; return true; }
};
struct SchedMoe {
    const LAS int* tile_e; const LAS int* tile_g; const LAS int* tile_s0; const LAS int* gcnt; int rt0, rt1, G, c; const char* A; const char* B; size_t at, bt, be; const int* list; bool gather;
    __device__ __forceinline__ bool next(int i, Unit& u) const {
        const int L = i * G + c, n = (rt1 - rt0) * 8; if (L >= n) return false;
        u.pm = rt0 + (L >> 3); u.pn = L & 7; const int e = tile_e[u.pm], g = tile_g[u.pm], s0 = tile_s0[u.pm];
        u.a = gather ? A : A + (size_t)u.pm * at; u.b = B + (size_t)e * be + (size_t)u.pn * bt;
        u.rows = list + (size_t)g * M + s0; u.nvalid = gcnt[g] - s0; return true; }
};

struct SchedFill {
    int lo, hi, nN, rank, nlight; const char* A; const char* B; size_t at, bt;
    __device__ __forceinline__ bool next(int i, Unit& u) const {
        if (rank < 0) return false; const int k = lo + rank + i * nlight; if (k >= hi) return false;
        u.pm = k / nN; u.pn = k % nN; u.a = A + (size_t)u.pm * at; u.b = B + (size_t)u.pn * bt; u.rows = nullptr; u.nvalid = 0; return true; }
};
__device__ __forceinline__ void load_rstd(const float* ssp, int row0, int fq, float (&rs)[2][4]) {
#pragma unroll
    for (int ai = 0; ai < 2; ++ai)
#pragma unroll
        for (int m = 0; m < 4; ++m) {
            const float* sp = ssp + (size_t)(row0 + ai * 128 + m * 16) * 32 + fq * 8;
            const f32x4 a = *(const f32x4*)sp, b = *(const f32x4*)(sp + 4);
            float s = ((a[0] + a[1]) + (a[2] + a[3])) + ((b[0] + b[1]) + (b[2] + b[3]));
            s += __shfl_xor(s, 16); s += __shfl_xor(s, 32);
            rs[ai][m] = 1.0f / sqrtf(s * (1.0f / DM) + EPS);
        }
}
constexpr int RS_TBL_OFF = LDSCTL_OFF + 4096, RS_TBL_UNITS = 11;
template <class Sched> __device__ __forceinline__ void build_rstd_table(LAS unsigned char* lds, const Sched& S, const float* ssp, int tid) {
    LAS float* tbl = (LAS float*)(lds + RS_TBL_OFF); const int row = tid >> 1, half = tid & 1;
    for (int i0 = 0; i0 < RS_TBL_UNITS; i0 += 4) {
        f32x4 v[4][4]; bool ok[4];
#pragma unroll
        for (int q = 0; q < 4; ++q) { Unit u; ok[q] = (i0 + q < RS_TBL_UNITS) && S.next(i0 + q, u);
            if (ok[q]) { const f32x4* sp = (const f32x4*)(ssp + (size_t)(u.pm * 256 + row) * 32 + half * 16);
#pragma unroll
                for (int j = 0; j < 4; ++j) v[q][j] = sp[j]; } }
#pragma unroll
        for (int q = 0; q < 4; ++q) if (ok[q]) { float s = 0.f;
#pragma unroll
            for (int j = 0; j < 4; ++j) s += (v[q][j][0] + v[q][j][1]) + (v[q][j][2] + v[q][j][3]);
            s += __shfl_xor(s, 1);
            if (half == 0) tbl[(i0 + q) * 256 + row] = 1.0f / sqrtf(s * (1.0f / DM) + EPS); }
    }
    LDS_BAR();
}
__device__ __forceinline__ void table_rstd(const LAS float* tbl, int ord, int wr, int fr, float (&rs)[2][4]) {
#pragma unroll
    for (int ai = 0; ai < 2; ++ai)
#pragma unroll
        for (int m = 0; m < 4; ++m) rs[ai][m] = tbl[ord * 256 + wr * 64 + fr + ai * 128 + m * 16];
}
struct EpiInProj {
    static constexpr bool PERM = true;
    bf16* U; const float* ssp; const float* lbv; const LAS float* tbl;
    __device__ __forceinline__ void operator()(const f32x4 (&acc)[2][2][4][2], const Unit& u, int wr, int wc, int fr, int fq) const {
        const int row0 = u.pm * 256 + wr * 64 + fr;
        float rs[2][4]; if (RS_TABLE) table_rstd(tbl, u.ord, wr, fr, rs); else load_rstd(ssp, row0, fq, rs);
        const int pn = u.pn;
        if (pn >= 20) {
            const int col0 = 5120 + (pn - 20) * 128 + wc * 32 + 8 * fq;
#pragma unroll
            for (int ai = 0; ai < 2; ++ai)
#pragma unroll
                for (int m = 0; m < 4; ++m) { const float r2 = rs[ai][m] * rs[ai][m];
                    const f32x4 a0 = acc[ai][0][m][0] * acc[ai][1][m][0] * r2, a1 = acc[ai][0][m][1] * acc[ai][1][m][1] * r2;
                    v4u w; w.x = cvt_pk_bf16(a0[0], a0[1]); w.y = cvt_pk_bf16(a0[2], a0[3]); w.z = cvt_pk_bf16(a1[0], a1[1]); w.w = cvt_pk_bf16(a1[2], a1[3]);
                    *(v4u*)(U + (size_t)(row0 + ai * 128 + m * 16) * UP + col0) = w; }
            return;
        }
        const int kind = pn >> 2;
        const int col0 = pn * 256 + wc * 32 + 8 * fq;
        f32x4 lb[2][2];
        if (kind == 1) {
#pragma unroll
            for (int bj = 0; bj < 2; ++bj)
#pragma unroll
                for (int n = 0; n < 2; ++n) lb[bj][n] = *(const f32x4*)(lbv + (col0 - 1024) + bj * 128 + 4 * n);
            asm volatile("" :: "v"(lb[0][0]), "v"(lb[0][1]), "v"(lb[1][0]), "v"(lb[1][1]));
        }
#pragma unroll
        for (int ai = 0; ai < 2; ++ai)
#pragma unroll
            for (int m = 0; m < 4; ++m) { bf16* rowp = U + (size_t)(row0 + ai * 128 + m * 16) * UP + col0; const float r = rs[ai][m];
#pragma unroll
                for (int bj = 0; bj < 2; ++bj) { f32x4 v0 = acc[ai][bj][m][0] * r, v1 = acc[ai][bj][m][1] * r;
                    if (kind == 0 || kind == 3) {
#pragma unroll
                        for (int j = 0; j < 4; ++j) { v0[j] = siluf_(v0[j]); v1[j] = siluf_(v1[j]); }
                    } else if (kind == 1) {
#pragma unroll
                        for (int j = 0; j < 4; ++j) { v0[j] = __builtin_amdgcn_logf(lb[bj][0][j] + (1.0f - lb[bj][0][j]) * sigmoidf_(v0[j])); v1[j] = __builtin_amdgcn_logf(lb[bj][1][j] + (1.0f - lb[bj][1][j]) * sigmoidf_(v1[j]));     }
                    }
                    v4u w; w.x = cvt_pk_bf16(v0[0], v0[1]); w.y = cvt_pk_bf16(v0[2], v0[3]); w.z = cvt_pk_bf16(v1[0], v1[1]); w.w = cvt_pk_bf16(v1[2], v1[3]);
                    *(v4u*)(rowp + bj * 128) = w; } }
    }
};
struct EpiBf16Plain {
    static constexpr bool PERM = true;
    bf16* O; int ldc;
    __device__ __forceinline__ void operator()(const f32x4 (&acc)[2][2][4][2], const Unit& u, int wr, int wc, int fr, int fq) const {
        const int row0 = u.pm * 256 + wr * 64 + fr, col0 = u.pn * 256 + wc * 32 + 8 * fq;
#pragma unroll
        for (int ai = 0; ai < 2; ++ai)
#pragma unroll
            for (int m = 0; m < 4; ++m) { bf16* rowp = O + (size_t)(row0 + ai * 128 + m * 16) * ldc + col0;
#pragma unroll
                for (int bj = 0; bj < 2; ++bj) { const f32x4 v0 = acc[ai][bj][m][0], v1 = acc[ai][bj][m][1];
                    v4u w; w.x = cvt_pk_bf16(v0[0], v0[1]); w.y = cvt_pk_bf16(v0[2], v0[3]); w.z = cvt_pk_bf16(v1[0], v1[1]); w.w = cvt_pk_bf16(v1[2], v1[3]);
                    *(v4u*)(rowp + bj * 128) = w; } }
    }
};
template <bool ROWTAB, bool F8> struct EpiSwiglu {
    static constexpr bool PERM = true;
    void* H; int ldc; const float* ssp; const float* rtab; const int* list; const LAS float* tbl;
    __device__ __forceinline__ void operator()(const f32x4 (&acc)[2][2][4][2], const Unit& u, int wr, int wc, int fr, int fq) const {
        if constexpr (ROWTAB) asm volatile("" : "+v"(fr), "+v"(fq));
        const int row0 = u.pm * 256 + wr * 64 + fr, col0 = u.pn * 128 + wc * 32 + 8 * fq;
        float rs[2][4];
        if constexpr (ROWTAB) {
            const float* rt_ = rtab + (u.rows - list);
#pragma unroll
            for (int ai = 0; ai < 2; ++ai)
#pragma unroll
                for (int m = 0; m < 4; ++m) { const int rl = wr * 64 + fr + ai * 128 + m * 16; const float v_ = rt_[rl < u.nvalid ? rl : u.nvalid - 1]; rs[ai][m] = rl < u.nvalid ? v_ : 0.f; }
        } else { if (RS_TABLE) table_rstd(tbl, u.ord, wr, fr, rs); else load_rstd(ssp, row0, fq, rs); }
#pragma unroll
        for (int ai = 0; ai < 2; ++ai)
#pragma unroll
            for (int m = 0; m < 4; ++m) { const float r = rs[ai][m];
                f32x4 h0, h1;
#pragma unroll
                for (int j = 0; j < 4; ++j) { h0[j] = siluf_(acc[ai][0][m][0][j] * r) * (acc[ai][1][m][0][j] * r); h1[j] = siluf_(acc[ai][0][m][1][j] * r) * (acc[ai][1][m][1][j] * r); }
                const size_t o = (size_t)(row0 + ai * 128 + m * 16) * ldc + col0;
                if constexpr (F8) *(v2u*)((unsigned char*)H + o) = pk8_fp8(h0, h1);
                else { v4u w; w.x = cvt_pk_bf16(h0[0], h0[1]); w.y = cvt_pk_bf16(h0[2], h0[3]); w.z = cvt_pk_bf16(h1[0], h1[1]); w.w = cvt_pk_bf16(h1[2], h1[3]); *(v4u*)((bf16*)H + o) = w; } }
    }
};
__device__ __forceinline__ void unpack8(const v4u w, f32x4& a, f32x4& b) { a[0] = bflo(w.x); a[1] = bfhi(w.x); a[2] = bflo(w.y); a[3] = bfhi(w.y); b[0] = bflo(w.z); b[1] = bfhi(w.z); b[2] = bflo(w.w); b[3] = bfhi(w.w); }
template <int MODE  , bool XF32, bool F8C = false  > struct EpiResid {
    static constexpr bool PERM = true;
    const float* xf; const bf16* xold; bf16* xnew; float* ssp_out; const float* colscale; const float* ssp_in; const bf16* PJ; unsigned char* xq;
    static constexpr int NG = (MODE == 2) ? 1 : 2, NS = 8 / NG;
    struct Q { v4u xo[NG][2], pj[NG][2]; f32x4 xf0[NG][2], xf1[NG][2]; };
    __device__ __forceinline__ void qload(Q& q, int st, int row0, int col0) const {
#pragma unroll
        for (int mm = 0; mm < NG; ++mm)
#pragma unroll
            for (int bj = 0; bj < 2; ++bj) { const int g = st * NG + mm, ai = g >> 2, m = g & 3; const size_t o = (size_t)(row0 + ai * 128 + m * 16) * DM + col0 + bj * 128;
                if constexpr (XF32) { q.xf0[mm][bj] = *(const f32x4*)(xf + o); q.xf1[mm][bj] = *(const f32x4*)(xf + o + 4); } else q.xo[mm][bj] = *(const v4u*)(xold + o);
                if constexpr (MODE == 2) q.pj[mm][bj] = *(const v4u*)(PJ + o); }
    }
    __device__ __forceinline__ void operator()(const f32x4 (&acc)[2][2][4][2], const Unit& u, int wr, int wc, int fr, int fq) const {
        const int row0 = u.pm * 256 + wr * 64 + fr, col0 = u.pn * 256 + wc * 32 + 8 * fq;
        Q qa, qb;
        qload(qa, 0, row0, col0);
        float rs[2][4];
        if constexpr (MODE == 2) load_rstd(ssp_in, row0, fq, rs);
        f32x4 cs[2][2];
        if constexpr (MODE == 1) {
#pragma unroll
            for (int bj = 0; bj < 2; ++bj)
#pragma unroll
                for (int n = 0; n < 2; ++n) cs[bj][n] = *(const f32x4*)(colscale + col0 + bj * 128 + 4 * n);
        }
#pragma unroll
        for (int st = 0; st < NS; ++st) {
            Q& q = (st & 1) ? qb : qa;
            if (st + 1 < NS) qload((st & 1) ? qa : qb, st + 1, row0, col0);
            asm volatile("" ::: "memory");
#pragma unroll
            for (int mm = 0; mm < NG; ++mm) { const int g = st * NG + mm, ai = g >> 2, m = g & 3; const int row = row0 + ai * 128 + m * 16; const size_t off = (size_t)row * DM + col0; float ss = 0.f;
#pragma unroll
                for (int bj = 0; bj < 2; ++bj) { const size_t o = off + bj * 128; f32x4 v0 = acc[ai][bj][m][0], v1 = acc[ai][bj][m][1];
                    if constexpr (MODE == 1) { v0 = v0 * cs[bj][0]; v1 = v1 * cs[bj][1]; }
                    if constexpr (MODE == 2) { f32x4 p0, p1; unpack8(q.pj[mm][bj], p0, p1); const float r = rs[ai][m];
#pragma unroll
                        for (int j = 0; j < 4; ++j) { v0[j] = sigmoidf_(v0[j] * r) * p0[j]; v1[j] = sigmoidf_(v1[j] * r) * p1[j]; } }
                    f32x4 x0, x1;
                    if constexpr (XF32) { x0 = q.xf0[mm][bj]; x1 = q.xf1[mm][bj]; } else unpack8(q.xo[mm][bj], x0, x1);
                    x0 += v0; x1 += v1;
                    v4u w; w.x = cvt_pk_bf16(x0[0], x0[1]); w.y = cvt_pk_bf16(x0[2], x0[3]); w.z = cvt_pk_bf16(x1[0], x1[1]); w.w = cvt_pk_bf16(x1[2], x1[3]);
                    *(v4u*)(xnew + o) = w;
                    if constexpr (F8C) *(v2u*)(xq + o) = pk8_fp8(x0, x1);
                    ss += ((x0[0] * x0[0] + x0[1] * x0[1]) + (x0[2] * x0[2] + x0[3] * x0[3])) + ((x1[0] * x1[0] + x1[1] * x1[1]) + (x1[2] * x1[2] + x1[3] * x1[3])); }
                ss += __shfl_xor(ss, 16); ss += __shfl_xor(ss, 32);
                if (fq == 0) ssp_out[(size_t)row * 32 + u.pn * 4 + wc] = ss;
            }
            asm volatile("" ::: "memory");
        }
    }
};
template <bool RANK2, bool F8C = false> struct EpiMoeDown {
    static constexpr bool PERM = true;
    bf16* X; float* ssp_out; const int* list; const float* gwl; unsigned char* xq;
    __device__ __forceinline__ void operator()(const f32x4 (&acc)[2][2][4][2], const Unit& u, int wr, int wc, int fr, int fq) const {
        asm volatile("" : "+v"(fr), "+v"(fq));
        const int col0 = u.pn * 256 + wc * 32 + 8 * fq;
#pragma unroll
        for (int ai = 0; ai < 2; ++ai)
#pragma unroll
            for (int m = 0; m < 4; ++m) { const int rl = wr * 64 + fr + ai * 128 + m * 16; const bool ok = rl < u.nvalid; const int rc_ = ok ? rl : u.nvalid - 1; const int tok = u.rows[rc_]; const float gw = gwl[(u.rows - list) + rc_];
                const size_t off = (size_t)(ok ? tok : 0) * DM + col0; float ss = 0.f;
#pragma unroll
                for (int bj = 0; bj < 2; ++bj) { const size_t o = off + bj * 128;
                    if (ok) { f32x4 x0, x1; unpack8(*(const v4u*)(X + o), x0, x1); x0 += acc[ai][bj][m][0] * gw; x1 += acc[ai][bj][m][1] * gw;
                        v4u w; w.x = cvt_pk_bf16(x0[0], x0[1]); w.y = cvt_pk_bf16(x0[2], x0[3]); w.z = cvt_pk_bf16(x1[0], x1[1]); w.w = cvt_pk_bf16(x1[2], x1[3]);
                        *(v4u*)(X + o) = w;
                        if constexpr (RANK2 && F8C) *(v2u*)(xq + o) = pk8_fp8(x0, x1);
                        if constexpr (RANK2) ss += ((x0[0] * x0[0] + x0[1] * x0[1]) + (x0[2] * x0[2] + x0[3] * x0[3])) + ((x1[0] * x1[0] + x1[1] * x1[1]) + (x1[2] * x1[2] + x1[3] * x1[3])); } }
                if constexpr (RANK2) { ss += __shfl_xor(ss, 16); ss += __shfl_xor(ss, 32);
                    if (fq == 0 && ok) ssp_out[(size_t)tok * 32 + u.pn * 4 + wc] = ss; }
                if (m & 1) asm volatile("" ::: "memory");
            }
    }
};

template <class EE> struct EpiTwice { static constexpr bool PERM = EE::PERM; EE e;
    __device__ __forceinline__ void operator()(const f32x4 (&acc)[2][2][4][2], const Unit& u, int wr, int wc, int fr, int fq) const { int n_ = 2; asm volatile("" : "+s"(n_));
#pragma nounroll
        for (int k_ = 0; k_ < n_; ++k_) { e(acc, u, wr, wc, fr, fq); asm volatile("" ::: "memory"); } } };
struct Args { const float* in[24]; float* out; unsigned char* ws; };
struct Frame {
    LAS unsigned char* lds; volatile LAS unsigned* MISC; gu32* ctl;
    int tid, lane, wave, G, bx;
};

constexpr int TRP = 136;
constexpr int TRP8 = 68;
struct TrJob { const float* W0; const float* W1; int c0, c1, ldw, K, N, NP; bf16* WT; const float* gain; int f8; };
__device__ __forceinline__ int tr_items(const TrJob& J) { return (J.K / 64) * (J.NP ? J.NP * 4 : J.N / 64); }
__device__ __forceinline__ void tr_map(const TrJob& J, int it, int& kb, int& nb) {
    const int nnb = J.NP ? J.NP * 4 : J.N / 64, sup = it >> 3, sub = it & 7, nsn = nnb >> 1;
    kb = (sup / nsn) * 4 + (sub >> 1); nb = (sup % nsn) * 2 + (sub & 1);
}
__device__ __forceinline__ void tr_src(const TrJob& J, int nb, const float*& W, int& sc) {
    W = J.W0; sc = J.c0 + nb * 64;
    if (J.NP) { const int j = nb >> 2, q = nb & 3; W = (q < 2) ? J.W0 : J.W1; sc = ((q < 2) ? J.c0 : J.c1) + 128 * j + 64 * (q & 1); }
}
__device__ __forceinline__ void tr_load(const TrJob& J, int it, f32x4 (&v)[16], float (&g)[16], int lane) {
    int kb, nb; tr_map(J, it, kb, nb); const float* W; int sc; tr_src(J, nb, W, sc);
    const float* src = W + (size_t)(kb * 64 + (lane >> 4)) * J.ldw + sc + 4 * (lane & 15);
#pragma unroll
    for (int i = 0; i < 16; ++i) v[i] = *(const f32x4*)(src + (size_t)(4 * i) * J.ldw);
    if (J.gain) {
#pragma unroll
        for (int i = 0; i < 16; ++i) g[i] = J.gain[kb * 64 + 4 * i + (lane >> 4)];
    } else {
#pragma unroll
        for (int i = 0; i < 16; ++i) g[i] = 1.0f;
    }
}
__device__ __forceinline__ void tr_store(const TrJob& J, int it, const f32x4 (&v)[16], const float (&gg)[16], LAS unsigned char* scr, int lane) {
    int kb, nb; tr_map(J, it, kb, nb); const int k0 = kb * 64, drow0 = nb * 64;
    if (J.f8) {
#pragma unroll
        for (int i = 0; i < 16; ++i) { const int kk = 4 * i + (lane >> 4); const float g = gg[i] * 64.0f;
            int w = 0; w = __builtin_amdgcn_cvt_pk_fp8_f32(v[i][0] * g, v[i][1] * g, w, false); w = __builtin_amdgcn_cvt_pk_fp8_f32(v[i][2] * g, v[i][3] * g, w, true);
            *(LAS int*)(scr + kk * TRP8 + 4 * (lane & 15)) = w; }
        LDS_WAIT(); asm volatile("" ::: "memory");
        const int c = lane & 3; unsigned char* WT = (unsigned char*)J.WT;
#pragma unroll
        for (int j = 0; j < 4; ++j) { const int n = (lane >> 2) + 16 * j; const LAS unsigned char* s = scr + (16 * c) * TRP8 + n;
            v4u o;
            o.x = (unsigned)s[0 * TRP8] | ((unsigned)s[1 * TRP8] << 8) | ((unsigned)s[2 * TRP8] << 16) | ((unsigned)s[3 * TRP8] << 24);
            o.y = (unsigned)s[4 * TRP8] | ((unsigned)s[5 * TRP8] << 8) | ((unsigned)s[6 * TRP8] << 16) | ((unsigned)s[7 * TRP8] << 24);
            o.z = (unsigned)s[8 * TRP8] | ((unsigned)s[9 * TRP8] << 8) | ((unsigned)s[10 * TRP8] << 16) | ((unsigned)s[11 * TRP8] << 24);
            o.w = (unsigned)s[12 * TRP8] | ((unsigned)s[13 * TRP8] << 8) | ((unsigned)s[14 * TRP8] << 16) | ((unsigned)s[15 * TRP8] << 24);
            *(GAS v4u*)(WT + (size_t)(drow0 + n) * J.K + k0 + 16 * c) = o; }
    } else {
#pragma unroll
        for (int i = 0; i < 16; ++i) { const int kk = 4 * i + (lane >> 4); const float g = gg[i];
            v2u w; w.x = cvt_pk_bf16(v[i][0] * g, v[i][1] * g); w.y = cvt_pk_bf16(v[i][2] * g, v[i][3] * g);
            *(LAS v2u*)(scr + kk * TRP + 8 * (lane & 15)) = w; }
        LDS_WAIT(); asm volatile("" ::: "memory");
        const int c = lane & 7;
#pragma unroll
        for (int j = 0; j < 8; ++j) { const int n = (lane >> 3) + 8 * j; const LAS unsigned short* s = (const LAS unsigned short*)(scr + (8 * c) * TRP + 2 * n);
            v4u o; o.x = (unsigned)s[0] | ((unsigned)s[TRP / 2] << 16); o.y = (unsigned)s[2 * (TRP / 2)] | ((unsigned)s[3 * (TRP / 2)] << 16);
            o.z = (unsigned)s[4 * (TRP / 2)] | ((unsigned)s[5 * (TRP / 2)] << 16); o.w = (unsigned)s[6 * (TRP / 2)] | ((unsigned)s[7 * (TRP / 2)] << 16);
            *(GAS v4u*)(J.WT + (size_t)(drow0 + n) * J.K + k0 + 8 * c) = o; }
    }
    LDS_WAIT(); asm volatile("" ::: "memory");
}
__device__ __forceinline__ int tr_job(const TrJob& J, int base, int wv, int nw, LAS unsigned char* scr, int lane) {
    const int nit = tr_items(J);
    int it = (wv - base % nw + nw) % nw;
    f32x4 va[16], vb[16]; float ga[16], gb[16];
    if (it < nit) tr_load(J, it, va, ga, lane);
    while (it < nit) {
        const int nx = it + nw;
        if (nx < nit) tr_load(J, nx, vb, gb, lane);
        tr_store(J, it, va, ga, scr, lane);
        if (nx >= nit) break;
        const int nx2 = nx + nw;
        if (nx2 < nit) tr_load(J, nx2, va, ga, lane);
        tr_store(J, nx, vb, gb, scr, lane);
        it = nx2;
    }
    return base + nit;
}

constexpr int H_QT = 0, H_KT = 17408, H_QC = 34816, H_KH = 52224, H_VT = 70656, H_TOT = 89088, H_DEC = 93184, H_NRM = 93696  , H_END = 95744;
constexpr int TP = 272  , CP = 144  ;
__device__ __forceinline__ f32x16 mfma32(bf16x8 a, bf16x8 b, f32x16 c) { return __builtin_amdgcn_mfma_f32_32x32x16_bf16(a, b, c, 0, 0, 0); }
__device__ __forceinline__ bf16x8 pack8(const f32x16& v, int o) {
    v4u w; w.x = cvt_pk_bf16(v[o + 0], v[o + 1]); w.y = cvt_pk_bf16(v[o + 2], v[o + 3]); w.z = cvt_pk_bf16(v[o + 4], v[o + 5]); w.w = cvt_pk_bf16(v[o + 6], v[o + 7]);
    return __builtin_bit_cast(bf16x8, w);
}
__device__ __forceinline__ bf16x8 ld2x8(const LAS unsigned char* p) {
    const v2u a = *(const LAS v2u*)p, b = *(const LAS v2u*)(p + 16); v4u w; w.x = a.x; w.y = a.y; w.z = b.x; w.w = b.y; return __builtin_bit_cast(bf16x8, w);
}
struct HgRegs { unsigned lf[8], qs[8], v[8], lf32; };
#define EX2(x) __builtin_amdgcn_exp2f(x)
__device__ __forceinline__ void hg_finish(LAS unsigned char* L, int nbuf, const f32x16& O, const v2u (&gs)[4], const f32x4 (&gn_)[4], bf16* A2o, int tb, int r) {
    float tot = 0.f;
#pragma unroll
    for (int e4 = 0; e4 < 4; ++e4) tot += *(const LAS float*)(L + H_NRM + nbuf * 1024 + (e4 * 64 + 32 * tb + r) * 4);
    const float rstd = 1.0f / sqrtf(tot * (1.0f / HD) + EPS);
#pragma unroll
    for (int q = 0; q < 4; ++q) {
        const f32x4 gn = gn_[q];
        const float o0 = O[4 * q + 0] * rstd * gn[0] * bflo(gs[q].x), o1 = O[4 * q + 1] * rstd * gn[1] * bfhi(gs[q].x);
        const float o2 = O[4 * q + 2] * rstd * gn[2] * bflo(gs[q].y), o3 = O[4 * q + 3] * rstd * gn[3] * bfhi(gs[q].y);
        v2u wv; wv.x = cvt_pk_bf16(o0, o1); wv.y = cvt_pk_bf16(o2, o3);
        *(v2u*)(A2o + 8 * q) = wv; }
}
__device__ __forceinline__ void hgrn_phase(Frame& F, const bf16* U, bf16* A2, const float* hgain) {
    const int b = F.bx >> 3, h = F.bx & 7, w = F.wave, lane = F.lane;
    LAS unsigned char* L = F.lds;
    const int eb = w >> 1, tb = w & 1, r = lane & 31, hh = lane >> 5;
    f32x16 S[4];
#pragma unroll
    for (int d = 0; d < 4; ++d)
#pragma unroll
        for (int i = 0; i < 16; ++i) S[d][i] = 0.f;
    const size_t rowbase0 = (size_t)b * SEQ;
    const bf16* Ucol = U + h * HD + 2 * lane;
    f32x4 gn_[4];
#pragma unroll
    for (int q = 0; q < 4; ++q) gn_[q] = *(const f32x4*)(hgain + h * HD + 32 * eb + 8 * q + 4 * hh);
    const bf16* Ugs = U + 3072 + h * HD + 32 * eb + 4 * hh + (rowbase0 + 32 * tb + r) * UP;
    bf16* A2o = A2 + (rowbase0 + 32 * tb + r) * DM + h * HD + 32 * eb + 4 * hh;
    HgRegs R; v2u gs_[4], gsp_[4];
    f32x16 Op;
#pragma unroll
    for (int i = 0; i < 16; ++i) Op[i] = 0.f;
#define HG_LOAD(n) do { const bf16* p = Ucol + (rowbase0 + (size_t)(n) * CHUNK + 8 * w) * UP; \
        _Pragma("unroll") for (int j = 0; j < 8; ++j) { R.qs[j] = *(const unsigned*)(p + (size_t)j * UP); R.lf[j] = *(const unsigned*)(p + (size_t)j * UP + 1024); R.v[j] = *(const unsigned*)(p + (size_t)j * UP + 2048); } \
        R.lf32 = *(const unsigned*)(Ucol + (rowbase0 + (size_t)(n) * CHUNK + 32) * UP + 1024); \
        _Pragma("unroll") for (int q = 0; q < 4; ++q) gs_[q] = *(const v2u*)(Ugs + (size_t)(n) * CHUNK * UP + 8 * q); } while (0)
    HG_LOAD(0);
    for (int n = 0; n < SEQ / CHUNK; ++n) {
        f32x2 c[8];
        { f32x2 a = (f32x2){0.f, 0.f};
#pragma unroll
          for (int j = 0; j < 8; ++j) { a += (f32x2){bflo(R.lf[j]), bfhi(R.lf[j])}; c[j] = a; }
          *(LAS f32x2*)(L + H_TOT + (w * 128 + 2 * lane) * 4) = a; }
        LDS_BAR();
        if (n > 0) hg_finish(L, (n - 1) & 1, Op, gsp_, gn_, A2o + (size_t)(n - 1) * CHUNK * DM, tb, r);
        { f32x2 pre = (f32x2){0.f, 0.f}, ref = pre, last = pre;
#pragma unroll
          for (int ww = 0; ww < 8; ++ww) { const f32x2 t = *(const LAS f32x2*)(L + H_TOT + (ww * 128 + 2 * lane) * 4);
              if (ww < w) pre += t; if (ww < 4) ref += t; last += t; }
          ref += (f32x2){bflo(R.lf32), bfhi(R.lf32)};
          const f32x2 lr = last - ref;
          const f32x2 eref = (f32x2){EX2(ref.x), EX2(ref.y)}, elr = (f32x2){EX2(lr.x), EX2(lr.y)};
          if (w == 0) *(LAS f32x2*)(L + H_DEC + 2 * lane * 4) = (f32x2){EX2(last.x), EX2(last.y)};
          unsigned kh0[4], kh1[4], vt0[4], vt1[4];
#pragma unroll
          for (int j = 0; j < 8; ++j) {
              const f32x2 d1 = (pre + c[j]) - ref;
              const f32x2 E1 = (f32x2){EX2(d1.x), EX2(d1.y)}, E2 = (f32x2){fast_rcp(E1.x), fast_rcp(E1.y)};
              const f32x2 fv = (f32x2){EX2(bflo(R.lf[j])), EX2(bfhi(R.lf[j]))};
              const f32x2 kq = (f32x2){1.0f, 1.0f} - fv, q = (f32x2){bflo(R.qs[j]), bfhi(R.qs[j])};
              const f32x2 qt = q * E1, kt = kq * E2, qc = qt * eref, kh = kt * elr;
              const int t = 8 * w + j;
              *(LAS unsigned*)(L + H_QT + t * TP + 4 * lane) = cvt_pk_bf16(qt.x, qt.y);
              *(LAS unsigned*)(L + H_KT + t * TP + 4 * lane) = cvt_pk_bf16(kt.x, kt.y);
              *(LAS unsigned*)(L + H_QC + t * TP + 4 * lane) = cvt_pk_bf16(qc.x, qc.y);
              const unsigned kk = cvt_pk_bf16(kh.x, kh.y);
              if (j & 1) { kh0[j >> 1] |= (kk << 16); kh1[j >> 1] |= (kk & 0xffff0000u); vt0[j >> 1] |= (R.v[j] << 16); vt1[j >> 1] |= (R.v[j] & 0xffff0000u); }
              else { kh0[j >> 1] = kk & 0xffffu; kh1[j >> 1] = kk >> 16; vt0[j >> 1] = R.v[j] & 0xffffu; vt1[j >> 1] = R.v[j] >> 16; }
          }
          *(LAS v4u*)(L + H_KH + (2 * lane) * CP + 16 * w) = (v4u){kh0[0], kh0[1], kh0[2], kh0[3]};
          *(LAS v4u*)(L + H_KH + (2 * lane + 1) * CP + 16 * w) = (v4u){kh1[0], kh1[1], kh1[2], kh1[3]};
          *(LAS v4u*)(L + H_VT + (2 * lane) * CP + 16 * w) = (v4u){vt0[0], vt0[1], vt0[2], vt0[3]};
          *(LAS v4u*)(L + H_VT + (2 * lane + 1) * CP + 16 * w) = (v4u){vt1[0], vt1[1], vt1[2], vt1[3]};
        }
        LDS_BAR();
#pragma unroll
        for (int q = 0; q < 4; ++q) gsp_[q] = gs_[q];
        if (n + 1 < SEQ / CHUNK) HG_LOAD(n + 1);
        f32x16 O;
#pragma unroll
        for (int i = 0; i < 16; ++i) O[i] = 0.f;
#pragma unroll
        for (int sb = 0; sb < 2; ++sb) {
            if (sb <= tb) {
                f32x16 P;
#pragma unroll
                for (int i = 0; i < 16; ++i) P[i] = 0.f;
#pragma unroll
                for (int kh = 0; kh < 2; ++kh) {
                    bf16x8 fa[4], fb[4];
#pragma unroll
                    for (int k4 = 0; k4 < 4; ++k4) { const int ks = 4 * kh + k4; fa[k4] = *(const LAS bf16x8*)(L + H_KT + (32 * sb + r) * TP + (16 * ks + 8 * hh) * 2); fb[k4] = *(const LAS bf16x8*)(L + H_QT + (32 * tb + r) * TP + (16 * ks + 8 * hh) * 2); }
#pragma unroll
                    for (int k4 = 0; k4 < 4; ++k4) P = mfma32(fa[k4], fb[k4], P);
                }
                if (sb == tb) {
#pragma unroll
                    for (int i = 0; i < 16; ++i) { const int s = (i & 3) + 8 * (i >> 2) + 4 * hh; if (s > r) P[i] = 0.f; }
                }
#pragma unroll
                for (int k2 = 0; k2 < 2; ++k2) {
                    const bf16x8 av = ld2x8(L + H_VT + (32 * eb + r) * CP + (32 * sb + 16 * k2 + 4 * hh) * 2);
                    O = mfma32(av, pack8(P, 8 * k2), O);
                }
            }
        }
        { bf16x8 fq[8];
#pragma unroll
          for (int i = 0; i < 8; ++i) fq[i] = ld2x8(L + H_QC + (32 * tb + r) * TP + (32 * (i >> 1) + 16 * (i & 1) + 4 * hh) * 2);
#pragma unroll
          for (int i = 0; i < 8; ++i) O = mfma32(pack8(S[i >> 1], 8 * (i & 1)), fq[i], O); }
        { bf16x8 fv[4];
#pragma unroll
          for (int ks = 0; ks < 4; ++ks) fv[ks] = *(const LAS bf16x8*)(L + H_VT + (32 * eb + r) * CP + (16 * ks + 8 * hh) * 2);
#pragma unroll
          for (int db = 0; db < 4; ++db) {
              bf16x8 fk[4];
#pragma unroll
              for (int ks = 0; ks < 4; ++ks) fk[ks] = *(const LAS bf16x8*)(L + H_KH + (32 * db + r) * CP + (16 * ks + 8 * hh) * 2);
#pragma unroll
              for (int q = 0; q < 4; ++q) { const f32x4 dc = *(const LAS f32x4*)(L + H_DEC + (32 * db + 8 * q + 4 * hh) * 4);
                  S[db][4 * q + 0] *= dc[0]; S[db][4 * q + 1] *= dc[1]; S[db][4 * q + 2] *= dc[2]; S[db][4 * q + 3] *= dc[3]; }
#pragma unroll
              for (int ks = 0; ks < 4; ++ks) S[db] = mfma32(fk[ks], fv[ks], S[db]);
          } }
        float ssq = 0.f;
#pragma unroll
        for (int i = 0; i < 16; ++i) ssq += O[i] * O[i];
        ssq += __shfl_xor(ssq, 32);
        if (hh == 0) *(LAS float*)(L + H_NRM + (n & 1) * 1024 + (eb * 64 + 32 * tb + r) * 4) = ssq;
        Op = O;
    }
    LDS_BAR();
    hg_finish(L, (SEQ / CHUNK - 1) & 1, Op, gsp_, gn_, A2o + (size_t)(SEQ / CHUNK - 1) * CHUNK * DM, tb, r);
#undef HG_LOAD
}
#undef EX2
__device__ __forceinline__ void conv_phase(Frame& F, const bf16* U, bf16* A2, const float* convw, int first_block) {
    const int nb = F.G - first_block, me = F.bx - first_block, c = 2 * F.tid;
    const float w00 = convw[c], w01 = convw[c + 1], w10 = convw[DC + c], w11 = convw[DC + c + 1], w20 = convw[2 * DC + c], w21 = convw[2 * DC + c + 1];
    for (int u = me; u < M / 32; u += nb) {
        const int R0 = u * 32, t0 = R0 % SEQ;
        const bf16* up = U + (size_t)R0 * UP;
        float a0 = 0.f, a1 = 0.f, b0 = 0.f, b1 = 0.f;
        if (t0 != 0) { const unsigned p2 = *(const unsigned*)(up - 2 * (size_t)UP + 5120 + c), p1 = *(const unsigned*)(up - (size_t)UP + 5120 + c);
            a0 = bflo(p2); a1 = bfhi(p2); b0 = bflo(p1); b1 = bfhi(p1); }
#pragma unroll 8
        for (int j = 0; j < 32; ++j) {
            const unsigned tt = *(const unsigned*)(up + (size_t)j * UP + 5120 + c), gb = *(const unsigned*)(up + (size_t)j * UP + 4096 + c);
            const float t0f = bflo(tt), t1f = bfhi(tt);
            const float y0 = bflo(gb) * (w00 * a0 + w10 * b0 + w20 * t0f), y1 = bfhi(gb) * (w01 * a1 + w11 * b1 + w21 * t1f);
            *(unsigned*)(A2 + (size_t)(R0 + j) * DM + DH + c) = cvt_pk_bf16(y0, y1);
            a0 = b0; a1 = b1; b0 = t0f; b1 = t1f;
        }
    }
}

#ifndef PH_ENABLE
#define PH_ENABLE 0xffffffffu
#endif
#define PH(k) (((PH_ENABLE) >> (k)) & 1u)
#ifndef PROBE_DUP
#define PROBE_DUP (-1)
#endif
#define REPS(k) ((PROBE_DUP) == (k) ? 2 : 1)
__global__ void __launch_bounds__(NWAVES * 64, 2) fwd_kernel(Args args) {
    extern __shared__ __attribute__((aligned(16))) unsigned char lds[];
    Frame F;
    F.lds = (LAS unsigned char*)lds;
    F.MISC = (volatile LAS unsigned*)(F.lds + MISC_OFF);
    F.tid = threadIdx.x; F.lane = F.tid & 63; F.wave = __builtin_amdgcn_readfirstlane(F.tid >> 6);
    F.G = gridDim.x; F.bx = blockIdx.x;
    unsigned char* ws = args.ws;
    F.ctl = (gu32*)(ws + WS_CTL);
    for (int u = F.tid; u < (LDS_BYTES - LDSCTL_OFF) / 4; u += NWAVES * 64) ((LAS unsigned*)(F.lds + LDSCTL_OFF))[u] = 0u;
    __syncthreads();
    XcdBarrier bar = xcd_barrier_post((unsigned*)(F.ctl + CW_BAR), F.MISC + 8);
#define GRID_BAR() do { xcd_barrier(bar); if (PROBE_DUP == 99) xcd_barrier(bar); } while (0)
#define REFRESH() do { int t_ = threadIdx.x; asm volatile("" : "+v"(t_)); F.tid = t_; F.lane = t_ & 63; F.wave = __builtin_amdgcn_readfirstlane(t_ >> 6); \
        int b_ = blockIdx.x; asm volatile("" : "+s"(b_)); F.bx = b_; gw = F.bx * NWAVES + F.wave; \
        kp_ = (const float* const __attribute__((address_space(4)))*)__builtin_amdgcn_kernarg_segment_ptr(); asm volatile("" : "+s"(kp_)); \
        ws_ = (unsigned char*)kp_[25]; X_ = (float*)kp_[24]; } while (0)
    const float* const __attribute__((address_space(4)))* kp_ = (const float* const __attribute__((address_space(4)))*)__builtin_amdgcn_kernarg_segment_ptr();
    unsigned char* ws_ = args.ws; float* X_ = args.out;
#define I_x (kp_[0])
#define I_p (kp_[1])
#define I_final_gain (kp_[2])
#define I_lb_table (kp_[3])
#define I_mix_norm_even (kp_[4])
#define I_w_in (kp_[5])
#define I_hgrn_gain (kp_[6])
#define I_conv_w (kp_[7])
#define I_w_out (kp_[8])
#define I_ffn_norm_even (kp_[9])
#define I_w_gate (kp_[10])
#define I_w_up (kp_[11])
#define I_w_down (kp_[12])
#define I_mix_norm_odd (kp_[13])
#define I_pool_w (kp_[14])
#define I_pool_scale (kp_[15])
#define I_ffn_norm_odd (kp_[16])
#define I_w_router (kp_[17])
#define I_w_gate_e (kp_[18])
#define I_w_up_e (kp_[19])
#define I_w_down_e (kp_[20])
#define I_ple_norm (kp_[21])
#define I_ple_gate_w (kp_[22])
#define I_ple_proj (kp_[23])
#define W_lbv ((float*)(ws_ + WS_LBV))
#define W_rs4 ((float*)(ws_ + WS_RS4))
#define W_topi ((int*)(ws_ + WS_TOP))
#define W_topw ((float*)(ws_ + WS_TOPW))
#define W_sspA ((float*)(ws_ + WS_SSPA))
#define W_sspB ((float*)(ws_ + WS_SSPB))
#define W_list ((int*)(ws_ + WS_LIST))
#define W_gwl ((float*)(ws_ + WS_GWL))
#define W_rsl ((float*)(ws_ + WS_TOKC))
#define W_tokc ((int*)(ws_ + WS_TOKC))
#define W_gwc ((float*)(ws_ + WS_GWC))
#define W_rsc ((float*)(ws_ + WS_RSC))
#define W_Win_t ((bf16*)(ws_ + WS_WIN))
#define W_Wout_t ((bf16*)(ws_ + WS_WOUT))
#define W_Wgu_t ((bf16*)(ws_ + WS_WGU))
#define W_Wd_t ((bf16*)(ws_ + WS_WD))
#define W_Wpool_t ((bf16*)(ws_ + WS_WPOOL))
#define W_Wmgu_t ((bf16*)(ws_ + WS_WMGU))
#define W_Wmd_t ((bf16*)(ws_ + WS_WMD))
#define W_Wpg_t ((bf16*)(ws_ + WS_WPG))
#define W_Wpp_t ((bf16*)(ws_ + WS_WPP))
#define W_PB ((bf16*)(ws_ + WS_PB))
#define W_XB ((bf16*)(ws_ + WS_XB))
#define W_A2 ((bf16*)(ws_ + WS_A2))
#define W_PJ ((bf16*)(ws_ + WS_A2))
#define W_U ((bf16*)(ws_ + WS_BIG))
#define W_Hh ((bf16*)(ws_ + WS_BIG))
#define W_D1 ((bf16*)(ws_ + WS_BIG))
#define W_XG ((bf16*)(ws_ + WS_BIG))
#define W_HE ((bf16*)(ws_ + WS_HE))
#define W_X (X_)
#define W_XS0 ((bf16*)(ws_ + WS_XB))
#define W_XQ ((unsigned char*)X_)
#define W_XQ1 ((unsigned char*)X_ + 64 * MiB)
#define W_XS1 ((bf16*)((unsigned char*)X_ + 64 * MiB))
#define W_XB0 ((bf16*)X_)
    int gw = F.bx * NWAVES + F.wave; const int NGW = F.G * NWAVES;

#ifndef CONV_MODE
#define CONV_MODE 0
#endif
#define CONVERT_REST(FIRSTB) do { \
            LDS_BAR(); \
            LAS unsigned char* scr = F.lds + F.wave * 16384; \
            const int wv = (F.bx - (FIRSTB)) * NWAVES + F.wave, nw = (F.G - (FIRSTB)) * NWAVES; int base = 0; \
            { const TrJob J{I_w_out, I_w_out, 0, 0, DM, DM, DM, 0, W_Wout_t, nullptr, 0}; base = tr_job(J, base, wv, nw, scr, F.lane); } \
            { const TrJob J{I_w_gate, I_w_up, 0, 0, DFF, DM, 0, DFF / 128, W_Wgu_t, I_ffn_norm_even, F8_GU}; base = tr_job(J, base, wv, nw, scr, F.lane); } \
            { const TrJob J{I_w_down, I_w_down, 0, 0, DM, DFF, DM, 0, W_Wd_t, nullptr, F8_DN}; base = tr_job(J, base, wv, nw, scr, F.lane); } \
            for (int i = 0; i < 2; ++i) { const TrJob J{I_ple_proj + (size_t)i * DPLE * DM, nullptr, 0, 0, DM, DPLE, DM, 0, W_Wpp_t + (size_t)i * DM * DPLE, nullptr, 0}; base = tr_job(J, base, wv, nw, scr, F.lane); } \
            for (int i = 0; i < 2; ++i) { const TrJob J{I_ple_gate_w + (size_t)i * DM * DM, nullptr, 0, 0, DM, DM, DM, 0, W_Wpg_t + (size_t)i * DM * DM, I_ple_norm + i * DM, (i == 1 && F8_PLE1) ? 1 : 0}; base = tr_job(J, base, wv, nw, scr, F.lane); } \
            for (int g = 0; g < 4; ++g) { const TrJob J{I_pool_w + (size_t)g * 512 * 512, nullptr, 0, 0, 512, 512, 512, 0, W_Wpool_t + (size_t)512 * g * 512, I_mix_norm_odd + 512 * g, 0}; base = tr_job(J, base, wv, nw, scr, F.lane); } \
            for (int e = 0; e < NE; ++e) { const TrJob J{I_w_gate_e + (size_t)e * DM * DFE, I_w_up_e + (size_t)e * DM * DFE, 0, 0, DFE, DM, 0, DFE / 128, W_Wmgu_t + (size_t)e * 2048 * DM / (F8_MOE ? 2 : 1), I_ffn_norm_odd, F8_MOE}; base = tr_job(J, base, wv, nw, scr, F.lane); } \
            for (int e = 0; e < NE; ++e) { const TrJob J{I_w_down_e + (size_t)e * DFE * DM, nullptr, 0, 0, DM, DFE, DM, 0, W_Wmd_t + (size_t)e * DM * DFE / (F8_MOE ? 2 : 1), nullptr, F8_MOE}; base = tr_job(J, base, wv, nw, scr, F.lane); } \
            for (size_t i = (size_t)(F.bx - (FIRSTB)) * 512 + F.tid; i < (size_t)2 * M * DPLE / 8; i += (size_t)(F.G - (FIRSTB)) * 512) { \
                const f32x4 a = ((const f32x4*)I_p)[2 * i], b2 = ((const f32x4*)I_p)[2 * i + 1]; \
                v4u w; w.x = cvt_pk_bf16(a[0], a[1]); w.y = cvt_pk_bf16(a[2], a[3]); w.z = cvt_pk_bf16(b2[0], b2[1]); w.w = cvt_pk_bf16(b2[2], b2[3]); ((v4u*)W_PB)[i] = w; } \
        } while (0)
    for (int rep_ = 0; rep_ < REPS(0); ++rep_) { REFRESH();
        LAS unsigned char* scr = F.lds + F.wave * 16384;
        int base = 0;
        { const TrJob J{I_w_in, I_w_in, 0, 0, NIN, DM, 5120, 0, W_Win_t, I_mix_norm_even, 0}; base = tr_job(J, base, gw, NGW, scr, F.lane); }
        { const TrJob J{I_w_in, I_w_in, 5120, 6144, NIN, DM, 0, 8, W_Win_t + (size_t)5120 * DM, I_mix_norm_even, 0}; base = tr_job(J, base, gw, NGW, scr, F.lane); }
        for (int m = gw; m < M; m += NGW) {
            const GAS f32x4* xr = (const GAS f32x4*)(I_x + (size_t)m * DM) + F.lane; GAS v2u* o8 = (GAS v2u*)(W_XB0 + (size_t)m * DM) + F.lane; float s = 0.f;
#pragma unroll
            for (int j = 0; j < 8; ++j) { const f32x4 v = xr[64 * j]; s += (v[0] * v[0] + v[1] * v[1]) + (v[2] * v[2] + v[3] * v[3]); v2u w; w.x = cvt_pk_bf16(v[0], v[1]); w.y = cvt_pk_bf16(v[2], v[3]); o8[64 * j] = w; }
            s = wave_sum(s);
            if (F.lane < 32) W_sspA[(size_t)m * 32 + F.lane] = (F.lane == 0) ? s : 0.f;
        }
        if (F.bx == 0) for (int j = F.tid; j < DH; j += 512) { const float t0 = I_lb_table[j], t1 = I_lb_table[DH + j], t2 = I_lb_table[2 * DH + j]; const float mx = fmaxf(t0, fmaxf(t1, t2));
            const float e0 = __expf(t0 - mx), e1 = __expf(t1 - mx), e2 = __expf(t2 - mx); W_lbv[j] = e0 / (e0 + e1 + e2); }
    }
    GRID_BAR();
    const size_t TB2048 = (size_t)256 * DM * 2;
    for (int rep_ = 0; rep_ < (PH(1) ? REPS(1) : 0); ++rep_) { REFRESH();
        SchedGrid S; S.o.init(M / 256, NIN / 256, F.G, F.bx); S.A = (const char*)W_XB0; S.B = (const char*)W_Win_t; S.at = TB2048; S.bt = TB2048;
        if (RS_TABLE) build_rstd_table(F.lds, S, W_sspA, F.tid);
        EpiInProj E{W_U, W_sspA, W_lbv, (const LAS float*)(F.lds + RS_TBL_OFF)};
        pg8::gemm_phase<EpiInProj, SchedGrid, true>(F.lds, DM, DM, DM, S, E);
    }
    GRID_BAR();
    for (int rep_ = 0; rep_ < REPS(2); ++rep_) { REFRESH(); if (F.bx < BATCH * NH) { hgrn_phase(F, W_U, W_A2, I_hgrn_gain); if (PROBE_DUP == 20) hgrn_phase(F, W_U, W_A2, I_hgrn_gain); }
        else for (int rep2_ = 0; rep2_ < (PROBE_DUP == 21 ? 2 : 1); ++rep2_) {
            conv_phase(F, W_U, W_A2, I_conv_w, BATCH * NH);
            if (CONV_MODE == 0) CONVERT_REST(BATCH * NH);
        }
    }
    GRID_BAR();
    if (CONV_MODE == 1) { for (int rep_ = 0; rep_ < REPS(16); ++rep_) { REFRESH(); CONVERT_REST(0); } GRID_BAR(); }
    for (int rep_ = 0; rep_ < (PH(3) ? REPS(3) : 0); ++rep_) { REFRESH();
        SchedGrid S; S.o.init(M / 256, DM / 256, F.G, F.bx); S.A = (const char*)W_A2; S.B = (const char*)W_Wout_t; S.at = TB2048; S.bt = TB2048;
        EpiResid<0, false, F8_GU> E{nullptr, W_XB0, W_XS0, W_sspB, nullptr, nullptr, nullptr, W_XQ1};
        pg8::gemm_phase<EpiResid<0, false, F8_GU>, SchedGrid, true>(F.lds, DM, DM, DM, S, E);
    }
    GRID_BAR();
    for (int rep_ = 0; rep_ < (PH(4) ? REPS(4) : 0); ++rep_) { REFRESH();
        constexpr int EB = F8_GU ? 1 : 2;
        SchedGrid S; S.o.init(M / 256, 2 * DFF / 256, F.G, F.bx); S.A = F8_GU ? (const char*)W_XQ1 : (const char*)W_XS0; S.B = (const char*)W_Wgu_t; S.at = (size_t)256 * DM * EB; S.bt = (size_t)256 * DM * EB;
        if (RS_TABLE) build_rstd_table(F.lds, S, W_sspB, F.tid);
        EpiSwiglu<false, F8_DN> E{W_Hh, DFF, W_sspB, nullptr, nullptr, (const LAS float*)(F.lds + RS_TBL_OFF)};
        pg8::gemm_phase<EpiSwiglu<false, F8_DN>, SchedGrid, true, F8_GU>(F.lds, DM * EB / 2, DM * EB / 2, DM * EB / 2, S, E);
        REFRESH();
        SchedGrid S2; S2.o.init(M / 256, DM / 256, F.G, F.bx); S2.A = (const char*)W_PB; S2.B = (const char*)W_Wpp_t; S2.at = (size_t)256 * DPLE * 2; S2.bt = (size_t)256 * DPLE * 2;
        EpiBf16Plain E2{W_PJ, DM};
        pg8::gemm_phase<EpiBf16Plain, SchedGrid, true>(F.lds, DPLE, DPLE, DPLE, S2, E2);
    }
    GRID_BAR();
    for (int rep_ = 0; rep_ < (PH(5) ? REPS(5) : 0); ++rep_) { REFRESH();
        SchedGrid S; S.o.init(M / 256, DM / 256, F.G, F.bx); constexpr int EB = F8_DN ? 1 : 2; S.A = (const char*)W_Hh; S.B = (const char*)W_Wd_t; S.at = (size_t)256 * DFF * EB; S.bt = (size_t)256 * DFF * EB;
        EpiResid<0, false> E{nullptr, W_XS0, W_XS0, W_sspA, nullptr, nullptr, nullptr, nullptr};
        pg8::gemm_phase<EpiResid<0, false>, SchedGrid, true, F8_DN>(F.lds, DFF * EB / 2, DFF * EB / 2, DFF * EB / 2, S, E);
    }
    GRID_BAR();
    for (int rep_ = 0; rep_ < (PH(6) ? REPS(6) : 0); ++rep_) { REFRESH();
        SchedGrid S; S.o.init(M / 256, DM / 256, F.G, F.bx); S.A = (const char*)W_XB; S.B = (const char*)W_Wpg_t; S.at = TB2048; S.bt = TB2048;
        EpiResid<2, false> E{nullptr, W_XS0, W_XS1, W_sspB, nullptr, W_sspA, W_PJ, nullptr};
        pg8::gemm_phase<EpiResid<2, false>, SchedGrid, true>(F.lds, DM, DM, DM, S, E);
    }
    GRID_BAR();
    for (int rep_ = 0; rep_ < (PH(7) ? REPS(7) : 0); ++rep_) { REFRESH();
        LAS float* rt = (LAS float*)F.lds;
        for (int seg = F.bx; seg < M / 64; seg += F.G) {
            const int R0 = seg * 64, t0 = R0 % SEQ;
            for (int i = F.wave; i < 80; i += NWAVES) { const int row = R0 - 16 + i; float v = 0.f;
                if (row >= 0 && F.lane < 32) v = W_sspB[(size_t)row * 32 + F.lane];
                v = wave_sum(v); if (F.lane == 0) rt[i] = 1.0f / sqrtf(v * (1.0f / DM) + EPS); }
            LDS_BAR();
            const int wdw = 2 << (F.tid >> 7);
            const bf16* xc = W_XS1 + (size_t)R0 * DM + 4 * F.tid;
#define LD4(ptr, sc) ({ const v2u q_ = *(const v2u*)(ptr); f32x4 r_; r_[0] = bflo(q_.x) * (sc); r_[1] = bfhi(q_.x) * (sc); r_[2] = bflo(q_.y) * (sc); r_[3] = bfhi(q_.y) * (sc); r_; })
            f32x4 Ssum = (f32x4){0.f, 0.f, 0.f, 0.f};
            for (int k = 1; k <= wdw; ++k) if (t0 - k >= 0) Ssum += LD4(xc - (size_t)k * DM, rt[16 - k]);
#pragma unroll 4
            for (int j = 0; j < 64; ++j) {
                const f32x4 hv = LD4(xc + (size_t)j * DM, rt[16 + j]);
                Ssum += hv;
                const int tp = t0 + j;
                if (tp - wdw >= 0) Ssum -= LD4(xc + (size_t)(j - wdw) * DM, rt[16 + j - wdw]);
                const float inv = 1.0f / (float)((tp + 1 < wdw) ? (tp + 1) : wdw);
                const f32x4 d = Ssum * inv - hv;
                v2u w; w.x = cvt_pk_bf16(d[0], d[1]); w.y = cvt_pk_bf16(d[2], d[3]);
                *(v2u*)(W_D1 + (size_t)(R0 + j) * DM + 4 * F.tid) = w;
            }
#undef LD4
            LDS_BAR();
        }
    }
    GRID_BAR();
    for (int rep_ = 0; rep_ < (PH(8) ? REPS(8) : 0); ++rep_) { REFRESH();
        SchedPool S; S.o.init(M / 256, DM / 256, F.G, F.bx); S.A = (const char*)W_D1; S.B = (const char*)W_Wpool_t; S.at = TB2048; S.bt = (size_t)256 * 512 * 2;
        EpiResid<1, false, F8_MOE> E{nullptr, W_XS1, W_XS1, W_sspA, I_pool_scale, nullptr, nullptr, W_XQ};
        pg8::gemm_phase<EpiResid<1, false, F8_MOE>, SchedPool, true>(F.lds, 512, DM, 512, S, E);
    }
    GRID_BAR();
    for (int rep_ = 0; rep_ < (PH(9) ? REPS(9) : 0); ++rep_) { REFRESH();
        LAS float* wr = (LAS float*)F.lds;
        LAS int* e12 = (LAS int*)(F.lds + 65536);
        LAS float* w12 = (LAS float*)(F.lds + 65536 + 512);
        LAS float* rs1 = (LAS float*)(F.lds + 65536 + 1024);
        for (int i = F.tid; i < DM * NE / 4; i += 512) { const int k = i >> 1, e0 = (i & 1) * 4; const f32x4 v = *(const f32x4*)(I_w_router + (size_t)k * NE + e0) * I_ffn_norm_odd[k];
            *(LAS f32x4*)(wr + (((k & 7) * 256 + (k >> 3)) * 8 + e0)) = v; }
        LDS_BAR();
        for (int seg = F.bx; seg < M / 64; seg += F.G) {
            v4u xcur[4], xnxt[4];
            { const GAS v4u* xr0 = (const GAS v4u*)(W_XS1 + (size_t)(seg * 64 + F.wave * 8) * DM) + F.lane;
#pragma unroll
              for (int c = 0; c < 4; ++c) xcur[c] = xr0[64 * c]; }
            for (int rr = 0; rr < 8; ++rr) {
                const int lrow = F.wave * 8 + rr, row = seg * 64 + lrow;
                if (rr < 7) { const GAS v4u* xr1 = (const GAS v4u*)(W_XS1 + (size_t)(row + 1) * DM) + F.lane;
#pragma unroll
                    for (int c = 0; c < 4; ++c) xnxt[c] = xr1[64 * c]; }
                float acc[8]; float ss = 0.f;
#pragma unroll
                for (int e = 0; e < 8; ++e) acc[e] = 0.f;
#pragma unroll
                for (int c = 0; c < 4; ++c) { f32x4 xa, xb; unpack8(xcur[c], xa, xb);
                    ss += ((xa[0] * xa[0] + xa[1] * xa[1]) + (xa[2] * xa[2] + xa[3] * xa[3])) + ((xb[0] * xb[0] + xb[1] * xb[1]) + (xb[2] * xb[2] + xb[3] * xb[3]));
#pragma unroll
                    for (int kk = 0; kk < 8; ++kk) { const float xk = kk < 4 ? xa[kk & 3] : xb[kk & 3];
                        const LAS float* wp = wr + ((kk * 256 + c * 64 + F.lane) * 8); const f32x4 w0 = *(const LAS f32x4*)wp, w1 = *(const LAS f32x4*)(wp + 4);
                        acc[0] += xk * w0[0]; acc[1] += xk * w0[1]; acc[2] += xk * w0[2]; acc[3] += xk * w0[3];
                        acc[4] += xk * w1[0]; acc[5] += xk * w1[1]; acc[6] += xk * w1[2]; acc[7] += xk * w1[3]; } }
                ss = wave_sum(ss);
#pragma unroll
                for (int e = 0; e < 8; ++e) acc[e] = wave_sum(acc[e]);
                const float rstd = 1.0f / sqrtf(ss * (1.0f / DM) + EPS);
                int i1 = 0; float l1 = acc[0];
#pragma unroll
                for (int e = 1; e < 8; ++e) if (acc[e] > l1) { l1 = acc[e]; i1 = e; }
                int i2 = -1; float l2 = -3.0e38f;
#pragma unroll
                for (int e = 0; e < 8; ++e) if (e != i1 && acc[e] > l2) { l2 = acc[e]; i2 = e; }
                const float wt1 = 1.0f / (1.0f + __expf((l2 - l1) * rstd)), wt2 = 1.0f - wt1;
                if (F.lane == 0) { e12[2 * lrow] = i1; e12[2 * lrow + 1] = i2; w12[2 * lrow] = wt1; w12[2 * lrow + 1] = wt2; rs1[lrow] = rstd; }
#pragma unroll
                for (int c = 0; c < 4; ++c) xcur[c] = xnxt[c];
            }
            LDS_BAR();
            if (F.wave == 0) {
                const int row = seg * 64 + F.lane; const int e1 = e12[2 * F.lane], e2 = e12[2 * F.lane + 1]; const float wt1 = w12[2 * F.lane], wt2 = w12[2 * F.lane + 1], rsv = rs1[F.lane];
                unsigned long long mk[16]; int mycnt = 0;
#pragma unroll
                for (int g = 0; g < 16; ++g) { const bool pr = (g < 8) ? (e1 == g) : (e2 == g - 8); mk[g] = __ballot(pr); if (F.lane == g) mycnt = __popcll(mk[g]); }
                int base = 0;
                if (F.lane < 16) base = (int)__hip_atomic_fetch_add((unsigned*)(F.ctl + CW_MOE) + F.lane, (unsigned)mycnt, RLX_AGENT);
                const unsigned long long lt = (1ull << F.lane) - 1ull;
#pragma unroll
                for (int g = 0; g < 16; ++g) { const int bg = __shfl(base, g); const bool pr = (g < 8) ? (e1 == g) : (e2 == g - 8);
                    if (pr) { const int slot = bg + __popcll(mk[g] & lt); W_list[(size_t)g * M + slot] = row; W_gwl[(size_t)g * M + slot] = (g < 8) ? wt1 : wt2; W_rsl[(size_t)g * M + slot] = rsv; } }
            }
            LDS_BAR();
        }
    }
    GRID_BAR();
    LAS int* tile_e = (LAS int*)(F.lds + LDSCTL_OFF + 1024);
    LAS int* tile_g = (LAS int*)(F.lds + LDSCTL_OFF + 1024 + 640);
    LAS int* tile_s0 = (LAS int*)(F.lds + LDSCTL_OFF + 1024 + 1280);
    LAS int* gtab = (LAS int*)(F.lds + LDSCTL_OFF + 1024 + 1920);
    for (int rep_ = 0; rep_ < (PH(11) ? REPS(11) : 0); ++rep_) { REFRESH();
        if (F.tid == 0) { int ti = 0;
            for (int g = 0; g < 16; ++g) { const int c = (int)__hip_atomic_load((unsigned*)(F.ctl + CW_MOE) + g, RLX_AGENT); const int nt = (c + 255) >> 8;
                gtab[g] = c; for (int t = 0; t < nt; ++t) { tile_e[ti] = g & 7; tile_g[ti] = g; tile_s0[ti] = t * 256; ++ti; } if (g == 7) gtab[17] = ti; }
            gtab[16] = ti; }
        LDS_BAR();
        constexpr int EB = F8_MOE ? 1 : 2;
        SchedMoe S{tile_e, tile_g, tile_s0, gtab, 0, gtab[16], F.G, F.bx, F8_MOE ? (const char*)W_XQ : (const char*)W_XS1, (const char*)W_Wmgu_t, 0, (size_t)256 * DM * EB, (size_t)2048 * DM * EB, W_list, true};
        EpiSwiglu<true, F8_MOE> E{W_HE, DFE, nullptr, W_rsl, W_list, nullptr};
        pg8::gemm_phase<EpiSwiglu<true, F8_MOE>, SchedMoe, true, F8_MOE, true>(F.lds, DM * EB / 2, DM * EB / 2, DM * EB / 2, S, E);
    }
    GRID_BAR();
    for (int rep_ = 0; rep_ < (PH(12) ? REPS(12) : 0); ++rep_) { REFRESH();
        constexpr int EB = F8_MOE ? 1 : 2;
        SchedMoe S{tile_e, tile_g, tile_s0, gtab, 0, gtab[17], F.G, F.bx, (const char*)W_HE, (const char*)W_Wmd_t, (size_t)256 * DFE * EB, (size_t)256 * DFE * EB, (size_t)DM * DFE * EB, W_list, false};
        EpiMoeDown<false> E{W_XS1, W_sspB, W_list, W_gwl, nullptr};
        pg8::gemm_phase<EpiMoeDown<false>, SchedMoe, true, F8_MOE>(F.lds, DFE * EB / 2, DFE * EB / 2, DFE * EB / 2, S, E);
        REFRESH();
        { const int rem = (gtab[17] * 8) % F.G; SchedFill S2{0, 256, DM / 256, F.bx >= rem ? F.bx - rem : -1, F.G - rem, (const char*)(W_PB + (size_t)M * DPLE), (const char*)(W_Wpp_t + (size_t)DM * DPLE), (size_t)256 * DPLE * 2, (size_t)256 * DPLE * 2};
          EpiBf16Plain E2{W_PJ, DM};
          pg8::gemm_phase<EpiBf16Plain, SchedFill, true>(F.lds, DPLE, DPLE, DPLE, S2, E2); }
    }
    GRID_BAR();
    for (int rep_ = 0; rep_ < (PH(13) ? REPS(13) : 0); ++rep_) { REFRESH();
        constexpr int EB = F8_MOE ? 1 : 2;
        SchedMoe S{tile_e, tile_g, tile_s0, gtab, gtab[17], gtab[16], F.G, F.bx, (const char*)W_HE, (const char*)W_Wmd_t, (size_t)256 * DFE * EB, (size_t)256 * DFE * EB, (size_t)DM * DFE * EB, W_list, false};
        EpiMoeDown<true, F8_PLE1> E{W_XS1, W_sspB, W_list, W_gwl, W_XQ};
        pg8::gemm_phase<EpiMoeDown<true, F8_PLE1>, SchedMoe, true, F8_MOE>(F.lds, DFE * EB / 2, DFE * EB / 2, DFE * EB / 2, S, E);
        REFRESH();
        { const int rem = ((gtab[16] - gtab[17]) * 8) % F.G; SchedFill S2{256, 512, DM / 256, F.bx >= rem ? F.bx - rem : -1, F.G - rem, (const char*)(W_PB + (size_t)M * DPLE), (const char*)(W_Wpp_t + (size_t)DM * DPLE), (size_t)256 * DPLE * 2, (size_t)256 * DPLE * 2};
          EpiBf16Plain E2{W_PJ, DM};
          pg8::gemm_phase<EpiBf16Plain, SchedFill, true>(F.lds, DPLE, DPLE, DPLE, S2, E2); }
    }
    GRID_BAR();
    for (int rep_ = 0; rep_ < (PH(14) ? REPS(14) : 0); ++rep_) { REFRESH();
        SchedGrid S; S.o.init(M / 256, DM / 256, F.G, F.bx); constexpr int EB = F8_PLE1 ? 1 : 2; S.A = F8_PLE1 ? (const char*)W_XQ : (const char*)W_XS1; S.B = (const char*)(W_Wpg_t + (size_t)DM * DM); S.at = (size_t)256 * DM * EB; S.bt = (size_t)256 * DM * EB;
        EpiResid<2, false> E{nullptr, W_XS1, W_XS0, W_sspA, nullptr, W_sspB, W_PJ, nullptr};
        pg8::gemm_phase<EpiResid<2, false>, SchedGrid, true, F8_PLE1>(F.lds, DM * EB / 2, DM * EB / 2, DM * EB / 2, S, E);
    }
    GRID_BAR();
    REFRESH();
    if (PH(15)) for (int m0 = gw; m0 < M; m0 += 4 * NGW) {
        v4u xv[4][4]; float sv[4];
#pragma unroll
        for (int q = 0; q < 4; ++q) { const int m = m0 + q * NGW; if (m < M) { const GAS v4u* xs = (const GAS v4u*)(W_XS0 + (size_t)m * DM) + F.lane;
#pragma unroll
                for (int j = 0; j < 4; ++j) xv[q][j] = xs[64 * j];
                sv[q] = (F.lane < 32) ? W_sspA[(size_t)m * 32 + F.lane] : 0.f; } }
#pragma unroll
        for (int q = 0; q < 4; ++q) { const int m = m0 + q * NGW; if (m < M) {
                const float rstd = 1.0f / sqrtf(wave_sum(sv[q]) * (1.0f / DM) + EPS);
                GAS f32x4* xo = (GAS f32x4*)(W_X + (size_t)m * DM) + 2 * F.lane; const f32x4* gp = (const f32x4*)I_final_gain + 2 * F.lane;
#pragma unroll
                for (int j = 0; j < 4; ++j) { f32x4 a, b; unpack8(xv[q][j], a, b); xo[128 * j] = a * rstd * gp[128 * j]; xo[128 * j + 1] = b * rstd * gp[128 * j + 1]; } } }
    }
}

extern "C" void kernel_launch(void* const* d_in, const int* in_sizes, int n_in, void* d_out, int out_size, void* d_ws, size_t ws_size, hipStream_t stream) {
    (void)in_sizes; (void)out_size;
    static int grid = 0;
    if (grid == 0) {
        if (n_in != 24 || ws_size < WS_END) { fprintf(stderr, "kernel_launch: bad arguments (n_in %d, ws %zu)\n", n_in, ws_size); grid = -1; return; }
        int dev = 0, cus = 0, per_cu = 0;
        if (hipGetDevice(&dev) != hipSuccess || hipDeviceGetAttribute(&cus, hipDeviceAttributeMultiprocessorCount, dev) != hipSuccess) { grid = -1; return; }
        if (hipFuncSetAttribute((const void*)fwd_kernel, hipFuncAttributeMaxDynamicSharedMemorySize, LDS_BYTES) != hipSuccess) { grid = -1; return; }
        if (hipOccupancyMaxActiveBlocksPerMultiprocessor(&per_cu, (const void*)fwd_kernel, NWAVES * 64, LDS_BYTES) != hipSuccess || per_cu < 1) { fprintf(stderr, "kernel_launch: occupancy query says %d\n", per_cu); }
        (void)hipGetLastError();
        grid = cus;
    }
    if (grid < 0) return;
    if (hipMemsetAsync((char*)d_ws + WS_CTL, 0, CTL_ZERO_BYTES, stream) != hipSuccess) return;
    Args a{};
    for (int i = 0; i < 24; ++i) a.in[i] = (const float*)d_in[i];
    a.out = (float*)d_out; a.ws = (unsigned char*)d_ws;
    hipLaunchKernelGGL(fwd_kernel, dim3(grid), dim3(NWAVES * 64), LDS_BYTES, stream, a);
}
```

```cpp
#include <hip/hip_runtime.h>
#include <cstdio>
#include <cstdint>

constexpr int DM = 2048, BATCH = 8, SEQ = 2048, M = BATCH * SEQ;
constexpr int DH = 1024, NH = 8, HD = 128, CHUNK = 64, DC = 1024, DFF = 5632, NE = 8, DFE = 1024, DPLE = 256;
constexpr int NIN = 7168;
constexpr int UP = 6144;
constexpr float EPS = 1e-6f;
constexpr int NWAVES = 8;
#ifndef RS_TABLE
#define RS_TABLE 1
#endif
#ifndef F8_GU
#define F8_GU 1
#endif
#ifndef F8_DN
#define F8_DN 1
#endif
#ifndef F8_MOE
#define F8_MOE 1
#endif
#ifndef F8_PLE1
#define F8_PLE1 1
#endif

constexpr size_t MiB = 1u << 20;
constexpr size_t WS_CTL = 0, CTL_ZERO_BYTES = 256 * 1024;
constexpr size_t WS_LBV = 1 * MiB;
constexpr size_t WS_RS4 = 1 * MiB + 64 * 1024;
constexpr size_t WS_TOP = 1 * MiB + 192 * 1024;
constexpr size_t WS_TOPW = 1 * MiB + 320 * 1024;
constexpr size_t WS_SSPA = 2 * MiB, WS_SSPB = 4 * MiB;
constexpr size_t WS_LIST = 6 * MiB;
constexpr size_t WS_GWL = 7 * MiB;
constexpr size_t WS_TOKC = 8 * MiB;
constexpr int RCAP = 36864;
constexpr size_t WS_GWC = WS_TOKC + (size_t)RCAP * 4, WS_RSC = WS_GWC + (size_t)RCAP * 4;
constexpr size_t WS_WIN = 10 * MiB;
constexpr size_t WS_WOUT = 38 * MiB;
constexpr size_t WS_WGU = 46 * MiB;
constexpr size_t WS_WD = 90 * MiB;
constexpr size_t WS_WPOOL = 112 * MiB;
constexpr size_t WS_WMGU = 114 * MiB;
constexpr size_t WS_WMD = 178 * MiB;
constexpr size_t WS_WPG = 210 * MiB;
constexpr size_t WS_WPP = 226 * MiB;
constexpr size_t WS_PB = 228 * MiB;
constexpr size_t WS_XB = 244 * MiB;
constexpr size_t WS_A2 = 308 * MiB;
constexpr size_t WS_BIG = 372 * MiB;
constexpr size_t WS_HE = 10 * MiB;
constexpr size_t WS_END = 564 * MiB;
static_assert(WS_BIG + (size_t)M * UP * 2 <= WS_END && WS_HE + (size_t)RCAP * DFE * 2 <= WS_WD, "ws map");
static_assert(WS_BIG + (size_t)RCAP * DM * 2 <= WS_END, "ws map XG");
static_assert(WS_BIG + (size_t)M * DFF <= WS_BIG + 128 * MiB && WS_BIG + 128 * MiB + (size_t)M * DM * 2 <= WS_END, "ws map PJ0 (H is fp8)");
constexpr int CW_BAR = 4096;
constexpr int CW_MOE = 16384;
constexpr int CW_DBG = 20000;

constexpr int RING_BYTES = 131072;
constexpr int LDSCTL_OFF = RING_BYTES, MISC_OFF = LDSCTL_OFF + 320;
constexpr int LDS_BYTES = 147456;

#define GAS __attribute__((address_space(1)))
#define LAS __attribute__((address_space(3)))
typedef unsigned short bf16;
typedef unsigned v4u __attribute__((ext_vector_type(4)));
typedef unsigned v2u __attribute__((ext_vector_type(2)));
typedef float f32x4 __attribute__((ext_vector_type(4)));
typedef float f32x2 __attribute__((ext_vector_type(2)));
typedef float f32x16 __attribute__((ext_vector_type(16)));
typedef short bf16x8 __attribute__((ext_vector_type(8)));
typedef short bf16x4 __attribute__((ext_vector_type(4)));
typedef GAS unsigned gu32;
#define RLX_AGENT __ATOMIC_RELAXED, __HIP_MEMORY_SCOPE_AGENT
#define LDS_WAIT() asm volatile("s_waitcnt lgkmcnt(0)" ::: "memory")
#define VM_WAIT() asm volatile("s_waitcnt vmcnt(0)" ::: "memory")
#define LDS_BAR() do { asm volatile("s_waitcnt lgkmcnt(0)" ::: "memory"); __builtin_amdgcn_s_barrier(); asm volatile("" ::: "memory"); } while (0)
__device__ __forceinline__ unsigned f2bf(float f) { unsigned u = __builtin_bit_cast(unsigned, f); return (u + 0x7fffu + ((u >> 16) & 1u)) >> 16; }
__device__ __forceinline__ unsigned pk2(float lo, float hi) { return f2bf(lo) | (f2bf(hi) << 16); }
__device__ __forceinline__ unsigned cvt_pk_bf16(float lo, float hi) { unsigned r; asm volatile("v_cvt_pk_bf16_f32 %0, %1, %2" : "=v"(r) : "v"(lo), "v"(hi)); return r; }
__device__ __forceinline__ float clamp8(float v) { return __builtin_amdgcn_fmed3f(v, -448.0f, 448.0f); }
__device__ __forceinline__ v2u pk8_fp8(const f32x4 a, const f32x4 b) {
    int w0 = 0, w1 = 0;
    w0 = __builtin_amdgcn_cvt_pk_fp8_f32(clamp8(a[0]), clamp8(a[1]), w0, false); w0 = __builtin_amdgcn_cvt_pk_fp8_f32(clamp8(a[2]), clamp8(a[3]), w0, true);
    w1 = __builtin_amdgcn_cvt_pk_fp8_f32(clamp8(b[0]), clamp8(b[1]), w1, false); w1 = __builtin_amdgcn_cvt_pk_fp8_f32(clamp8(b[2]), clamp8(b[3]), w1, true);
    v2u r; r.x = (unsigned)w0; r.y = (unsigned)w1; return r;
}
__device__ __forceinline__ float bflo(unsigned u) { return __builtin_bit_cast(float, u << 16); }
__device__ __forceinline__ float bfhi(unsigned u) { return __builtin_bit_cast(float, u & 0xffff0000u); }
__device__ __forceinline__ float fast_rcp(float x) { return __builtin_amdgcn_rcpf(x); }
__device__ __forceinline__ float sigmoidf_(float x) { return fast_rcp(1.0f + __expf(-x)); }
__device__ __forceinline__ float siluf_(float x) { return x * sigmoidf_(x); }
__device__ __forceinline__ f32x2 sigden2(f32x2 v, float c) { const f32x2 e = v * c; const f32x2 d = (f32x2){__builtin_amdgcn_exp2f(e.x), __builtin_amdgcn_exp2f(e.y)} + 1.0f; return (f32x2){fast_rcp(d.x), fast_rcp(d.y)}; }
__device__ __forceinline__ f32x2 silu2(f32x2 v, float r, float c) { return (v * r) * sigden2(v, c); }
__device__ __forceinline__ f32x2 swiglu2(f32x2 g, f32x2 u, float c, float r2) { return (g * u) * (sigden2(g, c) * r2); }
__device__ __forceinline__ f32x4 cat2(f32x2 a, f32x2 b) { return (f32x4){a.x, a.y, b.x, b.y}; }
constexpr float NLOG2E = -1.4426950408889634f;
__device__ __forceinline__ float rows_sum4(float v) {
    unsigned u = __builtin_bit_cast(unsigned, v);
    auto r = __builtin_amdgcn_permlane16_swap(u, u, false, false);
    float s = __builtin_bit_cast(float, (unsigned)r[0]) + __builtin_bit_cast(float, (unsigned)r[1]);
    u = __builtin_bit_cast(unsigned, s);
    auto q = __builtin_amdgcn_permlane32_swap(u, u, false, false);
    return __builtin_bit_cast(float, (unsigned)q[0]) + __builtin_bit_cast(float, (unsigned)q[1]);
}
__device__ __forceinline__ float wave_sum(float v) {
#pragma unroll
    for (int o = 1; o < 64; o <<= 1) v += __shfl_xor(v, o);
    return v;
}

#define XB_TMO      128
#define XB_XCNT(j)  (256  + 64 * (j))
#define XB_XSUB(j)  (1280 + 64 * (j))
#define XB_XGEN(j)  (2304 + 64 * (j))
#define XB_TOP      3328
#define XB_TOPGEN   3392
#define XCD_BAR_WORDS 3456
#define XB_SPIN_CAP (1u << 18)
__device__ __forceinline__ unsigned xb_ld(unsigned* p)              { return __hip_atomic_load(p, __ATOMIC_RELAXED, __HIP_MEMORY_SCOPE_AGENT); }
__device__ __forceinline__ unsigned xb_add(unsigned* p, unsigned v) { return __hip_atomic_fetch_add(p, v, __ATOMIC_RELAXED, __HIP_MEMORY_SCOPE_AGENT); }
__device__ __forceinline__ unsigned xb_xcc_id() { return (unsigned)__builtin_amdgcn_s_getreg((3 << 11) | 20) & 0xFu; }
#define XB_SPIN(cond, bar) do { unsigned _sp = 0; while (cond) { __builtin_amdgcn_s_sleep(1); \
    if ((++_sp & 255u) == 0u) { if (xb_ld(&(bar)[XB_TMO])) break; if (_sp > XB_SPIN_CAP) { atomicAdd(&(bar)[XB_TMO], 1u); break; } } } } while (0)
struct XcdBarrier { unsigned* bar; unsigned x; volatile LAS unsigned* st; };
__device__ __forceinline__ XcdBarrier xcd_barrier_post(unsigned* bar, volatile LAS unsigned* st) {
    XcdBarrier b; b.bar = bar; b.x = xb_xcc_id(); b.st = st;
    if (threadIdx.x == 0) (void)xb_add(&bar[XB_XCNT(b.x)], 1u);
    return b;
}
__device__ __forceinline__ void xcd_barrier_complete(unsigned* bar, unsigned x, unsigned& nloc, unsigned& nx) {
    const unsigned G = gridDim.x * gridDim.y * gridDim.z;
    unsigned sum, cnt, mine, sp = 0u;
    for (;;) {
        sum = 0u; cnt = 0u; mine = 0u;
#pragma unroll
        for (unsigned j = 0; j < 16; ++j) { const unsigned c = xb_ld(&bar[XB_XCNT(j)]); sum += c; cnt += (c > 0u) ? 1u : 0u; mine = (j == x) ? c : mine; }
        if (sum == G) break;
        __builtin_amdgcn_s_sleep(1);
        if ((++sp & 255u) == 0u) { if (xb_ld(&bar[XB_TMO])) break; if (sp > XB_SPIN_CAP) { atomicAdd(&bar[XB_TMO], 1u); break; } }
    }
    nloc = mine > 0u ? mine : 1u; nx = cnt > 0u ? cnt : 1u;
}
__device__ __forceinline__ void xcd_barrier(const XcdBarrier& b) {
    asm volatile("s_waitcnt vmcnt(0)" ::: "memory");
    __syncthreads();
    if (threadIdx.x == 0) {
        unsigned* bar = b.bar;
        __builtin_amdgcn_s_waitcnt(0);
        unsigned nloc = b.st[0], nx = b.st[1];
        if (nloc == 0u) { xcd_barrier_complete(bar, b.x, nloc, nx); b.st[0] = nloc; b.st[1] = nx; }
        const unsigned old = xb_add(&bar[XB_XSUB(b.x)], 1u);
        const unsigned gen = old / nloc;
        if (old + 1u == (gen + 1u) * nloc) {
            __builtin_amdgcn_fence(__ATOMIC_RELEASE, "agent");
            asm volatile("s_waitcnt vmcnt(0)" ::: "memory");
            const unsigned og = xb_add(&bar[XB_TOP], 1u);
            const unsigned tg = og / nx;
            if (og + 1u == (tg + 1u) * nx) xb_add(&bar[XB_TOPGEN], 1u);
            else XB_SPIN(xb_ld(&bar[XB_TOPGEN]) == tg, bar);
            __builtin_amdgcn_fence(__ATOMIC_ACQUIRE, "agent");
            xb_add(&bar[XB_XGEN(b.x)], 1u);
            asm volatile("s_waitcnt vmcnt(0)" ::: "memory");
        } else {
            XB_SPIN(xb_ld(&bar[XB_XGEN(b.x)]) == gen, bar);
            __builtin_amdgcn_fence(__ATOMIC_ACQUIRE, "agent");
            asm volatile("s_waitcnt vmcnt(0)" ::: "memory");
        }
    }
    __syncthreads();
}

#ifndef NG_M2
#define NG_M2 2
#endif
#ifndef F8_NOSCALE
#define F8_NOSCALE 1
#endif
#ifndef XCD_ROT
#define XCD_ROT 1
#endif
namespace pg8 {
constexpr int BM = 256, BK = 64, HALF = 128, HTB = HALF * BK * 2, STAGE_BYTES = 8 * HTB, NXCD = 8, WGM = 8;
__host__ __device__ __forceinline__ int lds_byte(int r, int c) { const int st = (r >> 4) * 2 + (c >> 5), rr = r & 15, cc = c & 31, ob = rr * 64 + cc * 2; return st * 1024 + (ob ^ (((ob >> 9) & 1) << 5)); }
__host__ __device__ __forceinline__ void stage_rc(int b, int& R, int& C) { const int st = b / 1024, sb = b % 1024, swz = sb ^ (((sb >> 9) & 1) << 5); R = (st >> 1) * 16 + swz / 64; C = (st & 1) * 32 + (swz % 64) / 2; }
__host__ __device__ __forceinline__ int perm32(int rho) { const int n = rho >> 4, i = rho & 15; return 8 * (i >> 2) + 4 * n + (i & 3); }
struct Unit { int pm, pn; const char* a; const char* b; const int* rows; int nvalid; int ord; };
typedef int v4i_t __attribute__((ext_vector_type(4)));
typedef int v8i_t __attribute__((ext_vector_type(8)));
__device__ __forceinline__ bf16x8 lo8(v8i_t v) { return __builtin_bit_cast(bf16x8, __builtin_shufflevector(v, v, 0, 1, 2, 3)); }
__device__ __forceinline__ bf16x8 hi8(v8i_t v) { return __builtin_bit_cast(bf16x8, __builtin_shufflevector(v, v, 4, 5, 6, 7)); }
__device__ __forceinline__ v8i_t cat8(bf16x8 lo, bf16x8 hi) { return __builtin_shufflevector(__builtin_bit_cast(v4i_t, lo), __builtin_bit_cast(v4i_t, hi), 0, 1, 2, 3, 4, 5, 6, 7); }
struct GridOrder {
    int nM, nN, nwg, G, c, rot;
    __device__ __forceinline__ void init(int nM_, int nN_, int G_, int c_) { nM = nM_; nN = nN_; nwg = nM * nN; G = G_; c = c_; rot = (XCD_ROT && nM_ == NXCD * WGM && (nN_ & 3) == 0) ? (c_ % NXCD) % (nN_ >> 2) : -1; }
    __device__ __forceinline__ bool tile(int i, int& pm, int& pn) const {
        const long L = (long)i * G + c; if (L >= nwg) return false;
        int wgid = (int)L; { const int q = nwg / NXCD, r = nwg % NXCD, xcd = wgid % NXCD, off = wgid / NXCD; wgid = (xcd < r ? xcd * (q + 1) : r * (q + 1) + (xcd - r) * q) + off; }
        const int nig = WGM * nN, gid = wgid / nig, fm = gid * WGM, gsz = (nM - fm) < WGM ? (nM - fm) : WGM;
        pm = fm + ((wgid % nig) % gsz); pn = (wgid % nig) / gsz;
        if (rot >= 0) { const int ngr = nN >> 2, st = (ngr > NXCD && (ngr & 1)) ? NXCD : 1;
            const int g = ((pn >> 2) * st + rot) % ngr; pn = 4 * g + (pn & 3); }
        return true;
    }
};

template <class Epi, class Sched, bool ALIGN_EPI, bool FP8 = false, bool GATHER = false>
__device__ __forceinline__ void gemm_phase(LAS unsigned char* lds, const int K, const int lda, const int ldb, const Sched& S, const Epi& E) {
    int tid_ = threadIdx.x; asm volatile("" : "+v"(tid_));
    const int tid = tid_, wid = __builtin_amdgcn_readfirstlane(tid >> 6), lane = tid & 63, wr = wid >> 2, wc = wid & 3, fr = lane & 15, fq = lane >> 4;
    const int nt = K / BK;
    unsigned voffA[2], voffB[2];
#pragma unroll
    for (int i = 0; i < 2; ++i) { int R, C; stage_rc(tid * 16 + i * 8192, R, C); const int Rb = Epi::PERM ? ((R & ~31) + perm32(R & 31)) : R;
        voffA[i] = (unsigned)(R * lda + C) * 2u; voffB[i] = (unsigned)(Rb * ldb + C) * 2u; }
    unsigned vG[2][2]; int tkn[2][2];
#pragma unroll
    for (int i = 0; i < 2; ++i) { vG[0][i] = vG[1][i] = 0u; tkn[0][i] = tkn[1][i] = 0; }
    const size_t kstep = (size_t)(BK * 2);
    const size_t hstepA = (size_t)HALF * lda * 2, hstepB = (size_t)HALF * ldb * 2;
    const unsigned ldsw = (unsigned)wid * 1024u;
    const int aoff = lds_byte(wr * 64 + fr, fq * 8), boff = lds_byte(wc * 32 + fr, fq * 8);
#define PG8_SA(b, h) (((b) * 2 + (h)) * HTB)
#define PG8_SB(b, h) ((4 + (b) * 2 + (h)) * HTB)
#define PG8_STAGE(bufoff, gbase, voff) do { _Pragma("unroll") for (int _i = 0; _i < 2; ++_i) \
        __builtin_amdgcn_global_load_lds((const unsigned*)((const char*)(gbase) + (voff)[_i]), (LAS unsigned*)(lds + (bufoff) + ldsw + _i * 8192), 16, 0, 0); } while (0)
#define PG8_STAGEA(bufoff, gk, h) do { if constexpr (GATHER) { PG8_STAGE(bufoff, gk, vG[h]); } else { PG8_STAGE(bufoff, (gk) + (h) * hstepA, voffA); } } while (0)
#define PG8_TOKLOAD(u, tk) do { _Pragma("unroll") for (int _h = 0; _h < 2; ++_h) _Pragma("unroll") for (int _i = 0; _i < 2; ++_i) { int gR_, gC_; stage_rc(tid * 16 + _i * 8192, gR_, gC_); const int row_ = _h * HALF + gR_; tk[_h][_i] = (u).rows[row_ < (u).nvalid ? row_ : (u).nvalid - 1]; }     } while (0)
#define PG8_TOKSET(tk) do { _Pragma("unroll") for (int _h = 0; _h < 2; ++_h) _Pragma("unroll") for (int _i = 0; _i < 2; ++_i) { int gR_, gC_; stage_rc(tid * 16 + _i * 8192, gR_, gC_); vG[_h][_i] = (unsigned)tk[_h][_i] * (unsigned)(lda * 2) + (unsigned)gC_ * 2u; } } while (0)
#define PG8_LDA(dst, b, h) do { _Pragma("unroll") for (int m = 0; m < 4; ++m) { const bf16x8 lo_ = *(const LAS bf16x8*)(lds + PG8_SA(b, h) + aoff + m * 2048), hi_ = *(const LAS bf16x8*)(lds + PG8_SA(b, h) + aoff + m * 2048 + 1024); dst[m] = cat8(lo_, hi_); } } while (0)
#define PG8_LDB(dst, b, h) do { _Pragma("unroll") for (int n = 0; n < 2; ++n) { const bf16x8 lo_ = *(const LAS bf16x8*)(lds + PG8_SB(b, h) + boff + n * 2048), hi_ = *(const LAS bf16x8*)(lds + PG8_SB(b, h) + boff + n * 2048 + 1024); dst[n] = cat8(lo_, hi_); } } while (0)
#define PG8_MMA(ai, bj, At, Bt) do { __builtin_amdgcn_s_setprio(1); _Pragma("unroll") for (int m = 0; m < 4; ++m) _Pragma("unroll") for (int n = 0; n < 2; ++n) { \
        if constexpr (FP8) { if (F8_NOSCALE) asm volatile("v_mfma_f32_16x16x128_f8f6f4 %0, %1, %2, %0" : "+v"(acc[ai][bj][m][n]) : "v"(Bt[n]), "v"(At[m])); \
                             else asm volatile("v_mfma_scale_f32_16x16x128_f8f6f4 %0, %1, %2, %0, %3, %4 op_sel_hi:[0,0,0]" : "+v"(acc[ai][bj][m][n]) : "v"(Bt[n]), "v"(At[m]), "v"(sc_w), "v"(sc_x)); } \
        else { acc[ai][bj][m][n] = __builtin_amdgcn_mfma_f32_16x16x32_bf16(lo8(Bt[n]), lo8(At[m]), acc[ai][bj][m][n], 0, 0, 0); \
               acc[ai][bj][m][n] = __builtin_amdgcn_mfma_f32_16x16x32_bf16(hi8(Bt[n]), hi8(At[m]), acc[ai][bj][m][n], 0, 0, 0); } } __builtin_amdgcn_s_setprio(0); } while (0)
#define PG8_WAIT_V(n) asm volatile("s_waitcnt vmcnt(" #n ")" ::: "memory")
#define PG8_WAIT_L(n) asm volatile("s_waitcnt lgkmcnt(" #n ")" ::: "memory")
#define PG8_BAR __builtin_amdgcn_s_barrier()
#define PG8_SCHED __builtin_amdgcn_sched_barrier(0)
    Unit cur, nxt; int ui = 0;
    if (!S.next(0, cur)) return;
    cur.ord = 0;
    f32x4 acc[2][2][4][2];
#pragma unroll
    for (int a = 0; a < 2; ++a)
#pragma unroll
        for (int b = 0; b < 2; ++b)
#pragma unroll
            for (int m = 0; m < 4; ++m)
#pragma unroll
                for (int n = 0; n < 2; ++n) acc[a][b][m][n] = (f32x4){0.f, 0.f, 0.f, 0.f};
    v8i_t At[4], B0[2], B1[2];
    const int sc_w = 0x79797979, sc_x = 0x7f7f7f7f;
    (void)sc_w; (void)sc_x;
    const char* cA = cur.a; const char* cB = cur.b;
    if constexpr (GATHER) { PG8_TOKLOAD(cur, tkn); PG8_TOKSET(tkn); }
    PG8_STAGE(PG8_SB(0, 0), cB, voffB); PG8_STAGE(PG8_SB(0, 1), cB + hstepB, voffB); PG8_STAGEA(PG8_SA(0, 0), cA, 0); PG8_STAGEA(PG8_SA(0, 1), cA, 1);
    if (wr == 1) PG8_BAR;
    PG8_WAIT_V(2); PG8_BAR;
    PG8_STAGE(PG8_SB(1, 0), cB + kstep, voffB); PG8_STAGEA(PG8_SA(1, 0), cA + kstep, 0); PG8_STAGE(PG8_SB(1, 1), cB + hstepB + kstep, voffB);
    PG8_WAIT_V(6); PG8_BAR;
    for (;;) {
        const bool has_next = S.next(ui + 1, nxt); nxt.ord = ui + 1;
        const char* nA = has_next ? nxt.a : cA; const char* nB = has_next ? nxt.b : cB;
#pragma nounroll
        for (int t = 0; t < nt; t += 2) {
            const bool last = (t == nt - 2);
            const char* a1 = cA + (size_t)(t + 1) * kstep;
            const char* a2 = last ? nA : cA + (size_t)(t + 2) * kstep; const char* b2 = last ? nB : cB + (size_t)(t + 2) * kstep;
            const char* a3 = a2 + kstep; const char* b3 = b2 + kstep;
            if constexpr (GATHER) { if (has_next && t == nt - 4) PG8_TOKLOAD(nxt, tkn); }
            PG8_LDB(B0, 0, 0); PG8_LDB(B1, 0, 1); PG8_SCHED; PG8_LDA(At, 0, 0); PG8_STAGEA(PG8_SA(1, 1), a1, 1);
            if constexpr (GATHER) { if (last && has_next) PG8_TOKSET(tkn); }
            PG8_WAIT_V(8); PG8_WAIT_L(0); PG8_BAR; PG8_MMA(0, 0, At, B0); PG8_MMA(0, 1, At, B1); PG8_BAR; PG8_SCHED;
            PG8_LDA(At, 0, 1); PG8_STAGE(PG8_SB(0, 0), b2, voffB); PG8_STAGE(PG8_SB(0, 1), b2 + hstepB, voffB); PG8_STAGEA(PG8_SA(0, 0), a2, 0);
            PG8_WAIT_V(8); PG8_WAIT_L(0); PG8_BAR; PG8_MMA(1, 0, At, B0); PG8_MMA(1, 1, At, B1); PG8_BAR; PG8_SCHED;
            PG8_LDB(B0, 1, 0); PG8_LDB(B1, 1, 1); PG8_SCHED; PG8_LDA(At, 1, 0); PG8_STAGEA(PG8_SA(0, 1), a2, 1);
            PG8_WAIT_V(8); PG8_WAIT_L(0); PG8_BAR; PG8_MMA(0, 0, At, B0); PG8_MMA(0, 1, At, B1); PG8_BAR; PG8_SCHED;
            PG8_LDA(At, 1, 1); PG8_STAGE(PG8_SB(1, 0), b3, voffB); PG8_STAGE(PG8_SB(1, 1), b3 + hstepB, voffB); PG8_STAGEA(PG8_SA(1, 0), a3, 0);
            PG8_WAIT_V(8); PG8_WAIT_L(0); PG8_BAR; PG8_MMA(1, 0, At, B0); PG8_MMA(1, 1, At, B1); PG8_BAR; PG8_SCHED;
        }
        if constexpr (ALIGN_EPI) { if (wr == 0) PG8_BAR; }
        if constexpr (FP8) asm volatile("s_nop 15\n\ts_nop 15" ::: "memory");
        if constexpr (FP8 && F8_NOSCALE) {
#pragma unroll
            for (int a = 0; a < 2; ++a)
#pragma unroll
                for (int b = 0; b < 2; ++b)
#pragma unroll
                    for (int m = 0; m < 4; ++m)
#pragma unroll
                        for (int n = 0; n < 2; ++n) acc[a][b][m][n] = acc[a][b][m][n] * 0.015625f;
        }
        E(acc, cur, wr, wc, fr, fq);
        if (!has_next) break;
#pragma unroll
        for (int a = 0; a < 2; ++a)
#pragma unroll
            for (int b = 0; b < 2; ++b)
#pragma unroll
                for (int m = 0; m < 4; ++m)
#pragma unroll
                    for (int n = 0; n < 2; ++n) acc[a][b][m][n] = (f32x4){0.f, 0.f, 0.f, 0.f};
        cur = nxt; cA = nA; cB = nB; ++ui;
        if constexpr (ALIGN_EPI) { if (wr == 1) PG8_BAR; }
    }
    PG8_WAIT_V(0);
    if constexpr (!ALIGN_EPI) { if (wr == 0) PG8_BAR; }
    PG8_BAR;
#undef PG8_SA
#undef PG8_SB
#undef PG8_STAGE
#undef PG8_STAGEA
#undef PG8_TOKLOAD
#undef PG8_TOKSET
#undef PG8_LDA
#undef PG8_LDB
#undef PG8_MMA
#undef PG8_WAIT_V
#undef PG8_WAIT_L
#undef PG8_BAR
#undef PG8_SCHED
}
}
using pg8::Unit;

struct SchedGrid {
    pg8::GridOrder o; const char* A; const char* B; size_t at, bt;
    __device__ __forceinline__ bool next(int i, Unit& u) const { if (!o.tile(i, u.pm, u.pn)) return false; u.a = A + (size_t)u.pm * at; u.b = B + (size_t)u.pn * bt; return true; }
};
struct SchedPick {
    SchedGrid s; int k;
    __device__ __forceinline__ bool next(int i, Unit& u) const { return i == 0 && s.next(k, u); }
};
struct SchedPool {
    pg8::GridOrder o; const char* A; const char* B; size_t at, bt;
    __device__ __forceinline__ bool next(int i, Unit& u) const { if (!o.tile(i, u.pm, u.pn)) return false; u.a = A + (size_t)u.pm * at + (size_t)(u.pn >> 1) * 1024; u.b = B + (size_t)u.pn * bt; return true; }
};
struct SchedPJ {
    pg8::GridOrder o; const char* A; const char* B; size_t at, bt;
    __device__ __forceinline__ bool next(int i, Unit& u) const { if (!o.tile(i, u.pm, u.pn)) return false; u.a = A + (size_t)u.pm * at; u.b = B + (size_t)((u.pm >> 6) * 8 + u.pn) * bt; return true; }
};
struct SchedMoe {
    const LAS int* tile_e; const LAS int* tile_g; const LAS int* tile_s0; const LAS int* gcnt; int rt0, rt1, G, c; const char* A; const char* B; size_t at, bt, be; const int* list; bool gather;
    __device__ __forceinline__ bool next(int i, Unit& u) const {
        const int L = i * G + c, n = (rt1 - rt0) * 8; if (L >= n) return false;
        u.pm = rt0 + (L >> 3); u.pn = L & 7; const int e = tile_e[u.pm], g = tile_g[u.pm], s0 = tile_s0[u.pm];
        u.a = gather ? A : A + (size_t)u.pm * at; u.b = B + (size_t)e * be + (size_t)u.pn * bt;
        u.rows = list + (size_t)g * M + s0; u.nvalid = gcnt[g] - s0; return true; }
};

struct SchedFill {
    int lo, hi, nN, rank, nlight; const char* A; const char* B; size_t at, bt;
    __device__ __forceinline__ bool next(int i, Unit& u) const {
        if (rank < 0) return false; const int k = lo + rank + i * nlight; if (k >= hi) return false;
        u.pm = k / nN; u.pn = k % nN; u.a = A + (size_t)u.pm * at; u.b = B + (size_t)u.pn * bt; u.rows = nullptr; u.nvalid = 0; return true; }
};
__device__ __forceinline__ void load_rstd(const float* ssp, int row0, int fq, float (&rs)[2][4]) {
#pragma unroll
    for (int ai = 0; ai < 2; ++ai)
#pragma unroll
        for (int m = 0; m < 4; ++m) {
            const float* sp = ssp + (size_t)(row0 + ai * 128 + m * 16) * 32 + fq * 8;
            const f32x4 a = *(const f32x4*)sp, b = *(const f32x4*)(sp + 4);
            float s = ((a[0] + a[1]) + (a[2] + a[3])) + ((b[0] + b[1]) + (b[2] + b[3]));
            s += __shfl_xor(s, 16); s += __shfl_xor(s, 32);
            rs[ai][m] = 1.0f / sqrtf(s * (1.0f / DM) + EPS);
        }
}
constexpr int RS_TBL_OFF = LDSCTL_OFF + 4096, RS_TBL_UNITS = 11;
template <class Sched> __device__ __forceinline__ void build_rstd_table(LAS unsigned char* lds, const Sched& S, const float* ssp, int tid) {
    LAS float* tbl = (LAS float*)(lds + RS_TBL_OFF); const int row = tid >> 1, half = tid & 1;
    for (int i0 = 0; i0 < RS_TBL_UNITS; i0 += 4) {
        f32x4 v[4][4]; bool ok[4];
#pragma unroll
        for (int q = 0; q < 4; ++q) { Unit u; ok[q] = (i0 + q < RS_TBL_UNITS) && S.next(i0 + q, u);
            if (ok[q]) { const f32x4* sp = (const f32x4*)(ssp + (size_t)(u.pm * 256 + row) * 32 + half * 16);
#pragma unroll
                for (int j = 0; j < 4; ++j) v[q][j] = sp[j]; } }
#pragma unroll
        for (int q = 0; q < 4; ++q) if (ok[q]) { float s = 0.f;
#pragma unroll
            for (int j = 0; j < 4; ++j) s += (v[q][j][0] + v[q][j][1]) + (v[q][j][2] + v[q][j][3]);
            s += __shfl_xor(s, 1);
            if (half == 0) tbl[(i0 + q) * 256 + row] = 1.0f / sqrtf(s * (1.0f / DM) + EPS); }
    }
    LDS_BAR();
}
__device__ __forceinline__ void table_rstd(const LAS float* tbl, int ord, int wr, int fr, float (&rs)[2][4]) {
#pragma unroll
    for (int ai = 0; ai < 2; ++ai)
#pragma unroll
        for (int m = 0; m < 4; ++m) rs[ai][m] = tbl[ord * 256 + wr * 64 + fr + ai * 128 + m * 16];
}
template <class Sched> __device__ __forceinline__ void build_moe_tables(LAS unsigned char* lds, const Sched& S, const int* list, const float* fsrc, bool want_tok, int tid) {
    LAS float* tf = (LAS float*)(lds + RS_TBL_OFF); LAS int* ti = (LAS int*)(lds + RS_TBL_OFF + 6144);
    for (int i = 0; i < 6; ++i) { Unit u; if (!S.next(i, u)) break;
        if (tid < 256) { const bool ok = tid < u.nvalid; const int rc = ok ? tid : u.nvalid - 1;
            const float fv = fsrc[(u.rows - list) + rc]; tf[i * 256 + tid] = ok ? fv : 0.f;
            if (want_tok) { const int tk = u.rows[rc]; ti[i * 256 + tid] = ok ? tk : -1; } } }
    LDS_BAR();
}
struct EpiInProj {
    static constexpr bool PERM = true;
    bf16* U; const float* ssp; const float* lbv; const LAS float* tbl;
    __device__ __forceinline__ void operator()(const f32x4 (&acc)[2][2][4][2], const Unit& u, int wr, int wc, int fr, int fq) const {
        const int row0 = u.pm * 256 + wr * 64 + fr;
        float rs[2][4]; if (RS_TABLE) table_rstd(tbl, u.ord, wr, fr, rs); else load_rstd(ssp, row0, fq, rs);
        const int pn = u.pn;
        if (pn >= 20) {
            const int col0 = 5120 + (pn - 20) * 128 + wc * 32 + 8 * fq;
#pragma unroll
            for (int ai = 0; ai < 2; ++ai)
#pragma unroll
                for (int m = 0; m < 4; ++m) { const float r2 = rs[ai][m] * rs[ai][m];
                    const f32x4 a0 = acc[ai][0][m][0] * acc[ai][1][m][0] * r2, a1 = acc[ai][0][m][1] * acc[ai][1][m][1] * r2;
                    v4u w; w.x = cvt_pk_bf16(a0[0], a0[1]); w.y = cvt_pk_bf16(a0[2], a0[3]); w.z = cvt_pk_bf16(a1[0], a1[1]); w.w = cvt_pk_bf16(a1[2], a1[3]);
                    *(v4u*)(U + (size_t)(row0 + ai * 128 + m * 16) * UP + col0) = w; }
            return;
        }
        const int kind = pn >> 2;
        const int col0 = pn * 256 + wc * 32 + 8 * fq;
        f32x4 lb[2][2];
        if (kind == 1) {
#pragma unroll
            for (int bj = 0; bj < 2; ++bj)
#pragma unroll
                for (int n = 0; n < 2; ++n) lb[bj][n] = *(const f32x4*)(lbv + (col0 - 1024) + bj * 128 + 4 * n);
            asm volatile("" :: "v"(lb[0][0]), "v"(lb[0][1]), "v"(lb[1][0]), "v"(lb[1][1]));
        }
#pragma unroll
        for (int ai = 0; ai < 2; ++ai)
#pragma unroll
            for (int m = 0; m < 4; ++m) { bf16* rowp = U + (size_t)(row0 + ai * 128 + m * 16) * UP + col0; const float r = rs[ai][m], c = r * NLOG2E;
#pragma unroll
                for (int bj = 0; bj < 2; ++bj) { const f32x4 a0 = acc[ai][bj][m][0], a1 = acc[ai][bj][m][1]; f32x4 v0, v1;
                    if (kind == 0 || kind == 3) { v0 = cat2(silu2(a0.xy, r, c), silu2(a0.zw, r, c)); v1 = cat2(silu2(a1.xy, r, c), silu2(a1.zw, r, c)); }
                    else if (kind == 1) { const f32x4 l0 = lb[bj][0], l1 = lb[bj][1], m0 = 1.0f - l0, m1 = 1.0f - l1;
                        const f32x4 s0 = cat2(sigden2(a0.xy, c), sigden2(a0.zw, c)), s1 = cat2(sigden2(a1.xy, c), sigden2(a1.zw, c)), t0 = l0 + m0 * s0, t1 = l1 + m1 * s1;
#pragma unroll
                        for (int j = 0; j < 4; ++j) { v0[j] = __builtin_amdgcn_logf(t0[j]); v1[j] = __builtin_amdgcn_logf(t1[j]);     }
                    } else { v0 = a0 * r; v1 = a1 * r; }
                    v4u w; w.x = cvt_pk_bf16(v0[0], v0[1]); w.y = cvt_pk_bf16(v0[2], v0[3]); w.z = cvt_pk_bf16(v1[0], v1[1]); w.w = cvt_pk_bf16(v1[2], v1[3]);
                    *(v4u*)(rowp + bj * 128) = w; } }
    }
};
struct EpiBf16Plain {
    static constexpr bool PERM = true;
    bf16* O; int ldc;
    __device__ __forceinline__ void operator()(const f32x4 (&acc)[2][2][4][2], const Unit& u, int wr, int wc, int fr, int fq) const {
        const int row0 = u.pm * 256 + wr * 64 + fr, col0 = u.pn * 256 + wc * 32 + 8 * fq;
#pragma unroll
        for (int ai = 0; ai < 2; ++ai)
#pragma unroll
            for (int m = 0; m < 4; ++m) { bf16* rowp = O + (size_t)(row0 + ai * 128 + m * 16) * ldc + col0;
#pragma unroll
                for (int bj = 0; bj < 2; ++bj) { const f32x4 v0 = acc[ai][bj][m][0], v1 = acc[ai][bj][m][1];
                    v4u w; w.x = cvt_pk_bf16(v0[0], v0[1]); w.y = cvt_pk_bf16(v0[2], v0[3]); w.z = cvt_pk_bf16(v1[0], v1[1]); w.w = cvt_pk_bf16(v1[2], v1[3]);
                    *(v4u*)(rowp + bj * 128) = w; } }
    }
};
template <bool ROWTAB, bool F8> struct EpiSwiglu {
    static constexpr bool PERM = true;
    void* H; int ldc; const float* ssp; const float* rtab; const int* list; const LAS float* tbl;
    __device__ __forceinline__ void operator()(const f32x4 (&acc)[2][2][4][2], const Unit& u, int wr, int wc, int fr, int fq) const {
        if constexpr (ROWTAB) asm volatile("" : "+v"(fr), "+v"(fq));
        const int row0 = u.pm * 256 + wr * 64 + fr, col0 = u.pn * 128 + wc * 32 + 8 * fq;
        float rs[2][4];
        if constexpr (ROWTAB) {
            if (RS_TABLE) table_rstd(tbl, u.ord, wr, fr, rs);
            else { const float* rt_ = rtab + (u.rows - list);
#pragma unroll
            for (int ai = 0; ai < 2; ++ai)
#pragma unroll
                for (int m = 0; m < 4; ++m) { const int rl = wr * 64 + fr + ai * 128 + m * 16; const float v_ = rt_[rl < u.nvalid ? rl : u.nvalid - 1]; rs[ai][m] = rl < u.nvalid ? v_ : 0.f; } }
        } else { if (RS_TABLE) table_rstd(tbl, u.ord, wr, fr, rs); else load_rstd(ssp, row0, fq, rs); }
#pragma unroll
        for (int ai = 0; ai < 2; ++ai)
#pragma unroll
            for (int m = 0; m < 4; ++m) { const float r = rs[ai][m], c = r * NLOG2E, r2 = r * r;
                const f32x4 g0 = acc[ai][0][m][0], u0 = acc[ai][1][m][0], g1 = acc[ai][0][m][1], u1 = acc[ai][1][m][1];
                const f32x4 h0 = cat2(swiglu2(g0.xy, u0.xy, c, r2), swiglu2(g0.zw, u0.zw, c, r2)), h1 = cat2(swiglu2(g1.xy, u1.xy, c, r2), swiglu2(g1.zw, u1.zw, c, r2));
                const size_t o = (size_t)(row0 + ai * 128 + m * 16) * ldc + col0;
                if constexpr (F8) *(v2u*)((unsigned char*)H + o) = pk8_fp8(h0, h1);
                else { v4u w; w.x = cvt_pk_bf16(h0[0], h0[1]); w.y = cvt_pk_bf16(h0[2], h0[3]); w.z = cvt_pk_bf16(h1[0], h1[1]); w.w = cvt_pk_bf16(h1[2], h1[3]); *(v4u*)((bf16*)H + o) = w; } }
    }
};
__device__ __forceinline__ void unpack8(const v4u w, f32x4& a, f32x4& b) { a[0] = bflo(w.x); a[1] = bfhi(w.x); a[2] = bflo(w.y); a[3] = bfhi(w.y); b[0] = bflo(w.z); b[1] = bfhi(w.z); b[2] = bflo(w.w); b[3] = bfhi(w.w); }
template <int MODE  , bool XF32, bool F8C = false  > struct EpiResid {
    static constexpr bool PERM = true;
    const float* xf; const bf16* xold; bf16* xnew; float* ssp_out; const float* colscale; const float* ssp_in; const bf16* PJ; unsigned char* xq; const LAS float* tbl;
    static constexpr int NG = (MODE == 2) ? NG_M2 : 2, NS = 8 / NG;
    struct Q { v4u xo[NG][2], pj[NG][2]; f32x4 xf0[NG][2], xf1[NG][2]; };
    __device__ __forceinline__ void qload(Q& q, int st, int row0, int col0) const {
#pragma unroll
        for (int mm = 0; mm < NG; ++mm)
#pragma unroll
            for (int bj = 0; bj < 2; ++bj) { const int g = st * NG + mm, ai = g >> 2, m = g & 3; const size_t o = (size_t)(row0 + ai * 128 + m * 16) * DM + col0 + bj * 128;
                if constexpr (XF32) { q.xf0[mm][bj] = *(const f32x4*)(xf + o); q.xf1[mm][bj] = *(const f32x4*)(xf + o + 4); } else q.xo[mm][bj] = *(const v4u*)(xold + o);
                if constexpr (MODE == 2) q.pj[mm][bj] = *(const v4u*)(PJ + o); }
    }
    __device__ __forceinline__ void operator()(const f32x4 (&acc)[2][2][4][2], const Unit& u, int wr, int wc, int fr, int fq) const {
        const int row0 = u.pm * 256 + wr * 64 + fr, col0 = u.pn * 256 + wc * 32 + 8 * fq;
        Q qa, qb;
        qload(qa, 0, row0, col0);
        float rs[2][4];
        if constexpr (MODE == 2) { if (RS_TABLE) table_rstd(tbl, u.ord, wr, fr, rs); else load_rstd(ssp_in, row0, fq, rs); }
        f32x4 cs[2][2];
        if constexpr (MODE == 1) {
#pragma unroll
            for (int bj = 0; bj < 2; ++bj)
#pragma unroll
                for (int n = 0; n < 2; ++n) cs[bj][n] = *(const f32x4*)(colscale + col0 + bj * 128 + 4 * n);
        }
#pragma unroll
        for (int st = 0; st < NS; ++st) {
            Q& q = (st & 1) ? qb : qa;
            if (st + 1 < NS) qload((st & 1) ? qa : qb, st + 1, row0, col0);
            asm volatile("" ::: "memory");
#pragma unroll
            for (int mm = 0; mm < NG; ++mm) { const int g = st * NG + mm, ai = g >> 2, m = g & 3; const int row = row0 + ai * 128 + m * 16; const size_t off = (size_t)row * DM + col0; float ss = 0.f;
#pragma unroll
                for (int bj = 0; bj < 2; ++bj) { const size_t o = off + bj * 128; f32x4 v0 = acc[ai][bj][m][0], v1 = acc[ai][bj][m][1];
                    if constexpr (MODE == 1) { v0 = v0 * cs[bj][0]; v1 = v1 * cs[bj][1]; }
                    if constexpr (MODE == 2) { f32x4 p0, p1; unpack8(q.pj[mm][bj], p0, p1); const float r = rs[ai][m];
#pragma unroll
                        for (int j = 0; j < 4; ++j) { v0[j] = sigmoidf_(v0[j] * r) * p0[j]; v1[j] = sigmoidf_(v1[j] * r) * p1[j]; } }
                    f32x4 x0, x1;
                    if constexpr (XF32) { x0 = q.xf0[mm][bj]; x1 = q.xf1[mm][bj]; } else unpack8(q.xo[mm][bj], x0, x1);
                    x0 += v0; x1 += v1;
                    v4u w; w.x = cvt_pk_bf16(x0[0], x0[1]); w.y = cvt_pk_bf16(x0[2], x0[3]); w.z = cvt_pk_bf16(x1[0], x1[1]); w.w = cvt_pk_bf16(x1[2], x1[3]);
                    *(v4u*)(xnew + o) = w;
                    if constexpr (F8C) *(v2u*)(xq + o) = pk8_fp8(x0, x1);
                    ss += ((x0[0] * x0[0] + x0[1] * x0[1]) + (x0[2] * x0[2] + x0[3] * x0[3])) + ((x1[0] * x1[0] + x1[1] * x1[1]) + (x1[2] * x1[2] + x1[3] * x1[3])); }
                ss = rows_sum4(ss);
                if (fq == 0) ssp_out[(size_t)row * 32 + u.pn * 4 + wc] = ss;
            }
            asm volatile("" ::: "memory");
        }
    }
};
template <bool RANK2, bool F8C = false> struct EpiMoeDown {
    static constexpr bool PERM = true;
    bf16* X; float* ssp_out; const int* list; const float* gwl; unsigned char* xq; const LAS float* tf; const LAS int* ti;
    __device__ __forceinline__ void operator()(const f32x4 (&acc)[2][2][4][2], const Unit& u, int wr, int wc, int fr, int fq) const {
        asm volatile("" : "+v"(fr), "+v"(fq));
        const int col0 = u.pn * 256 + wc * 32 + 8 * fq;
#pragma unroll
        for (int ai = 0; ai < 2; ++ai)
#pragma unroll
            for (int m = 0; m < 4; ++m) { const int rl = wr * 64 + fr + ai * 128 + m * 16; const bool ok = rl < u.nvalid; int tok; float gw;
                if (RS_TABLE) { tok = ti[u.ord * 256 + rl]; gw = tf[u.ord * 256 + rl]; if (!ok) tok = 0; } else { const int rc_ = ok ? rl : u.nvalid - 1; tok = u.rows[rc_]; gw = gwl[(u.rows - list) + rc_]; }
                const size_t off = (size_t)(ok ? tok : 0) * DM + col0; float ss = 0.f;
#pragma unroll
                for (int bj = 0; bj < 2; ++bj) { const size_t o = off + bj * 128;
                    if (ok) { f32x4 x0, x1; unpack8(*(const v4u*)(X + o), x0, x1); x0 += acc[ai][bj][m][0] * gw; x1 += acc[ai][bj][m][1] * gw;
                        v4u w; w.x = cvt_pk_bf16(x0[0], x0[1]); w.y = cvt_pk_bf16(x0[2], x0[3]); w.z = cvt_pk_bf16(x1[0], x1[1]); w.w = cvt_pk_bf16(x1[2], x1[3]);
                        *(v4u*)(X + o) = w;
                        if constexpr (RANK2 && F8C) *(v2u*)(xq + o) = pk8_fp8(x0, x1);
                        if constexpr (RANK2) ss += ((x0[0] * x0[0] + x0[1] * x0[1]) + (x0[2] * x0[2] + x0[3] * x0[3])) + ((x1[0] * x1[0] + x1[1] * x1[1]) + (x1[2] * x1[2] + x1[3] * x1[3])); } }
                if constexpr (RANK2) { ss = rows_sum4(ss);
                    if (fq == 0 && ok) ssp_out[(size_t)tok * 32 + u.pn * 4 + wc] = ss; }
                if (m & 1) asm volatile("" ::: "memory");
            }
    }
};

template <class EE> struct EpiTwice { static constexpr bool PERM = EE::PERM; EE e;
    __device__ __forceinline__ void operator()(const f32x4 (&acc)[2][2][4][2], const Unit& u, int wr, int wc, int fr, int fq) const { int n_ = 2; asm volatile("" : "+s"(n_));
#pragma nounroll
        for (int k_ = 0; k_ < n_; ++k_) { e(acc, u, wr, wc, fr, fq); asm volatile("" ::: "memory"); } } };
struct Args { const float* in[24]; float* out; unsigned char* ws; };
struct Frame {
    LAS unsigned char* lds; volatile LAS unsigned* MISC; gu32* ctl;
    int tid, lane, wave, G, bx;
};

constexpr int TRP = 136;
constexpr int TRP8 = 68;
struct TrJob { const float* W0; const float* W1; int c0, c1, ldw, K, N, NP; bf16* WT; const float* gain; int f8; };
__device__ __forceinline__ int tr_items(const TrJob& J) { return (J.K / 64) * (J.NP ? J.NP * 4 : J.N / 64); }
__device__ __forceinline__ void tr_map(const TrJob& J, int it, int& kb, int& nb) {
    const int nnb = J.NP ? J.NP * 4 : J.N / 64, sup = it >> 3, sub = it & 7, nsn = nnb >> 1;
    kb = (sup / nsn) * 4 + (sub >> 1); nb = (sup % nsn) * 2 + (sub & 1);
}
__device__ __forceinline__ void tr_src(const TrJob& J, int nb, const float*& W, int& sc) {
    W = J.W0; sc = J.c0 + nb * 64;
    if (J.NP) { const int j = nb >> 2, q = nb & 3; W = (q < 2) ? J.W0 : J.W1; sc = ((q < 2) ? J.c0 : J.c1) + 128 * j + 64 * (q & 1); }
}
__device__ __forceinline__ void tr_load(const TrJob& J, int it, f32x4 (&v)[16], float (&g)[16], int lane) {
    int kb, nb; tr_map(J, it, kb, nb); const float* W; int sc; tr_src(J, nb, W, sc);
    const float* src = W + (size_t)(kb * 64 + (lane >> 4)) * J.ldw + sc + 4 * (lane & 15);
#pragma unroll
    for (int i = 0; i < 16; ++i) v[i] = *(const f32x4*)(src + (size_t)(4 * i) * J.ldw);
    if (J.gain) {
#pragma unroll
        for (int i = 0; i < 16; ++i) g[i] = J.gain[kb * 64 + 4 * i + (lane >> 4)];
    } else {
#pragma unroll
        for (int i = 0; i < 16; ++i) g[i] = 1.0f;
    }
}
__device__ __forceinline__ void tr_store(const TrJob& J, int it, const f32x4 (&v)[16], const float (&gg)[16], LAS unsigned char* scr, int lane) {
    int kb, nb; tr_map(J, it, kb, nb); const int k0 = kb * 64, drow0 = nb * 64;
    if (J.f8) {
#pragma unroll
        for (int i = 0; i < 16; ++i) { const int kk = 4 * i + (lane >> 4); const float g = gg[i] * 64.0f;
            int w = 0; w = __builtin_amdgcn_cvt_pk_fp8_f32(v[i][0] * g, v[i][1] * g, w, false); w = __builtin_amdgcn_cvt_pk_fp8_f32(v[i][2] * g, v[i][3] * g, w, true);
            *(LAS int*)(scr + kk * TRP8 + 4 * (lane & 15)) = w; }
        LDS_WAIT(); asm volatile("" ::: "memory");
        const int c = lane & 3; unsigned char* WT = (unsigned char*)J.WT;
#pragma unroll
        for (int j = 0; j < 4; ++j) { const int n = (lane >> 2) + 16 * j; const LAS unsigned char* s = scr + (16 * c) * TRP8 + n;
            v4u o;
            o.x = (unsigned)s[0 * TRP8] | ((unsigned)s[1 * TRP8] << 8) | ((unsigned)s[2 * TRP8] << 16) | ((unsigned)s[3 * TRP8] << 24);
            o.y = (unsigned)s[4 * TRP8] | ((unsigned)s[5 * TRP8] << 8) | ((unsigned)s[6 * TRP8] << 16) | ((unsigned)s[7 * TRP8] << 24);
            o.z = (unsigned)s[8 * TRP8] | ((unsigned)s[9 * TRP8] << 8) | ((unsigned)s[10 * TRP8] << 16) | ((unsigned)s[11 * TRP8] << 24);
            o.w = (unsigned)s[12 * TRP8] | ((unsigned)s[13 * TRP8] << 8) | ((unsigned)s[14 * TRP8] << 16) | ((unsigned)s[15 * TRP8] << 24);
            *(GAS v4u*)(WT + (size_t)(drow0 + n) * J.K + k0 + 16 * c) = o; }
    } else {
#pragma unroll
        for (int i = 0; i < 16; ++i) { const int kk = 4 * i + (lane >> 4); const float g = gg[i];
            v2u w; w.x = cvt_pk_bf16(v[i][0] * g, v[i][1] * g); w.y = cvt_pk_bf16(v[i][2] * g, v[i][3] * g);
            *(LAS v2u*)(scr + kk * TRP + 8 * (lane & 15)) = w; }
        LDS_WAIT(); asm volatile("" ::: "memory");
        const int c = lane & 7;
#pragma unroll
        for (int j = 0; j < 8; ++j) { const int n = (lane >> 3) + 8 * j; const LAS unsigned short* s = (const LAS unsigned short*)(scr + (8 * c) * TRP + 2 * n);
            v4u o; o.x = (unsigned)s[0] | ((unsigned)s[TRP / 2] << 16); o.y = (unsigned)s[2 * (TRP / 2)] | ((unsigned)s[3 * (TRP / 2)] << 16);
            o.z = (unsigned)s[4 * (TRP / 2)] | ((unsigned)s[5 * (TRP / 2)] << 16); o.w = (unsigned)s[6 * (TRP / 2)] | ((unsigned)s[7 * (TRP / 2)] << 16);
            *(GAS v4u*)(J.WT + (size_t)(drow0 + n) * J.K + k0 + 8 * c) = o; }
    }
    LDS_WAIT(); asm volatile("" ::: "memory");
}
__device__ __forceinline__ int tr_job(const TrJob& J, int base, int wv, int nw, LAS unsigned char* scr, int lane) {
    const int nit = tr_items(J);
    int it = (wv - base % nw + nw) % nw;
    f32x4 va[16], vb[16]; float ga[16], gb[16];
    if (it < nit) tr_load(J, it, va, ga, lane);
    while (it < nit) {
        const int nx = it + nw;
        if (nx < nit) tr_load(J, nx, vb, gb, lane);
        tr_store(J, it, va, ga, scr, lane);
        if (nx >= nit) break;
        const int nx2 = nx + nw;
        if (nx2 < nit) tr_load(J, nx2, va, ga, lane);
        tr_store(J, nx, vb, gb, scr, lane);
        it = nx2;
    }
    return base + nit;
}

constexpr int H_QT = 0, H_KT = 17408, H_QC = 34816, H_KH = 52224, H_VT = 70656, H_TOT = 89088, H_DEC = 93184, H_NRM = 93696  , H_END = 95744;
constexpr int TP = 272  , CP = 144  ;
__device__ __forceinline__ f32x16 mfma32(bf16x8 a, bf16x8 b, f32x16 c) { return __builtin_amdgcn_mfma_f32_32x32x16_bf16(a, b, c, 0, 0, 0); }
__device__ __forceinline__ bf16x8 pack8(const f32x16& v, int o) {
    v4u w; w.x = cvt_pk_bf16(v[o + 0], v[o + 1]); w.y = cvt_pk_bf16(v[o + 2], v[o + 3]); w.z = cvt_pk_bf16(v[o + 4], v[o + 5]); w.w = cvt_pk_bf16(v[o + 6], v[o + 7]);
    return __builtin_bit_cast(bf16x8, w);
}
__device__ __forceinline__ bf16x8 ld2x8(const LAS unsigned char* p) {
    const v2u a = *(const LAS v2u*)p, b = *(const LAS v2u*)(p + 16); v4u w; w.x = a.x; w.y = a.y; w.z = b.x; w.w = b.y; return __builtin_bit_cast(bf16x8, w);
}
struct HgRegs { unsigned lf[8], qs[8], v[8], lf32; };
#define EX2(x) __builtin_amdgcn_exp2f(x)
__device__ __forceinline__ void hg_finish(LAS unsigned char* L, int nbuf, const f32x16& O, const v2u (&gs)[4], const f32x4 (&gn_)[4], bf16* A2o, int tb, int r) {
    float tot = 0.f;
#pragma unroll
    for (int e4 = 0; e4 < 4; ++e4) tot += *(const LAS float*)(L + H_NRM + nbuf * 1024 + (e4 * 64 + 32 * tb + r) * 4);
    const float rstd = 1.0f / sqrtf(tot * (1.0f / HD) + EPS);
#pragma unroll
    for (int q = 0; q < 4; ++q) {
        const f32x4 gn = gn_[q];
        const float o0 = O[4 * q + 0] * rstd * gn[0] * bflo(gs[q].x), o1 = O[4 * q + 1] * rstd * gn[1] * bfhi(gs[q].x);
        const float o2 = O[4 * q + 2] * rstd * gn[2] * bflo(gs[q].y), o3 = O[4 * q + 3] * rstd * gn[3] * bfhi(gs[q].y);
        v2u wv; wv.x = cvt_pk_bf16(o0, o1); wv.y = cvt_pk_bf16(o2, o3);
        *(v2u*)(A2o + 8 * q) = wv; }
}
__device__ __forceinline__ void hgrn_phase(Frame& F, const bf16* U, bf16* A2, const float* hgain) {
    const int b = F.bx >> 3, h = F.bx & 7, w = F.wave, lane = F.lane;
    LAS unsigned char* L = F.lds;
    const int eb = w >> 1, tb = w & 1, r = lane & 31, hh = lane >> 5;
    f32x16 S[4];
#pragma unroll
    for (int d = 0; d < 4; ++d)
#pragma unroll
        for (int i = 0; i < 16; ++i) S[d][i] = 0.f;
    const size_t rowbase0 = (size_t)b * SEQ;
    const bf16* Ucol = U + h * HD + 2 * lane;
    f32x4 gn_[4];
#pragma unroll
    for (int q = 0; q < 4; ++q) gn_[q] = *(const f32x4*)(hgain + h * HD + 32 * eb + 8 * q + 4 * hh);
    const bf16* Ugs = U + 3072 + h * HD + 32 * eb + 4 * hh + (rowbase0 + 32 * tb + r) * UP;
    bf16* A2o = A2 + (rowbase0 + 32 * tb + r) * DM + h * HD + 32 * eb + 4 * hh;
    HgRegs R; v2u gs_[4], gsp_[4];
    f32x16 Op;
#pragma unroll
    for (int i = 0; i < 16; ++i) Op[i] = 0.f;
#define HG_LOAD(n) do { const bf16* p = Ucol + (rowbase0 + (size_t)(n) * CHUNK + 8 * w) * UP; \
        _Pragma("unroll") for (int j = 0; j < 8; ++j) { R.qs[j] = *(const unsigned*)(p + (size_t)j * UP); R.lf[j] = *(const unsigned*)(p + (size_t)j * UP + 1024); R.v[j] = *(const unsigned*)(p + (size_t)j * UP + 2048); } \
        R.lf32 = *(const unsigned*)(Ucol + (rowbase0 + (size_t)(n) * CHUNK + 32) * UP + 1024); \
        _Pragma("unroll") for (int q = 0; q < 4; ++q) gs_[q] = *(const v2u*)(Ugs + (size_t)(n) * CHUNK * UP + 8 * q); } while (0)
    HG_LOAD(0);
    for (int n = 0; n < SEQ / CHUNK; ++n) {
        f32x2 c[8];
        { f32x2 a = (f32x2){0.f, 0.f};
#pragma unroll
          for (int j = 0; j < 8; ++j) { a += (f32x2){bflo(R.lf[j]), bfhi(R.lf[j])}; c[j] = a; }
          *(LAS f32x2*)(L + H_TOT + (w * 128 + 2 * lane) * 4) = a; }
        LDS_BAR();
        if (n > 0) hg_finish(L, (n - 1) & 1, Op, gsp_, gn_, A2o + (size_t)(n - 1) * CHUNK * DM, tb, r);
        { f32x2 pre = (f32x2){0.f, 0.f}, ref = pre, last = pre;
#pragma unroll
          for (int ww = 0; ww < 8; ++ww) { const f32x2 t = *(const LAS f32x2*)(L + H_TOT + (ww * 128 + 2 * lane) * 4);
              if (ww < w) pre += t; if (ww < 4) ref += t; last += t; }
          ref += (f32x2){bflo(R.lf32), bfhi(R.lf32)};
          const f32x2 lr = last - ref;
          const f32x2 eref = (f32x2){EX2(ref.x), EX2(ref.y)}, elr = (f32x2){EX2(lr.x), EX2(lr.y)};
          if (w == 0) *(LAS f32x2*)(L + H_DEC + 2 * lane * 4) = (f32x2){EX2(last.x), EX2(last.y)};
          unsigned kh0[4], kh1[4], vt0[4], vt1[4];
#pragma unroll
          for (int j = 0; j < 8; ++j) {
              const f32x2 d1 = (pre + c[j]) - ref;
              const f32x2 E1 = (f32x2){EX2(d1.x), EX2(d1.y)}, E2 = (f32x2){fast_rcp(E1.x), fast_rcp(E1.y)};
              const f32x2 fv = (f32x2){EX2(bflo(R.lf[j])), EX2(bfhi(R.lf[j]))};
              const f32x2 kq = (f32x2){1.0f, 1.0f} - fv, q = (f32x2){bflo(R.qs[j]), bfhi(R.qs[j])};
              const f32x2 qt = q * E1, kt = kq * E2, qc = qt * eref, kh = kt * elr;
              const int t = 8 * w + j;
              *(LAS unsigned*)(L + H_QT + t * TP + 4 * lane) = cvt_pk_bf16(qt.x, qt.y);
              *(LAS unsigned*)(L + H_KT + t * TP + 4 * lane) = cvt_pk_bf16(kt.x, kt.y);
              *(LAS unsigned*)(L + H_QC + t * TP + 4 * lane) = cvt_pk_bf16(qc.x, qc.y);
              const unsigned kk = cvt_pk_bf16(kh.x, kh.y);
              if (j & 1) { kh0[j >> 1] |= (kk << 16); kh1[j >> 1] |= (kk & 0xffff0000u); vt0[j >> 1] |= (R.v[j] << 16); vt1[j >> 1] |= (R.v[j] & 0xffff0000u); }
              else { kh0[j >> 1] = kk & 0xffffu; kh1[j >> 1] = kk >> 16; vt0[j >> 1] = R.v[j] & 0xffffu; vt1[j >> 1] = R.v[j] >> 16; }
          }
          *(LAS v4u*)(L + H_KH + (2 * lane) * CP + 16 * w) = (v4u){kh0[0], kh0[1], kh0[2], kh0[3]};
          *(LAS v4u*)(L + H_KH + (2 * lane + 1) * CP + 16 * w) = (v4u){kh1[0], kh1[1], kh1[2], kh1[3]};
          *(LAS v4u*)(L + H_VT + (2 * lane) * CP + 16 * w) = (v4u){vt0[0], vt0[1], vt0[2], vt0[3]};
          *(LAS v4u*)(L + H_VT + (2 * lane + 1) * CP + 16 * w) = (v4u){vt1[0], vt1[1], vt1[2], vt1[3]};
        }
        LDS_BAR();
#pragma unroll
        for (int q = 0; q < 4; ++q) gsp_[q] = gs_[q];
        if (n + 1 < SEQ / CHUNK) HG_LOAD(n + 1);
        f32x16 O;
#pragma unroll
        for (int i = 0; i < 16; ++i) O[i] = 0.f;
#pragma unroll
        for (int sb = 0; sb < 2; ++sb) {
            if (sb <= tb) {
                f32x16 P;
#pragma unroll
                for (int i = 0; i < 16; ++i) P[i] = 0.f;
#pragma unroll
                for (int kh = 0; kh < 2; ++kh) {
                    bf16x8 fa[4], fb[4];
#pragma unroll
                    for (int k4 = 0; k4 < 4; ++k4) { const int ks = 4 * kh + k4; fa[k4] = *(const LAS bf16x8*)(L + H_KT + (32 * sb + r) * TP + (16 * ks + 8 * hh) * 2); fb[k4] = *(const LAS bf16x8*)(L + H_QT + (32 * tb + r) * TP + (16 * ks + 8 * hh) * 2); }
#pragma unroll
                    for (int k4 = 0; k4 < 4; ++k4) P = mfma32(fa[k4], fb[k4], P);
                }
                if (sb == tb) {
#pragma unroll
                    for (int i = 0; i < 16; ++i) { const int s = (i & 3) + 8 * (i >> 2) + 4 * hh; if (s > r) P[i] = 0.f; }
                }
#pragma unroll
                for (int k2 = 0; k2 < 2; ++k2) {
                    const bf16x8 av = ld2x8(L + H_VT + (32 * eb + r) * CP + (32 * sb + 16 * k2 + 4 * hh) * 2);
                    O = mfma32(av, pack8(P, 8 * k2), O);
                }
            }
        }
        { bf16x8 fq[8];
#pragma unroll
          for (int i = 0; i < 8; ++i) fq[i] = ld2x8(L + H_QC + (32 * tb + r) * TP + (32 * (i >> 1) + 16 * (i & 1) + 4 * hh) * 2);
#pragma unroll
          for (int i = 0; i < 8; ++i) O = mfma32(pack8(S[i >> 1], 8 * (i & 1)), fq[i], O); }
        { bf16x8 fv[4];
#pragma unroll
          for (int ks = 0; ks < 4; ++ks) fv[ks] = *(const LAS bf16x8*)(L + H_VT + (32 * eb + r) * CP + (16 * ks + 8 * hh) * 2);
#pragma unroll
          for (int db = 0; db < 4; ++db) {
              bf16x8 fk[4];
#pragma unroll
              for (int ks = 0; ks < 4; ++ks) fk[ks] = *(const LAS bf16x8*)(L + H_KH + (32 * db + r) * CP + (16 * ks + 8 * hh) * 2);
#pragma unroll
              for (int q = 0; q < 4; ++q) { const f32x4 dc = *(const LAS f32x4*)(L + H_DEC + (32 * db + 8 * q + 4 * hh) * 4);
                  S[db][4 * q + 0] *= dc[0]; S[db][4 * q + 1] *= dc[1]; S[db][4 * q + 2] *= dc[2]; S[db][4 * q + 3] *= dc[3]; }
#pragma unroll
              for (int ks = 0; ks < 4; ++ks) S[db] = mfma32(fk[ks], fv[ks], S[db]);
          } }
        float ssq = 0.f;
#pragma unroll
        for (int i = 0; i < 16; ++i) ssq += O[i] * O[i];
        ssq += __shfl_xor(ssq, 32);
        if (hh == 0) *(LAS float*)(L + H_NRM + (n & 1) * 1024 + (eb * 64 + 32 * tb + r) * 4) = ssq;
        Op = O;
    }
    LDS_BAR();
    hg_finish(L, (SEQ / CHUNK - 1) & 1, Op, gsp_, gn_, A2o + (size_t)(SEQ / CHUNK - 1) * CHUNK * DM, tb, r);
#undef HG_LOAD
}
#undef EX2
__device__ __forceinline__ void conv_phase(Frame& F, const bf16* U, bf16* A2, const float* convw, int first_block) {
    const int nb = F.G - first_block, me = F.bx - first_block, c = 2 * F.tid;
    const float w00 = convw[c], w01 = convw[c + 1], w10 = convw[DC + c], w11 = convw[DC + c + 1], w20 = convw[2 * DC + c], w21 = convw[2 * DC + c + 1];
    for (int u = me; u < M / 32; u += nb) {
        const int R0 = u * 32, t0 = R0 % SEQ;
        const bf16* up = U + (size_t)R0 * UP;
        float a0 = 0.f, a1 = 0.f, b0 = 0.f, b1 = 0.f;
        if (t0 != 0) { const unsigned p2 = *(const unsigned*)(up - 2 * (size_t)UP + 5120 + c), p1 = *(const unsigned*)(up - (size_t)UP + 5120 + c);
            a0 = bflo(p2); a1 = bfhi(p2); b0 = bflo(p1); b1 = bfhi(p1); }
#pragma unroll 8
        for (int j = 0; j < 32; ++j) {
            const unsigned tt = *(const unsigned*)(up + (size_t)j * UP + 5120 + c), gb = *(const unsigned*)(up + (size_t)j * UP + 4096 + c);
            const float t0f = bflo(tt), t1f = bfhi(tt);
            const float y0 = bflo(gb) * (w00 * a0 + w10 * b0 + w20 * t0f), y1 = bfhi(gb) * (w01 * a1 + w11 * b1 + w21 * t1f);
            *(unsigned*)(A2 + (size_t)(R0 + j) * DM + DH + c) = cvt_pk_bf16(y0, y1);
            a0 = b0; a1 = b1; b0 = t0f; b1 = t1f;
        }
    }
}

template <int W> __device__ __forceinline__ void pool_rows(const bf16* xc, bf16* dc, const LAS float* rt, int roff, bool seq_start) {
    v4u ring[16]; f32x4 S0 = (f32x4){0.f, 0.f, 0.f, 0.f}, S1 = S0;
#pragma unroll
    for (int k = W; k >= 1; --k) {
        v4u v = (v4u){0u, 0u, 0u, 0u};
        if (!seq_start) { v = *(const v4u*)(xc - (size_t)k * DM); f32x4 a, b; unpack8(v, a, b); const float r = rt[16 + roff - k]; S0 += a * r; S1 += b * r; }
        ring[(16 - k) & 15] = v;
    }
#pragma unroll
    for (int jb = 0; jb < 4; ++jb) {
        v4u tmp[8];
#pragma unroll
        for (int q = 0; q < 8; ++q) tmp[q] = *(const v4u*)(xc + (size_t)(8 * jb + q) * DM);
#pragma unroll
        for (int q = 0; q < 8; ++q) { const int j = 8 * jb + q;
            f32x4 a, b; unpack8(tmp[q], a, b); const float rn = rt[16 + roff + j]; a = a * rn; b = b * rn; S0 += a; S1 += b;
            if (!seq_start || j >= W) { f32x4 oa, ob; unpack8(ring[(j - W) & 15], oa, ob); const float ro = rt[16 + roff + j - W]; S0 -= oa * ro; S1 -= ob * ro; }
            ring[j & 15] = tmp[q];
            const float inv = 1.0f / (float)((seq_start && j + 1 < W) ? (j + 1) : W);
            const f32x4 d0 = S0 * inv - a, d1 = S1 * inv - b;
            v4u w; w.x = cvt_pk_bf16(d0[0], d0[1]); w.y = cvt_pk_bf16(d0[2], d0[3]); w.z = cvt_pk_bf16(d1[0], d1[1]); w.w = cvt_pk_bf16(d1[2], d1[3]);
            *(v4u*)(dc + (size_t)j * DM) = w; }
    }
}
#ifndef PH_ENABLE
#define PH_ENABLE 0xffffffffu
#endif
#define PH(k) (((PH_ENABLE) >> (k)) & 1u)
#ifndef PROBE_DUP
#define PROBE_DUP (-1)
#endif
#define REPS(k) ((PROBE_DUP) == (k) ? 2 : 1)
__global__ void __launch_bounds__(NWAVES * 64, 2) fwd_kernel(Args args) {
    extern __shared__ __attribute__((aligned(16))) unsigned char lds[];
    Frame F;
    F.lds = (LAS unsigned char*)lds;
    F.MISC = (volatile LAS unsigned*)(F.lds + MISC_OFF);
    F.tid = threadIdx.x; F.lane = F.tid & 63; F.wave = __builtin_amdgcn_readfirstlane(F.tid >> 6);
    F.G = gridDim.x; F.bx = blockIdx.x;
    unsigned char* ws = args.ws;
    F.ctl = (gu32*)(ws + WS_CTL);
    for (int u = F.tid; u < (LDS_BYTES - LDSCTL_OFF) / 4; u += NWAVES * 64) ((LAS unsigned*)(F.lds + LDSCTL_OFF))[u] = 0u;
    __syncthreads();
    XcdBarrier bar = xcd_barrier_post((unsigned*)(F.ctl + CW_BAR), F.MISC + 8);
#define PJ0_UNIT(k_) do { SchedPick SP; SP.s.o.init(M / 256, DM / 256, F.G, F.bx); SP.s.A = (const char*)W_PB; SP.s.B = (const char*)W_Wpp_t; SP.s.at = (size_t)256 * DPLE * 2; SP.s.bt = (size_t)256 * DPLE * 2; SP.k = (k_); \
        EpiBf16Plain EP{W_PJ0, DM}; pg8::gemm_phase<EpiBf16Plain, SchedPick, true>(F.lds, DPLE, DPLE, DPLE, SP, EP); } while (0)
#define GRID_BAR() do { xcd_barrier(bar); if (PROBE_DUP == 99) xcd_barrier(bar); } while (0)
#define REFRESH() do { int t_ = threadIdx.x; asm volatile("" : "+v"(t_)); F.tid = t_; F.lane = t_ & 63; F.wave = __builtin_amdgcn_readfirstlane(t_ >> 6); \
        int b_ = blockIdx.x; asm volatile("" : "+s"(b_)); F.bx = b_; gw = F.bx * NWAVES + F.wave; \
        kp_ = (const float* const __attribute__((address_space(4)))*)__builtin_amdgcn_kernarg_segment_ptr(); asm volatile("" : "+s"(kp_)); \
        ws_ = (unsigned char*)kp_[25]; X_ = (float*)kp_[24]; } while (0)
    const float* const __attribute__((address_space(4)))* kp_ = (const float* const __attribute__((address_space(4)))*)__builtin_amdgcn_kernarg_segment_ptr();
    unsigned char* ws_ = args.ws; float* X_ = args.out;
#define I_x (kp_[0])
#define I_p (kp_[1])
#define I_final_gain (kp_[2])
#define I_lb_table (kp_[3])
#define I_mix_norm_even (kp_[4])
#define I_w_in (kp_[5])
#define I_hgrn_gain (kp_[6])
#define I_conv_w (kp_[7])
#define I_w_out (kp_[8])
#define I_ffn_norm_even (kp_[9])
#define I_w_gate (kp_[10])
#define I_w_up (kp_[11])
#define I_w_down (kp_[12])
#define I_mix_norm_odd (kp_[13])
#define I_pool_w (kp_[14])
#define I_pool_scale (kp_[15])
#define I_ffn_norm_odd (kp_[16])
#define I_w_router (kp_[17])
#define I_w_gate_e (kp_[18])
#define I_w_up_e (kp_[19])
#define I_w_down_e (kp_[20])
#define I_ple_norm (kp_[21])
#define I_ple_gate_w (kp_[22])
#define I_ple_proj (kp_[23])
#define W_lbv ((float*)(ws_ + WS_LBV))
#define W_rs4 ((float*)(ws_ + WS_RS4))
#define W_topi ((int*)(ws_ + WS_TOP))
#define W_topw ((float*)(ws_ + WS_TOPW))
#define W_sspA ((float*)(ws_ + WS_SSPA))
#define W_sspB ((float*)(ws_ + WS_SSPB))
#define W_list ((int*)(ws_ + WS_LIST))
#define W_gwl ((float*)(ws_ + WS_GWL))
#define W_rsl ((float*)(ws_ + WS_TOKC))
#define W_tokc ((int*)(ws_ + WS_TOKC))
#define W_gwc ((float*)(ws_ + WS_GWC))
#define W_rsc ((float*)(ws_ + WS_RSC))
#define W_Win_t ((bf16*)(ws_ + WS_WIN))
#define W_Wout_t ((bf16*)(ws_ + WS_WOUT))
#define W_Wgu_t ((bf16*)(ws_ + WS_WGU))
#define W_Wd_t ((bf16*)(ws_ + WS_WD))
#define W_Wpool_t ((bf16*)(ws_ + WS_WPOOL))
#define W_Wmgu_t ((bf16*)(ws_ + WS_WMGU))
#define W_Wmd_t ((bf16*)(ws_ + WS_WMD))
#define W_Wpg_t ((bf16*)(ws_ + WS_WPG))
#define W_Wpp_t ((bf16*)(ws_ + WS_WPP))
#define W_PB ((bf16*)(ws_ + WS_PB))
#define W_XB ((bf16*)(ws_ + WS_XB))
#define W_A2 ((bf16*)(ws_ + WS_A2))
#define W_PJ ((bf16*)(ws_ + WS_A2))
#define W_PJ0 ((bf16*)(ws_ + WS_BIG + 128 * MiB))
#define W_U ((bf16*)(ws_ + WS_BIG))
#define W_Hh ((bf16*)(ws_ + WS_BIG))
#define W_D1 ((bf16*)(ws_ + WS_BIG))
#define W_XG ((bf16*)(ws_ + WS_BIG))
#define W_HE ((bf16*)(ws_ + WS_HE))
#define W_X (X_)
#define W_XS0 ((bf16*)(ws_ + WS_XB))
#define W_XQ ((unsigned char*)X_)
#define W_XQ1 ((unsigned char*)X_ + 64 * MiB)
#define W_XS1 ((bf16*)((unsigned char*)X_ + 64 * MiB))
#define W_XB0 ((bf16*)X_)
    int gw = F.bx * NWAVES + F.wave; const int NGW = F.G * NWAVES;

#ifndef CONV_MODE
#define CONV_MODE 0
#endif
#define CONVERT_REST(FIRSTB) do { \
            LDS_BAR(); \
            LAS unsigned char* scr = F.lds + F.wave * 16384; \
            const int wv = (F.bx - (FIRSTB)) * NWAVES + F.wave, nw = (F.G - (FIRSTB)) * NWAVES; int base = 0; \
            { const TrJob J{I_w_out, I_w_out, 0, 0, DM, DM, DM, 0, W_Wout_t, nullptr, 0}; base = tr_job(J, base, wv, nw, scr, F.lane); } \
            { const TrJob J{I_w_gate, I_w_up, 0, 0, DFF, DM, 0, DFF / 128, W_Wgu_t, I_ffn_norm_even, F8_GU}; base = tr_job(J, base, wv, nw, scr, F.lane); } \
            { const TrJob J{I_w_down, I_w_down, 0, 0, DM, DFF, DM, 0, W_Wd_t, nullptr, F8_DN}; base = tr_job(J, base, wv, nw, scr, F.lane); } \
            for (int i = 0; i < 2; ++i) { const TrJob J{I_ple_proj + (size_t)i * DPLE * DM, nullptr, 0, 0, DM, DPLE, DM, 0, W_Wpp_t + (size_t)i * DM * DPLE, nullptr, 0}; base = tr_job(J, base, wv, nw, scr, F.lane); } \
            for (int i = 0; i < 2; ++i) { const TrJob J{I_ple_gate_w + (size_t)i * DM * DM, nullptr, 0, 0, DM, DM, DM, 0, W_Wpg_t + (size_t)i * DM * DM, I_ple_norm + i * DM, (i == 1 && F8_PLE1) ? 1 : 0}; base = tr_job(J, base, wv, nw, scr, F.lane); } \
            for (int g = 0; g < 4; ++g) { const TrJob J{I_pool_w + (size_t)g * 512 * 512, nullptr, 0, 0, 512, 512, 512, 0, W_Wpool_t + (size_t)512 * g * 512, I_mix_norm_odd + 512 * g, 0}; base = tr_job(J, base, wv, nw, scr, F.lane); } \
            for (int e = 0; e < NE; ++e) { const TrJob J{I_w_gate_e + (size_t)e * DM * DFE, I_w_up_e + (size_t)e * DM * DFE, 0, 0, DFE, DM, 0, DFE / 128, W_Wmgu_t + (size_t)e * 2048 * DM / (F8_MOE ? 2 : 1), I_ffn_norm_odd, F8_MOE}; base = tr_job(J, base, wv, nw, scr, F.lane); } \
            for (int e = 0; e < NE; ++e) { const TrJob J{I_w_down_e + (size_t)e * DFE * DM, nullptr, 0, 0, DM, DFE, DM, 0, W_Wmd_t + (size_t)e * DM * DFE / (F8_MOE ? 2 : 1), nullptr, F8_MOE}; base = tr_job(J, base, wv, nw, scr, F.lane); } \
            for (size_t i = (size_t)(F.bx - (FIRSTB)) * 512 + F.tid; i < (size_t)2 * M * DPLE / 8; i += (size_t)(F.G - (FIRSTB)) * 512) { \
                const f32x4 a = ((const f32x4*)I_p)[2 * i], b2 = ((const f32x4*)I_p)[2 * i + 1]; \
                v4u w; w.x = cvt_pk_bf16(a[0], a[1]); w.y = cvt_pk_bf16(a[2], a[3]); w.z = cvt_pk_bf16(b2[0], b2[1]); w.w = cvt_pk_bf16(b2[2], b2[3]); ((v4u*)W_PB)[i] = w; } \
        } while (0)
    for (int rep_ = 0; rep_ < REPS(0); ++rep_) { REFRESH();
        LAS unsigned char* scr = F.lds + F.wave * 16384;
        int base = 0;
        { const TrJob J{I_w_in, I_w_in, 0, 0, NIN, DM, 5120, 0, W_Win_t, I_mix_norm_even, 0}; base = tr_job(J, base, gw, NGW, scr, F.lane); }
        { const TrJob J{I_w_in, I_w_in, 5120, 6144, NIN, DM, 0, 8, W_Win_t + (size_t)5120 * DM, I_mix_norm_even, 0}; base = tr_job(J, base, gw, NGW, scr, F.lane); }
        for (int m = gw; m < M; m += NGW) {
            const GAS f32x4* xr = (const GAS f32x4*)(I_x + (size_t)m * DM) + F.lane; GAS v2u* o8 = (GAS v2u*)(W_XB0 + (size_t)m * DM) + F.lane; float s = 0.f;
#pragma unroll
            for (int j = 0; j < 8; ++j) { const f32x4 v = xr[64 * j]; s += (v[0] * v[0] + v[1] * v[1]) + (v[2] * v[2] + v[3] * v[3]); v2u w; w.x = cvt_pk_bf16(v[0], v[1]); w.y = cvt_pk_bf16(v[2], v[3]); o8[64 * j] = w; }
            s = wave_sum(s);
            if (F.lane < 32) W_sspA[(size_t)m * 32 + F.lane] = (F.lane == 0) ? s : 0.f;
        }
        if (F.bx == 0) for (int j = F.tid; j < DH; j += 512) { const float t0 = I_lb_table[j], t1 = I_lb_table[DH + j], t2 = I_lb_table[2 * DH + j]; const float mx = fmaxf(t0, fmaxf(t1, t2));
            const float e0 = __expf(t0 - mx), e1 = __expf(t1 - mx), e2 = __expf(t2 - mx); W_lbv[j] = e0 / (e0 + e1 + e2); }
    }
    GRID_BAR();
    const size_t TB2048 = (size_t)256 * DM * 2;
    for (int rep_ = 0; rep_ < (PH(1) ? REPS(1) : 0); ++rep_) { REFRESH();
        SchedGrid S; S.o.init(M / 256, NIN / 256, F.G, F.bx); S.A = (const char*)W_XB0; S.B = (const char*)W_Win_t; S.at = TB2048; S.bt = TB2048;
        if (RS_TABLE) build_rstd_table(F.lds, S, W_sspA, F.tid);
        EpiInProj E{W_U, W_sspA, W_lbv, (const LAS float*)(F.lds + RS_TBL_OFF)};
        pg8::gemm_phase<EpiInProj, SchedGrid, true>(F.lds, DM, DM, DM, S, E);
    }
    GRID_BAR();
    for (int rep_ = 0; rep_ < REPS(2); ++rep_) { REFRESH(); if (F.bx < BATCH * NH) { hgrn_phase(F, W_U, W_A2, I_hgrn_gain); if (PROBE_DUP == 20) hgrn_phase(F, W_U, W_A2, I_hgrn_gain); }
        else for (int rep2_ = 0; rep2_ < (PROBE_DUP == 21 ? 2 : 1); ++rep2_) {
            conv_phase(F, W_U, W_A2, I_conv_w, BATCH * NH);
            if (CONV_MODE == 0) CONVERT_REST(BATCH * NH);
        }
    }
    GRID_BAR();
    if (CONV_MODE == 1) { for (int rep_ = 0; rep_ < REPS(16); ++rep_) { REFRESH(); CONVERT_REST(0); } GRID_BAR(); }
    for (int rep_ = 0; rep_ < (PH(3) ? REPS(3) : 0); ++rep_) { REFRESH();
        SchedGrid S; S.o.init(M / 256, DM / 256, F.G, F.bx); S.A = (const char*)W_A2; S.B = (const char*)W_Wout_t; S.at = TB2048; S.bt = TB2048;
        EpiResid<0, false, F8_GU> E{nullptr, W_XB0, W_XS0, W_sspB, nullptr, nullptr, nullptr, W_XQ1, nullptr};
        for (int step = 0; step < 3; ++step) {
            if (step == 1) pg8::gemm_phase<EpiResid<0, false, F8_GU>, SchedGrid, true>(F.lds, DM, DM, DM, S, E);
            else if ((step == 0) == (((F.bx >> 3) & 1) != 0)) { REFRESH(); PJ0_UNIT(0); }
            REFRESH();
        }
    }
    GRID_BAR();
    for (int rep_ = 0; rep_ < (PH(4) ? REPS(4) : 0); ++rep_) { REFRESH();
        constexpr int EB = F8_GU ? 1 : 2;
        SchedGrid S; S.o.init(M / 256, 2 * DFF / 256, F.G, F.bx); S.A = F8_GU ? (const char*)W_XQ1 : (const char*)W_XS0; S.B = (const char*)W_Wgu_t; S.at = (size_t)256 * DM * EB; S.bt = (size_t)256 * DM * EB;
        if (RS_TABLE) build_rstd_table(F.lds, S, W_sspB, F.tid);
        EpiSwiglu<false, F8_DN> E{W_Hh, DFF, W_sspB, nullptr, nullptr, (const LAS float*)(F.lds + RS_TBL_OFF)};
        pg8::gemm_phase<EpiSwiglu<false, F8_DN>, SchedGrid, true, F8_GU>(F.lds, DM * EB / 2, DM * EB / 2, DM * EB / 2, S, E);
    }
    GRID_BAR();
    for (int rep_ = 0; rep_ < (PH(5) ? REPS(5) : 0); ++rep_) { REFRESH();
        SchedGrid S; S.o.init(M / 256, DM / 256, F.G, F.bx); constexpr int EB = F8_DN ? 1 : 2; S.A = (const char*)W_Hh; S.B = (const char*)W_Wd_t; S.at = (size_t)256 * DFF * EB; S.bt = (size_t)256 * DFF * EB;
        EpiResid<0, false> E{nullptr, W_XS0, W_XS0, W_sspA, nullptr, nullptr, nullptr, nullptr, nullptr};
        for (int step = 0; step < 3; ++step) {
            if (step == 1) pg8::gemm_phase<EpiResid<0, false>, SchedGrid, true, F8_DN>(F.lds, DFF * EB / 2, DFF * EB / 2, DFF * EB / 2, S, E);
            else if ((step == 0) == (((F.bx >> 3) & 1) != 0)) { REFRESH(); PJ0_UNIT(1); }
            REFRESH();
        }
    }
    GRID_BAR();
    for (int rep_ = 0; rep_ < (PH(6) ? REPS(6) : 0); ++rep_) { REFRESH();
        SchedGrid S; S.o.init(M / 256, DM / 256, F.G, F.bx); S.A = (const char*)W_XB; S.B = (const char*)W_Wpg_t; S.at = TB2048; S.bt = TB2048;
        if (RS_TABLE) build_rstd_table(F.lds, S, W_sspA, F.tid);
        EpiResid<2, false> E{nullptr, W_XS0, W_XS1, W_sspB, nullptr, W_sspA, W_PJ0, nullptr, (const LAS float*)(F.lds + RS_TBL_OFF)};
        pg8::gemm_phase<EpiResid<2, false>, SchedGrid, true>(F.lds, DM, DM, DM, S, E);
    }
    GRID_BAR();
    for (int rep_ = 0; rep_ < (PH(7) ? REPS(7) : 0); ++rep_) { REFRESH();
        LAS float* rt = (LAS float*)F.lds;
        for (int seg = F.bx; seg < M / 64; seg += F.G) {
            const int R0 = seg * 64, t0 = R0 % SEQ;
            for (int i = F.wave; i < 80; i += NWAVES) { const int row = R0 - 16 + i; float v = 0.f;
                if (row >= 0 && F.lane < 32) v = W_sspB[(size_t)row * 32 + F.lane];
                v = wave_sum(v); if (F.lane == 0) rt[i] = 1.0f / sqrtf(v * (1.0f / DM) + EPS); }
            LDS_BAR();
            { const int tg = F.tid >> 8, tl = F.tid & 255, gi = tl >> 6, roff = 32 * tg;
              const bf16* xc = W_XS1 + (size_t)(R0 + roff) * DM + 8 * tl; bf16* dc = W_D1 + (size_t)(R0 + roff) * DM + 8 * tl;
              const bool ss = (t0 + roff) == 0;
              if (gi == 0) pool_rows<2>(xc, dc, rt, roff, ss); else if (gi == 1) pool_rows<4>(xc, dc, rt, roff, ss); else if (gi == 2) pool_rows<8>(xc, dc, rt, roff, ss); else pool_rows<16>(xc, dc, rt, roff, ss); }
            LDS_BAR();
        }
    }
    GRID_BAR();
    for (int rep_ = 0; rep_ < (PH(8) ? REPS(8) : 0); ++rep_) { REFRESH();
        SchedPool S; S.o.init(M / 256, DM / 256, F.G, F.bx); S.A = (const char*)W_D1; S.B = (const char*)W_Wpool_t; S.at = TB2048; S.bt = (size_t)256 * 512 * 2;
        EpiResid<1, false, F8_MOE> E{nullptr, W_XS1, W_XS1, W_sspA, I_pool_scale, nullptr, nullptr, W_XQ, nullptr};
        pg8::gemm_phase<EpiResid<1, false, F8_MOE>, SchedPool, true>(F.lds, 512, DM, 512, S, E);
    }
    GRID_BAR();
    for (int rep_ = 0; rep_ < (PH(9) ? REPS(9) : 0); ++rep_) { REFRESH();
        LAS unsigned char* L9 = F.lds;
        LAS float* plog = (LAS float*)(F.lds + 65536);
        LAS float* pss = (LAS float*)(F.lds + 65536 + 4096);
        for (int idx = F.tid; idx < 64 * 64; idx += 512) { const int i = idx >> 6, ln = idx & 63, n = ln & 15, kq = ln >> 4, e = n & 7; unsigned hw[8];
#pragma unroll
            for (int j = 0; j < 8; ++j) { const int k = 32 * i + 8 * kq + j; const float w = I_w_router[(size_t)k * NE + e] * I_ffn_norm_odd[k]; const unsigned hi = f2bf(w), lo = f2bf(w - __builtin_bit_cast(float, hi << 16)); hw[j] = (n < 8) ? hi : lo; }
            v4u pk; pk.x = hw[0] | (hw[1] << 16); pk.y = hw[2] | (hw[3] << 16); pk.z = hw[4] | (hw[5] << 16); pk.w = hw[6] | (hw[7] << 16);
            *(LAS v4u*)(L9 + (size_t)idx * 16) = pk; }
        LDS_BAR();
        for (int seg = F.bx; seg < M / 64; seg += F.G) {
            { const int rb = F.wave & 3, kh = F.wave >> 2, m = F.lane & 15, kq = F.lane >> 4;
              const bf16* xrow = W_XS1 + (size_t)(seg * 64 + rb * 16 + m) * DM + kh * 1024 + 8 * kq;
              f32x4 acc = (f32x4){0.f, 0.f, 0.f, 0.f}; float ss = 0.f;
#pragma unroll
              for (int bq = 0; bq < 2; ++bq) { v4u xa[16];
#pragma unroll
                  for (int i = 0; i < 16; ++i) xa[i] = *(const v4u*)(xrow + (bq * 16 + i) * 32);
#pragma unroll
                  for (int i = 0; i < 16; ++i) { const int ks = kh * 32 + bq * 16 + i; const v4u bw = *(const LAS v4u*)(L9 + (size_t)(ks * 64 + F.lane) * 16);
                      acc = __builtin_amdgcn_mfma_f32_16x16x32_bf16(__builtin_bit_cast(bf16x8, xa[i]), __builtin_bit_cast(bf16x8, bw), acc, 0, 0, 0);
                      f32x4 xa0, xa1; unpack8(xa[i], xa0, xa1);
                      ss += ((xa0[0] * xa0[0] + xa0[1] * xa0[1]) + (xa0[2] * xa0[2] + xa0[3] * xa0[3])) + ((xa1[0] * xa1[0] + xa1[1] * xa1[1]) + (xa1[2] * xa1[2] + xa1[3] * xa1[3])); } }
#pragma unroll
              for (int r = 0; r < 4; ++r) { const float v = acc[r] + __shfl(acc[r], F.lane + 8); if (m < 8) plog[(kh * 64 + rb * 16 + 4 * kq + r) * 8 + m] = v; }
              ss += __shfl_xor(ss, 16); ss += __shfl_xor(ss, 32);
              if (F.lane < 16) pss[kh * 64 + rb * 16 + m] = ss; }
            LDS_BAR();
            if (F.wave == 0) {
                float lg[8];
                { const f32x4 p0 = *(const LAS f32x4*)(plog + F.lane * 8), p1 = *(const LAS f32x4*)(plog + F.lane * 8 + 4), q0 = *(const LAS f32x4*)(plog + (64 + F.lane) * 8), q1 = *(const LAS f32x4*)(plog + (64 + F.lane) * 8 + 4);
#pragma unroll
                  for (int e = 0; e < 4; ++e) { lg[e] = p0[e] + q0[e]; lg[4 + e] = p1[e] + q1[e]; } }
                const float rsv = 1.0f / sqrtf((pss[F.lane] + pss[64 + F.lane]) * (1.0f / DM) + EPS);
                int i1 = 0; float l1 = lg[0];
#pragma unroll
                for (int e = 1; e < 8; ++e) if (lg[e] > l1) { l1 = lg[e]; i1 = e; }
                int i2 = -1; float l2 = -3.0e38f;
#pragma unroll
                for (int e = 0; e < 8; ++e) if (e != i1 && lg[e] > l2) { l2 = lg[e]; i2 = e; }
                const float wt1 = 1.0f / (1.0f + __expf((l2 - l1) * rsv)), wt2 = 1.0f - wt1;
                const int row = seg * 64 + F.lane; const int e1 = i1, e2 = i2;
                unsigned long long mk[16]; int mycnt = 0;
#pragma unroll
                for (int g = 0; g < 16; ++g) { const bool pr = (g < 8) ? (e1 == g) : (e2 == g - 8); mk[g] = __ballot(pr); if (F.lane == g) mycnt = __popcll(mk[g]); }
                int base = 0;
                if (F.lane < 16) base = (int)__hip_atomic_fetch_add((unsigned*)(F.ctl + CW_MOE) + F.lane, (unsigned)mycnt, RLX_AGENT);
                const unsigned long long lt = (1ull << F.lane) - 1ull;
#pragma unroll
                for (int g = 0; g < 16; ++g) { const int bg = __shfl(base, g); const bool pr = (g < 8) ? (e1 == g) : (e2 == g - 8);
                    if (pr) { const int slot = bg + __popcll(mk[g] & lt); W_list[(size_t)g * M + slot] = row; W_gwl[(size_t)g * M + slot] = (g < 8) ? wt1 : wt2; W_rsl[(size_t)g * M + slot] = rsv; } }
            }
            LDS_BAR();
        }
    }
    GRID_BAR();
    LAS int* tile_e = (LAS int*)(F.lds + LDSCTL_OFF + 1024);
    LAS int* tile_g = (LAS int*)(F.lds + LDSCTL_OFF + 1024 + 640);
    LAS int* tile_s0 = (LAS int*)(F.lds + LDSCTL_OFF + 1024 + 1280);
    LAS int* gtab = (LAS int*)(F.lds + LDSCTL_OFF + 1024 + 1920);
    for (int rep_ = 0; rep_ < (PH(11) ? REPS(11) : 0); ++rep_) { REFRESH();
        if (F.tid < 16) gtab[F.tid] = (int)__hip_atomic_load((unsigned*)(F.ctl + CW_MOE) + F.tid, RLX_AGENT);
        LDS_BAR();
        if (F.tid == 0) { int ti = 0;
            for (int g = 0; g < 16; ++g) { const int c = gtab[g]; const int nt = (c + 255) >> 8;
                for (int t = 0; t < nt; ++t) { tile_e[ti] = g & 7; tile_g[ti] = g; tile_s0[ti] = t * 256; ++ti; } if (g == 7) gtab[17] = ti; }
            gtab[16] = ti; }
        LDS_BAR();
        constexpr int EB = F8_MOE ? 1 : 2;
        SchedMoe S{tile_e, tile_g, tile_s0, gtab, 0, gtab[16], F.G, F.bx, F8_MOE ? (const char*)W_XQ : (const char*)W_XS1, (const char*)W_Wmgu_t, 0, (size_t)256 * DM * EB, (size_t)2048 * DM * EB, W_list, true};
        if (RS_TABLE) build_moe_tables(F.lds, S, W_list, W_rsl, false, F.tid);
        EpiSwiglu<true, F8_MOE> E{W_HE, DFE, nullptr, W_rsl, W_list, (const LAS float*)(F.lds + RS_TBL_OFF)};
        pg8::gemm_phase<EpiSwiglu<true, F8_MOE>, SchedMoe, true, F8_MOE, true>(F.lds, DM * EB / 2, DM * EB / 2, DM * EB / 2, S, E);
    }
    GRID_BAR();
    for (int rep_ = 0; rep_ < (PH(12) ? REPS(12) : 0); ++rep_) { REFRESH();
        constexpr int EB = F8_MOE ? 1 : 2;
        SchedMoe S{tile_e, tile_g, tile_s0, gtab, 0, gtab[17], F.G, F.bx, (const char*)W_HE, (const char*)W_Wmd_t, (size_t)256 * DFE * EB, (size_t)256 * DFE * EB, (size_t)DM * DFE * EB, W_list, false};
        if (RS_TABLE) build_moe_tables(F.lds, S, W_list, W_gwl, true, F.tid);
        EpiMoeDown<false> E{W_XS1, W_sspB, W_list, W_gwl, nullptr, (const LAS float*)(F.lds + RS_TBL_OFF), (const LAS int*)(F.lds + RS_TBL_OFF + 6144)};
        pg8::gemm_phase<EpiMoeDown<false>, SchedMoe, true, F8_MOE>(F.lds, DFE * EB / 2, DFE * EB / 2, DFE * EB / 2, S, E);
        REFRESH();
        { const int rem = (gtab[17] * 8) % F.G; SchedFill S2{0, 256, DM / 256, F.bx >= rem ? F.bx - rem : -1, F.G - rem, (const char*)(W_PB + (size_t)M * DPLE), (const char*)(W_Wpp_t + (size_t)DM * DPLE), (size_t)256 * DPLE * 2, (size_t)256 * DPLE * 2};
          EpiBf16Plain E2{W_PJ, DM};
          pg8::gemm_phase<EpiBf16Plain, SchedFill, true>(F.lds, DPLE, DPLE, DPLE, S2, E2); }
    }
    GRID_BAR();
    for (int rep_ = 0; rep_ < (PH(13) ? REPS(13) : 0); ++rep_) { REFRESH();
        constexpr int EB = F8_MOE ? 1 : 2;
        SchedMoe S{tile_e, tile_g, tile_s0, gtab, gtab[17], gtab[16], F.G, F.bx, (const char*)W_HE, (const char*)W_Wmd_t, (size_t)256 * DFE * EB, (size_t)256 * DFE * EB, (size_t)DM * DFE * EB, W_list, false};
        if (RS_TABLE) build_moe_tables(F.lds, S, W_list, W_gwl, true, F.tid);
        EpiMoeDown<true, F8_PLE1> E{W_XS1, W_sspB, W_list, W_gwl, W_XQ, (const LAS float*)(F.lds + RS_TBL_OFF), (const LAS int*)(F.lds + RS_TBL_OFF + 6144)};
        pg8::gemm_phase<EpiMoeDown<true, F8_PLE1>, SchedMoe, true, F8_MOE>(F.lds, DFE * EB / 2, DFE * EB / 2, DFE * EB / 2, S, E);
        REFRESH();
        { const int rem = ((gtab[16] - gtab[17]) * 8) % F.G; SchedFill S2{256, 512, DM / 256, F.bx >= rem ? F.bx - rem : -1, F.G - rem, (const char*)(W_PB + (size_t)M * DPLE), (const char*)(W_Wpp_t + (size_t)DM * DPLE), (size_t)256 * DPLE * 2, (size_t)256 * DPLE * 2};
          EpiBf16Plain E2{W_PJ, DM};
          pg8::gemm_phase<EpiBf16Plain, SchedFill, true>(F.lds, DPLE, DPLE, DPLE, S2, E2); }
    }
    GRID_BAR();
    for (int rep_ = 0; rep_ < (PH(14) ? REPS(14) : 0); ++rep_) { REFRESH();
        SchedGrid S; S.o.init(M / 256, DM / 256, F.G, F.bx); constexpr int EB = F8_PLE1 ? 1 : 2; S.A = F8_PLE1 ? (const char*)W_XQ : (const char*)W_XS1; S.B = (const char*)(W_Wpg_t + (size_t)DM * DM); S.at = (size_t)256 * DM * EB; S.bt = (size_t)256 * DM * EB;
        if (RS_TABLE) build_rstd_table(F.lds, S, W_sspB, F.tid);
        EpiResid<2, false> E{nullptr, W_XS1, W_XS0, W_sspA, nullptr, W_sspB, W_PJ, nullptr, (const LAS float*)(F.lds + RS_TBL_OFF)};
        pg8::gemm_phase<EpiResid<2, false>, SchedGrid, true, F8_PLE1>(F.lds, DM * EB / 2, DM * EB / 2, DM * EB / 2, S, E);
    }
    GRID_BAR();
    REFRESH();
    if (PH(15)) for (int m0 = gw; m0 < M; m0 += 4 * NGW) {
        v4u xv[4][4]; float sv[4];
#pragma unroll
        for (int q = 0; q < 4; ++q) { const int m = m0 + q * NGW; if (m < M) { const GAS v4u* xs = (const GAS v4u*)(W_XS0 + (size_t)m * DM) + F.lane;
#pragma unroll
                for (int j = 0; j < 4; ++j) xv[q][j] = xs[64 * j];
                sv[q] = (F.lane < 32) ? W_sspA[(size_t)m * 32 + F.lane] : 0.f; } }
#pragma unroll
        for (int q = 0; q < 4; ++q) { const int m = m0 + q * NGW; if (m < M) {
                const float rstd = 1.0f / sqrtf(wave_sum(sv[q]) * (1.0f / DM) + EPS);
                GAS f32x4* xo = (GAS f32x4*)(W_X + (size_t)m * DM) + 2 * F.lane; const f32x4* gp = (const f32x4*)I_final_gain + 2 * F.lane;
#pragma unroll
                for (int j = 0; j < 4; ++j) { f32x4 a, b; unpack8(xv[q][j], a, b); xo[128 * j] = a * rstd * gp[128 * j]; xo[128 * j + 1] = b * rstd * gp[128 * j + 1]; } } }
    }
}

extern "C" void kernel_launch(void* const* d_in, const int* in_sizes, int n_in, void* d_out, int out_size, void* d_ws, size_t ws_size, hipStream_t stream) {
    (void)in_sizes; (void)out_size;
    static int grid = 0;
    if (grid == 0) {
        if (n_in != 24 || ws_size < WS_END) { fprintf(stderr, "kernel_launch: bad arguments (n_in %d, ws %zu)\n", n_in, ws_size); grid = -1; return; }
        int dev = 0, cus = 0, per_cu = 0;
        if (hipGetDevice(&dev) != hipSuccess || hipDeviceGetAttribute(&cus, hipDeviceAttributeMultiprocessorCount, dev) != hipSuccess) { grid = -1; return; }
        if (hipFuncSetAttribute((const void*)fwd_kernel, hipFuncAttributeMaxDynamicSharedMemorySize, LDS_BYTES) != hipSuccess) { grid = -1; return; }
        if (hipOccupancyMaxActiveBlocksPerMultiprocessor(&per_cu, (const void*)fwd_kernel, NWAVES * 64, LDS_BYTES) != hipSuccess || per_cu < 1) { fprintf(stderr, "kernel_launch: occupancy query says %d\n", per_cu); }
        (void)hipGetLastError();
        grid = cus;
    }
    if (grid < 0) return;
    if (hipMemsetAsync((char*)d_ws + WS_CTL, 0, CTL_ZERO_BYTES, stream) != hipSuccess) return;
    Args a{};
    for (int i = 0; i < 24; ++i) a.in[i] = (const float*)d_in[i];
    a.out = (float*)d_out; a.ws = (unsigned char*)d_ws;
    hipLaunchKernelGGL(fwd_kernel, dim3(grid), dim3(NWAVES * 64), LDS_BYTES, stream, a);
}
```

```cpp
#include <hip/hip_runtime.h>
#include <cstdio>
#include <cstdint>

constexpr int DM = 2048, BATCH = 8, SEQ = 2048, M = BATCH * SEQ;
constexpr int DH = 1024, NH = 8, HD = 128, CHUNK = 64, DC = 1024, DFF = 5632, NE = 8, DFE = 1024, DPLE = 256;
constexpr int NIN = 7168;
constexpr int UP = 6144;
constexpr float EPS = 1e-6f;
constexpr int NWAVES = 8;
#ifndef RS_TABLE
#define RS_TABLE 1
#endif
#ifndef F8_GU
#define F8_GU 1
#endif
#ifndef F8_DN
#define F8_DN 1
#endif
#ifndef F8_MOE
#define F8_MOE 1
#endif
#ifndef F8_PLE1
#define F8_PLE1 1
#endif

constexpr size_t MiB = 1u << 20;
constexpr size_t WS_CTL = 0, CTL_ZERO_BYTES = 256 * 1024;
constexpr size_t WS_LBV = 1 * MiB;
constexpr size_t WS_RS4 = 1 * MiB + 64 * 1024;
constexpr size_t WS_TOP = 1 * MiB + 192 * 1024;
constexpr size_t WS_TOPW = 1 * MiB + 320 * 1024;
constexpr size_t WS_SSPA = 2 * MiB, WS_SSPB = 4 * MiB;
constexpr size_t WS_LIST = 6 * MiB;
constexpr size_t WS_GWL = 7 * MiB;
constexpr size_t WS_TOKC = 8 * MiB;
constexpr int RCAP = 36864;
constexpr size_t WS_GWC = WS_TOKC + (size_t)RCAP * 4, WS_RSC = WS_GWC + (size_t)RCAP * 4;
constexpr size_t WS_WIN = 10 * MiB;
constexpr size_t WS_WOUT = 38 * MiB;
constexpr size_t WS_WGU = 46 * MiB;
constexpr size_t WS_WD = 90 * MiB;
constexpr size_t WS_WPOOL = 112 * MiB;
constexpr size_t WS_WMGU = 114 * MiB;
constexpr size_t WS_WMD = 178 * MiB;
constexpr size_t WS_WPG = 210 * MiB;
constexpr size_t WS_WPP = 226 * MiB;
constexpr size_t WS_PB = 228 * MiB;
constexpr size_t WS_XB = 244 * MiB;
constexpr size_t WS_A2 = 308 * MiB;
constexpr size_t WS_BIG = 372 * MiB;
constexpr size_t WS_HE = 10 * MiB;
constexpr size_t WS_END = 564 * MiB;
static_assert(WS_BIG + (size_t)M * UP * 2 <= WS_END && WS_HE + (size_t)RCAP * DFE * 2 <= WS_WD, "ws map");
static_assert(WS_BIG + (size_t)RCAP * DM * 2 <= WS_END, "ws map XG");
static_assert(WS_BIG + (size_t)M * DFF <= WS_BIG + 128 * MiB && WS_BIG + 128 * MiB + (size_t)M * DM * 2 <= WS_END, "ws map PJ0 (H is fp8)");
constexpr int CW_BAR = 4096;
constexpr int CW_MOE = 16384;
constexpr int CW_DBG = 20000;

constexpr int RING_BYTES = 131072;
constexpr int LDSCTL_OFF = RING_BYTES, MISC_OFF = LDSCTL_OFF + 320;
constexpr int LDS_BYTES = 147456;

#define GAS __attribute__((address_space(1)))
#define LAS __attribute__((address_space(3)))
typedef unsigned short bf16;
typedef unsigned v4u __attribute__((ext_vector_type(4)));
typedef unsigned v2u __attribute__((ext_vector_type(2)));
typedef float f32x4 __attribute__((ext_vector_type(4)));
typedef float f32x2 __attribute__((ext_vector_type(2)));
typedef float f32x16 __attribute__((ext_vector_type(16)));
typedef short bf16x8 __attribute__((ext_vector_type(8)));
typedef short bf16x4 __attribute__((ext_vector_type(4)));
typedef GAS unsigned gu32;
#define RLX_AGENT __ATOMIC_RELAXED, __HIP_MEMORY_SCOPE_AGENT
#define LDS_WAIT() asm volatile("s_waitcnt lgkmcnt(0)" ::: "memory")
#define VM_WAIT() asm volatile("s_waitcnt vmcnt(0)" ::: "memory")
#define LDS_BAR() do { asm volatile("s_waitcnt lgkmcnt(0)" ::: "memory"); __builtin_amdgcn_s_barrier(); asm volatile("" ::: "memory"); } while (0)
__device__ __forceinline__ unsigned f2bf(float f) { unsigned u = __builtin_bit_cast(unsigned, f); return (u + 0x7fffu + ((u >> 16) & 1u)) >> 16; }
__device__ __forceinline__ unsigned pk2(float lo, float hi) { return f2bf(lo) | (f2bf(hi) << 16); }
__device__ __forceinline__ unsigned cvt_pk_bf16(float lo, float hi) { unsigned r; asm volatile("v_cvt_pk_bf16_f32 %0, %1, %2" : "=v"(r) : "v"(lo), "v"(hi)); return r; }
__device__ __forceinline__ float clamp8(float v) { return __builtin_amdgcn_fmed3f(v, -448.0f, 448.0f); }
__device__ __forceinline__ v2u pk8_fp8(const f32x4 a, const f32x4 b) {
    int w0 = 0, w1 = 0;
    w0 = __builtin_amdgcn_cvt_pk_fp8_f32(clamp8(a[0]), clamp8(a[1]), w0, false); w0 = __builtin_amdgcn_cvt_pk_fp8_f32(clamp8(a[2]), clamp8(a[3]), w0, true);
    w1 = __builtin_amdgcn_cvt_pk_fp8_f32(clamp8(b[0]), clamp8(b[1]), w1, false); w1 = __builtin_amdgcn_cvt_pk_fp8_f32(clamp8(b[2]), clamp8(b[3]), w1, true);
    v2u r; r.x = (unsigned)w0; r.y = (unsigned)w1; return r;
}
__device__ __forceinline__ float bflo(unsigned u) { return __builtin_bit_cast(float, u << 16); }
__device__ __forceinline__ float bfhi(unsigned u) { return __builtin_bit_cast(float, u & 0xffff0000u); }
__device__ __forceinline__ float fast_rcp(float x) { return __builtin_amdgcn_rcpf(x); }
__device__ __forceinline__ float sigmoidf_(float x) { return fast_rcp(1.0f + __expf(-x)); }
__device__ __forceinline__ float siluf_(float x) { return x * sigmoidf_(x); }
__device__ __forceinline__ f32x2 sigden2(f32x2 v, float c) { const f32x2 e = v * c; const f32x2 d = (f32x2){__builtin_amdgcn_exp2f(e.x), __builtin_amdgcn_exp2f(e.y)} + 1.0f; return (f32x2){fast_rcp(d.x), fast_rcp(d.y)}; }
__device__ __forceinline__ f32x2 silu2(f32x2 v, float r, float c) { return (v * r) * sigden2(v, c); }
__device__ __forceinline__ f32x2 swiglu2(f32x2 g, f32x2 u, float c, float r2) { return (g * u) * (sigden2(g, c) * r2); }
__device__ __forceinline__ f32x4 cat2(f32x2 a, f32x2 b) { return (f32x4){a.x, a.y, b.x, b.y}; }
constexpr float NLOG2E = -1.4426950408889634f;
__device__ __forceinline__ float rows_sum4(float v) {
    unsigned u = __builtin_bit_cast(unsigned, v);
    auto r = __builtin_amdgcn_permlane16_swap(u, u, false, false);
    float s = __builtin_bit_cast(float, (unsigned)r[0]) + __builtin_bit_cast(float, (unsigned)r[1]);
    u = __builtin_bit_cast(unsigned, s);
    auto q = __builtin_amdgcn_permlane32_swap(u, u, false, false);
    return __builtin_bit_cast(float, (unsigned)q[0]) + __builtin_bit_cast(float, (unsigned)q[1]);
}
__device__ __forceinline__ float wave_sum(float v) {
#pragma unroll
    for (int o = 1; o < 64; o <<= 1) v += __shfl_xor(v, o);
    return v;
}

#define XB_TMO      128
#define XB_XCNT(j)  (256  + 64 * (j))
#define XB_XSUB(j)  (1280 + 64 * (j))
#define XB_XGEN(j)  (2304 + 64 * (j))
#define XB_TOP      3328
#define XB_TOPGEN   3392
#define XCD_BAR_WORDS 3456
#define XB_SPIN_CAP (1u << 18)
__device__ __forceinline__ unsigned xb_ld(unsigned* p)              { return __hip_atomic_load(p, __ATOMIC_RELAXED, __HIP_MEMORY_SCOPE_AGENT); }
__device__ __forceinline__ unsigned xb_add(unsigned* p, unsigned v) { return __hip_atomic_fetch_add(p, v, __ATOMIC_RELAXED, __HIP_MEMORY_SCOPE_AGENT); }
__device__ __forceinline__ unsigned xb_xcc_id() { return (unsigned)__builtin_amdgcn_s_getreg((3 << 11) | 20) & 0xFu; }
#define XB_SPIN(cond, bar) do { unsigned _sp = 0; while (cond) { __builtin_amdgcn_s_sleep(1); \
    if ((++_sp & 255u) == 0u) { if (xb_ld(&(bar)[XB_TMO])) break; if (_sp > XB_SPIN_CAP) { atomicAdd(&(bar)[XB_TMO], 1u); break; } } } } while (0)
struct XcdBarrier { unsigned* bar; unsigned x; volatile LAS unsigned* st; };
__device__ __forceinline__ XcdBarrier xcd_barrier_post(unsigned* bar, volatile LAS unsigned* st) {
    XcdBarrier b; b.bar = bar; b.x = xb_xcc_id(); b.st = st;
    if (threadIdx.x == 0) (void)xb_add(&bar[XB_XCNT(b.x)], 1u);
    return b;
}
__device__ __forceinline__ void xcd_barrier_complete(unsigned* bar, unsigned x, unsigned& nloc, unsigned& nx) {
    const unsigned G = gridDim.x * gridDim.y * gridDim.z;
    unsigned sum, cnt, mine, sp = 0u;
    for (;;) {
        sum = 0u; cnt = 0u; mine = 0u;
#pragma unroll
        for (unsigned j = 0; j < 16; ++j) { const unsigned c = xb_ld(&bar[XB_XCNT(j)]); sum += c; cnt += (c > 0u) ? 1u : 0u; mine = (j == x) ? c : mine; }
        if (sum == G) break;
        __builtin_amdgcn_s_sleep(1);
        if ((++sp & 255u) == 0u) { if (xb_ld(&bar[XB_TMO])) break; if (sp > XB_SPIN_CAP) { atomicAdd(&bar[XB_TMO], 1u); break; } }
    }
    nloc = mine > 0u ? mine : 1u; nx = cnt > 0u ? cnt : 1u;
}
__device__ __forceinline__ void xcd_barrier(const XcdBarrier& b) {
    asm volatile("s_waitcnt vmcnt(0)" ::: "memory");
    __syncthreads();
    if (threadIdx.x == 0) {
        unsigned* bar = b.bar;
        __builtin_amdgcn_s_waitcnt(0);
        unsigned nloc = b.st[0], nx = b.st[1];
        if (nloc == 0u) { xcd_barrier_complete(bar, b.x, nloc, nx); b.st[0] = nloc; b.st[1] = nx; }
        const unsigned old = xb_add(&bar[XB_XSUB(b.x)], 1u);
        const unsigned gen = old / nloc;
        if (old + 1u == (gen + 1u) * nloc) {
            __builtin_amdgcn_fence(__ATOMIC_RELEASE, "agent");
            asm volatile("s_waitcnt vmcnt(0)" ::: "memory");
            const unsigned og = xb_add(&bar[XB_TOP], 1u);
            const unsigned tg = og / nx;
            if (og + 1u == (tg + 1u) * nx) xb_add(&bar[XB_TOPGEN], 1u);
            else XB_SPIN(xb_ld(&bar[XB_TOPGEN]) == tg, bar);
            __builtin_amdgcn_fence(__ATOMIC_ACQUIRE, "agent");
            xb_add(&bar[XB_XGEN(b.x)], 1u);
            asm volatile("s_waitcnt vmcnt(0)" ::: "memory");
        } else {
            XB_SPIN(xb_ld(&bar[XB_XGEN(b.x)]) == gen, bar);
            __builtin_amdgcn_fence(__ATOMIC_ACQUIRE, "agent");
            asm volatile("s_waitcnt vmcnt(0)" ::: "memory");
        }
    }
    __syncthreads();
}

#ifndef NG_M2
#define NG_M2 2
#endif
#ifndef F8_NOSCALE
#define F8_NOSCALE 1
#endif
#ifndef XCD_ROT
#define XCD_ROT 1
#endif
namespace pg8 {
constexpr int BM = 256, BK = 64, HALF = 128, HTB = HALF * BK * 2, STAGE_BYTES = 8 * HTB, NXCD = 8, WGM = 8;
__host__ __device__ __forceinline__ int lds_byte(int r, int c) { const int st = (r >> 4) * 2 + (c >> 5), rr = r & 15, cc = c & 31, ob = rr * 64 + cc * 2; return st * 1024 + (ob ^ (((ob >> 9) & 1) << 5)); }
__host__ __device__ __forceinline__ void stage_rc(int b, int& R, int& C) { const int st = b / 1024, sb = b % 1024, swz = sb ^ (((sb >> 9) & 1) << 5); R = (st >> 1) * 16 + swz / 64; C = (st & 1) * 32 + (swz % 64) / 2; }
__host__ __device__ __forceinline__ int perm32(int rho) { const int n = rho >> 4, i = rho & 15; return 8 * (i >> 2) + 4 * n + (i & 3); }
struct Unit { int pm, pn; const char* a; const char* b; const int* rows; int nvalid; int ord; };
typedef int v4i_t __attribute__((ext_vector_type(4)));
typedef int v8i_t __attribute__((ext_vector_type(8)));
__device__ __forceinline__ bf16x8 lo8(v8i_t v) { return __builtin_bit_cast(bf16x8, __builtin_shufflevector(v, v, 0, 1, 2, 3)); }
__device__ __forceinline__ bf16x8 hi8(v8i_t v) { return __builtin_bit_cast(bf16x8, __builtin_shufflevector(v, v, 4, 5, 6, 7)); }
__device__ __forceinline__ v8i_t cat8(bf16x8 lo, bf16x8 hi) { return __builtin_shufflevector(__builtin_bit_cast(v4i_t, lo), __builtin_bit_cast(v4i_t, hi), 0, 1, 2, 3, 4, 5, 6, 7); }
struct GridOrder {
    int nM, nN, nwg, G, c, rot;
    __device__ __forceinline__ void init(int nM_, int nN_, int G_, int c_) { nM = nM_; nN = nN_; nwg = nM * nN; G = G_; c = c_; rot = (XCD_ROT && nM_ == NXCD * WGM && (nN_ & 3) == 0) ? (c_ % NXCD) % (nN_ >> 2) : -1; }
    __device__ __forceinline__ bool tile(int i, int& pm, int& pn) const {
        const long L = (long)i * G + c; if (L >= nwg) return false;
        int wgid = (int)L; { const int q = nwg / NXCD, r = nwg % NXCD, xcd = wgid % NXCD, off = wgid / NXCD; wgid = (xcd < r ? xcd * (q + 1) : r * (q + 1) + (xcd - r) * q) + off; }
        const int nig = WGM * nN, gid = wgid / nig, fm = gid * WGM, gsz = (nM - fm) < WGM ? (nM - fm) : WGM;
        pm = fm + ((wgid % nig) % gsz); pn = (wgid % nig) / gsz;
        if (rot >= 0) { const int ngr = nN >> 2, st = (ngr > NXCD && (ngr & 1)) ? NXCD : 1;
            const int g = ((pn >> 2) * st + rot) % ngr; pn = 4 * g + (pn & 3); }
        return true;
    }
};

template <class Epi, class Sched, bool ALIGN_EPI, bool FP8 = false, bool GATHER = false>
__device__ __forceinline__ void gemm_phase(LAS unsigned char* lds, const int K, const int lda, const int ldb, const Sched& S, const Epi& E) {
    int tid_ = threadIdx.x; asm volatile("" : "+v"(tid_));
    const int tid = tid_, wid = __builtin_amdgcn_readfirstlane(tid >> 6), lane = tid & 63, wr = wid >> 2, wc = wid & 3, fr = lane & 15, fq = lane >> 4;
    const int nt = K / BK;
    unsigned voffA[2], voffB[2];
#pragma unroll
    for (int i = 0; i < 2; ++i) { int R, C; stage_rc(tid * 16 + i * 8192, R, C); const int Rb = Epi::PERM ? ((R & ~31) + perm32(R & 31)) : R;
        voffA[i] = (unsigned)(R * lda + C) * 2u; voffB[i] = (unsigned)(Rb * ldb + C) * 2u; }
    unsigned vG[2][2]; int tkn[2][2];
#pragma unroll
    for (int i = 0; i < 2; ++i) { vG[0][i] = vG[1][i] = 0u; tkn[0][i] = tkn[1][i] = 0; }
    const size_t kstep = (size_t)(BK * 2);
    const size_t hstepA = (size_t)HALF * lda * 2, hstepB = (size_t)HALF * ldb * 2;
    const unsigned ldsw = (unsigned)wid * 1024u;
    const int aoff = lds_byte(wr * 64 + fr, fq * 8), boff = lds_byte(wc * 32 + fr, fq * 8);
#define PG8_SA(b, h) (((b) * 2 + (h)) * HTB)
#define PG8_SB(b, h) ((4 + (b) * 2 + (h)) * HTB)
#define PG8_STAGE(bufoff, gbase, voff) do { _Pragma("unroll") for (int _i = 0; _i < 2; ++_i) \
        __builtin_amdgcn_global_load_lds((const unsigned*)((const char*)(gbase) + (voff)[_i]), (LAS unsigned*)(lds + (bufoff) + ldsw + _i * 8192), 16, 0, 0); } while (0)
#define PG8_STAGEA(bufoff, gk, h) do { if constexpr (GATHER) { PG8_STAGE(bufoff, gk, vG[h]); } else { PG8_STAGE(bufoff, (gk) + (h) * hstepA, voffA); } } while (0)
#define PG8_TOKLOAD(u, tk) do { _Pragma("unroll") for (int _h = 0; _h < 2; ++_h) _Pragma("unroll") for (int _i = 0; _i < 2; ++_i) { int gR_, gC_; stage_rc(tid * 16 + _i * 8192, gR_, gC_); const int row_ = _h * HALF + gR_; tk[_h][_i] = (u).rows[row_ < (u).nvalid ? row_ : (u).nvalid - 1]; }     } while (0)
#define PG8_TOKSET(tk) do { _Pragma("unroll") for (int _h = 0; _h < 2; ++_h) _Pragma("unroll") for (int _i = 0; _i < 2; ++_i) { int gR_, gC_; stage_rc(tid * 16 + _i * 8192, gR_, gC_); vG[_h][_i] = (unsigned)tk[_h][_i] * (unsigned)(lda * 2) + (unsigned)gC_ * 2u; } } while (0)
#define PG8_LDA(dst, b, h) do { _Pragma("unroll") for (int m = 0; m < 4; ++m) { const bf16x8 lo_ = *(const LAS bf16x8*)(lds + PG8_SA(b, h) + aoff + m * 2048), hi_ = *(const LAS bf16x8*)(lds + PG8_SA(b, h) + aoff + m * 2048 + 1024); dst[m] = cat8(lo_, hi_); } } while (0)
#define PG8_LDB(dst, b, h) do { _Pragma("unroll") for (int n = 0; n < 2; ++n) { const bf16x8 lo_ = *(const LAS bf16x8*)(lds + PG8_SB(b, h) + boff + n * 2048), hi_ = *(const LAS bf16x8*)(lds + PG8_SB(b, h) + boff + n * 2048 + 1024); dst[n] = cat8(lo_, hi_); } } while (0)
#define PG8_MMA(ai, bj, At, Bt) do { __builtin_amdgcn_s_setprio(1); _Pragma("unroll") for (int m = 0; m < 4; ++m) _Pragma("unroll") for (int n = 0; n < 2; ++n) { \
        if constexpr (FP8) { if (F8_NOSCALE) asm volatile("v_mfma_f32_16x16x128_f8f6f4 %0, %1, %2, %0" : "+v"(acc[ai][bj][m][n]) : "v"(Bt[n]), "v"(At[m])); \
                             else asm volatile("v_mfma_scale_f32_16x16x128_f8f6f4 %0, %1, %2, %0, %3, %4 op_sel_hi:[0,0,0]" : "+v"(acc[ai][bj][m][n]) : "v"(Bt[n]), "v"(At[m]), "v"(sc_w), "v"(sc_x)); } \
        else { acc[ai][bj][m][n] = __builtin_amdgcn_mfma_f32_16x16x32_bf16(lo8(Bt[n]), lo8(At[m]), acc[ai][bj][m][n], 0, 0, 0); \
               acc[ai][bj][m][n] = __builtin_amdgcn_mfma_f32_16x16x32_bf16(hi8(Bt[n]), hi8(At[m]), acc[ai][bj][m][n], 0, 0, 0); } } __builtin_amdgcn_s_setprio(0); } while (0)
#define PG8_WAIT_V(n) asm volatile("s_waitcnt vmcnt(" #n ")" ::: "memory")
#define PG8_WAIT_L(n) asm volatile("s_waitcnt lgkmcnt(" #n ")" ::: "memory")
#define PG8_BAR __builtin_amdgcn_s_barrier()
#define PG8_SCHED __builtin_amdgcn_sched_barrier(0)
    Unit cur, nxt; int ui = 0;
    if (!S.next(0, cur)) return;
    cur.ord = 0;
    f32x4 acc[2][2][4][2];
#pragma unroll
    for (int a = 0; a < 2; ++a)
#pragma unroll
        for (int b = 0; b < 2; ++b)
#pragma unroll
            for (int m = 0; m < 4; ++m)
#pragma unroll
                for (int n = 0; n < 2; ++n) acc[a][b][m][n] = (f32x4){0.f, 0.f, 0.f, 0.f};
    v8i_t At[4], B0[2], B1[2];
    const int sc_w = 0x79797979, sc_x = 0x7f7f7f7f;
    (void)sc_w; (void)sc_x;
    const char* cA = cur.a; const char* cB = cur.b;
    if constexpr (GATHER) { PG8_TOKLOAD(cur, tkn); PG8_TOKSET(tkn); }
    PG8_STAGE(PG8_SB(0, 0), cB, voffB); PG8_STAGE(PG8_SB(0, 1), cB + hstepB, voffB); PG8_STAGEA(PG8_SA(0, 0), cA, 0); PG8_STAGEA(PG8_SA(0, 1), cA, 1);
    if (wr == 1) PG8_BAR;
    PG8_WAIT_V(2); PG8_BAR;
    PG8_STAGE(PG8_SB(1, 0), cB + kstep, voffB); PG8_STAGEA(PG8_SA(1, 0), cA + kstep, 0); PG8_STAGE(PG8_SB(1, 1), cB + hstepB + kstep, voffB);
    PG8_WAIT_V(6); PG8_BAR;
    for (;;) {
        const bool has_next = S.next(ui + 1, nxt); nxt.ord = ui + 1;
        const char* nA = has_next ? nxt.a : cA; const char* nB = has_next ? nxt.b : cB;
#pragma nounroll
        for (int t = 0; t < nt; t += 2) {
            const bool last = (t == nt - 2);
            const char* a1 = cA + (size_t)(t + 1) * kstep;
            const char* a2 = last ? nA : cA + (size_t)(t + 2) * kstep; const char* b2 = last ? nB : cB + (size_t)(t + 2) * kstep;
            const char* a3 = a2 + kstep; const char* b3 = b2 + kstep;
            if constexpr (GATHER) { if (has_next && t == nt - 4) PG8_TOKLOAD(nxt, tkn); }
            PG8_LDB(B0, 0, 0); PG8_LDB(B1, 0, 1); PG8_SCHED; PG8_LDA(At, 0, 0); PG8_STAGEA(PG8_SA(1, 1), a1, 1);
            if constexpr (GATHER) { if (last && has_next) PG8_TOKSET(tkn); }
            PG8_WAIT_V(8); PG8_WAIT_L(0); PG8_BAR; PG8_MMA(0, 0, At, B0); PG8_MMA(0, 1, At, B1); PG8_BAR; PG8_SCHED;
            PG8_LDA(At, 0, 1); PG8_STAGE(PG8_SB(0, 0), b2, voffB); PG8_STAGE(PG8_SB(0, 1), b2 + hstepB, voffB); PG8_STAGEA(PG8_SA(0, 0), a2, 0);
            PG8_WAIT_V(8); PG8_WAIT_L(0); PG8_BAR; PG8_MMA(1, 0, At, B0); PG8_MMA(1, 1, At, B1); PG8_BAR; PG8_SCHED;
            PG8_LDB(B0, 1, 0); PG8_LDB(B1, 1, 1); PG8_SCHED; PG8_LDA(At, 1, 0); PG8_STAGEA(PG8_SA(0, 1), a2, 1);
            PG8_WAIT_V(8); PG8_WAIT_L(0); PG8_BAR; PG8_MMA(0, 0, At, B0); PG8_MMA(0, 1, At, B1); PG8_BAR; PG8_SCHED;
            PG8_LDA(At, 1, 1); PG8_STAGE(PG8_SB(1, 0), b3, voffB); PG8_STAGE(PG8_SB(1, 1), b3 + hstepB, voffB); PG8_STAGEA(PG8_SA(1, 0), a3, 0);
            PG8_WAIT_V(8); PG8_WAIT_L(0); PG8_BAR; PG8_MMA(1, 0, At, B0); PG8_MMA(1, 1, At, B1); PG8_BAR; PG8_SCHED;
        }
        if constexpr (ALIGN_EPI) { if (wr == 0) PG8_BAR; }
        if constexpr (FP8) asm volatile("s_nop 15\n\ts_nop 15" ::: "memory");
        if constexpr (FP8 && F8_NOSCALE) {
#pragma unroll
            for (int a = 0; a < 2; ++a)
#pragma unroll
                for (int b = 0; b < 2; ++b)
#pragma unroll
                    for (int m = 0; m < 4; ++m)
#pragma unroll
                        for (int n = 0; n < 2; ++n) acc[a][b][m][n] = acc[a][b][m][n] * 0.015625f;
        }
        E(acc, cur, wr, wc, fr, fq);
        if (!has_next) break;
#pragma unroll
        for (int a = 0; a < 2; ++a)
#pragma unroll
            for (int b = 0; b < 2; ++b)
#pragma unroll
                for (int m = 0; m < 4; ++m)
#pragma unroll
                    for (int n = 0; n < 2; ++n) acc[a][b][m][n] = (f32x4){0.f, 0.f, 0.f, 0.f};
        cur = nxt; cA = nA; cB = nB; ++ui;
        if constexpr (ALIGN_EPI) { if (wr == 1) PG8_BAR; }
    }
    PG8_WAIT_V(0);
    if constexpr (!ALIGN_EPI) { if (wr == 0) PG8_BAR; }
    PG8_BAR;
#undef PG8_SA
#undef PG8_SB
#undef PG8_STAGE
#undef PG8_STAGEA
#undef PG8_TOKLOAD
#undef PG8_TOKSET
#undef PG8_LDA
#undef PG8_LDB
#undef PG8_MMA
#undef PG8_WAIT_V
#undef PG8_WAIT_L
#undef PG8_BAR
#undef PG8_SCHED
}
}
using pg8::Unit;

struct SchedGrid {
    pg8::GridOrder o; const char* A; const char* B; size_t at, bt;
    __device__ __forceinline__ bool next(int i, Unit& u) const { if (!o.tile(i, u.pm, u.pn)) return false; u.a = A + (size_t)u.pm * at; u.b = B + (size_t)u.pn * bt; return true; }
};
struct SchedPick {
    SchedGrid s; int k;
    __device__ __forceinline__ bool next(int i, Unit& u) const { return i == 0 && s.next(k, u); }
};
struct SchedPool {
    pg8::GridOrder o; const char* A; const char* B; size_t at, bt;
    __device__ __forceinline__ bool next(int i, Unit& u) const { if (!o.tile(i, u.pm, u.pn)) return false; u.a = A + (size_t)u.pm * at + (size_t)(u.pn >> 1) * 1024; u.b = B + (size_t)u.pn * bt; return true; }
};
struct SchedPJ {
    pg8::GridOrder o; const char* A; const char* B; size_t at, bt;
    __device__ __forceinline__ bool next(int i, Unit& u) const { if (!o.tile(i, u.pm, u.pn)) return false; u.a = A + (size_t)u.pm * at; u.b = B + (size_t)((u.pm >> 6) * 8 + u.pn) * bt; return true; }
};
struct SchedMoe {
    const LAS int* tile_e; const LAS int* tile_g; const LAS int* tile_s0; const LAS int* gcnt; int rt0, rt1, G, c; const char* A; const char* B; size_t at, bt, be; const int* list; bool gather;
    __device__ __forceinline__ bool next(int i, Unit& u) const {
        const int L = i * G + c, n = (rt1 - rt0) * 8; if (L >= n) return false;
        u.pm = rt0 + (L >> 3); u.pn = L & 7; const int e = tile_e[u.pm], g = tile_g[u.pm], s0 = tile_s0[u.pm];
        u.a = gather ? A : A + (size_t)u.pm * at; u.b = B + (size_t)e * be + (size_t)u.pn * bt;
        u.rows = list + (size_t)g * M + s0; u.nvalid = gcnt[g] - s0; return true; }
};

struct SchedFill {
    int lo, hi, nN, rank, nlight; const char* A; const char* B; size_t at, bt;
    __device__ __forceinline__ bool next(int i, Unit& u) const {
        if (rank < 0) return false; const int k = lo + rank + i * nlight; if (k >= hi) return false;
        u.pm = k / nN; u.pn = k % nN; u.a = A + (size_t)u.pm * at; u.b = B + (size_t)u.pn * bt; u.rows = nullptr; u.nvalid = 0; return true; }
};
__device__ __forceinline__ void load_rstd(const float* ssp, int row0, int fq, float (&rs)[2][4]) {
#pragma unroll
    for (int ai = 0; ai < 2; ++ai)
#pragma unroll
        for (int m = 0; m < 4; ++m) {
            const float* sp = ssp + (size_t)(row0 + ai * 128 + m * 16) * 32 + fq * 8;
            const f32x4 a = *(const f32x4*)sp, b = *(const f32x4*)(sp + 4);
            float s = ((a[0] + a[1]) + (a[2] + a[3])) + ((b[0] + b[1]) + (b[2] + b[3]));
            s += __shfl_xor(s, 16); s += __shfl_xor(s, 32);
            rs[ai][m] = 1.0f / sqrtf(s * (1.0f / DM) + EPS);
        }
}
constexpr int RS_TBL_OFF = LDSCTL_OFF + 4096, RS_TBL_UNITS = 11;
template <class Sched> __device__ __forceinline__ void build_rstd_table(LAS unsigned char* lds, const Sched& S, const float* ssp, int tid) {
    LAS float* tbl = (LAS float*)(lds + RS_TBL_OFF); const int row = tid >> 1, half = tid & 1;
    for (int i0 = 0; i0 < RS_TBL_UNITS; i0 += 4) {
        f32x4 v[4][4]; bool ok[4];
#pragma unroll
        for (int q = 0; q < 4; ++q) { Unit u; ok[q] = (i0 + q < RS_TBL_UNITS) && S.next(i0 + q, u);
            if (ok[q]) { const f32x4* sp = (const f32x4*)(ssp + (size_t)(u.pm * 256 + row) * 32 + half * 16);
#pragma unroll
                for (int j = 0; j < 4; ++j) v[q][j] = sp[j]; } }
#pragma unroll
        for (int q = 0; q < 4; ++q) if (ok[q]) { float s = 0.f;
#pragma unroll
            for (int j = 0; j < 4; ++j) s += (v[q][j][0] + v[q][j][1]) + (v[q][j][2] + v[q][j][3]);
            s += __shfl_xor(s, 1);
            if (half == 0) tbl[(i0 + q) * 256 + row] = 1.0f / sqrtf(s * (1.0f / DM) + EPS); }
    }
    LDS_BAR();
}
__device__ __forceinline__ void table_rstd(const LAS float* tbl, int ord, int wr, int fr, float (&rs)[2][4]) {
#pragma unroll
    for (int ai = 0; ai < 2; ++ai)
#pragma unroll
        for (int m = 0; m < 4; ++m) rs[ai][m] = tbl[ord * 256 + wr * 64 + fr + ai * 128 + m * 16];
}
template <class Sched> __device__ __forceinline__ void build_moe_tables(LAS unsigned char* lds, const Sched& S, const int* list, const float* fsrc, bool want_tok, int tid) {
    LAS float* tf = (LAS float*)(lds + RS_TBL_OFF); LAS int* ti = (LAS int*)(lds + RS_TBL_OFF + 6144);
    float fv[3]; int tk[3]; bool have[3], ok[3]; const int r = tid & 255;
#pragma unroll
    for (int k = 0; k < 3; ++k) { Unit u; have[k] = S.next(2 * k + (tid >> 8), u); ok[k] = false; fv[k] = 0.f; tk[k] = -1;
        if (have[k]) { ok[k] = r < u.nvalid; const int rc = ok[k] ? r : u.nvalid - 1; fv[k] = fsrc[(u.rows - list) + rc]; if (want_tok) tk[k] = u.rows[rc]; } }
#pragma unroll
    for (int k = 0; k < 3; ++k) if (have[k]) { const int i = 2 * k + (tid >> 8); tf[i * 256 + r] = ok[k] ? fv[k] : 0.f; if (want_tok) ti[i * 256 + r] = ok[k] ? tk[k] : -1; }
    LDS_BAR();
}
struct EpiInProj {
    static constexpr bool PERM = true;
    bf16* U; const float* ssp; const float* lbv; const LAS float* tbl;
    __device__ __forceinline__ void operator()(const f32x4 (&acc)[2][2][4][2], const Unit& u, int wr, int wc, int fr, int fq) const {
        const int row0 = u.pm * 256 + wr * 64 + fr;
        float rs[2][4]; if (RS_TABLE) table_rstd(tbl, u.ord, wr, fr, rs); else load_rstd(ssp, row0, fq, rs);
        const int pn = u.pn;
        if (pn >= 20) {
            const int col0 = 5120 + (pn - 20) * 128 + wc * 32 + 8 * fq;
#pragma unroll
            for (int ai = 0; ai < 2; ++ai)
#pragma unroll
                for (int m = 0; m < 4; ++m) { const float r2 = rs[ai][m] * rs[ai][m];
                    const f32x4 a0 = acc[ai][0][m][0] * acc[ai][1][m][0] * r2, a1 = acc[ai][0][m][1] * acc[ai][1][m][1] * r2;
                    v4u w; w.x = cvt_pk_bf16(a0[0], a0[1]); w.y = cvt_pk_bf16(a0[2], a0[3]); w.z = cvt_pk_bf16(a1[0], a1[1]); w.w = cvt_pk_bf16(a1[2], a1[3]);
                    *(v4u*)(U + (size_t)(row0 + ai * 128 + m * 16) * UP + col0) = w; }
            return;
        }
        const int kind = pn >> 2;
        const int col0 = pn * 256 + wc * 32 + 8 * fq;
        f32x4 lb[2][2];
        if (kind == 1) {
#pragma unroll
            for (int bj = 0; bj < 2; ++bj)
#pragma unroll
                for (int n = 0; n < 2; ++n) lb[bj][n] = *(const f32x4*)(lbv + (col0 - 1024) + bj * 128 + 4 * n);
            asm volatile("" :: "v"(lb[0][0]), "v"(lb[0][1]), "v"(lb[1][0]), "v"(lb[1][1]));
        }
#pragma unroll
        for (int ai = 0; ai < 2; ++ai)
#pragma unroll
            for (int m = 0; m < 4; ++m) { bf16* rowp = U + (size_t)(row0 + ai * 128 + m * 16) * UP + col0; const float r = rs[ai][m], c = r * NLOG2E;
#pragma unroll
                for (int bj = 0; bj < 2; ++bj) { const f32x4 a0 = acc[ai][bj][m][0], a1 = acc[ai][bj][m][1]; f32x4 v0, v1;
                    if (kind == 0 || kind == 3) { v0 = cat2(silu2(a0.xy, r, c), silu2(a0.zw, r, c)); v1 = cat2(silu2(a1.xy, r, c), silu2(a1.zw, r, c)); }
                    else if (kind == 1) { const f32x4 l0 = lb[bj][0], l1 = lb[bj][1], m0 = 1.0f - l0, m1 = 1.0f - l1;
                        const f32x4 s0 = cat2(sigden2(a0.xy, c), sigden2(a0.zw, c)), s1 = cat2(sigden2(a1.xy, c), sigden2(a1.zw, c)), t0 = l0 + m0 * s0, t1 = l1 + m1 * s1;
#pragma unroll
                        for (int j = 0; j < 4; ++j) { v0[j] = __builtin_amdgcn_logf(t0[j]); v1[j] = __builtin_amdgcn_logf(t1[j]);     }
                    } else { v0 = a0 * r; v1 = a1 * r; }
                    v4u w; w.x = cvt_pk_bf16(v0[0], v0[1]); w.y = cvt_pk_bf16(v0[2], v0[3]); w.z = cvt_pk_bf16(v1[0], v1[1]); w.w = cvt_pk_bf16(v1[2], v1[3]);
                    *(v4u*)(rowp + bj * 128) = w; } }
    }
};
struct EpiBf16Plain {
    static constexpr bool PERM = true;
    bf16* O; int ldc;
    __device__ __forceinline__ void operator()(const f32x4 (&acc)[2][2][4][2], const Unit& u, int wr, int wc, int fr, int fq) const {
        const int row0 = u.pm * 256 + wr * 64 + fr, col0 = u.pn * 256 + wc * 32 + 8 * fq;
#pragma unroll
        for (int ai = 0; ai < 2; ++ai)
#pragma unroll
            for (int m = 0; m < 4; ++m) { bf16* rowp = O + (size_t)(row0 + ai * 128 + m * 16) * ldc + col0;
#pragma unroll
                for (int bj = 0; bj < 2; ++bj) { const f32x4 v0 = acc[ai][bj][m][0], v1 = acc[ai][bj][m][1];
                    v4u w; w.x = cvt_pk_bf16(v0[0], v0[1]); w.y = cvt_pk_bf16(v0[2], v0[3]); w.z = cvt_pk_bf16(v1[0], v1[1]); w.w = cvt_pk_bf16(v1[2], v1[3]);
                    *(v4u*)(rowp + bj * 128) = w; } }
    }
};
template <bool ROWTAB, bool F8> struct EpiSwiglu {
    static constexpr bool PERM = true;
    void* H; int ldc; const float* ssp; const float* rtab; const int* list; const LAS float* tbl;
    __device__ __forceinline__ void operator()(const f32x4 (&acc)[2][2][4][2], const Unit& u, int wr, int wc, int fr, int fq) const {
        if constexpr (ROWTAB) asm volatile("" : "+v"(fr), "+v"(fq));
        const int row0 = u.pm * 256 + wr * 64 + fr, col0 = u.pn * 128 + wc * 32 + 8 * fq;
        float rs[2][4];
        if constexpr (ROWTAB) {
            if (RS_TABLE) table_rstd(tbl, u.ord, wr, fr, rs);
            else { const float* rt_ = rtab + (u.rows - list);
#pragma unroll
            for (int ai = 0; ai < 2; ++ai)
#pragma unroll
                for (int m = 0; m < 4; ++m) { const int rl = wr * 64 + fr + ai * 128 + m * 16; const float v_ = rt_[rl < u.nvalid ? rl : u.nvalid - 1]; rs[ai][m] = rl < u.nvalid ? v_ : 0.f; } }
        } else { if (RS_TABLE) table_rstd(tbl, u.ord, wr, fr, rs); else load_rstd(ssp, row0, fq, rs); }
#pragma unroll
        for (int ai = 0; ai < 2; ++ai)
#pragma unroll
            for (int m = 0; m < 4; ++m) { const float r = rs[ai][m], c = r * NLOG2E, r2 = r * r;
                const f32x4 g0 = acc[ai][0][m][0], u0 = acc[ai][1][m][0], g1 = acc[ai][0][m][1], u1 = acc[ai][1][m][1];
                const f32x4 h0 = cat2(swiglu2(g0.xy, u0.xy, c, r2), swiglu2(g0.zw, u0.zw, c, r2)), h1 = cat2(swiglu2(g1.xy, u1.xy, c, r2), swiglu2(g1.zw, u1.zw, c, r2));
                const size_t o = (size_t)(row0 + ai * 128 + m * 16) * ldc + col0;
                if constexpr (F8) *(v2u*)((unsigned char*)H + o) = pk8_fp8(h0, h1);
                else { v4u w; w.x = cvt_pk_bf16(h0[0], h0[1]); w.y = cvt_pk_bf16(h0[2], h0[3]); w.z = cvt_pk_bf16(h1[0], h1[1]); w.w = cvt_pk_bf16(h1[2], h1[3]); *(v4u*)((bf16*)H + o) = w; } }
    }
};
__device__ __forceinline__ void unpack8(const v4u w, f32x4& a, f32x4& b) { a[0] = bflo(w.x); a[1] = bfhi(w.x); a[2] = bflo(w.y); a[3] = bfhi(w.y); b[0] = bflo(w.z); b[1] = bfhi(w.z); b[2] = bflo(w.w); b[3] = bfhi(w.w); }
template <int MODE  , bool XF32, bool F8C = false  > struct EpiResid {
    static constexpr bool PERM = true;
    const float* xf; const bf16* xold; bf16* xnew; float* ssp_out; const float* colscale; const float* ssp_in; const bf16* PJ; unsigned char* xq; const LAS float* tbl;
    static constexpr int NG = (MODE == 2) ? NG_M2 : 2, NS = 8 / NG;
    struct Q { v4u xo[NG][2], pj[NG][2]; f32x4 xf0[NG][2], xf1[NG][2]; };
    __device__ __forceinline__ void qload(Q& q, int st, int row0, int col0) const {
#pragma unroll
        for (int mm = 0; mm < NG; ++mm)
#pragma unroll
            for (int bj = 0; bj < 2; ++bj) { const int g = st * NG + mm, ai = g >> 2, m = g & 3; const size_t o = (size_t)(row0 + ai * 128 + m * 16) * DM + col0 + bj * 128;
                if constexpr (XF32) { q.xf0[mm][bj] = *(const f32x4*)(xf + o); q.xf1[mm][bj] = *(const f32x4*)(xf + o + 4); } else q.xo[mm][bj] = *(const v4u*)(xold + o);
                if constexpr (MODE == 2) q.pj[mm][bj] = *(const v4u*)(PJ + o); }
    }
    __device__ __forceinline__ void operator()(const f32x4 (&acc)[2][2][4][2], const Unit& u, int wr, int wc, int fr, int fq) const {
        const int row0 = u.pm * 256 + wr * 64 + fr, col0 = u.pn * 256 + wc * 32 + 8 * fq;
        Q qa, qb;
        qload(qa, 0, row0, col0);
        float rs[2][4];
        if constexpr (MODE == 2) { if (RS_TABLE) table_rstd(tbl, u.ord, wr, fr, rs); else load_rstd(ssp_in, row0, fq, rs); }
        f32x4 cs[2][2];
        if constexpr (MODE == 1) {
#pragma unroll
            for (int bj = 0; bj < 2; ++bj)
#pragma unroll
                for (int n = 0; n < 2; ++n) cs[bj][n] = *(const f32x4*)(colscale + col0 + bj * 128 + 4 * n);
        }
#pragma unroll
        for (int st = 0; st < NS; ++st) {
            Q& q = (st & 1) ? qb : qa;
            if (st + 1 < NS) qload((st & 1) ? qa : qb, st + 1, row0, col0);
            asm volatile("" ::: "memory");
#pragma unroll
            for (int mm = 0; mm < NG; ++mm) { const int g = st * NG + mm, ai = g >> 2, m = g & 3; const int row = row0 + ai * 128 + m * 16; const size_t off = (size_t)row * DM + col0; float ss = 0.f;
#pragma unroll
                for (int bj = 0; bj < 2; ++bj) { const size_t o = off + bj * 128; f32x4 v0 = acc[ai][bj][m][0], v1 = acc[ai][bj][m][1];
                    if constexpr (MODE == 1) { v0 = v0 * cs[bj][0]; v1 = v1 * cs[bj][1]; }
                    if constexpr (MODE == 2) { f32x4 p0, p1; unpack8(q.pj[mm][bj], p0, p1); const float r = rs[ai][m];
#pragma unroll
                        for (int j = 0; j < 4; ++j) { v0[j] = sigmoidf_(v0[j] * r) * p0[j]; v1[j] = sigmoidf_(v1[j] * r) * p1[j]; } }
                    f32x4 x0, x1;
                    if constexpr (XF32) { x0 = q.xf0[mm][bj]; x1 = q.xf1[mm][bj]; } else unpack8(q.xo[mm][bj], x0, x1);
                    x0 += v0; x1 += v1;
                    v4u w; w.x = cvt_pk_bf16(x0[0], x0[1]); w.y = cvt_pk_bf16(x0[2], x0[3]); w.z = cvt_pk_bf16(x1[0], x1[1]); w.w = cvt_pk_bf16(x1[2], x1[3]);
                    *(v4u*)(xnew + o) = w;
                    if constexpr (F8C) *(v2u*)(xq + o) = pk8_fp8(x0, x1);
                    ss += ((x0[0] * x0[0] + x0[1] * x0[1]) + (x0[2] * x0[2] + x0[3] * x0[3])) + ((x1[0] * x1[0] + x1[1] * x1[1]) + (x1[2] * x1[2] + x1[3] * x1[3])); }
                ss = rows_sum4(ss);
                if (fq == 0) ssp_out[(size_t)row * 32 + u.pn * 4 + wc] = ss;
            }
            asm volatile("" ::: "memory");
        }
    }
};
template <bool RANK2, bool F8C = false> struct EpiMoeDown {
    static constexpr bool PERM = true;
    bf16* X; float* ssp_out; const int* list; const float* gwl; unsigned char* xq; const LAS float* tf; const LAS int* ti;
    __device__ __forceinline__ void operator()(const f32x4 (&acc)[2][2][4][2], const Unit& u, int wr, int wc, int fr, int fq) const {
        asm volatile("" : "+v"(fr), "+v"(fq));
        const int col0 = u.pn * 256 + wc * 32 + 8 * fq;
#pragma unroll
        for (int ai = 0; ai < 2; ++ai)
#pragma unroll
            for (int m = 0; m < 4; ++m) { const int rl = wr * 64 + fr + ai * 128 + m * 16; const bool ok = rl < u.nvalid; int tok; float gw;
                if (RS_TABLE) { tok = ti[u.ord * 256 + rl]; gw = tf[u.ord * 256 + rl]; if (!ok) tok = 0; } else { const int rc_ = ok ? rl : u.nvalid - 1; tok = u.rows[rc_]; gw = gwl[(u.rows - list) + rc_]; }
                const size_t off = (size_t)(ok ? tok : 0) * DM + col0; float ss = 0.f;
#pragma unroll
                for (int bj = 0; bj < 2; ++bj) { const size_t o = off + bj * 128;
                    if (ok) { f32x4 x0, x1; unpack8(*(const v4u*)(X + o), x0, x1); x0 += acc[ai][bj][m][0] * gw; x1 += acc[ai][bj][m][1] * gw;
                        v4u w; w.x = cvt_pk_bf16(x0[0], x0[1]); w.y = cvt_pk_bf16(x0[2], x0[3]); w.z = cvt_pk_bf16(x1[0], x1[1]); w.w = cvt_pk_bf16(x1[2], x1[3]);
                        *(v4u*)(X + o) = w;
                        if constexpr (RANK2 && F8C) *(v2u*)(xq + o) = pk8_fp8(x0, x1);
                        if constexpr (RANK2) ss += ((x0[0] * x0[0] + x0[1] * x0[1]) + (x0[2] * x0[2] + x0[3] * x0[3])) + ((x1[0] * x1[0] + x1[1] * x1[1]) + (x1[2] * x1[2] + x1[3] * x1[3])); } }
                if constexpr (RANK2) { ss = rows_sum4(ss);
                    if (fq == 0 && ok) ssp_out[(size_t)tok * 32 + u.pn * 4 + wc] = ss; }
                if (m & 1) asm volatile("" ::: "memory");
            }
    }
};

template <class EE> struct EpiTwice { static constexpr bool PERM = EE::PERM; EE e;
    __device__ __forceinline__ void operator()(const f32x4 (&acc)[2][2][4][2], const Unit& u, int wr, int wc, int fr, int fq) const { int n_ = 2; asm volatile("" : "+s"(n_));
#pragma nounroll
        for (int k_ = 0; k_ < n_; ++k_) { e(acc, u, wr, wc, fr, fq); asm volatile("" ::: "memory"); } } };
struct Args { const float* in[24]; float* out; unsigned char* ws; };
struct Frame {
    LAS unsigned char* lds; volatile LAS unsigned* MISC; gu32* ctl;
    int tid, lane, wave, G, bx;
};

constexpr int TRP = 136;
constexpr int TRP8 = 68;
struct TrJob { const float* W0; const float* W1; int c0, c1, ldw, K, N, NP; bf16* WT; const float* gain; int f8; };
__device__ __forceinline__ int tr_items(const TrJob& J) { return (J.K / 64) * (J.NP ? J.NP * 4 : J.N / 64); }
__device__ __forceinline__ void tr_map(const TrJob& J, int it, int& kb, int& nb) {
    const int nnb = J.NP ? J.NP * 4 : J.N / 64, sup = it >> 3, sub = it & 7, nsn = nnb >> 1;
    kb = (sup / nsn) * 4 + (sub >> 1); nb = (sup % nsn) * 2 + (sub & 1);
}
__device__ __forceinline__ void tr_src(const TrJob& J, int nb, const float*& W, int& sc) {
    W = J.W0; sc = J.c0 + nb * 64;
    if (J.NP) { const int j = nb >> 2, q = nb & 3; W = (q < 2) ? J.W0 : J.W1; sc = ((q < 2) ? J.c0 : J.c1) + 128 * j + 64 * (q & 1); }
}
__device__ __forceinline__ void tr_load(const TrJob& J, int it, f32x4 (&v)[16], float (&g)[16], int lane) {
    int kb, nb; tr_map(J, it, kb, nb); const float* W; int sc; tr_src(J, nb, W, sc);
    const float* src = W + (size_t)(kb * 64 + (lane >> 4)) * J.ldw + sc + 4 * (lane & 15);
#pragma unroll
    for (int i = 0; i < 16; ++i) v[i] = *(const f32x4*)(src + (size_t)(4 * i) * J.ldw);
    if (J.gain) {
#pragma unroll
        for (int i = 0; i < 16; ++i) g[i] = J.gain[kb * 64 + 4 * i + (lane >> 4)];
    } else {
#pragma unroll
        for (int i = 0; i < 16; ++i) g[i] = 1.0f;
    }
}
__device__ __forceinline__ void tr_store(const TrJob& J, int it, const f32x4 (&v)[16], const float (&gg)[16], LAS unsigned char* scr, int lane) {
    int kb, nb; tr_map(J, it, kb, nb); const int k0 = kb * 64, drow0 = nb * 64;
    if (J.f8) {
#pragma unroll
        for (int i = 0; i < 16; ++i) { const int kk = 4 * i + (lane >> 4); const float g = gg[i] * 64.0f;
            int w = 0; w = __builtin_amdgcn_cvt_pk_fp8_f32(v[i][0] * g, v[i][1] * g, w, false); w = __builtin_amdgcn_cvt_pk_fp8_f32(v[i][2] * g, v[i][3] * g, w, true);
            *(LAS int*)(scr + kk * TRP8 + 4 * (lane & 15)) = w; }
        LDS_WAIT(); asm volatile("" ::: "memory");
        const int c = lane & 3; unsigned char* WT = (unsigned char*)J.WT;
#pragma unroll
        for (int j = 0; j < 4; ++j) { const int n = (lane >> 2) + 16 * j; const LAS unsigned char* s = scr + (16 * c) * TRP8 + n;
            v4u o;
            o.x = (unsigned)s[0 * TRP8] | ((unsigned)s[1 * TRP8] << 8) | ((unsigned)s[2 * TRP8] << 16) | ((unsigned)s[3 * TRP8] << 24);
            o.y = (unsigned)s[4 * TRP8] | ((unsigned)s[5 * TRP8] << 8) | ((unsigned)s[6 * TRP8] << 16) | ((unsigned)s[7 * TRP8] << 24);
            o.z = (unsigned)s[8 * TRP8] | ((unsigned)s[9 * TRP8] << 8) | ((unsigned)s[10 * TRP8] << 16) | ((unsigned)s[11 * TRP8] << 24);
            o.w = (unsigned)s[12 * TRP8] | ((unsigned)s[13 * TRP8] << 8) | ((unsigned)s[14 * TRP8] << 16) | ((unsigned)s[15 * TRP8] << 24);
            *(GAS v4u*)(WT + (size_t)(drow0 + n) * J.K + k0 + 16 * c) = o; }
    } else {
#pragma unroll
        for (int i = 0; i < 16; ++i) { const int kk = 4 * i + (lane >> 4); const float g = gg[i];
            v2u w; w.x = cvt_pk_bf16(v[i][0] * g, v[i][1] * g); w.y = cvt_pk_bf16(v[i][2] * g, v[i][3] * g);
            *(LAS v2u*)(scr + kk * TRP + 8 * (lane & 15)) = w; }
        LDS_WAIT(); asm volatile("" ::: "memory");
        const int c = lane & 7;
#pragma unroll
        for (int j = 0; j < 8; ++j) { const int n = (lane >> 3) + 8 * j; const LAS unsigned short* s = (const LAS unsigned short*)(scr + (8 * c) * TRP + 2 * n);
            v4u o; o.x = (unsigned)s[0] | ((unsigned)s[TRP / 2] << 16); o.y = (unsigned)s[2 * (TRP / 2)] | ((unsigned)s[3 * (TRP / 2)] << 16);
            o.z = (unsigned)s[4 * (TRP / 2)] | ((unsigned)s[5 * (TRP / 2)] << 16); o.w = (unsigned)s[6 * (TRP / 2)] | ((unsigned)s[7 * (TRP / 2)] << 16);
            *(GAS v4u*)(J.WT + (size_t)(drow0 + n) * J.K + k0 + 8 * c) = o; }
    }
    LDS_WAIT(); asm volatile("" ::: "memory");
}
__device__ __forceinline__ int tr_job(const TrJob& J, int base, int wv, int nw, LAS unsigned char* scr, int lane) {
    const int nit = tr_items(J);
    int it = (wv - base % nw + nw) % nw;
    f32x4 va[16], vb[16]; float ga[16], gb[16];
    if (it < nit) tr_load(J, it, va, ga, lane);
    while (it < nit) {
        const int nx = it + nw;
        if (nx < nit) tr_load(J, nx, vb, gb, lane);
        tr_store(J, it, va, ga, scr, lane);
        if (nx >= nit) break;
        const int nx2 = nx + nw;
        if (nx2 < nit) tr_load(J, nx2, va, ga, lane);
        tr_store(J, nx, vb, gb, scr, lane);
        it = nx2;
    }
    return base + nit;
}

constexpr int H_QT = 0, H_KT = 17408, H_QC = 34816, H_KH = 52224, H_VT = 70656, H_TOT = 89088, H_DEC = 93184, H_NRM = 93696  , H_END = 95744;
constexpr int TP = 272  , CP = 144  ;
__device__ __forceinline__ f32x16 mfma32(bf16x8 a, bf16x8 b, f32x16 c) { return __builtin_amdgcn_mfma_f32_32x32x16_bf16(a, b, c, 0, 0, 0); }
__device__ __forceinline__ bf16x8 pack8(const f32x16& v, int o) {
    v4u w; w.x = cvt_pk_bf16(v[o + 0], v[o + 1]); w.y = cvt_pk_bf16(v[o + 2], v[o + 3]); w.z = cvt_pk_bf16(v[o + 4], v[o + 5]); w.w = cvt_pk_bf16(v[o + 6], v[o + 7]);
    return __builtin_bit_cast(bf16x8, w);
}
__device__ __forceinline__ bf16x8 ld2x8(const LAS unsigned char* p) {
    const v2u a = *(const LAS v2u*)p, b = *(const LAS v2u*)(p + 16); v4u w; w.x = a.x; w.y = a.y; w.z = b.x; w.w = b.y; return __builtin_bit_cast(bf16x8, w);
}
struct HgRegs { unsigned lf[8], qs[8], v[8], lf32; };
#define EX2(x) __builtin_amdgcn_exp2f(x)
__device__ __forceinline__ void hg_finish(LAS unsigned char* L, int nbuf, const f32x16& O, const v2u (&gs)[4], const f32x4 (&gn_)[4], bf16* A2o, int tb, int r) {
    float tot = 0.f;
#pragma unroll
    for (int e4 = 0; e4 < 4; ++e4) tot += *(const LAS float*)(L + H_NRM + nbuf * 1024 + (e4 * 64 + 32 * tb + r) * 4);
    const float rstd = 1.0f / sqrtf(tot * (1.0f / HD) + EPS);
#pragma unroll
    for (int q = 0; q < 4; ++q) {
        const f32x4 gn = gn_[q];
        const float o0 = O[4 * q + 0] * rstd * gn[0] * bflo(gs[q].x), o1 = O[4 * q + 1] * rstd * gn[1] * bfhi(gs[q].x);
        const float o2 = O[4 * q + 2] * rstd * gn[2] * bflo(gs[q].y), o3 = O[4 * q + 3] * rstd * gn[3] * bfhi(gs[q].y);
        v2u wv; wv.x = cvt_pk_bf16(o0, o1); wv.y = cvt_pk_bf16(o2, o3);
        *(v2u*)(A2o + 8 * q) = wv; }
}
__device__ __forceinline__ void hgrn_phase(Frame& F, const bf16* U, bf16* A2, const float* hgain) {
    const int b = F.bx >> 3, h = F.bx & 7, w = F.wave, lane = F.lane;
    LAS unsigned char* L = F.lds;
    const int eb = w >> 1, tb = w & 1, r = lane & 31, hh = lane >> 5;
    f32x16 S[4];
#pragma unroll
    for (int d = 0; d < 4; ++d)
#pragma unroll
        for (int i = 0; i < 16; ++i) S[d][i] = 0.f;
    const size_t rowbase0 = (size_t)b * SEQ;
    const bf16* Ucol = U + h * HD + 2 * lane;
    f32x4 gn_[4];
#pragma unroll
    for (int q = 0; q < 4; ++q) gn_[q] = *(const f32x4*)(hgain + h * HD + 32 * eb + 8 * q + 4 * hh);
    const bf16* Ugs = U + 3072 + h * HD + 32 * eb + 4 * hh + (rowbase0 + 32 * tb + r) * UP;
    bf16* A2o = A2 + (rowbase0 + 32 * tb + r) * DM + h * HD + 32 * eb + 4 * hh;
    HgRegs R; v2u gs_[4], gsp_[4];
    f32x16 Op;
#pragma unroll
    for (int i = 0; i < 16; ++i) Op[i] = 0.f;
#define HG_LOAD(n) do { const bf16* p = Ucol + (rowbase0 + (size_t)(n) * CHUNK + 8 * w) * UP; \
        _Pragma("unroll") for (int j = 0; j < 8; ++j) { R.qs[j] = *(const unsigned*)(p + (size_t)j * UP); R.lf[j] = *(const unsigned*)(p + (size_t)j * UP + 1024); R.v[j] = *(const unsigned*)(p + (size_t)j * UP + 2048); } \
        R.lf32 = *(const unsigned*)(Ucol + (rowbase0 + (size_t)(n) * CHUNK + 32) * UP + 1024); \
        _Pragma("unroll") for (int q = 0; q < 4; ++q) gs_[q] = *(const v2u*)(Ugs + (size_t)(n) * CHUNK * UP + 8 * q); } while (0)
    HG_LOAD(0);
    for (int n = 0; n < SEQ / CHUNK; ++n) {
        f32x2 c[8];
        { f32x2 a = (f32x2){0.f, 0.f};
#pragma unroll
          for (int j = 0; j < 8; ++j) { a += (f32x2){bflo(R.lf[j]), bfhi(R.lf[j])}; c[j] = a; }
          *(LAS f32x2*)(L + H_TOT + (w * 128 + 2 * lane) * 4) = a; }
        LDS_BAR();
        if (n > 0) hg_finish(L, (n - 1) & 1, Op, gsp_, gn_, A2o + (size_t)(n - 1) * CHUNK * DM, tb, r);
        { f32x2 pre = (f32x2){0.f, 0.f}, ref = pre, last = pre;
#pragma unroll
          for (int ww = 0; ww < 8; ++ww) { const f32x2 t = *(const LAS f32x2*)(L + H_TOT + (ww * 128 + 2 * lane) * 4);
              if (ww < w) pre += t; if (ww < 4) ref += t; last += t; }
          ref += (f32x2){bflo(R.lf32), bfhi(R.lf32)};
          const f32x2 lr = last - ref;
          const f32x2 eref = (f32x2){EX2(ref.x), EX2(ref.y)}, elr = (f32x2){EX2(lr.x), EX2(lr.y)};
          if (w == 0) *(LAS f32x2*)(L + H_DEC + 2 * lane * 4) = (f32x2){EX2(last.x), EX2(last.y)};
          unsigned kh0[4], kh1[4], vt0[4], vt1[4];
#pragma unroll
          for (int j = 0; j < 8; ++j) {
              const f32x2 d1 = (pre + c[j]) - ref;
              const f32x2 E1 = (f32x2){EX2(d1.x), EX2(d1.y)}, E2 = (f32x2){fast_rcp(E1.x), fast_rcp(E1.y)};
              const f32x2 fv = (f32x2){EX2(bflo(R.lf[j])), EX2(bfhi(R.lf[j]))};
              const f32x2 kq = (f32x2){1.0f, 1.0f} - fv, q = (f32x2){bflo(R.qs[j]), bfhi(R.qs[j])};
              const f32x2 qt = q * E1, kt = kq * E2, qc = qt * eref, kh = kt * elr;
              const int t = 8 * w + j;
              *(LAS unsigned*)(L + H_QT + t * TP + 4 * lane) = cvt_pk_bf16(qt.x, qt.y);
              *(LAS unsigned*)(L + H_KT + t * TP + 4 * lane) = cvt_pk_bf16(kt.x, kt.y);
              *(LAS unsigned*)(L + H_QC + t * TP + 4 * lane) = cvt_pk_bf16(qc.x, qc.y);
              const unsigned kk = cvt_pk_bf16(kh.x, kh.y);
              if (j & 1) { kh0[j >> 1] |= (kk << 16); kh1[j >> 1] |= (kk & 0xffff0000u); vt0[j >> 1] |= (R.v[j] << 16); vt1[j >> 1] |= (R.v[j] & 0xffff0000u); }
              else { kh0[j >> 1] = kk & 0xffffu; kh1[j >> 1] = kk >> 16; vt0[j >> 1] = R.v[j] & 0xffffu; vt1[j >> 1] = R.v[j] >> 16; }
          }
          *(LAS v4u*)(L + H_KH + (2 * lane) * CP + 16 * w) = (v4u){kh0[0], kh0[1], kh0[2], kh0[3]};
          *(LAS v4u*)(L + H_KH + (2 * lane + 1) * CP + 16 * w) = (v4u){kh1[0], kh1[1], kh1[2], kh1[3]};
          *(LAS v4u*)(L + H_VT + (2 * lane) * CP + 16 * w) = (v4u){vt0[0], vt0[1], vt0[2], vt0[3]};
          *(LAS v4u*)(L + H_VT + (2 * lane + 1) * CP + 16 * w) = (v4u){vt1[0], vt1[1], vt1[2], vt1[3]};
        }
        LDS_BAR();
#pragma unroll
        for (int q = 0; q < 4; ++q) gsp_[q] = gs_[q];
        if (n + 1 < SEQ / CHUNK) HG_LOAD(n + 1);
        f32x16 O;
#pragma unroll
        for (int i = 0; i < 16; ++i) O[i] = 0.f;
#pragma unroll
        for (int sb = 0; sb < 2; ++sb) {
            if (sb <= tb) {
                f32x16 P;
#pragma unroll
                for (int i = 0; i < 16; ++i) P[i] = 0.f;
#pragma unroll
                for (int kh = 0; kh < 2; ++kh) {
                    bf16x8 fa[4], fb[4];
#pragma unroll
                    for (int k4 = 0; k4 < 4; ++k4) { const int ks = 4 * kh + k4; fa[k4] = *(const LAS bf16x8*)(L + H_KT + (32 * sb + r) * TP + (16 * ks + 8 * hh) * 2); fb[k4] = *(const LAS bf16x8*)(L + H_QT + (32 * tb + r) * TP + (16 * ks + 8 * hh) * 2); }
#pragma unroll
                    for (int k4 = 0; k4 < 4; ++k4) P = mfma32(fa[k4], fb[k4], P);
                }
                if (sb == tb) {
#pragma unroll
                    for (int i = 0; i < 16; ++i) { const int s = (i & 3) + 8 * (i >> 2) + 4 * hh; if (s > r) P[i] = 0.f; }
                }
#pragma unroll
                for (int k2 = 0; k2 < 2; ++k2) {
                    const bf16x8 av = ld2x8(L + H_VT + (32 * eb + r) * CP + (32 * sb + 16 * k2 + 4 * hh) * 2);
                    O = mfma32(av, pack8(P, 8 * k2), O);
                }
            }
        }
        { bf16x8 fq[8];
#pragma unroll
          for (int i = 0; i < 8; ++i) fq[i] = ld2x8(L + H_QC + (32 * tb + r) * TP + (32 * (i >> 1) + 16 * (i & 1) + 4 * hh) * 2);
#pragma unroll
          for (int i = 0; i < 8; ++i) O = mfma32(pack8(S[i >> 1], 8 * (i & 1)), fq[i], O); }
        { bf16x8 fv[4];
#pragma unroll
          for (int ks = 0; ks < 4; ++ks) fv[ks] = *(const LAS bf16x8*)(L + H_VT + (32 * eb + r) * CP + (16 * ks + 8 * hh) * 2);
#pragma unroll
          for (int db = 0; db < 4; ++db) {
              bf16x8 fk[4];
#pragma unroll
              for (int ks = 0; ks < 4; ++ks) fk[ks] = *(const LAS bf16x8*)(L + H_KH + (32 * db + r) * CP + (16 * ks + 8 * hh) * 2);
#pragma unroll
              for (int q = 0; q < 4; ++q) { const f32x4 dc = *(const LAS f32x4*)(L + H_DEC + (32 * db + 8 * q + 4 * hh) * 4);
                  S[db][4 * q + 0] *= dc[0]; S[db][4 * q + 1] *= dc[1]; S[db][4 * q + 2] *= dc[2]; S[db][4 * q + 3] *= dc[3]; }
#pragma unroll
              for (int ks = 0; ks < 4; ++ks) S[db] = mfma32(fk[ks], fv[ks], S[db]);
          } }
        float ssq = 0.f;
#pragma unroll
        for (int i = 0; i < 16; ++i) ssq += O[i] * O[i];
        ssq += __shfl_xor(ssq, 32);
        if (hh == 0) *(LAS float*)(L + H_NRM + (n & 1) * 1024 + (eb * 64 + 32 * tb + r) * 4) = ssq;
        Op = O;
    }
    LDS_BAR();
    hg_finish(L, (SEQ / CHUNK - 1) & 1, Op, gsp_, gn_, A2o + (size_t)(SEQ / CHUNK - 1) * CHUNK * DM, tb, r);
#undef HG_LOAD
}
#undef EX2
__device__ __forceinline__ void conv_phase(Frame& F, const bf16* U, bf16* A2, const float* convw, int first_block) {
    const int nb = F.G - first_block, me = F.bx - first_block, c = 2 * F.tid;
    const float w00 = convw[c], w01 = convw[c + 1], w10 = convw[DC + c], w11 = convw[DC + c + 1], w20 = convw[2 * DC + c], w21 = convw[2 * DC + c + 1];
    for (int u = me; u < M / 32; u += nb) {
        const int R0 = u * 32, t0 = R0 % SEQ;
        const bf16* up = U + (size_t)R0 * UP;
        float a0 = 0.f, a1 = 0.f, b0 = 0.f, b1 = 0.f;
        if (t0 != 0) { const unsigned p2 = *(const unsigned*)(up - 2 * (size_t)UP + 5120 + c), p1 = *(const unsigned*)(up - (size_t)UP + 5120 + c);
            a0 = bflo(p2); a1 = bfhi(p2); b0 = bflo(p1); b1 = bfhi(p1); }
#pragma unroll 8
        for (int j = 0; j < 32; ++j) {
            const unsigned tt = *(const unsigned*)(up + (size_t)j * UP + 5120 + c), gb = *(const unsigned*)(up + (size_t)j * UP + 4096 + c);
            const float t0f = bflo(tt), t1f = bfhi(tt);
            const float y0 = bflo(gb) * (w00 * a0 + w10 * b0 + w20 * t0f), y1 = bfhi(gb) * (w01 * a1 + w11 * b1 + w21 * t1f);
            *(unsigned*)(A2 + (size_t)(R0 + j) * DM + DH + c) = cvt_pk_bf16(y0, y1);
            a0 = b0; a1 = b1; b0 = t0f; b1 = t1f;
        }
    }
}

template <int W> __device__ __forceinline__ void pool_rows(const bf16* xc, bf16* dc, const LAS float* rt, int roff, bool seq_start) {
    v4u ring[16]; f32x4 S0 = (f32x4){0.f, 0.f, 0.f, 0.f}, S1 = S0;
#pragma unroll
    for (int k = W; k >= 1; --k) {
        v4u v = (v4u){0u, 0u, 0u, 0u};
        if (!seq_start) { v = *(const v4u*)(xc - (size_t)k * DM); f32x4 a, b; unpack8(v, a, b); const float r = rt[16 + roff - k]; S0 += a * r; S1 += b * r; }
        ring[(16 - k) & 15] = v;
    }
#pragma unroll
    for (int jb = 0; jb < 4; ++jb) {
        v4u tmp[8];
#pragma unroll
        for (int q = 0; q < 8; ++q) tmp[q] = *(const v4u*)(xc + (size_t)(8 * jb + q) * DM);
#pragma unroll
        for (int q = 0; q < 8; ++q) { const int j = 8 * jb + q;
            f32x4 a, b; unpack8(tmp[q], a, b); const float rn = rt[16 + roff + j]; a = a * rn; b = b * rn; S0 += a; S1 += b;
            if (!seq_start || j >= W) { f32x4 oa, ob; unpack8(ring[(j - W) & 15], oa, ob); const float ro = rt[16 + roff + j - W]; S0 -= oa * ro; S1 -= ob * ro; }
            ring[j & 15] = tmp[q];
            const float inv = 1.0f / (float)((seq_start && j + 1 < W) ? (j + 1) : W);
            const f32x4 d0 = S0 * inv - a, d1 = S1 * inv - b;
            v4u w; w.x = cvt_pk_bf16(d0[0], d0[1]); w.y = cvt_pk_bf16(d0[2], d0[3]); w.z = cvt_pk_bf16(d1[0], d1[1]); w.w = cvt_pk_bf16(d1[2], d1[3]);
            *(v4u*)(dc + (size_t)j * DM) = w; }
    }
}
#ifndef PH_ENABLE
#define PH_ENABLE 0xffffffffu
#endif
#define PH(k) (((PH_ENABLE) >> (k)) & 1u)
#ifndef PROBE_DUP
#define PROBE_DUP (-1)
#endif
#define REPS(k) ((PROBE_DUP) == (k) ? 2 : 1)
__global__ void __launch_bounds__(NWAVES * 64, 2) fwd_kernel(Args args) {
    extern __shared__ __attribute__((aligned(16))) unsigned char lds[];
    Frame F;
    F.lds = (LAS unsigned char*)lds;
    F.MISC = (volatile LAS unsigned*)(F.lds + MISC_OFF);
    F.tid = threadIdx.x; F.lane = F.tid & 63; F.wave = __builtin_amdgcn_readfirstlane(F.tid >> 6);
    F.G = gridDim.x; F.bx = blockIdx.x;
    unsigned char* ws = args.ws;
    F.ctl = (gu32*)(ws + WS_CTL);
    for (int u = F.tid; u < (LDS_BYTES - LDSCTL_OFF) / 4; u += NWAVES * 64) ((LAS unsigned*)(F.lds + LDSCTL_OFF))[u] = 0u;
    __syncthreads();
    XcdBarrier bar = xcd_barrier_post((unsigned*)(F.ctl + CW_BAR), F.MISC + 8);
#define PJ0_UNIT(k_) do { SchedPick SP; SP.s.o.init(M / 256, DM / 256, F.G, F.bx); SP.s.A = (const char*)W_PB; SP.s.B = (const char*)W_Wpp_t; SP.s.at = (size_t)256 * DPLE * 2; SP.s.bt = (size_t)256 * DPLE * 2; SP.k = (k_); \
        EpiBf16Plain EP{W_PJ0, DM}; pg8::gemm_phase<EpiBf16Plain, SchedPick, true>(F.lds, DPLE, DPLE, DPLE, SP, EP); } while (0)
#define GRID_BAR() do { xcd_barrier(bar); if (PROBE_DUP == 99) xcd_barrier(bar); } while (0)
#define REFRESH() do { int t_ = threadIdx.x; asm volatile("" : "+v"(t_)); F.tid = t_; F.lane = t_ & 63; F.wave = __builtin_amdgcn_readfirstlane(t_ >> 6); \
        int b_ = blockIdx.x; asm volatile("" : "+s"(b_)); F.bx = b_; gw = F.bx * NWAVES + F.wave; \
        kp_ = (const float* const __attribute__((address_space(4)))*)__builtin_amdgcn_kernarg_segment_ptr(); asm volatile("" : "+s"(kp_)); \
        ws_ = (unsigned char*)kp_[25]; X_ = (float*)kp_[24]; } while (0)
    const float* const __attribute__((address_space(4)))* kp_ = (const float* const __attribute__((address_space(4)))*)__builtin_amdgcn_kernarg_segment_ptr();
    unsigned char* ws_ = args.ws; float* X_ = args.out;
#define I_x (kp_[0])
#define I_p (kp_[1])
#define I_final_gain (kp_[2])
#define I_lb_table (kp_[3])
#define I_mix_norm_even (kp_[4])
#define I_w_in (kp_[5])
#define I_hgrn_gain (kp_[6])
#define I_conv_w (kp_[7])
#define I_w_out (kp_[8])
#define I_ffn_norm_even (kp_[9])
#define I_w_gate (kp_[10])
#define I_w_up (kp_[11])
#define I_w_down (kp_[12])
#define I_mix_norm_odd (kp_[13])
#define I_pool_w (kp_[14])
#define I_pool_scale (kp_[15])
#define I_ffn_norm_odd (kp_[16])
#define I_w_router (kp_[17])
#define I_w_gate_e (kp_[18])
#define I_w_up_e (kp_[19])
#define I_w_down_e (kp_[20])
#define I_ple_norm (kp_[21])
#define I_ple_gate_w (kp_[22])
#define I_ple_proj (kp_[23])
#define W_lbv ((float*)(ws_ + WS_LBV))
#define W_rs4 ((float*)(ws_ + WS_RS4))
#define W_topi ((int*)(ws_ + WS_TOP))
#define W_topw ((float*)(ws_ + WS_TOPW))
#define W_sspA ((float*)(ws_ + WS_SSPA))
#define W_sspB ((float*)(ws_ + WS_SSPB))
#define W_list ((int*)(ws_ + WS_LIST))
#define W_gwl ((float*)(ws_ + WS_GWL))
#define W_rsl ((float*)(ws_ + WS_TOKC))
#define W_tokc ((int*)(ws_ + WS_TOKC))
#define W_gwc ((float*)(ws_ + WS_GWC))
#define W_rsc ((float*)(ws_ + WS_RSC))
#define W_Win_t ((bf16*)(ws_ + WS_WIN))
#define W_Wout_t ((bf16*)(ws_ + WS_WOUT))
#define W_Wgu_t ((bf16*)(ws_ + WS_WGU))
#define W_Wd_t ((bf16*)(ws_ + WS_WD))
#define W_Wpool_t ((bf16*)(ws_ + WS_WPOOL))
#define W_Wmgu_t ((bf16*)(ws_ + WS_WMGU))
#define W_Wmd_t ((bf16*)(ws_ + WS_WMD))
#define W_Wpg_t ((bf16*)(ws_ + WS_WPG))
#define W_Wpp_t ((bf16*)(ws_ + WS_WPP))
#define W_PB ((bf16*)(ws_ + WS_PB))
#define W_XB ((bf16*)(ws_ + WS_XB))
#define W_A2 ((bf16*)(ws_ + WS_A2))
#define W_PJ ((bf16*)(ws_ + WS_A2))
#define W_PJ0 ((bf16*)(ws_ + WS_BIG + 128 * MiB))
#define W_U ((bf16*)(ws_ + WS_BIG))
#define W_Hh ((bf16*)(ws_ + WS_BIG))
#define W_D1 ((bf16*)(ws_ + WS_BIG))
#define W_XG ((bf16*)(ws_ + WS_BIG))
#define W_HE ((bf16*)(ws_ + WS_HE))
#define W_X (X_)
#define W_XS0 ((bf16*)(ws_ + WS_XB))
#define W_XQ ((unsigned char*)X_)
#define W_XQ1 ((unsigned char*)X_ + 64 * MiB)
#define W_XS1 ((bf16*)((unsigned char*)X_ + 64 * MiB))
#define W_XB0 ((bf16*)X_)
    int gw = F.bx * NWAVES + F.wave; const int NGW = F.G * NWAVES;

#ifndef CONV_MODE
#define CONV_MODE 0
#endif
#define CONVERT_REST(FIRSTB) do { \
            LDS_BAR(); \
            LAS unsigned char* scr = F.lds + F.wave * 16384; \
            const int wv = (F.bx - (FIRSTB)) * NWAVES + F.wave, nw = (F.G - (FIRSTB)) * NWAVES; int base = 0; \
            { const TrJob J{I_w_out, I_w_out, 0, 0, DM, DM, DM, 0, W_Wout_t, nullptr, 0}; base = tr_job(J, base, wv, nw, scr, F.lane); } \
            { const TrJob J{I_w_gate, I_w_up, 0, 0, DFF, DM, 0, DFF / 128, W_Wgu_t, I_ffn_norm_even, F8_GU}; base = tr_job(J, base, wv, nw, scr, F.lane); } \
            { const TrJob J{I_w_down, I_w_down, 0, 0, DM, DFF, DM, 0, W_Wd_t, nullptr, F8_DN}; base = tr_job(J, base, wv, nw, scr, F.lane); } \
            for (int i = 0; i < 2; ++i) { const TrJob J{I_ple_proj + (size_t)i * DPLE * DM, nullptr, 0, 0, DM, DPLE, DM, 0, W_Wpp_t + (size_t)i * DM * DPLE, nullptr, 0}; base = tr_job(J, base, wv, nw, scr, F.lane); } \
            for (int i = 0; i < 2; ++i) { const TrJob J{I_ple_gate_w + (size_t)i * DM * DM, nullptr, 0, 0, DM, DM, DM, 0, W_Wpg_t + (size_t)i * DM * DM, I_ple_norm + i * DM, (i == 1 && F8_PLE1) ? 1 : 0}; base = tr_job(J, base, wv, nw, scr, F.lane); } \
            for (int g = 0; g < 4; ++g) { const TrJob J{I_pool_w + (size_t)g * 512 * 512, nullptr, 0, 0, 512, 512, 512, 0, W_Wpool_t + (size_t)512 * g * 512, I_mix_norm_odd + 512 * g, 0}; base = tr_job(J, base, wv, nw, scr, F.lane); } \
            for (int e = 0; e < NE; ++e) { const TrJob J{I_w_gate_e + (size_t)e * DM * DFE, I_w_up_e + (size_t)e * DM * DFE, 0, 0, DFE, DM, 0, DFE / 128, W_Wmgu_t + (size_t)e * 2048 * DM / (F8_MOE ? 2 : 1), I_ffn_norm_odd, F8_MOE}; base = tr_job(J, base, wv, nw, scr, F.lane); } \
            for (int e = 0; e < NE; ++e) { const TrJob J{I_w_down_e + (size_t)e * DFE * DM, nullptr, 0, 0, DM, DFE, DM, 0, W_Wmd_t + (size_t)e * DM * DFE / (F8_MOE ? 2 : 1), nullptr, F8_MOE}; base = tr_job(J, base, wv, nw, scr, F.lane); } \
            for (size_t i = (size_t)(F.bx - (FIRSTB)) * 512 + F.tid; i < (size_t)2 * M * DPLE / 8; i += (size_t)(F.G - (FIRSTB)) * 512) { \
                const f32x4 a = ((const f32x4*)I_p)[2 * i], b2 = ((const f32x4*)I_p)[2 * i + 1]; \
                v4u w; w.x = cvt_pk_bf16(a[0], a[1]); w.y = cvt_pk_bf16(a[2], a[3]); w.z = cvt_pk_bf16(b2[0], b2[1]); w.w = cvt_pk_bf16(b2[2], b2[3]); ((v4u*)W_PB)[i] = w; } \
        } while (0)
    for (int rep_ = 0; rep_ < REPS(0); ++rep_) { REFRESH();
        LAS unsigned char* scr = F.lds + F.wave * 16384;
        int base = 0;
        { const TrJob J{I_w_in, I_w_in, 0, 0, NIN, DM, 5120, 0, W_Win_t, I_mix_norm_even, 0}; base = tr_job(J, base, gw, NGW, scr, F.lane); }
        { const TrJob J{I_w_in, I_w_in, 5120, 6144, NIN, DM, 0, 8, W_Win_t + (size_t)5120 * DM, I_mix_norm_even, 0}; base = tr_job(J, base, gw, NGW, scr, F.lane); }
        for (int m = gw; m < M; m += NGW) {
            const GAS f32x4* xr = (const GAS f32x4*)(I_x + (size_t)m * DM) + F.lane; GAS v2u* o8 = (GAS v2u*)(W_XB0 + (size_t)m * DM) + F.lane; float s = 0.f;
#pragma unroll
            for (int j = 0; j < 8; ++j) { const f32x4 v = xr[64 * j]; s += (v[0] * v[0] + v[1] * v[1]) + (v[2] * v[2] + v[3] * v[3]); v2u w; w.x = cvt_pk_bf16(v[0], v[1]); w.y = cvt_pk_bf16(v[2], v[3]); o8[64 * j] = w; }
            s = wave_sum(s);
            if (F.lane < 32) W_sspA[(size_t)m * 32 + F.lane] = (F.lane == 0) ? s : 0.f;
        }
        if (F.bx == 0) for (int j = F.tid; j < DH; j += 512) { const float t0 = I_lb_table[j], t1 = I_lb_table[DH + j], t2 = I_lb_table[2 * DH + j]; const float mx = fmaxf(t0, fmaxf(t1, t2));
            const float e0 = __expf(t0 - mx), e1 = __expf(t1 - mx), e2 = __expf(t2 - mx); W_lbv[j] = e0 / (e0 + e1 + e2); }
    }
    GRID_BAR();
    const size_t TB2048 = (size_t)256 * DM * 2;
    for (int rep_ = 0; rep_ < (PH(1) ? REPS(1) : 0); ++rep_) { REFRESH();
        SchedGrid S; S.o.init(M / 256, NIN / 256, F.G, F.bx); S.A = (const char*)W_XB0; S.B = (const char*)W_Win_t; S.at = TB2048; S.bt = TB2048;
        if (RS_TABLE) build_rstd_table(F.lds, S, W_sspA, F.tid);
        EpiInProj E{W_U, W_sspA, W_lbv, (const LAS float*)(F.lds + RS_TBL_OFF)};
        pg8::gemm_phase<EpiInProj, SchedGrid, true>(F.lds, DM, DM, DM, S, E);
    }
    GRID_BAR();
    for (int rep_ = 0; rep_ < REPS(2); ++rep_) { REFRESH(); if (F.bx < BATCH * NH) { hgrn_phase(F, W_U, W_A2, I_hgrn_gain); if (PROBE_DUP == 20) hgrn_phase(F, W_U, W_A2, I_hgrn_gain); }
        else for (int rep2_ = 0; rep2_ < (PROBE_DUP == 21 ? 2 : 1); ++rep2_) {
            conv_phase(F, W_U, W_A2, I_conv_w, BATCH * NH);
            if (CONV_MODE == 0) CONVERT_REST(BATCH * NH);
        }
    }
    GRID_BAR();
    if (CONV_MODE == 1) { for (int rep_ = 0; rep_ < REPS(16); ++rep_) { REFRESH(); CONVERT_REST(0); } GRID_BAR(); }
    for (int rep_ = 0; rep_ < (PH(3) ? REPS(3) : 0); ++rep_) { REFRESH();
        SchedGrid S; S.o.init(M / 256, DM / 256, F.G, F.bx); S.A = (const char*)W_A2; S.B = (const char*)W_Wout_t; S.at = TB2048; S.bt = TB2048;
        EpiResid<0, false, F8_GU> E{nullptr, W_XB0, W_XS0, W_sspB, nullptr, nullptr, nullptr, W_XQ1, nullptr};
        for (int step = 0; step < 3; ++step) {
            if (step == 1) pg8::gemm_phase<EpiResid<0, false, F8_GU>, SchedGrid, true>(F.lds, DM, DM, DM, S, E);
            else if ((step == 0) == (((F.bx >> 3) & 1) != 0)) { REFRESH(); PJ0_UNIT(0); }
            REFRESH();
        }
    }
    GRID_BAR();
    for (int rep_ = 0; rep_ < (PH(4) ? REPS(4) : 0); ++rep_) { REFRESH();
        constexpr int EB = F8_GU ? 1 : 2;
        SchedGrid S; S.o.init(M / 256, 2 * DFF / 256, F.G, F.bx); S.A = F8_GU ? (const char*)W_XQ1 : (const char*)W_XS0; S.B = (const char*)W_Wgu_t; S.at = (size_t)256 * DM * EB; S.bt = (size_t)256 * DM * EB;
        if (RS_TABLE) build_rstd_table(F.lds, S, W_sspB, F.tid);
        EpiSwiglu<false, F8_DN> E{W_Hh, DFF, W_sspB, nullptr, nullptr, (const LAS float*)(F.lds + RS_TBL_OFF)};
        pg8::gemm_phase<EpiSwiglu<false, F8_DN>, SchedGrid, true, F8_GU>(F.lds, DM * EB / 2, DM * EB / 2, DM * EB / 2, S, E);
    }
    GRID_BAR();
    for (int rep_ = 0; rep_ < (PH(5) ? REPS(5) : 0); ++rep_) { REFRESH();
        SchedGrid S; S.o.init(M / 256, DM / 256, F.G, F.bx); constexpr int EB = F8_DN ? 1 : 2; S.A = (const char*)W_Hh; S.B = (const char*)W_Wd_t; S.at = (size_t)256 * DFF * EB; S.bt = (size_t)256 * DFF * EB;
        EpiResid<0, false> E{nullptr, W_XS0, W_XS0, W_sspA, nullptr, nullptr, nullptr, nullptr, nullptr};
        for (int step = 0; step < 3; ++step) {
            if (step == 1) pg8::gemm_phase<EpiResid<0, false>, SchedGrid, true, F8_DN>(F.lds, DFF * EB / 2, DFF * EB / 2, DFF * EB / 2, S, E);
            else if ((step == 0) == (((F.bx >> 3) & 1) != 0)) { REFRESH(); PJ0_UNIT(1); }
            REFRESH();
        }
    }
    GRID_BAR();
    for (int rep_ = 0; rep_ < (PH(6) ? REPS(6) : 0); ++rep_) { REFRESH();
        SchedGrid S; S.o.init(M / 256, DM / 256, F.G, F.bx); S.A = (const char*)W_XB; S.B = (const char*)W_Wpg_t; S.at = TB2048; S.bt = TB2048;
        if (RS_TABLE) build_rstd_table(F.lds, S, W_sspA, F.tid);
        EpiResid<2, false> E{nullptr, W_XS0, W_XS1, W_sspB, nullptr, W_sspA, W_PJ0, nullptr, (const LAS float*)(F.lds + RS_TBL_OFF)};
        pg8::gemm_phase<EpiResid<2, false>, SchedGrid, true>(F.lds, DM, DM, DM, S, E);
    }
    GRID_BAR();
    for (int rep_ = 0; rep_ < (PH(7) ? REPS(7) : 0); ++rep_) { REFRESH();
        LAS float* rt = (LAS float*)F.lds;
        for (int seg = F.bx; seg < M / 64; seg += F.G) {
            const int R0 = seg * 64, t0 = R0 % SEQ;
            { float v[10];
#pragma unroll
              for (int q = 0; q < 10; ++q) { const int row = R0 - 16 + F.wave + NWAVES * q; v[q] = (row >= 0 && F.lane < 32) ? W_sspB[(size_t)(row >= 0 ? row : 0) * 32 + (F.lane & 31)] : 0.f; }
#pragma unroll
              for (int q = 0; q < 10; ++q) { const float s = wave_sum(v[q]); if (F.lane == 0) rt[F.wave + NWAVES * q] = 1.0f / sqrtf(s * (1.0f / DM) + EPS); } }
            LDS_BAR();
            { const int tg = F.tid >> 8, tl = F.tid & 255, gi = tl >> 6, roff = 32 * tg;
              const bf16* xc = W_XS1 + (size_t)(R0 + roff) * DM + 8 * tl; bf16* dc = W_D1 + (size_t)(R0 + roff) * DM + 8 * tl;
              const bool ss = (t0 + roff) == 0;
              if (gi == 0) pool_rows<2>(xc, dc, rt, roff, ss); else if (gi == 1) pool_rows<4>(xc, dc, rt, roff, ss); else if (gi == 2) pool_rows<8>(xc, dc, rt, roff, ss); else pool_rows<16>(xc, dc, rt, roff, ss); }
            LDS_BAR();
        }
    }
    GRID_BAR();
    for (int rep_ = 0; rep_ < (PH(8) ? REPS(8) : 0); ++rep_) { REFRESH();
        SchedPool S; S.o.init(M / 256, DM / 256, F.G, F.bx); S.A = (const char*)W_D1; S.B = (const char*)W_Wpool_t; S.at = TB2048; S.bt = (size_t)256 * 512 * 2;
        EpiResid<1, false, F8_MOE> E{nullptr, W_XS1, W_XS1, W_sspA, I_pool_scale, nullptr, nullptr, W_XQ, nullptr};
        pg8::gemm_phase<EpiResid<1, false, F8_MOE>, SchedPool, true>(F.lds, 512, DM, 512, S, E);
    }
    GRID_BAR();
    for (int rep_ = 0; rep_ < (PH(9) ? REPS(9) : 0); ++rep_) { REFRESH();
        LAS unsigned char* L9 = F.lds;
        LAS float* plog = (LAS float*)(F.lds + 65536);
        LAS float* pss = (LAS float*)(F.lds + 65536 + 4096);
        for (int idx = F.tid; idx < 64 * 64; idx += 512) { const int i = idx >> 6, ln = idx & 63, n = ln & 15, kq = ln >> 4, e = n & 7; unsigned hw[8];
#pragma unroll
            for (int j = 0; j < 8; ++j) { const int k = 32 * i + 8 * kq + j; const float w = I_w_router[(size_t)k * NE + e] * I_ffn_norm_odd[k]; const unsigned hi = f2bf(w), lo = f2bf(w - __builtin_bit_cast(float, hi << 16)); hw[j] = (n < 8) ? hi : lo; }
            v4u pk; pk.x = hw[0] | (hw[1] << 16); pk.y = hw[2] | (hw[3] << 16); pk.z = hw[4] | (hw[5] << 16); pk.w = hw[6] | (hw[7] << 16);
            *(LAS v4u*)(L9 + (size_t)idx * 16) = pk; }
        LDS_BAR();
        for (int seg = F.bx; seg < M / 64; seg += F.G) {
            { const int rb = F.wave & 3, kh = F.wave >> 2, m = F.lane & 15, kq = F.lane >> 4;
              const bf16* xrow = W_XS1 + (size_t)(seg * 64 + rb * 16 + m) * DM + kh * 1024 + 8 * kq;
              f32x4 acc = (f32x4){0.f, 0.f, 0.f, 0.f}; float ss = 0.f;
#pragma unroll
              for (int bq = 0; bq < 2; ++bq) { v4u xa[16];
#pragma unroll
                  for (int i = 0; i < 16; ++i) xa[i] = *(const v4u*)(xrow + (bq * 16 + i) * 32);
#pragma unroll
                  for (int i = 0; i < 16; ++i) { const int ks = kh * 32 + bq * 16 + i; const v4u bw = *(const LAS v4u*)(L9 + (size_t)(ks * 64 + F.lane) * 16);
                      acc = __builtin_amdgcn_mfma_f32_16x16x32_bf16(__builtin_bit_cast(bf16x8, xa[i]), __builtin_bit_cast(bf16x8, bw), acc, 0, 0, 0);
                      f32x4 xa0, xa1; unpack8(xa[i], xa0, xa1);
                      ss += ((xa0[0] * xa0[0] + xa0[1] * xa0[1]) + (xa0[2] * xa0[2] + xa0[3] * xa0[3])) + ((xa1[0] * xa1[0] + xa1[1] * xa1[1]) + (xa1[2] * xa1[2] + xa1[3] * xa1[3])); } }
#pragma unroll
              for (int r = 0; r < 4; ++r) { const float v = acc[r] + __shfl(acc[r], F.lane + 8); if (m < 8) plog[(kh * 64 + rb * 16 + 4 * kq + r) * 8 + m] = v; }
              ss += __shfl_xor(ss, 16); ss += __shfl_xor(ss, 32);
              if (F.lane < 16) pss[kh * 64 + rb * 16 + m] = ss; }
            LDS_BAR();
            if (F.wave == 0) {
                float lg[8];
                { const f32x4 p0 = *(const LAS f32x4*)(plog + F.lane * 8), p1 = *(const LAS f32x4*)(plog + F.lane * 8 + 4), q0 = *(const LAS f32x4*)(plog + (64 + F.lane) * 8), q1 = *(const LAS f32x4*)(plog + (64 + F.lane) * 8 + 4);
#pragma unroll
                  for (int e = 0; e < 4; ++e) { lg[e] = p0[e] + q0[e]; lg[4 + e] = p1[e] + q1[e]; } }
                const float rsv = 1.0f / sqrtf((pss[F.lane] + pss[64 + F.lane]) * (1.0f / DM) + EPS);
                int i1 = 0; float l1 = lg[0];
#pragma unroll
                for (int e = 1; e < 8; ++e) if (lg[e] > l1) { l1 = lg[e]; i1 = e; }
                int i2 = -1; float l2 = -3.0e38f;
#pragma unroll
                for (int e = 0; e < 8; ++e) if (e != i1 && lg[e] > l2) { l2 = lg[e]; i2 = e; }
                const float wt1 = 1.0f / (1.0f + __expf((l2 - l1) * rsv)), wt2 = 1.0f - wt1;
                const int row = seg * 64 + F.lane; const int e1 = i1, e2 = i2;
                unsigned long long mk[16]; int mycnt = 0;
#pragma unroll
                for (int g = 0; g < 16; ++g) { const bool pr = (g < 8) ? (e1 == g) : (e2 == g - 8); mk[g] = __ballot(pr); if (F.lane == g) mycnt = __popcll(mk[g]); }
                int base = 0;
                if (F.lane < 16) base = (int)__hip_atomic_fetch_add((unsigned*)(F.ctl + CW_MOE) + F.lane, (unsigned)mycnt, RLX_AGENT);
                const unsigned long long lt = (1ull << F.lane) - 1ull;
#pragma unroll
                for (int g = 0; g < 16; ++g) { const int bg = __shfl(base, g); const bool pr = (g < 8) ? (e1 == g) : (e2 == g - 8);
                    if (pr) { const int slot = bg + __popcll(mk[g] & lt); W_list[(size_t)g * M + slot] = row; W_gwl[(size_t)g * M + slot] = (g < 8) ? wt1 : wt2; W_rsl[(size_t)g * M + slot] = rsv; } }
            }
            LDS_BAR();
        }
    }
    GRID_BAR();
    LAS int* tile_e = (LAS int*)(F.lds + LDSCTL_OFF + 1024);
    LAS int* tile_g = (LAS int*)(F.lds + LDSCTL_OFF + 1024 + 640);
    LAS int* tile_s0 = (LAS int*)(F.lds + LDSCTL_OFF + 1024 + 1280);
    LAS int* gtab = (LAS int*)(F.lds + LDSCTL_OFF + 1024 + 1920);
    for (int rep_ = 0; rep_ < (PH(11) ? REPS(11) : 0); ++rep_) { REFRESH();
        if (F.tid < 16) gtab[F.tid] = (int)__hip_atomic_load((unsigned*)(F.ctl + CW_MOE) + F.tid, RLX_AGENT);
        LDS_BAR();
        if (F.tid == 0) { int ti = 0;
            for (int g = 0; g < 16; ++g) { const int c = gtab[g]; const int nt = (c + 255) >> 8;
                for (int t = 0; t < nt; ++t) { tile_e[ti] = g & 7; tile_g[ti] = g; tile_s0[ti] = t * 256; ++ti; } if (g == 7) gtab[17] = ti; }
            gtab[16] = ti; }
        LDS_BAR();
        constexpr int EB = F8_MOE ? 1 : 2;
        SchedMoe S{tile_e, tile_g, tile_s0, gtab, 0, gtab[16], F.G, F.bx, F8_MOE ? (const char*)W_XQ : (const char*)W_XS1, (const char*)W_Wmgu_t, 0, (size_t)256 * DM * EB, (size_t)2048 * DM * EB, W_list, true};
        if (RS_TABLE) build_moe_tables(F.lds, S, W_list, W_rsl, false, F.tid);
        EpiSwiglu<true, F8_MOE> E{W_HE, DFE, nullptr, W_rsl, W_list, (const LAS float*)(F.lds + RS_TBL_OFF)};
        pg8::gemm_phase<EpiSwiglu<true, F8_MOE>, SchedMoe, true, F8_MOE, true>(F.lds, DM * EB / 2, DM * EB / 2, DM * EB / 2, S, E);
    }
    GRID_BAR();
    for (int rep_ = 0; rep_ < (PH(12) ? REPS(12) : 0); ++rep_) { REFRESH();
        constexpr int EB = F8_MOE ? 1 : 2;
        SchedMoe S{tile_e, tile_g, tile_s0, gtab, 0, gtab[17], F.G, F.bx, (const char*)W_HE, (const char*)W_Wmd_t, (size_t)256 * DFE * EB, (size_t)256 * DFE * EB, (size_t)DM * DFE * EB, W_list, false};
        if (RS_TABLE) build_moe_tables(F.lds, S, W_list, W_gwl, true, F.tid);
        EpiMoeDown<false> E{W_XS1, W_sspB, W_list, W_gwl, nullptr, (const LAS float*)(F.lds + RS_TBL_OFF), (const LAS int*)(F.lds + RS_TBL_OFF + 6144)};
        pg8::gemm_phase<EpiMoeDown<false>, SchedMoe, true, F8_MOE>(F.lds, DFE * EB / 2, DFE * EB / 2, DFE * EB / 2, S, E);
        REFRESH();
        { const int rem = (gtab[17] * 8) % F.G; SchedFill S2{0, 256, DM / 256, F.bx >= rem ? F.bx - rem : -1, F.G - rem, (const char*)(W_PB + (size_t)M * DPLE), (const char*)(W_Wpp_t + (size_t)DM * DPLE), (size_t)256 * DPLE * 2, (size_t)256 * DPLE * 2};
          EpiBf16Plain E2{W_PJ, DM};
          pg8::gemm_phase<EpiBf16Plain, SchedFill, true>(F.lds, DPLE, DPLE, DPLE, S2, E2); }
    }
    GRID_BAR();
    for (int rep_ = 0; rep_ < (PH(13) ? REPS(13) : 0); ++rep_) { REFRESH();
        constexpr int EB = F8_MOE ? 1 : 2;
        SchedMoe S{tile_e, tile_g, tile_s0, gtab, gtab[17], gtab[16], F.G, F.bx, (const char*)W_HE, (const char*)W_Wmd_t, (size_t)256 * DFE * EB, (size_t)256 * DFE * EB, (size_t)DM * DFE * EB, W_list, false};
        if (RS_TABLE) build_moe_tables(F.lds, S, W_list, W_gwl, true, F.tid);
        EpiMoeDown<true, F8_PLE1> E{W_XS1, W_sspB, W_list, W_gwl, W_XQ, (const LAS float*)(F.lds + RS_TBL_OFF), (const LAS int*)(F.lds + RS_TBL_OFF + 6144)};
        pg8::gemm_phase<EpiMoeDown<true, F8_PLE1>, SchedMoe, true, F8_MOE>(F.lds, DFE * EB / 2, DFE * EB / 2, DFE * EB / 2, S, E);
        REFRESH();
        { const int rem = ((gtab[16] - gtab[17]) * 8) % F.G; SchedFill S2{256, 512, DM / 256, F.bx >= rem ? F.bx - rem : -1, F.G - rem, (const char*)(W_PB + (size_t)M * DPLE), (const char*)(W_Wpp_t + (size_t)DM * DPLE), (size_t)256 * DPLE * 2, (size_t)256 * DPLE * 2};
          EpiBf16Plain E2{W_PJ, DM};
          pg8::gemm_phase<EpiBf16Plain, SchedFill, true>(F.lds, DPLE, DPLE, DPLE, S2, E2); }
    }
    GRID_BAR();
    for (int rep_ = 0; rep_ < (PH(14) ? REPS(14) : 0); ++rep_) { REFRESH();
        SchedGrid S; S.o.init(M / 256, DM / 256, F.G, F.bx); constexpr int EB = F8_PLE1 ? 1 : 2; S.A = F8_PLE1 ? (const char*)W_XQ : (const char*)W_XS1; S.B = (const char*)(W_Wpg_t + (size_t)DM * DM); S.at = (size_t)256 * DM * EB; S.bt = (size_t)256 * DM * EB;
        if (RS_TABLE) build_rstd_table(F.lds, S, W_sspB, F.tid);
        EpiResid<2, false> E{nullptr, W_XS1, W_XS0, W_sspA, nullptr, W_sspB, W_PJ, nullptr, (const LAS float*)(F.lds + RS_TBL_OFF)};
        pg8::gemm_phase<EpiResid<2, false>, SchedGrid, true, F8_PLE1>(F.lds, DM * EB / 2, DM * EB / 2, DM * EB / 2, S, E);
    }
    GRID_BAR();
    REFRESH();
    if (PH(15)) for (int m0 = gw; m0 < M; m0 += 4 * NGW) {
        v4u xv[4][4]; float sv[4];
#pragma unroll
        for (int q = 0; q < 4; ++q) { const int m = m0 + q * NGW; if (m < M) { const GAS v4u* xs = (const GAS v4u*)(W_XS0 + (size_t)m * DM) + F.lane;
#pragma unroll
                for (int j = 0; j < 4; ++j) xv[q][j] = xs[64 * j];
                sv[q] = (F.lane < 32) ? W_sspA[(size_t)m * 32 + F.lane] : 0.f; } }
#pragma unroll
        for (int q = 0; q < 4; ++q) { const int m = m0 + q * NGW; if (m < M) {
                const float rstd = 1.0f / sqrtf(wave_sum(sv[q]) * (1.0f / DM) + EPS);
                GAS f32x4* xo = (GAS f32x4*)(W_X + (size_t)m * DM) + 2 * F.lane; const f32x4* gp = (const f32x4*)I_final_gain + 2 * F.lane;
#pragma unroll
                for (int j = 0; j < 4; ++j) { f32x4 a, b; unpack8(xv[q][j], a, b); xo[128 * j] = a * rstd * gp[128 * j]; xo[128 * j + 1] = b * rstd * gp[128 * j + 1]; } } }
    }
}

extern "C" void kernel_launch(void* const* d_in, const int* in_sizes, int n_in, void* d_out, int out_size, void* d_ws, size_t ws_size, hipStream_t stream) {
    (void)in_sizes; (void)out_size;
    static int grid = 0;
    if (grid == 0) {
        if (n_in != 24 || ws_size < WS_END) { fprintf(stderr, "kernel_launch: bad arguments (n_in %d, ws %zu)\n", n_in, ws_size); grid = -1; return; }
        int dev = 0, cus = 0, per_cu = 0;
        if (hipGetDevice(&dev) != hipSuccess || hipDeviceGetAttribute(&cus, hipDeviceAttributeMultiprocessorCount, dev) != hipSuccess) { grid = -1; return; }
        if (hipFuncSetAttribute((const void*)fwd_kernel, hipFuncAttributeMaxDynamicSharedMemorySize, LDS_BYTES) != hipSuccess) { grid = -1; return; }
        if (hipOccupancyMaxActiveBlocksPerMultiprocessor(&per_cu, (const void*)fwd_kernel, NWAVES * 64, LDS_BYTES) != hipSuccess || per_cu < 1) { fprintf(stderr, "kernel_launch: occupancy query says %d\n", per_cu); }
        (void)hipGetLastError();
        grid = cus;
    }
    if (grid < 0) return;
    if (hipMemsetAsync((char*)d_ws + WS_CTL, 0, CTL_ZERO_BYTES, stream) != hipSuccess) return;
    Args a{};
    for (int i = 0; i < 24; ++i) a.in[i] = (const float*)d_in[i];
    a.out = (float*)d_out; a.ws = (unsigned char*)d_ws;
    hipLaunchKernelGGL(fwd_kernel, dim3(grid), dim3(NWAVES * 64), LDS_BYTES, stream, a);
}
```
